# Optimizing an MI355X kernel written in HIP

```python
import jax
import jax.numpy as jnp
from jax import lax
import numpy as np

D_MODEL = 1024
BATCH = 16
SEQ = 2048
DEPTH = 4

N_META = 16
POOL_WIDTH = D_MODEL // 2
POOL_WINDOWS = (2, 4, 8, 16)
N_POOL_GROUPS = len(POOL_WINDOWS)
POOL_GROUP = POOL_WIDTH // N_POOL_GROUPS
RWKV_WIDTH = D_MODEL - POOL_WIDTH
HEAD_SIZE = 64
N_RWKV_HEADS = RWKV_WIDTH // HEAD_SIZE
DECAY_LORA = 64
AAA_LORA = 64
MV_LORA = 32
GATE_LORA = 160
D_FF = -(-8 * D_MODEL // (3 * 256)) * 256
RMS_EPS = 1e-6
GN_EPS = 64e-5
L2_EPS = 1e-12

SHIFT_WIDTHS = (RWKV_WIDTH, RWKV_WIDTH, RWKV_WIDTH, DECAY_LORA, AAA_LORA, GATE_LORA)
N_SHIFT = sum(SHIFT_WIDTHS)
N_IN = POOL_WIDTH + N_SHIFT

kernel_name = "hymba_pool_rwkv7_hybrid"


def rms_norm(x, g):
    xf = x.astype(jnp.float32)
    y = xf * lax.rsqrt(jnp.mean(xf * xf, axis=-1, keepdims=True) + RMS_EPS)
    return (y * g.astype(jnp.float32)).astype(x.dtype)


def split_cols(p, widths):
    idx = np.cumsum(widths)[:-1].tolist()
    return jnp.split(p, idx, axis=-1)


def token_shift(p, mu):
    prev = jnp.pad(p, ((0, 0), (1, 0), (0, 0)))[:, :-1]
    return p + (prev - p) * mu


def to_heads(z):
    return z.reshape(z.shape[:-1] + (N_RWKV_HEADS, HEAD_SIZE))


def multiscale_pool(u, w_grp, scale):
    T = u.shape[1]
    uf = u.astype(jnp.float32)
    cs = jnp.pad(jnp.cumsum(uf, axis=1), ((0, 0), (1, 0), (0, 0)))
    pos = jnp.arange(T)
    outs = []
    for g, win in enumerate(POOL_WINDOWS):
        c = cs[..., g * POOL_GROUP:(g + 1) * POOL_GROUP]
        upper = c[:, 1:]
        lower = jnp.pad(c[:, :T + 1 - win], ((0, 0), (win - 1, 0), (0, 0)))
        count = jnp.minimum(pos + 1, win).astype(jnp.float32)[None, :, None]
        outs.append((upper - lower) / count)
    pooled = jnp.stack(outs, axis=2)
    diff = pooled - uf.reshape(pooled.shape)
    y = jnp.einsum('btgc,gcd->btgd', diff, w_grp.astype(jnp.float32))
    return (y.reshape(u.shape) * scale.astype(jnp.float32)).astype(u.dtype)


def rwkv7_scan(r, w, k, v, a, b):
    bsz = r.shape[0]

    def step(S, inp):
        r_t, w_t, k_t, v_t, a_t, b_t = inp
        sa = jnp.einsum('bhvk,bhk->bhv', S, a_t)
        S = (S * w_t[:, :, None, :] + sa[..., None] * b_t[:, :, None, :]
             + v_t[..., None] * k_t[:, :, None, :])
        y = jnp.einsum('bhvk,bhk->bhv', S, r_t)
        return S, y

    xs = tuple(jnp.moveaxis(z, 1, 0) for z in (r, w, k, v, a, b))
    S0 = jnp.zeros((bsz, N_RWKV_HEADS, HEAD_SIZE, HEAD_SIZE), jnp.float32)
    _, ys = lax.scan(step, S0, xs)
    return jnp.moveaxis(ys, 0, 1)


def setup_inputs(seed: int = 0) -> dict:
    key = jax.random.key(seed)
    ks = iter(jax.random.split(key, 32))

    def nrm(shape, scale):
        return jax.random.normal(next(ks), shape, jnp.float32) * scale

    def unif(shape, lo, hi):
        return jax.random.uniform(next(ks), shape, jnp.float32, lo, hi)

    L, Lv = DEPTH, DEPTH - 1
    return {
        "x": nrm((BATCH, SEQ, D_MODEL), 1.0),
        "meta_tokens": nrm((N_META, D_MODEL), 1.0),
        "ln1_g": 1.0 + nrm((L, D_MODEL), 0.05),
        "w_in": nrm((L, D_MODEL, N_IN), D_MODEL ** -0.5),
        "mu_shift": unif((L, N_SHIFT), 0.0, 1.0),
        "pool_w": nrm((L, N_POOL_GROUPS, POOL_GROUP, POOL_GROUP), POOL_GROUP ** -0.5),
        "pool_scale": 1.0 + nrm((L, POOL_WIDTH), 0.1),
        "w0": unif((L, RWKV_WIDTH), -6.0, -1.0),
        "w_lora_up": nrm((L, DECAY_LORA, RWKV_WIDTH), 0.5 * DECAY_LORA ** -0.5),
        "a0": nrm((L, RWKV_WIDTH), 0.1),
        "a_lora_up": nrm((L, AAA_LORA, RWKV_WIDTH), AAA_LORA ** -0.5),
        "g_lora_up": nrm((L, GATE_LORA, RWKV_WIDTH), GATE_LORA ** -0.5),
        "k_k": 0.85 + nrm((L, RWKV_WIDTH), 0.05),
        "k_a": 1.0 + nrm((L, RWKV_WIDTH), 0.05),
        "r_k": nrm((L, RWKV_WIDTH), 0.1),
        "gn_w": 1.0 + nrm((L, RWKV_WIDTH), 0.05),
        "gn_b": nrm((L, RWKV_WIDTH), 0.01),
        "w_in_vres": nrm((Lv, D_MODEL, MV_LORA), D_MODEL ** -0.5),
        "mu_vres": unif((Lv, MV_LORA), 0.0, 1.0),
        "v0": nrm((Lv, RWKV_WIDTH), 0.1),
        "v_lora_up": nrm((Lv, MV_LORA, RWKV_WIDTH), MV_LORA ** -0.5),
        "w_out": nrm((L, D_MODEL, D_MODEL), D_MODEL ** -0.5),
        "ln2_g": 1.0 + nrm((L, D_MODEL), 0.05),
        "w_gate_up": nrm((L, D_MODEL, 2 * D_FF), D_MODEL ** -0.5),
        "w_down": nrm((L, D_FF, D_MODEL), D_FF ** -0.5),
        "final_g": 1.0 + nrm((D_MODEL,), 0.05),
    }


def reference(x, meta_tokens, ln1_g, w_in, mu_shift, pool_w, pool_scale, w0, w_lora_up,
              a0, a_lora_up, g_lora_up, k_k, k_a, r_k, gn_w, gn_b, w_in_vres, mu_vres,
              v0, v_lora_up, w_out, ln2_g, w_gate_up, w_down, final_g):
    f32 = jnp.float32
    bsz = x.shape[0]
    dt = x.dtype
    meta = jnp.broadcast_to(meta_tokens.astype(dt)[None], (bsz, N_META, D_MODEL))
    h = jnp.concatenate([meta, x], axis=1)
    T = h.shape[1]
    v_first = None
    for l in range(DEPTH):
        hn = rms_norm(h, ln1_g[l])
        if l == 0:
            w_comb, mu = w_in[0], mu_shift[0]
            widths = SHIFT_WIDTHS
        else:
            w_comb = jnp.concatenate([w_in[l], w_in_vres[l - 1]], axis=1)
            mu = jnp.concatenate([mu_shift[l], mu_vres[l - 1]])
            widths = SHIFT_WIDTHS + (MV_LORA,)
        proj = hn @ w_comb

        pool_out = multiscale_pool(proj[..., :POOL_WIDTH], pool_w[l], pool_scale[l])

        s = token_shift(proj[..., POOL_WIDTH:].astype(f32), mu.astype(f32))
        parts = split_cols(s, widths)
        r, k, v, w_lo, a_lo, g_lo = parts[:6]
        w_log = -jax.nn.softplus(-(w0[l].astype(f32) + jnp.tanh(w_lo) @ w_lora_up[l].astype(f32))) - 0.5
        decay = jnp.exp(-jnp.exp(w_log))
        a = jax.nn.sigmoid(a0[l].astype(f32) + a_lo @ a_lora_up[l].astype(f32))
        g = jax.nn.sigmoid(g_lo) @ g_lora_up[l].astype(f32)
        if l == 0:
            v_first = v
        else:
            v_mix = jax.nn.sigmoid(v0[l - 1].astype(f32) + parts[6] @ v_lora_up[l - 1].astype(f32))
            v = v + (v_first - v) * v_mix
        kk = to_heads(k * k_k[l].astype(f32))
        kk = kk / jnp.maximum(jnp.linalg.norm(kk, axis=-1, keepdims=True), L2_EPS)
        k = k * (1.0 + (a - 1.0) * k_a[l].astype(f32))
        rh, kh, vh, ah = to_heads(r), to_heads(k), to_heads(v), to_heads(a)
        y = rwkv7_scan(rh, to_heads(decay), kh, vh, -kk, kk * ah)
        mean = jnp.mean(y, axis=-1, keepdims=True)
        var = jnp.mean(jnp.square(y - mean), axis=-1, keepdims=True)
        y = ((y - mean) * lax.rsqrt(var + GN_EPS)).reshape(bsz, T, RWKV_WIDTH)
        y = y * gn_w[l].astype(f32) + gn_b[l].astype(f32)
        bonus = jnp.sum(rh * kh * to_heads(r_k[l].astype(f32)), axis=-1, keepdims=True) * vh
        rwkv_out = ((y + bonus.reshape(bsz, T, RWKV_WIDTH)) * g).astype(dt)

        mixed = jnp.concatenate([pool_out, rwkv_out], axis=-1) @ w_out[l]
        h = h + mixed.astype(dt)

        hn2 = rms_norm(h, ln2_g[l])
        gate, up = jnp.split(hn2 @ w_gate_up[l], 2, axis=-1)
        h = h + ((jax.nn.silu(gate) * up) @ w_down[l]).astype(dt)

    out = rms_norm(h, final_g)
    return out[:, N_META:]
```

```cpp
#include <hip/hip_runtime.h>
#include <hip/hip_cooperative_groups.h>
#include <cstdio>
#include <cstdint>
namespace cg = cooperative_groups;

#ifndef MK_MULTI
#define MK_MULTI 0
#endif

#define LAS __attribute__((address_space(3)))
typedef unsigned short bf16_t;
typedef short bf16x8 __attribute__((ext_vector_type(8)));
typedef float f32x4 __attribute__((ext_vector_type(4)));
typedef float f32x2 __attribute__((ext_vector_type(2)));
typedef unsigned u32x4 __attribute__((ext_vector_type(4)));
typedef unsigned u32x2 __attribute__((ext_vector_type(2)));

constexpr int DM = 1024, BATCH = 16, SEQ = 2048, DEPTH = 4, NMETA = 16, TT = SEQ + NMETA  , MR = BATCH * TT  ;
constexpr int NIN = 2336, NSHIFT = 1824, DFF = 2816, NPROJ = 2560  , KL = 384  , NL = 2048;
constexpr float RMS_EPS = 1e-6f, GN_EPS = 64e-5f;
constexpr int LDS_BYTES = 131072;
constexpr int NPH = DEPTH * 9 + 1;

constexpr size_t WS_WC = 4096;
constexpr size_t WS_WOUT = WS_WC + (size_t)NPROJ * DM * 2;
constexpr size_t WS_WGU = WS_WOUT + (size_t)DM * DM * 2;
constexpr size_t WS_WDN = WS_WGU + (size_t)2 * DFF * DM * 2;
constexpr size_t WS_WL = WS_WDN + (size_t)DM * DFF * 2;
constexpr size_t WS_LBIAS = WS_WL + (size_t)NL * KL * 2;
constexpr size_t WS_H = WS_LBIAS + 8192;
constexpr size_t WS_R1 = WS_H + (size_t)MR * DM * 4;
constexpr size_t WS_LO = WS_R1 + (size_t)MR * DFF * 2;
constexpr size_t WS_END = WS_LO + (size_t)MR * NL * 2;
constexpr size_t DO_MIX = 0;
constexpr size_t DO_VF = DO_MIX + (size_t)MR * DM * 2;
constexpr size_t DO_LIN = DO_VF + (size_t)MR * 512 * 2;
static_assert(DO_LIN + (size_t)MR * KL * 2 <= (size_t)BATCH * SEQ * DM * 4, "d_out scratch");

struct Args { const float* in[26]; float* out; unsigned char* ws; int ph_lo, ph_hi; };
typedef const __attribute__((address_space(4))) Args* CArgs;

__device__ __forceinline__ float bf2f(unsigned b) { return __uint_as_float(b << 16); }
__device__ __forceinline__ unsigned f2bf(float f) { unsigned u = __float_as_uint(f); return (u + 0x7fffu + ((u >> 16) & 1u)) >> 16; }
__device__ __forceinline__ unsigned pk2(float lo, float hi) { unsigned r; asm volatile("v_cvt_pk_bf16_f32 %0, %1, %2" : "=v"(r) : "v"(lo), "v"(hi)); return r; }
__device__ __forceinline__ float sigmoidf_(float x) { return 1.0f / (1.0f + __expf(-x)); }
template <int CTRL> __device__ __forceinline__ float dppf(float x) { return __int_as_float(__builtin_amdgcn_update_dpp(0, __float_as_int(x), CTRL, 0xF, 0xF, true)); }
__device__ __forceinline__ float allred8(float x) { x += dppf<0xB1>(x); x += dppf<0x4E>(x); x += dppf<0x141>(x); return x; }
__device__ __forceinline__ float wave_sum(float x) {
    x += dppf<0xB1>(x); x += dppf<0x4E>(x); x += dppf<0x141>(x); x += dppf<0x140>(x);
    const int xi = __float_as_int(x);
    return (__int_as_float(__builtin_amdgcn_readlane(xi, 0)) + __int_as_float(__builtin_amdgcn_readlane(xi, 16))) + (__int_as_float(__builtin_amdgcn_readlane(xi, 32)) + __int_as_float(__builtin_amdgcn_readlane(xi, 48)));
}
__device__ __forceinline__ int tid_opaque() { int t = threadIdx.x; asm volatile("" : "+v"(t)); return t; }

namespace pg8 {
constexpr int BM = 256, BK = 64, HALF = 128, HTB = HALF * BK * 2, STAGE_BYTES = 8 * HTB, NXCD = 8, WGM = 8;
__host__ __device__ __forceinline__ int lds_byte(int r, int c) { const int st = (r >> 4) * 2 + (c >> 5), rr = r & 15, cc = c & 31, ob = rr * 64 + cc * 2; return st * 1024 + (ob ^ (((ob >> 9) & 1) << 5)); }
__host__ __device__ __forceinline__ void stage_rc(int b, int& R, int& C) { const int st = b / 1024, sb = b % 1024, swz = sb ^ (((sb >> 9) & 1) << 5); R = (st >> 1) * 16 + swz / 64; C = (st & 1) * 32 + (swz % 64) / 2; }
__host__ __device__ __forceinline__ int perm32(int rho) { const int n = rho >> 4, i = rho & 15; return 8 * (i >> 2) + 4 * n + (i & 3); }
struct Unit { int pm, pn; };
struct Gemm { const bf16_t* A; const bf16_t* Bt; int M, N, K; };
struct StaticOrder {
    int nM, nN, nwg, G, c;
    __device__ void init(int M, int N, int G_, int c_) { nM = M / BM; nN = N / BM; nwg = nM * nN; G = G_; c = c_; }
    __device__ bool next(int i, Unit& u) const {
        const long L = (long)i * G + c; if (L >= nwg) return false;
        int wgid = (int)L; { const int q = nwg / NXCD, r = nwg % NXCD, xcd = wgid % NXCD, off = wgid / NXCD; wgid = (xcd < r ? xcd * (q + 1) : r * (q + 1) + (xcd - r) * q) + off; }
        const int nig = WGM * nN, gid = wgid / nig, fm = gid * WGM, gsz = (nM - fm) < WGM ? (nM - fm) : WGM;
        u.pm = fm + ((wgid % nig) % gsz); u.pn = (wgid % nig) / gsz; return true;
    }
};
template <class Epi>
__device__ __forceinline__ void gemm_phase(LAS unsigned char* lds, const Gemm g, const StaticOrder& S, const Epi& E) {
    int tid_ = threadIdx.x; asm volatile("" : "+v"(tid_));
    const int tid = tid_, wid = __builtin_amdgcn_readfirstlane(tid >> 6), lane = tid & 63, wr = wid >> 2, wc = wid & 3, fr = lane & 15, fq = lane >> 4;
    const int K = g.K, nt = K / BK;
    unsigned voffA[2], voffB[2];
#pragma unroll
    for (int i = 0; i < 2; ++i) { int R, C; stage_rc(tid * 16 + i * 8192, R, C); const int Rb = Epi::PERM ? ((R & ~31) + perm32(R & 31)) : R;
        voffA[i] = (unsigned)(R * K + C) * 2u; voffB[i] = (unsigned)(Rb * K + C) * 2u; }
    const size_t kstep = (size_t)(BK * 2);
    const size_t hstep = (size_t)HALF * K * 2;
    const size_t tstep = 2 * hstep;
    const unsigned ldsw = (unsigned)wid * 1024u;
    const int aoff = lds_byte(wr * 64 + fr, fq * 8), boff = lds_byte(wc * 32 + fr, fq * 8);
#define PG8_SA(b, h) (((b) * 2 + (h)) * HTB)
#define PG8_SB(b, h) ((4 + (b) * 2 + (h)) * HTB)
#define PG8_STAGE(bufoff, gbase, voff) do { _Pragma("unroll") for (int _i = 0; _i < 2; ++_i) \
        __builtin_amdgcn_global_load_lds((const unsigned*)((const char*)(gbase) + (voff)[_i]), (LAS unsigned*)(lds + (bufoff) + ldsw + _i * 8192), 16, 0, 0); } while (0)
#define PG8_LDA(dst, b, h) do { _Pragma("unroll") for (int m = 0; m < 4; ++m) _Pragma("unroll") for (int k = 0; k < 2; ++k) dst[m][k] = *(const LAS bf16x8*)(lds + PG8_SA(b, h) + aoff + m * 2048 + k * 1024); } while (0)
#define PG8_LDB(dst, b, h) do { _Pragma("unroll") for (int n = 0; n < 2; ++n) _Pragma("unroll") for (int k = 0; k < 2; ++k) dst[n][k] = *(const LAS bf16x8*)(lds + PG8_SB(b, h) + boff + n * 2048 + k * 1024); } while (0)
#define PG8_MMA(ai, bj, At, Bt) do { __builtin_amdgcn_s_setprio(1); _Pragma("unroll") for (int m = 0; m < 4; ++m) _Pragma("unroll") for (int n = 0; n < 2; ++n) _Pragma("unroll") for (int k = 0; k < 2; ++k) \
        acc[ai][bj][m][n] = __builtin_amdgcn_mfma_f32_16x16x32_bf16(Bt[n][k], At[m][k], acc[ai][bj][m][n], 0, 0, 0); __builtin_amdgcn_s_setprio(0); } while (0)
#define PG8_WAIT_V(n) asm volatile("s_waitcnt vmcnt(" #n ")" ::: "memory")
#define PG8_WAIT_L(n) asm volatile("s_waitcnt lgkmcnt(" #n ")" ::: "memory")
#define PG8_BAR __builtin_amdgcn_s_barrier()
#define PG8_SCHED __builtin_amdgcn_sched_barrier(0)
    Unit cur, nxt; int ui = 0;
    if (!S.next(0, cur)) return;
    f32x4 acc[2][2][4][2];
#pragma unroll
    for (int a = 0; a < 2; ++a)
#pragma unroll
        for (int b = 0; b < 2; ++b)
#pragma unroll
            for (int m = 0; m < 4; ++m)
#pragma unroll
                for (int n = 0; n < 2; ++n) acc[a][b][m][n] = (f32x4){0.f, 0.f, 0.f, 0.f};
    bf16x8 At[4][2], B0[2][2], B1[2][2];
    const char* cA = (const char*)g.A + (size_t)cur.pm * tstep; const char* cB = (const char*)g.Bt + (size_t)cur.pn * tstep;
    PG8_STAGE(PG8_SB(0, 0), cB, voffB); PG8_STAGE(PG8_SA(0, 0), cA, voffA); PG8_STAGE(PG8_SB(0, 1), cB + hstep, voffB); PG8_STAGE(PG8_SA(0, 1), cA + hstep, voffA);
    if (wr == 1) PG8_BAR;
    PG8_WAIT_V(4); PG8_BAR;
    PG8_STAGE(PG8_SB(1, 0), cB + kstep, voffB); PG8_STAGE(PG8_SA(1, 0), cA + kstep, voffA); PG8_STAGE(PG8_SB(1, 1), cB + hstep + kstep, voffB);
    PG8_WAIT_V(6); PG8_BAR;
    for (;;) {
        const bool has_next = S.next(ui + 1, nxt);
        const char* nA = has_next ? (const char*)g.A + (size_t)nxt.pm * tstep : cA; const char* nB = has_next ? (const char*)g.Bt + (size_t)nxt.pn * tstep : cB;
        for (int t = 0; t < nt; t += 2) {
            const bool last = (t == nt - 2);
            const char* a1 = cA + (size_t)(t + 1) * kstep;
            const char* a2 = last ? nA : cA + (size_t)(t + 2) * kstep; const char* b2 = last ? nB : cB + (size_t)(t + 2) * kstep;
            const char* a3 = a2 + kstep; const char* b3 = b2 + kstep;
            PG8_LDB(B0, 0, 0); PG8_SCHED; PG8_LDA(At, 0, 0); PG8_STAGE(PG8_SA(1, 1), a1 + hstep, voffA);
            PG8_WAIT_L(8); PG8_BAR; PG8_WAIT_L(0); PG8_MMA(0, 0, At, B0); PG8_BAR; PG8_SCHED;
            PG8_LDB(B1, 0, 1); PG8_STAGE(PG8_SB(0, 0), b2, voffB);
            PG8_BAR; PG8_WAIT_L(0); PG8_MMA(0, 1, At, B1); PG8_BAR;
            PG8_LDA(At, 0, 1); PG8_STAGE(PG8_SA(0, 0), a2, voffA);
            PG8_BAR; PG8_WAIT_L(0); PG8_MMA(1, 0, At, B0); PG8_BAR; PG8_SCHED;
            PG8_STAGE(PG8_SB(0, 1), b2 + hstep, voffB);
            PG8_WAIT_V(6); PG8_BAR; PG8_MMA(1, 1, At, B1); PG8_BAR;
            PG8_LDB(B0, 1, 0); PG8_SCHED; PG8_LDA(At, 1, 0); PG8_STAGE(PG8_SA(0, 1), a2 + hstep, voffA);
            PG8_WAIT_L(8); PG8_BAR; PG8_WAIT_L(0); PG8_MMA(0, 0, At, B0); PG8_BAR; PG8_SCHED;
            PG8_LDB(B1, 1, 1); PG8_STAGE(PG8_SB(1, 0), b3, voffB);
            PG8_BAR; PG8_WAIT_L(0); PG8_MMA(0, 1, At, B1); PG8_BAR;
            PG8_LDA(At, 1, 1); PG8_STAGE(PG8_SA(1, 0), a3, voffA);
            PG8_BAR; PG8_WAIT_L(0); PG8_MMA(1, 0, At, B0); PG8_BAR; PG8_SCHED;
            PG8_STAGE(PG8_SB(1, 1), b3 + hstep, voffB);
            PG8_WAIT_V(6); PG8_BAR; PG8_MMA(1, 1, At, B1); PG8_BAR;
        }
        E(acc, cur, wr, wc, fr, fq);
        if (!has_next) break;
#pragma unroll
        for (int a = 0; a < 2; ++a)
#pragma unroll
            for (int b = 0; b < 2; ++b)
#pragma unroll
                for (int m = 0; m < 4; ++m)
#pragma unroll
                    for (int n = 0; n < 2; ++n) acc[a][b][m][n] = (f32x4){0.f, 0.f, 0.f, 0.f};
        cur = nxt; cA = nA; cB = nB; ++ui;
    }
    PG8_WAIT_V(0);
    if (wr == 0) PG8_BAR;
    PG8_BAR;
#undef PG8_SA
#undef PG8_SB
#undef PG8_STAGE
#undef PG8_LDA
#undef PG8_LDB
#undef PG8_MMA
#undef PG8_WAIT_V
#undef PG8_WAIT_L
#undef PG8_BAR
#undef PG8_SCHED
}

struct EpiProj {
    static constexpr bool PERM = true;
    bf16_t* O; int ldc;
    __device__ __forceinline__ void operator()(const f32x4 (&acc)[2][2][4][2], const Unit& u, int wr, int wc, int fr, int fq) const {
        const int row0 = u.pm * BM + wr * 64 + fr, col0 = u.pn * BM + wc * 32 + 8 * fq;
#pragma unroll
        for (int ai = 0; ai < 2; ++ai)
#pragma unroll
            for (int m = 0; m < 4; ++m) { bf16_t* rowp = O + (size_t)(row0 + ai * HALF + m * 16) * ldc + col0;
#pragma unroll
                for (int bj = 0; bj < 2; ++bj) { const f32x4 v0 = acc[ai][bj][m][0], v1 = acc[ai][bj][m][1];
                    u32x4 w; w.x = pk2(v0[0], v0[1]); w.y = pk2(v0[2], v0[3]); w.z = pk2(v1[0], v1[1]); w.w = pk2(v1[2], v1[3]);
                    *(u32x4*)(rowp + bj * HALF) = w; } }
    }
};
struct EpiResid {
    static constexpr bool PERM = false;
    float* H;
    __device__ __forceinline__ void operator()(const f32x4 (&acc)[2][2][4][2], const Unit& u, int wr, int wc, int fr, int fq) const {
        const int row0 = u.pm * BM + wr * 64 + fr, col0 = u.pn * BM + wc * 32 + 4 * fq;
#pragma unroll
        for (int ai = 0; ai < 2; ++ai)
#pragma unroll
            for (int m = 0; m < 4; ++m) { float* rowp = H + (size_t)(row0 + ai * HALF + m * 16) * DM + col0;
#pragma unroll
                for (int bj = 0; bj < 2; ++bj)
#pragma unroll
                    for (int n = 0; n < 2; ++n) { f32x4* p = (f32x4*)(rowp + bj * HALF + n * 16); *p = *p + acc[ai][bj][m][n]; } }
    }
};
struct EpiSwiglu {
    static constexpr bool PERM = true;
    bf16_t* O;
    __device__ __forceinline__ void operator()(const f32x4 (&acc)[2][2][4][2], const Unit& u, int wr, int wc, int fr, int fq) const {
        const int row0 = u.pm * BM + wr * 64 + fr, col0 = u.pn * 128 + wc * 16 + 4 * fq;
#pragma unroll
        for (int ai = 0; ai < 2; ++ai)
#pragma unroll
            for (int m = 0; m < 4; ++m) { bf16_t* rowp = O + (size_t)(row0 + ai * HALF + m * 16) * DFF + col0;
#pragma unroll
                for (int bj = 0; bj < 2; ++bj) { const f32x4 gt = acc[ai][bj][m][0], up = acc[ai][bj][m][1]; float o[4];
#pragma unroll
                    for (int j = 0; j < 4; ++j) o[j] = gt[j] * sigmoidf_(gt[j]) * up[j];
                    u32x2 w; w.x = pk2(o[0], o[1]); w.y = pk2(o[2], o[3]);
                    *(u32x2*)(rowp + bj * 64) = w; } }
    }
};
}

__device__ __forceinline__ void norm_rows(CArgs a, int mode, const float* gain, bf16_t* dst) {
    const int tid = tid_opaque(), wid = tid >> 6, lane = tid & 63;
    float* H = (float*)(a->ws + WS_H);
    f32x4 gv[4];
#pragma unroll
    for (int i = 0; i < 4; ++i) gv[i] = *(const f32x4*)(gain + lane * 4 + 256 * i);
    for (int row = blockIdx.x * 8 + wid; row < MR; row += gridDim.x * 8) {
        const int b = row / TT, t = row - b * TT;
        if (mode == 2 && t < NMETA) continue;
        const float* src = (mode == 0) ? (t < NMETA ? a->in[1] + (size_t)t * DM : a->in[0] + ((size_t)b * SEQ + (t - NMETA)) * DM) : H + (size_t)row * DM;
        f32x4 v[4]; float ss = 0.f;
#pragma unroll
        for (int i = 0; i < 4; ++i) { v[i] = *(const f32x4*)(src + lane * 4 + 256 * i); ss += v[i][0] * v[i][0] + v[i][1] * v[i][1] + v[i][2] * v[i][2] + v[i][3] * v[i][3]; }
        ss = wave_sum(ss);
        const float rs = rsqrtf(ss * (1.0f / DM) + RMS_EPS);
        if (mode == 0) {
#pragma unroll
            for (int i = 0; i < 4; ++i) *(f32x4*)(H + (size_t)row * DM + lane * 4 + 256 * i) = v[i];
        }
        if (mode == 2) {
            float* o = a->out + ((size_t)b * SEQ + (t - NMETA)) * DM;
#pragma unroll
            for (int i = 0; i < 4; ++i) *(f32x4*)(o + lane * 4 + 256 * i) = (v[i] * rs) * gv[i];
        } else {
#pragma unroll
            for (int i = 0; i < 4; ++i) { const f32x4 y = (v[i] * rs) * gv[i]; u32x2 w; w.x = pk2(y[0], y[1]); w.y = pk2(y[2], y[3]);
                *(u32x2*)(dst + (size_t)row * DM + lane * 4 + 256 * i) = w; }
        }
    }
}

template <int KIND> __device__ __forceinline__ float wsrc(CArgs a, int l, int k, int n) {
    if (KIND == 0) {
        if (n < NIN) return a->in[3][((size_t)l * DM + k) * NIN + n];
        if (n < NIN + 32 && l > 0) return a->in[17][((size_t)(l - 1) * DM + k) * 32 + (n - NIN)];
        return 0.f;
    } else if (KIND == 1) {
        return a->in[21][((size_t)l * DM + k) * DM + n];
    } else if (KIND == 2) {
        const int pn = n >> 8, c = n & 255, feat = pn * 128 + ((c >> 3) << 2) + (c & 3), isup = (c >> 2) & 1;
        return a->in[23][((size_t)l * DM + k) * (2 * DFF) + feat + isup * DFF];
    } else if (KIND == 3) {
        return a->in[24][((size_t)l * DFF + k) * DM + n];
    } else {
        const int j = n >> 9, nn = n & 511;
        if (j == 0) return (k < 64) ? a->in[8][((size_t)l * 64 + k) * 512 + nn] : 0.f;
        if (j == 1) return (k >= 64 && k < 128) ? a->in[10][((size_t)l * 64 + (k - 64)) * 512 + nn] : 0.f;
        if (j == 2) return (k >= 128 && k < 288) ? a->in[11][((size_t)l * 160 + (k - 128)) * 512 + nn] : 0.f;
        return (k >= 288 && k < 320 && l > 0) ? a->in[20][((size_t)(l - 1) * 32 + (k - 288)) * 512 + nn] : 0.f;
    }
}
template <int KIND> __device__ __forceinline__ void conv_tile(CArgs a, int l, LAS float* tile, bf16_t* out, int ldo, int n0, int k0) {
    const int tid = tid_opaque(), kk = tid >> 6, nn = tid & 63;
#pragma unroll
    for (int i = 0; i < 8; ++i) tile[(kk + 8 * i) * 65 + nn] = wsrc<KIND>(a, l, k0 + kk + 8 * i, n0 + nn);
    __syncthreads();
    const int n = tid >> 3, kq = tid & 7;
    u32x4 w;
    w.x = pk2(tile[(kq * 8 + 0) * 65 + n], tile[(kq * 8 + 1) * 65 + n]); w.y = pk2(tile[(kq * 8 + 2) * 65 + n], tile[(kq * 8 + 3) * 65 + n]);
    w.z = pk2(tile[(kq * 8 + 4) * 65 + n], tile[(kq * 8 + 5) * 65 + n]); w.w = pk2(tile[(kq * 8 + 6) * 65 + n], tile[(kq * 8 + 7) * 65 + n]);
    *(u32x4*)(out + (size_t)(n0 + n) * ldo + k0 + kq * 8) = w;
    __syncthreads();
}
__device__ __forceinline__ void fold_tile(CArgs a, int l, LAS float* lds, bf16_t* out, int n0, int k0) {
    LAS float* P = lds; LAS float* W = lds + 64 * 128;
    const int tid = tid_opaque(), g = k0 >> 7, c0 = k0 & 127;
    const float* pw = a->in[5] + ((size_t)(l * 4 + g) * 128 + c0) * 128; const float* sc = a->in[6] + (size_t)l * 512 + g * 128;
    const float* wo = a->in[21] + ((size_t)l * DM + g * 128) * DM + n0;
    for (int i = tid; i < 64 * 128; i += 512) { const int d = i & 127; P[i] = pw[i] * sc[d]; }
    for (int i = tid; i < 128 * 64; i += 512) { const int d = i >> 6, n = i & 63; W[i] = wo[(size_t)d * DM + n]; }
    __syncthreads();
    const int n = tid & 63, cq = tid >> 6;
    float acc[8];
#pragma unroll
    for (int j = 0; j < 8; ++j) acc[j] = 0.f;
    for (int d = 0; d < 128; ++d) { const float wv = W[d * 64 + n];
#pragma unroll
        for (int j = 0; j < 8; ++j) acc[j] += P[(cq * 8 + j) * 128 + d] * wv; }
    u32x4 w; w.x = pk2(acc[0], acc[1]); w.y = pk2(acc[2], acc[3]); w.z = pk2(acc[4], acc[5]); w.w = pk2(acc[6], acc[7]);
    *(u32x4*)(out + (size_t)(n0 + n) * DM + k0 + cq * 8) = w;
    __syncthreads();
}
__device__ __forceinline__ void weight_prep(CArgs a, int l, LAS float* lds) {
    bf16_t* WC = (bf16_t*)(a->ws + WS_WC); bf16_t* WO = (bf16_t*)(a->ws + WS_WOUT); bf16_t* WGU = (bf16_t*)(a->ws + WS_WGU);
    bf16_t* WDN = (bf16_t*)(a->ws + WS_WDN); bf16_t* WL = (bf16_t*)(a->ws + WS_WL);
    for (int ti = blockIdx.x; ti < 3200; ti += gridDim.x) {
        if (ti < 128) { fold_tile(a, l, lds, WO, (ti & 15) * 64, (ti >> 4) * 64); }
        else if (ti < 256) { const int q = ti - 128; conv_tile<1>(a, l, lds, WO, DM, (q & 15) * 64, 512 + (q >> 4) * 64); }
        else if (ti < 896) { const int q = ti - 256; conv_tile<0>(a, l, lds, WC, DM, (q >> 4) * 64, (q & 15) * 64); }
        else if (ti < 2304) { const int q = ti - 896; conv_tile<2>(a, l, lds, WGU, DM, (q >> 4) * 64, (q & 15) * 64); }
        else if (ti < 3008) { const int q = ti - 2304; conv_tile<3>(a, l, lds, WDN, DFF, (q / 44) * 64, (q % 44) * 64); }
        else { const int q = ti - 3008; conv_tile<4>(a, l, lds, WL, KL, (q / 6) * 64, (q % 6) * 64); }
    }
}

__device__ __forceinline__ void prep_phase(CArgs a, int l) {
    const bf16_t* PROJ = (const bf16_t*)(a->ws + WS_R1);
    bf16_t* MIX = (bf16_t*)((unsigned char*)a->out + DO_MIX); bf16_t* LIN = (bf16_t*)((unsigned char*)a->out + DO_LIN);
    const int tid = tid_opaque(), sub = tid >> 7, j = tid & 127;
    for (int rb = blockIdx.x * 4; rb < MR; rb += gridDim.x * 4) {
        const int row = rb + sub, t = row % TT;
        if (j < 64) {
            const int c0 = j * 8, win = 2 << (c0 >> 7), cnt = (t + 1 < win) ? t + 1 : win;
            float s[8], u0[8];
#pragma unroll
            for (int e = 0; e < 8; ++e) s[e] = 0.f;
            for (int q = 0; q < cnt; ++q) {
                const u32x4 w = *(const u32x4*)(PROJ + (size_t)(row - q) * NPROJ + c0);
                float x[8] = {bf2f(w.x & 0xffffu), bf2f(w.x >> 16), bf2f(w.y & 0xffffu), bf2f(w.y >> 16), bf2f(w.z & 0xffffu), bf2f(w.z >> 16), bf2f(w.w & 0xffffu), bf2f(w.w >> 16)};
#pragma unroll
                for (int e = 0; e < 8; ++e) { s[e] += x[e]; if (q == 0) u0[e] = x[e]; }
            }
            const float inv = 1.0f / (float)cnt;
            u32x4 o; o.x = pk2(s[0] * inv - u0[0], s[1] * inv - u0[1]); o.y = pk2(s[2] * inv - u0[2], s[3] * inv - u0[3]);
            o.z = pk2(s[4] * inv - u0[4], s[5] * inv - u0[5]); o.w = pk2(s[6] * inv - u0[6], s[7] * inv - u0[7]);
            *(u32x4*)(MIX + (size_t)row * DM + c0) = o;
        } else if (j < 104) {
            const int cb = (j - 64) * 8;
            const u32x4 wc = *(const u32x4*)(PROJ + (size_t)row * NPROJ + 2048 + cb);
            u32x4 wp = (u32x4){0u, 0u, 0u, 0u};
            if (t > 0) wp = *(const u32x4*)(PROJ + (size_t)(row - 1) * NPROJ + 2048 + cb);
            const float xc[8] = {bf2f(wc.x & 0xffffu), bf2f(wc.x >> 16), bf2f(wc.y & 0xffffu), bf2f(wc.y >> 16), bf2f(wc.z & 0xffffu), bf2f(wc.z >> 16), bf2f(wc.w & 0xffffu), bf2f(wc.w >> 16)};
            const float xp[8] = {bf2f(wp.x & 0xffffu), bf2f(wp.x >> 16), bf2f(wp.y & 0xffffu), bf2f(wp.y >> 16), bf2f(wp.z & 0xffffu), bf2f(wp.z >> 16), bf2f(wp.w & 0xffffu), bf2f(wp.w >> 16)};
            float y[8];
#pragma unroll
            for (int e = 0; e < 8; ++e) {
                const int ci = cb + e;
                const float mu = (cb < 288) ? a->in[4][(size_t)l * NSHIFT + 1536 + ci] : (l > 0 ? a->in[18][(l - 1) * 32 + (ci - 288)] : 0.f);
                const float sv = xc[e] + (xp[e] - xc[e]) * mu;
                y[e] = (cb < 64) ? tanhf(sv) : (cb < 128) ? sv : (cb < 288) ? sigmoidf_(sv) : sv;
            }
            u32x4 o; o.x = pk2(y[0], y[1]); o.y = pk2(y[2], y[3]); o.z = pk2(y[4], y[5]); o.w = pk2(y[6], y[7]);
            *(u32x4*)(LIN + (size_t)row * KL + cb) = o;
        } else if (j < 112) {
            unsigned z = 0u; asm volatile("" : "+v"(z));
            *(u32x4*)(LIN + (size_t)row * KL + 320 + (j - 104) * 8) = (u32x4){z, z, z, z};
        }
    }
}

constexpr int TC = 16, NCH = TT / TC;
__device__ __forceinline__ void scan_phase(CArgs a, int l, LAS float* lds) {
    const int bid = blockIdx.x; if (bid >= BATCH * 8) return;
    const int b = bid >> 3, h = bid & 7, tid = tid_opaque(), wid = tid >> 6, lane = tid & 63;
    LAS float* sW = lds; LAS float* sA = sW + TC * 64; LAS float* sB = sA + TC * 64; LAS float* sK = sB + TC * 64; LAS float* sR = sK + TC * 64;
    LAS float* sV = sR + TC * 64; LAS float* sG = sV + TC * 64; LAS float* sY = sG + TC * 64; LAS float* sC = sY + TC * 64;
    const bf16_t* PROJ = (const bf16_t*)(a->ws + WS_R1); const bf16_t* LO = (const bf16_t*)(a->ws + WS_LO);
    bf16_t* VF = (bf16_t*)((unsigned char*)a->out + DO_VF); bf16_t* MIX = (bf16_t*)((unsigned char*)a->out + DO_MIX);
    const int ch = h * 64 + lane;
    const float mu_r = a->in[4][(size_t)l * NSHIFT + ch], mu_k = a->in[4][(size_t)l * NSHIFT + 512 + ch], mu_v = a->in[4][(size_t)l * NSHIFT + 1024 + ch];
    const float w0_c = a->in[7][l * 512 + ch], a0_c = a->in[9][l * 512 + ch], v0_c = (l > 0) ? a->in[19][(l - 1) * 512 + ch] : 0.f;
    const float kk_c = a->in[12][l * 512 + ch], ka_c = a->in[13][l * 512 + ch], rk_c = a->in[14][l * 512 + ch], gw = a->in[15][l * 512 + ch], gb = a->in[16][l * 512 + ch];
    float S[8];
#pragma unroll
    for (int j = 0; j < 8; ++j) S[j] = 0.f;
    const int row = wid * 8 + (lane >> 3), seg = lane & 7;
    unsigned short ld[2][11];
#define SCAN_LOAD(c) do { _Pragma("unroll") for (int p = 0; p < 2; ++p) { const int t = (c) * TC + p * 8 + wid; const size_t m = (size_t)b * TT + t; \
        const bf16_t* pr = PROJ + m * NPROJ + 512 + ch; ld[p][0] = pr[0]; ld[p][1] = pr[512]; ld[p][2] = pr[1024]; \
        if (t > 0) { ld[p][3] = pr[-NPROJ]; ld[p][4] = pr[512 - NPROJ]; ld[p][5] = pr[1024 - NPROJ]; } else { ld[p][3] = 0; ld[p][4] = 0; ld[p][5] = 0; } \
        const bf16_t* po = LO + m * NL + ch; ld[p][6] = po[0]; ld[p][7] = po[512]; ld[p][8] = po[1024]; ld[p][9] = po[1536]; \
        ld[p][10] = (l > 0) ? VF[m * 512 + ch] : (unsigned short)0; } } while (0)
    SCAN_LOAD(0);
    for (int c = 0; c < NCH; ++c) {
#pragma unroll
        for (int p = 0; p < 2; ++p) {
            const int tl = p * 8 + wid; const size_t m = (size_t)b * TT + c * TC + tl;
            const float rc = bf2f(ld[p][0]), kc = bf2f(ld[p][1]), vc = bf2f(ld[p][2]), rp = bf2f(ld[p][3]), kp = bf2f(ld[p][4]), vp = bf2f(ld[p][5]);
            const float e = sigmoidf_(w0_c + bf2f(ld[p][6])) * 0.60653066f, av = sigmoidf_(a0_c + bf2f(ld[p][7])), gv = bf2f(ld[p][8]), vm = sigmoidf_(v0_c + bf2f(ld[p][9]));
            const float r = rc + (rp - rc) * mu_r, k = kc + (kp - kc) * mu_k; float v = vc + (vp - vc) * mu_v;
            if (l == 0) VF[m * 512 + ch] = (bf16_t)f2bf(v); else { const float vf = bf2f(ld[p][10]); v = v + (vf - v) * vm; }
            float kk = k * kk_c; const float n2 = wave_sum(kk * kk); kk = kk / fmaxf(sqrtf(n2), 1e-12f);
            const float k2 = k * (1.0f + (av - 1.0f) * ka_c);
            const float cf = wave_sum(r * k2 * rk_c);
            sW[tl * 64 + lane] = __expf(-e); sA[tl * 64 + lane] = -kk; sB[tl * 64 + lane] = kk * av; sK[tl * 64 + lane] = k2; sR[tl * 64 + lane] = r;
            sV[tl * 64 + lane] = v; sG[tl * 64 + lane] = gv; if (lane == 0) sC[tl] = cf;
        }
        __syncthreads();
        if (c + 1 < NCH) SCAN_LOAD(c + 1);
#pragma unroll 4
        for (int tl = 0; tl < TC; ++tl) {
            const int o = tl * 64 + seg * 8;
            const f32x4 w0 = *(const LAS f32x4*)(sW + o), w1 = *(const LAS f32x4*)(sW + o + 4), a0 = *(const LAS f32x4*)(sA + o), a1 = *(const LAS f32x4*)(sA + o + 4);
            const f32x4 b0 = *(const LAS f32x4*)(sB + o), b1 = *(const LAS f32x4*)(sB + o + 4), k0 = *(const LAS f32x4*)(sK + o), k1 = *(const LAS f32x4*)(sK + o + 4);
            const f32x4 r0 = *(const LAS f32x4*)(sR + o), r1 = *(const LAS f32x4*)(sR + o + 4);
            const float v = sV[tl * 64 + row];
            float p = 0.f;
#pragma unroll
            for (int j = 0; j < 4; ++j) p += S[j] * a0[j] + S[j + 4] * a1[j];
            const float sa = allred8(p);
            float q = 0.f;
#pragma unroll
            for (int j = 0; j < 4; ++j) {
                S[j] = S[j] * w0[j] + sa * b0[j] + v * k0[j]; S[j + 4] = S[j + 4] * w1[j] + sa * b1[j] + v * k1[j];
                q += S[j] * r0[j] + S[j + 4] * r1[j];
            }
            q = allred8(q);
            if (seg == 0) sY[tl * 64 + row] = q;
        }
        __syncthreads();
#pragma unroll
        for (int p = 0; p < 2; ++p) {
            const int tl = p * 8 + wid; const size_t m = (size_t)b * TT + c * TC + tl;
            const float y = sY[tl * 64 + lane];
            const float mean = wave_sum(y) * (1.0f / 64.0f), d = y - mean, var = wave_sum(d * d) * (1.0f / 64.0f);
            const float o = (d * rsqrtf(var + GN_EPS) * gw + gb + sC[tl] * sV[tl * 64 + lane]) * sG[tl * 64 + lane];
            MIX[m * DM + 512 + ch] = (bf16_t)f2bf(o);
        }
        __syncthreads();
    }
#undef SCAN_LOAD
}

__global__ void __launch_bounds__(512, 2) mega(Args a_unused) {
    extern __shared__ __attribute__((aligned(16))) unsigned char shm[];
    LAS unsigned char* lds = (LAS unsigned char*)shm;
    cg::grid_group grid = cg::this_grid();
    CArgs a0 = (CArgs)__builtin_amdgcn_kernarg_segment_ptr();
    const int ph_lo = a0->ph_lo, ph_hi = a0->ph_hi;
    for (int ph = ph_lo; ph < ph_hi; ++ph) {
        if (ph > ph_lo) grid.sync();
        CArgs a = a0; asm volatile("" : "+s"(a));
        bf16_t* HN = (bf16_t*)(a->ws + WS_LO);
        if (ph == NPH - 1) { norm_rows(a, 2, a->in[25], nullptr); continue; }
        const int l = ph / 9, s = ph % 9;
        if (s == 0) {
#ifndef SKIP_S0
 norm_rows(a, l == 0 ? 0 : 1, a->in[2] + (size_t)l * DM, HN); weight_prep(a, l, (LAS float*)lds);
#endif
 }
        else if (s == 1 || s == 3) {
            pg8::Gemm g{s == 1 ? HN : (const bf16_t*)((unsigned char*)a->out + DO_LIN), (const bf16_t*)(a->ws + (s == 1 ? WS_WC : WS_WL)), MR, s == 1 ? NPROJ : NL, s == 1 ? DM : KL};
            pg8::StaticOrder S; S.init(MR, g.N, gridDim.x, blockIdx.x);
            pg8::EpiProj E{(bf16_t*)(a->ws + (s == 1 ? WS_R1 : WS_LO)), g.N};
#ifndef SKIP_S1
            pg8::gemm_phase(lds, g, S, E);
#endif
        }
        else if (s == 2) {
#ifndef SKIP_S2
 prep_phase(a, l);
#endif
 }
        else if (s == 4) {
#ifndef SKIP_S4
 scan_phase(a, l, (LAS float*)lds);
#endif
 }
        else if (s == 5 || s == 8) {
            pg8::Gemm g{s == 5 ? (const bf16_t*)((unsigned char*)a->out + DO_MIX) : (const bf16_t*)(a->ws + WS_R1), (const bf16_t*)(a->ws + (s == 5 ? WS_WOUT : WS_WDN)), MR, DM, s == 5 ? DM : DFF};
            pg8::StaticOrder S; S.init(MR, DM, gridDim.x, blockIdx.x);
            pg8::EpiResid E{(float*)(a->ws + WS_H)};
#ifndef SKIP_S5
 pg8::gemm_phase(lds, g, S, E);
#endif

        }
        else if (s == 6) norm_rows(a, 1, a->in[22] + (size_t)l * DM, HN);
        else {
            pg8::Gemm g{HN, (const bf16_t*)(a->ws + WS_WGU), MR, 2 * DFF, DM}; pg8::StaticOrder S; S.init(MR, 2 * DFF, gridDim.x, blockIdx.x);
            pg8::EpiSwiglu E{(bf16_t*)(a->ws + WS_R1)};
#ifndef SKIP_S7
 pg8::gemm_phase(lds, g, S, E);
#endif

        }
    }
}

extern "C" void kernel_launch(void* const* d_in, const int* in_sizes, int n_in, void* d_out, int out_size, void* d_ws, size_t ws_size, hipStream_t stream) {
    static int grid = 0;
    if (grid == 0) {
        if (n_in != 26 || out_size != BATCH * SEQ * DM || ws_size < WS_END) { fprintf(stderr, "kernel_launch: unexpected shapes (n_in %d out %d ws %zu need %zu)\n", n_in, out_size, ws_size, (size_t)WS_END); grid = -1; return; }
        int dev = 0, cus = 0, per_cu = 0;
        hipGetDevice(&dev);
        hipDeviceGetAttribute(&cus, hipDeviceAttributeMultiprocessorCount, dev);
        if (hipFuncSetAttribute((const void*)mega, hipFuncAttributeMaxDynamicSharedMemorySize, LDS_BYTES) != hipSuccess) { fprintf(stderr, "kernel_launch: hipFuncSetAttribute failed\n"); grid = -1; return; }
        hipOccupancyMaxActiveBlocksPerMultiprocessor(&per_cu, (const void*)mega, 512, LDS_BYTES);
        if (per_cu < 1) { fprintf(stderr, "kernel_launch: occupancy query says %d blocks per CU\n", per_cu); per_cu = 1; }
        (void)hipGetLastError();
        grid = cus;
        fprintf(stderr, "kernel_launch: grid %d (per_cu %d)\n", grid, per_cu);
    }
    if (grid < 0) return;
    Args a{};
    for (int i = 0; i < 26; ++i) a.in[i] = (const float*)d_in[i];
    a.out = (float*)d_out; a.ws = (unsigned char*)d_ws;
#if MK_MULTI
    for (int ph = 0; ph < NPH; ++ph) {
        a.ph_lo = ph; a.ph_hi = ph + 1;
        void* args[] = {&a};
        hipError_t e = hipLaunchCooperativeKernel((const void*)mega, dim3(grid), dim3(512), args, LDS_BYTES, stream);
        if (e != hipSuccess) { fprintf(stderr, "cooperative launch failed: %s\n", hipGetErrorString(e)); break; }
    }
#else
    a.ph_lo = 0; a.ph_hi = NPH;
    void* args[] = {&a};
    hipError_t e = hipLaunchCooperativeKernel((const void*)mega, dim3(grid), dim3(512), args, LDS_BYTES, stream);
    if (e != hipSuccess) fprintf(stderr, "cooperative launch failed: %s (grid %d)\n", hipGetErrorString(e), grid);
#endif
}
```

```cpp
#include <hip/hip_runtime.h>
#include <hip/hip_cooperative_groups.h>
#include <cstdio>
#include <cstdint>
namespace cg = cooperative_groups;

#ifndef MK_MULTI
#define MK_MULTI 0
#endif

#define LAS __attribute__((address_space(3)))
typedef unsigned short bf16_t;
typedef short bf16x8 __attribute__((ext_vector_type(8)));
typedef float f32x4 __attribute__((ext_vector_type(4)));
typedef float f32x2 __attribute__((ext_vector_type(2)));
typedef unsigned u32x4 __attribute__((ext_vector_type(4)));
typedef unsigned u32x2 __attribute__((ext_vector_type(2)));

constexpr int DM = 1024, BATCH = 16, SEQ = 2048, DEPTH = 4, NMETA = 16, TT = SEQ + NMETA  , MR = BATCH * TT  ;
constexpr int NIN = 2336, NSHIFT = 1824, DFF = 2816, NPROJ = 2560  , KL = 384  , NL = 2048;
constexpr float RMS_EPS = 1e-6f, GN_EPS = 64e-5f;
constexpr int LDS_BYTES = 131072;
constexpr int NPH = DEPTH * 9 + 1;

constexpr size_t WS_WC = 4096;
constexpr size_t WS_WOUT = WS_WC + (size_t)NPROJ * DM * 2;
constexpr size_t WS_WGU = WS_WOUT + (size_t)DM * DM * 2;
constexpr size_t WS_WDN = WS_WGU + (size_t)2 * DFF * DM * 2;
constexpr size_t WS_WL = WS_WDN + (size_t)DM * DFF * 2;
constexpr size_t WS_LBIAS = WS_WL + (size_t)NL * KL * 2;
constexpr size_t WS_H = WS_LBIAS + 8192;
constexpr size_t WS_R1 = WS_H + (size_t)MR * DM * 4;
constexpr size_t WS_LO = WS_R1 + (size_t)MR * DFF * 2;
constexpr size_t WS_END = WS_LO + (size_t)MR * NL * 2;
constexpr size_t DO_MIX = 0;
constexpr size_t DO_VF = DO_MIX + (size_t)MR * DM * 2;
constexpr size_t DO_LIN = DO_VF + (size_t)MR * 512 * 2;
static_assert(DO_LIN + (size_t)MR * KL * 2 <= (size_t)BATCH * SEQ * DM * 4, "d_out scratch");

struct Args { const float* in[26]; float* out; unsigned char* ws; int ph_lo, ph_hi; };
typedef const __attribute__((address_space(4))) Args* CArgs;

__device__ __forceinline__ float bf2f(unsigned b) { return __uint_as_float(b << 16); }
__device__ __forceinline__ unsigned f2bf(float f) { unsigned u = __float_as_uint(f); return (u + 0x7fffu + ((u >> 16) & 1u)) >> 16; }
__device__ __forceinline__ unsigned pk2(float lo, float hi) { unsigned r; asm volatile("v_cvt_pk_bf16_f32 %0, %1, %2" : "=v"(r) : "v"(lo), "v"(hi)); return r; }
__device__ __forceinline__ float sigmoidf_(float x) { return __builtin_amdgcn_rcpf(1.0f + __builtin_amdgcn_exp2f(x * -1.44269504f)); }
template <int CTRL> __device__ __forceinline__ float dppf(float x) { return __int_as_float(__builtin_amdgcn_update_dpp(0, __float_as_int(x), CTRL, 0xF, 0xF, true)); }
__device__ __forceinline__ float allred8(float x) { x += dppf<0xB1>(x); x += dppf<0x4E>(x); x += dppf<0x141>(x); return x; }
__device__ __forceinline__ float wave_sum(float x) {
    x += dppf<0xB1>(x); x += dppf<0x4E>(x); x += dppf<0x141>(x); x += dppf<0x140>(x);
    const int xi = __float_as_int(x);
    return (__int_as_float(__builtin_amdgcn_readlane(xi, 0)) + __int_as_float(__builtin_amdgcn_readlane(xi, 16))) + (__int_as_float(__builtin_amdgcn_readlane(xi, 32)) + __int_as_float(__builtin_amdgcn_readlane(xi, 48)));
}
__device__ __forceinline__ int tid_opaque() { int t = threadIdx.x; asm volatile("" : "+v"(t)); return t; }

namespace pg8 {
constexpr int BM = 256, BK = 64, HALF = 128, HTB = HALF * BK * 2, STAGE_BYTES = 8 * HTB, NXCD = 8, WGM = 8;
__host__ __device__ __forceinline__ int lds_byte(int r, int c) { const int st = (r >> 4) * 2 + (c >> 5), rr = r & 15, cc = c & 31, ob = rr * 64 + cc * 2; return st * 1024 + (ob ^ (((ob >> 9) & 1) << 5)); }
__host__ __device__ __forceinline__ void stage_rc(int b, int& R, int& C) { const int st = b / 1024, sb = b % 1024, swz = sb ^ (((sb >> 9) & 1) << 5); R = (st >> 1) * 16 + swz / 64; C = (st & 1) * 32 + (swz % 64) / 2; }
__host__ __device__ __forceinline__ int perm32(int rho) { const int n = rho >> 4, i = rho & 15; return 8 * (i >> 2) + 4 * n + (i & 3); }
struct Unit { int pm, pn; };
struct Gemm { const bf16_t* A; const bf16_t* Bt; int M, N, K; };
struct StaticOrder {
    int nM, nN, nwg, G, c;
    __device__ void init(int M, int N, int G_, int c_) { nM = M / BM; nN = N / BM; nwg = nM * nN; G = G_; c = c_; }
    __device__ bool next(int i, Unit& u) const {
        const long L = (long)i * G + c; if (L >= nwg) return false;
        int wgid = (int)L; { const int q = nwg / NXCD, r = nwg % NXCD, xcd = wgid % NXCD, off = wgid / NXCD; wgid = (xcd < r ? xcd * (q + 1) : r * (q + 1) + (xcd - r) * q) + off; }
        const int nig = WGM * nN, gid = wgid / nig, fm = gid * WGM, gsz = (nM - fm) < WGM ? (nM - fm) : WGM;
        u.pm = fm + ((wgid % nig) % gsz); u.pn = (wgid % nig) / gsz; return true;
    }
};
template <class Epi>
__device__ __forceinline__ void gemm_phase(LAS unsigned char* lds, const Gemm g, const StaticOrder& S, const Epi& E) {
    int tid_ = threadIdx.x; asm volatile("" : "+v"(tid_));
    const int tid = tid_, wid = __builtin_amdgcn_readfirstlane(tid >> 6), lane = tid & 63, wr = wid >> 2, wc = wid & 3, fr = lane & 15, fq = lane >> 4;
    const int K = g.K, nt = K / BK;
    unsigned voffA[2], voffB[2];
#pragma unroll
    for (int i = 0; i < 2; ++i) { int R, C; stage_rc(tid * 16 + i * 8192, R, C); const int Rb = Epi::PERM ? ((R & ~31) + perm32(R & 31)) : R;
        voffA[i] = (unsigned)(R * K + C) * 2u; voffB[i] = (unsigned)(Rb * K + C) * 2u; }
    const size_t kstep = (size_t)(BK * 2);
    const size_t hstep = (size_t)HALF * K * 2;
    const size_t tstep = 2 * hstep;
    const unsigned ldsw = (unsigned)wid * 1024u;
    const int aoff = lds_byte(wr * 64 + fr, fq * 8), boff = lds_byte(wc * 32 + fr, fq * 8);
#define PG8_SA(b, h) (((b) * 2 + (h)) * HTB)
#define PG8_SB(b, h) ((4 + (b) * 2 + (h)) * HTB)
#define PG8_STAGE(bufoff, gbase, voff) do { _Pragma("unroll") for (int _i = 0; _i < 2; ++_i) \
        __builtin_amdgcn_global_load_lds((const unsigned*)((const char*)(gbase) + (voff)[_i]), (LAS unsigned*)(lds + (bufoff) + ldsw + _i * 8192), 16, 0, 0); } while (0)
#define PG8_LDA(dst, b, h) do { _Pragma("unroll") for (int m = 0; m < 4; ++m) _Pragma("unroll") for (int k = 0; k < 2; ++k) dst[m][k] = *(const LAS bf16x8*)(lds + PG8_SA(b, h) + aoff + m * 2048 + k * 1024); } while (0)
#define PG8_LDB(dst, b, h) do { _Pragma("unroll") for (int n = 0; n < 2; ++n) _Pragma("unroll") for (int k = 0; k < 2; ++k) dst[n][k] = *(const LAS bf16x8*)(lds + PG8_SB(b, h) + boff + n * 2048 + k * 1024); } while (0)
#define PG8_MMA(ai, bj, At, Bt) do { __builtin_amdgcn_s_setprio(1); _Pragma("unroll") for (int m = 0; m < 4; ++m) _Pragma("unroll") for (int n = 0; n < 2; ++n) _Pragma("unroll") for (int k = 0; k < 2; ++k) \
        acc[ai][bj][m][n] = __builtin_amdgcn_mfma_f32_16x16x32_bf16(Bt[n][k], At[m][k], acc[ai][bj][m][n], 0, 0, 0); __builtin_amdgcn_s_setprio(0); } while (0)
#define PG8_WAIT_V(n) asm volatile("s_waitcnt vmcnt(" #n ")" ::: "memory")
#define PG8_WAIT_L(n) asm volatile("s_waitcnt lgkmcnt(" #n ")" ::: "memory")
#define PG8_BAR __builtin_amdgcn_s_barrier()
#define PG8_SCHED __builtin_amdgcn_sched_barrier(0)
    Unit cur, nxt; int ui = 0;
    if (!S.next(0, cur)) return;
    f32x4 acc[2][2][4][2];
#pragma unroll
    for (int a = 0; a < 2; ++a)
#pragma unroll
        for (int b = 0; b < 2; ++b)
#pragma unroll
            for (int m = 0; m < 4; ++m)
#pragma unroll
                for (int n = 0; n < 2; ++n) acc[a][b][m][n] = (f32x4){0.f, 0.f, 0.f, 0.f};
    bf16x8 At[4][2], B0[2][2], B1[2][2];
    const char* cA = (const char*)g.A + (size_t)cur.pm * tstep; const char* cB = (const char*)g.Bt + (size_t)cur.pn * tstep;
    PG8_STAGE(PG8_SB(0, 0), cB, voffB); PG8_STAGE(PG8_SA(0, 0), cA, voffA); PG8_STAGE(PG8_SB(0, 1), cB + hstep, voffB); PG8_STAGE(PG8_SA(0, 1), cA + hstep, voffA);
    if (wr == 1) PG8_BAR;
    PG8_WAIT_V(4); PG8_BAR;
    PG8_STAGE(PG8_SB(1, 0), cB + kstep, voffB); PG8_STAGE(PG8_SA(1, 0), cA + kstep, voffA); PG8_STAGE(PG8_SB(1, 1), cB + hstep + kstep, voffB);
    PG8_WAIT_V(6); PG8_BAR;
    for (;;) {
        const bool has_next = S.next(ui + 1, nxt);
        const char* nA = has_next ? (const char*)g.A + (size_t)nxt.pm * tstep : cA; const char* nB = has_next ? (const char*)g.Bt + (size_t)nxt.pn * tstep : cB;
        for (int t = 0; t < nt; t += 2) {
            const bool last = (t == nt - 2);
            const char* a1 = cA + (size_t)(t + 1) * kstep;
            const char* a2 = last ? nA : cA + (size_t)(t + 2) * kstep; const char* b2 = last ? nB : cB + (size_t)(t + 2) * kstep;
            const char* a3 = a2 + kstep; const char* b3 = b2 + kstep;
            PG8_LDB(B0, 0, 0); PG8_SCHED; PG8_LDA(At, 0, 0); PG8_STAGE(PG8_SA(1, 1), a1 + hstep, voffA);
            PG8_WAIT_L(8); PG8_BAR; PG8_WAIT_L(0); PG8_MMA(0, 0, At, B0); PG8_BAR; PG8_SCHED;
            PG8_LDB(B1, 0, 1); PG8_STAGE(PG8_SB(0, 0), b2, voffB);
            PG8_BAR; PG8_WAIT_L(0); PG8_MMA(0, 1, At, B1); PG8_BAR;
            PG8_LDA(At, 0, 1); PG8_STAGE(PG8_SA(0, 0), a2, voffA);
            PG8_BAR; PG8_WAIT_L(0); PG8_MMA(1, 0, At, B0); PG8_BAR; PG8_SCHED;
            PG8_STAGE(PG8_SB(0, 1), b2 + hstep, voffB);
            PG8_WAIT_V(6); PG8_BAR; PG8_MMA(1, 1, At, B1); PG8_BAR;
            PG8_LDB(B0, 1, 0); PG8_SCHED; PG8_LDA(At, 1, 0); PG8_STAGE(PG8_SA(0, 1), a2 + hstep, voffA);
            PG8_WAIT_L(8); PG8_BAR; PG8_WAIT_L(0); PG8_MMA(0, 0, At, B0); PG8_BAR; PG8_SCHED;
            PG8_LDB(B1, 1, 1); PG8_STAGE(PG8_SB(1, 0), b3, voffB);
            PG8_BAR; PG8_WAIT_L(0); PG8_MMA(0, 1, At, B1); PG8_BAR;
            PG8_LDA(At, 1, 1); PG8_STAGE(PG8_SA(1, 0), a3, voffA);
            PG8_BAR; PG8_WAIT_L(0); PG8_MMA(1, 0, At, B0); PG8_BAR; PG8_SCHED;
            PG8_STAGE(PG8_SB(1, 1), b3 + hstep, voffB);
            PG8_WAIT_V(6); PG8_BAR; PG8_MMA(1, 1, At, B1); PG8_BAR;
        }
        E(acc, cur, wr, wc, fr, fq);
        if (!has_next) break;
#pragma unroll
        for (int a = 0; a < 2; ++a)
#pragma unroll
            for (int b = 0; b < 2; ++b)
#pragma unroll
                for (int m = 0; m < 4; ++m)
#pragma unroll
                    for (int n = 0; n < 2; ++n) acc[a][b][m][n] = (f32x4){0.f, 0.f, 0.f, 0.f};
        cur = nxt; cA = nA; cB = nB; ++ui;
    }
    PG8_WAIT_V(0);
    if (wr == 0) PG8_BAR;
    PG8_BAR;
#undef PG8_SA
#undef PG8_SB
#undef PG8_STAGE
#undef PG8_LDA
#undef PG8_LDB
#undef PG8_MMA
#undef PG8_WAIT_V
#undef PG8_WAIT_L
#undef PG8_BAR
#undef PG8_SCHED
}

struct EpiProj {
    static constexpr bool PERM = true;
    bf16_t* O; int ldc;
    __device__ __forceinline__ void operator()(const f32x4 (&acc)[2][2][4][2], const Unit& u, int wr, int wc, int fr, int fq) const {
        const int row0 = u.pm * BM + wr * 64 + fr, col0 = u.pn * BM + wc * 32 + 8 * fq;
#pragma unroll
        for (int ai = 0; ai < 2; ++ai)
#pragma unroll
            for (int m = 0; m < 4; ++m) { bf16_t* rowp = O + (size_t)(row0 + ai * HALF + m * 16) * ldc + col0;
#pragma unroll
                for (int bj = 0; bj < 2; ++bj) { const f32x4 v0 = acc[ai][bj][m][0], v1 = acc[ai][bj][m][1];
                    u32x4 w; w.x = pk2(v0[0], v0[1]); w.y = pk2(v0[2], v0[3]); w.z = pk2(v1[0], v1[1]); w.w = pk2(v1[2], v1[3]);
                    *(u32x4*)(rowp + bj * HALF) = w; } }
    }
};
struct EpiResid {
    static constexpr bool PERM = false;
    float* H;
    __device__ __forceinline__ void operator()(const f32x4 (&acc)[2][2][4][2], const Unit& u, int wr, int wc, int fr, int fq) const {
        const int row0 = u.pm * BM + wr * 64 + fr, col0 = u.pn * BM + wc * 32 + 4 * fq;
#pragma unroll
        for (int ai = 0; ai < 2; ++ai)
#pragma unroll
            for (int m = 0; m < 4; ++m) { float* rowp = H + (size_t)(row0 + ai * HALF + m * 16) * DM + col0;
#pragma unroll
                for (int bj = 0; bj < 2; ++bj)
#pragma unroll
                    for (int n = 0; n < 2; ++n) { f32x4* p = (f32x4*)(rowp + bj * HALF + n * 16); *p = *p + acc[ai][bj][m][n]; } }
    }
};
struct EpiSwiglu {
    static constexpr bool PERM = true;
    bf16_t* O;
    __device__ __forceinline__ void operator()(const f32x4 (&acc)[2][2][4][2], const Unit& u, int wr, int wc, int fr, int fq) const {
        const int row0 = u.pm * BM + wr * 64 + fr, col0 = u.pn * 128 + wc * 16 + 4 * fq;
#pragma unroll
        for (int ai = 0; ai < 2; ++ai)
#pragma unroll
            for (int m = 0; m < 4; ++m) { bf16_t* rowp = O + (size_t)(row0 + ai * HALF + m * 16) * DFF + col0;
#pragma unroll
                for (int bj = 0; bj < 2; ++bj) { const f32x4 gt = acc[ai][bj][m][0], up = acc[ai][bj][m][1]; float o[4];
#pragma unroll
                    for (int j = 0; j < 4; ++j) o[j] = gt[j] * sigmoidf_(gt[j]) * up[j];
                    u32x2 w; w.x = pk2(o[0], o[1]); w.y = pk2(o[2], o[3]);
                    *(u32x2*)(rowp + bj * 64) = w; } }
    }
};
}

__device__ __forceinline__ void norm_rows(CArgs a, int mode, const float* gain, bf16_t* dst) {
    const int tid = tid_opaque(), wid = tid >> 6, lane = tid & 63;
    float* H = (float*)(a->ws + WS_H);
    f32x4 gv[4];
#pragma unroll
    for (int i = 0; i < 4; ++i) gv[i] = *(const f32x4*)(gain + lane * 4 + 256 * i);
    for (int row = blockIdx.x * 8 + wid; row < MR; row += gridDim.x * 8) {
        const int b = row / TT, t = row - b * TT;
        if (mode == 2 && t < NMETA) continue;
        const float* src = (mode == 0) ? (t < NMETA ? a->in[1] + (size_t)t * DM : a->in[0] + ((size_t)b * SEQ + (t - NMETA)) * DM) : H + (size_t)row * DM;
        f32x4 v[4]; float ss = 0.f;
#pragma unroll
        for (int i = 0; i < 4; ++i) { v[i] = *(const f32x4*)(src + lane * 4 + 256 * i); ss += v[i][0] * v[i][0] + v[i][1] * v[i][1] + v[i][2] * v[i][2] + v[i][3] * v[i][3]; }
        ss = wave_sum(ss);
        const float rs = rsqrtf(ss * (1.0f / DM) + RMS_EPS);
        if (mode == 0) {
#pragma unroll
            for (int i = 0; i < 4; ++i) *(f32x4*)(H + (size_t)row * DM + lane * 4 + 256 * i) = v[i];
        }
        if (mode == 2) {
            float* o = a->out + ((size_t)b * SEQ + (t - NMETA)) * DM;
#pragma unroll
            for (int i = 0; i < 4; ++i) *(f32x4*)(o + lane * 4 + 256 * i) = (v[i] * rs) * gv[i];
        } else {
#pragma unroll
            for (int i = 0; i < 4; ++i) { const f32x4 y = (v[i] * rs) * gv[i]; u32x2 w; w.x = pk2(y[0], y[1]); w.y = pk2(y[2], y[3]);
                *(u32x2*)(dst + (size_t)row * DM + lane * 4 + 256 * i) = w; }
        }
    }
}

template <int KIND> __device__ __forceinline__ float wsrc(CArgs a, int l, int k, int n) {
    if (KIND == 0) {
        if (n < NIN) return a->in[3][((size_t)l * DM + k) * NIN + n];
        if (n < NIN + 32 && l > 0) return a->in[17][((size_t)(l - 1) * DM + k) * 32 + (n - NIN)];
        return 0.f;
    } else if (KIND == 1) {
        return a->in[21][((size_t)l * DM + k) * DM + n];
    } else if (KIND == 2) {
        const int pn = n >> 8, c = n & 255, feat = pn * 128 + ((c >> 3) << 2) + (c & 3), isup = (c >> 2) & 1;
        return a->in[23][((size_t)l * DM + k) * (2 * DFF) + feat + isup * DFF];
    } else if (KIND == 3) {
        return a->in[24][((size_t)l * DFF + k) * DM + n];
    } else {
        const int j = n >> 9, nn = n & 511;
        if (j == 0) return (k < 64) ? a->in[8][((size_t)l * 64 + k) * 512 + nn] : 0.f;
        if (j == 1) return (k >= 64 && k < 128) ? a->in[10][((size_t)l * 64 + (k - 64)) * 512 + nn] : 0.f;
        if (j == 2) return (k >= 128 && k < 288) ? a->in[11][((size_t)l * 160 + (k - 128)) * 512 + nn] : 0.f;
        return (k >= 288 && k < 320 && l > 0) ? a->in[20][((size_t)(l - 1) * 32 + (k - 288)) * 512 + nn] : 0.f;
    }
}
template <int KIND> __device__ __forceinline__ void conv_tile(CArgs a, int l, LAS float* tile, bf16_t* out, int ldo, int n0, int k0) {
    const int tid = tid_opaque(), kk = tid >> 6, nn = tid & 63;
#pragma unroll
    for (int i = 0; i < 8; ++i) tile[(kk + 8 * i) * 65 + nn] = wsrc<KIND>(a, l, k0 + kk + 8 * i, n0 + nn);
    __syncthreads();
    const int n = tid >> 3, kq = tid & 7;
    u32x4 w;
    w.x = pk2(tile[(kq * 8 + 0) * 65 + n], tile[(kq * 8 + 1) * 65 + n]); w.y = pk2(tile[(kq * 8 + 2) * 65 + n], tile[(kq * 8 + 3) * 65 + n]);
    w.z = pk2(tile[(kq * 8 + 4) * 65 + n], tile[(kq * 8 + 5) * 65 + n]); w.w = pk2(tile[(kq * 8 + 6) * 65 + n], tile[(kq * 8 + 7) * 65 + n]);
    *(u32x4*)(out + (size_t)(n0 + n) * ldo + k0 + kq * 8) = w;
    __syncthreads();
}
__device__ __forceinline__ void fold_tile(CArgs a, int l, LAS float* lds, bf16_t* out, int n0, int k0) {
    LAS float* P = lds; LAS float* W = lds + 64 * 128;
    const int tid = tid_opaque(), g = k0 >> 7, c0 = k0 & 127;
    const float* pw = a->in[5] + ((size_t)(l * 4 + g) * 128 + c0) * 128; const float* sc = a->in[6] + (size_t)l * 512 + g * 128;
    const float* wo = a->in[21] + ((size_t)l * DM + g * 128) * DM + n0;
    for (int i = tid; i < 64 * 128; i += 512) { const int d = i & 127; P[i] = pw[i] * sc[d]; }
    for (int i = tid; i < 128 * 64; i += 512) { const int d = i >> 6, n = i & 63; W[i] = wo[(size_t)d * DM + n]; }
    __syncthreads();
    const int n = tid & 63, cq = tid >> 6;
    float acc[8];
#pragma unroll
    for (int j = 0; j < 8; ++j) acc[j] = 0.f;
    for (int d = 0; d < 128; ++d) { const float wv = W[d * 64 + n];
#pragma unroll
        for (int j = 0; j < 8; ++j) acc[j] += P[(cq * 8 + j) * 128 + d] * wv; }
    u32x4 w; w.x = pk2(acc[0], acc[1]); w.y = pk2(acc[2], acc[3]); w.z = pk2(acc[4], acc[5]); w.w = pk2(acc[6], acc[7]);
    *(u32x4*)(out + (size_t)(n0 + n) * DM + k0 + cq * 8) = w;
    __syncthreads();
}
__device__ __forceinline__ void weight_prep(CArgs a, int l, LAS float* lds) {
    bf16_t* WC = (bf16_t*)(a->ws + WS_WC); bf16_t* WO = (bf16_t*)(a->ws + WS_WOUT); bf16_t* WGU = (bf16_t*)(a->ws + WS_WGU);
    bf16_t* WDN = (bf16_t*)(a->ws + WS_WDN); bf16_t* WL = (bf16_t*)(a->ws + WS_WL);
    for (int ti = blockIdx.x; ti < 3200; ti += gridDim.x) {
        if (ti < 128) { fold_tile(a, l, lds, WO, (ti & 15) * 64, (ti >> 4) * 64); }
        else if (ti < 256) { const int q = ti - 128; conv_tile<1>(a, l, lds, WO, DM, (q & 15) * 64, 512 + (q >> 4) * 64); }
        else if (ti < 896) { const int q = ti - 256; conv_tile<0>(a, l, lds, WC, DM, (q >> 4) * 64, (q & 15) * 64); }
        else if (ti < 2304) { const int q = ti - 896; conv_tile<2>(a, l, lds, WGU, DM, (q >> 4) * 64, (q & 15) * 64); }
        else if (ti < 3008) { const int q = ti - 2304; conv_tile<3>(a, l, lds, WDN, DFF, (q / 44) * 64, (q % 44) * 64); }
        else { const int q = ti - 3008; conv_tile<4>(a, l, lds, WL, KL, (q / 6) * 64, (q % 6) * 64); }
    }
}

__device__ __forceinline__ void unpack8(const u32x4 w, float (&x)[8]) {
    x[0] = bf2f(w.x & 0xffffu); x[1] = bf2f(w.x >> 16); x[2] = bf2f(w.y & 0xffffu); x[3] = bf2f(w.y >> 16);
    x[4] = bf2f(w.z & 0xffffu); x[5] = bf2f(w.z >> 16); x[6] = bf2f(w.w & 0xffffu); x[7] = bf2f(w.w >> 16);
}
__device__ __forceinline__ void prep_phase(CArgs a, int l) {
    const bf16_t* PROJ = (const bf16_t*)(a->ws + WS_R1);
    bf16_t* MIX = (bf16_t*)((unsigned char*)a->out + DO_MIX); bf16_t* LIN = (bf16_t*)((unsigned char*)a->out + DO_LIN);
    const int tid = tid_opaque(), gt = blockIdx.x * 512 + tid, nthr = gridDim.x * 512;
    for (int it = gt; it < (MR / 16) * 64; it += nthr) {
        const int run = it >> 6, c0 = (it & 63) * 8, row0 = run * 16, t0 = row0 % TT, win = 2 << (c0 >> 7);
        float s[8], x[8], y[8];
#pragma unroll
        for (int e = 0; e < 8; ++e) s[e] = 0.f;
        const int pre = (t0 < win) ? t0 : win;
        for (int q = 1; q <= pre; ++q) { unpack8(*(const u32x4*)(PROJ + (size_t)(row0 - q) * NPROJ + c0), x);
#pragma unroll
            for (int e = 0; e < 8; ++e) s[e] += x[e]; }
        for (int i = 0; i < 16; ++i) {
            const int row = row0 + i, t = t0 + i;
            unpack8(*(const u32x4*)(PROJ + (size_t)row * NPROJ + c0), x);
            if (t >= win) { unpack8(*(const u32x4*)(PROJ + (size_t)(row - win) * NPROJ + c0), y);
#pragma unroll
                for (int e = 0; e < 8; ++e) s[e] += x[e] - y[e]; }
            else {
#pragma unroll
                for (int e = 0; e < 8; ++e) s[e] += x[e]; }
            const float inv = 1.0f / (float)((t + 1 < win) ? t + 1 : win);
            u32x4 o; o.x = pk2(s[0] * inv - x[0], s[1] * inv - x[1]); o.y = pk2(s[2] * inv - x[2], s[3] * inv - x[3]);
            o.z = pk2(s[4] * inv - x[4], s[5] * inv - x[5]); o.w = pk2(s[6] * inv - x[6], s[7] * inv - x[7]);
            *(u32x4*)(MIX + (size_t)row * DM + c0) = o;
        }
    }
    for (int it = gt; it < MR * 48; it += nthr) {
        const int row = it / 48, cb = (it - row * 48) * 8, t = row % TT;
        u32x4 o = (u32x4){0u, 0u, 0u, 0u};
        if (cb < 320) {
            float xc[8], xp[8], mu[8], y[8];
            unpack8(*(const u32x4*)(PROJ + (size_t)row * NPROJ + 2048 + cb), xc);
            u32x4 wp = (u32x4){0u, 0u, 0u, 0u};
            if (t > 0) wp = *(const u32x4*)(PROJ + (size_t)(row - 1) * NPROJ + 2048 + cb);
            unpack8(wp, xp);
            const float* mp = (cb < 288) ? a->in[4] + (size_t)l * NSHIFT + 1536 + cb : a->in[18] + (l > 0 ? (l - 1) * 32 + (cb - 288) : 0);
            const f32x4 m0 = *(const f32x4*)mp, m1 = *(const f32x4*)(mp + 4);
            mu[0] = m0[0]; mu[1] = m0[1]; mu[2] = m0[2]; mu[3] = m0[3]; mu[4] = m1[0]; mu[5] = m1[1]; mu[6] = m1[2]; mu[7] = m1[3];
#pragma unroll
            for (int e = 0; e < 8; ++e) {
                const float sv = xc[e] + (xp[e] - xc[e]) * mu[e];
                y[e] = (cb < 64) ? 1.0f - 2.0f * __builtin_amdgcn_rcpf(1.0f + __builtin_amdgcn_exp2f(sv * 2.88539008f)) : (cb < 128) ? sv : (cb < 288) ? sigmoidf_(sv) : sv;
            }
            o.x = pk2(y[0], y[1]); o.y = pk2(y[2], y[3]); o.z = pk2(y[4], y[5]); o.w = pk2(y[6], y[7]);
        }
        *(u32x4*)(LIN + (size_t)row * KL + cb) = o;
    }
}

constexpr int TC = 16, NCH = TT / TC;
constexpr int SB_A = 0, SB_Q = 1, SB_W = 2, SB_B = 3, SB_K = 4, SB_V = 5, SB_G = 6, SB_Y = 7, SBUF = 8 * TC * 64 + TC * 4;
__device__ __forceinline__ void scan_phase(CArgs a, int l, LAS float* lds) {
    const int bid = blockIdx.x; if (bid >= BATCH * 8) return;
    const int b = bid >> 3, h = bid & 7, tid = tid_opaque(), wid = __builtin_amdgcn_readfirstlane(tid >> 6), lane = tid & 63;
    const bf16_t* PROJ = (const bf16_t*)(a->ws + WS_R1); const bf16_t* LO = (const bf16_t*)(a->ws + WS_LO);
    bf16_t* VF = (bf16_t*)((unsigned char*)a->out + DO_VF); bf16_t* MIX = (bf16_t*)((unsigned char*)a->out + DO_MIX);
    if (wid < 4) {
        __builtin_amdgcn_s_setprio(2);
        const int rp = wid * 16 + (lane >> 3) * 2, seg = lane & 7;
        f32x2 S0[4], S1[4];
#pragma unroll
        for (int j = 0; j < 4; ++j) { S0[j] = (f32x2){0.f, 0.f}; S1[j] = (f32x2){0.f, 0.f}; }
        for (int it = 0; it < NCH + 2; ++it) {
            if (it >= 1 && it <= NCH) {
                LAS float* buf = lds + ((it - 1) & 1) * SBUF;
#pragma unroll 4
                for (int tl = 0; tl < TC; ++tl) {
                    const LAS float* base = buf + tl * 64 + seg * 8;
                    const f32x4 a0 = *(const LAS f32x4*)(base + SB_A * TC * 64), a1 = *(const LAS f32x4*)(base + SB_A * TC * 64 + 4);
                    const f32x4 q0 = *(const LAS f32x4*)(base + SB_Q * TC * 64), q1 = *(const LAS f32x4*)(base + SB_Q * TC * 64 + 4);
                    const f32x4 w0 = *(const LAS f32x4*)(base + SB_W * TC * 64), w1 = *(const LAS f32x4*)(base + SB_W * TC * 64 + 4);
                    const f32x4 b0 = *(const LAS f32x4*)(base + SB_B * TC * 64), b1 = *(const LAS f32x4*)(base + SB_B * TC * 64 + 4);
                    const f32x4 k0 = *(const LAS f32x4*)(base + SB_K * TC * 64), k1 = *(const LAS f32x4*)(base + SB_K * TC * 64 + 4);
                    const f32x2 vv = *(const LAS f32x2*)(buf + SB_V * TC * 64 + tl * 64 + rp);
                    const f32x2 sc = *(const LAS f32x2*)(buf + 8 * TC * 64 + tl * 4);
                    const f32x2 av[4] = {{a0[0], a0[1]}, {a0[2], a0[3]}, {a1[0], a1[1]}, {a1[2], a1[3]}};
                    const f32x2 qv[4] = {{q0[0], q0[1]}, {q0[2], q0[3]}, {q1[0], q1[1]}, {q1[2], q1[3]}};
                    const f32x2 wv[4] = {{w0[0], w0[1]}, {w0[2], w0[3]}, {w1[0], w1[1]}, {w1[2], w1[3]}};
                    const f32x2 bv[4] = {{b0[0], b0[1]}, {b0[2], b0[3]}, {b1[0], b1[1]}, {b1[2], b1[3]}};
                    const f32x2 kv[4] = {{k0[0], k0[1]}, {k0[2], k0[3]}, {k1[0], k1[1]}, {k1[2], k1[3]}};
                    f32x2 pa0 = S0[0] * av[0], pa1 = S1[0] * av[0], pq0 = S0[0] * qv[0], pq1 = S1[0] * qv[0];
#pragma unroll
                    for (int j = 1; j < 4; ++j) { pa0 += S0[j] * av[j]; pa1 += S1[j] * av[j]; pq0 += S0[j] * qv[j]; pq1 += S1[j] * qv[j]; }
                    const float sa0 = allred8(pa0.x + pa0.y), sa1 = allred8(pa1.x + pa1.y), y0 = allred8(pq0.x + pq0.y), y1 = allred8(pq1.x + pq1.y);
                    const f32x2 sav0 = {sa0, sa0}, sav1 = {sa1, sa1}, vv0 = {vv.x, vv.x}, vv1 = {vv.y, vv.y};
#pragma unroll
                    for (int j = 0; j < 4; ++j) { S0[j] = S0[j] * wv[j] + sav0 * bv[j] + vv0 * kv[j]; S1[j] = S1[j] * wv[j] + sav1 * bv[j] + vv1 * kv[j]; }
                    if (seg == 0) *(LAS f32x2*)(buf + SB_Y * TC * 64 + tl * 64 + rp) = (f32x2){y0 + sa0 * sc.x + vv.x * sc.y, y1 + sa1 * sc.x + vv.y * sc.y};
                }
            }
            __syncthreads();
        }
        __builtin_amdgcn_s_setprio(0);
    } else {
        const int hw = wid - 4, ch = h * 64 + lane;
        const float mu_r = a->in[4][(size_t)l * NSHIFT + ch], mu_k = a->in[4][(size_t)l * NSHIFT + 512 + ch], mu_v = a->in[4][(size_t)l * NSHIFT + 1024 + ch];
        const float w0_c = a->in[7][l * 512 + ch], a0_c = a->in[9][l * 512 + ch], v0_c = (l > 0) ? a->in[19][(l - 1) * 512 + ch] : 0.f;
        const float kk_c = a->in[12][l * 512 + ch], ka_c = a->in[13][l * 512 + ch], rk_c = a->in[14][l * 512 + ch], gw = a->in[15][l * 512 + ch], gb = a->in[16][l * 512 + ch];
        unsigned short ld[4][11];
#define SCAN_LOAD(c) do { _Pragma("unroll") for (int p = 0; p < 4; ++p) { const int t = (c) * TC + p * 4 + hw; const size_t m = (size_t)b * TT + t; \
        const bf16_t* pr = PROJ + m * NPROJ + 512 + ch; ld[p][0] = pr[0]; ld[p][1] = pr[512]; ld[p][2] = pr[1024]; \
        if (t > 0) { ld[p][3] = pr[-NPROJ]; ld[p][4] = pr[512 - NPROJ]; ld[p][5] = pr[1024 - NPROJ]; } else { ld[p][3] = 0; ld[p][4] = 0; ld[p][5] = 0; } \
        const bf16_t* po = LO + m * NL + ch; ld[p][6] = po[0]; ld[p][7] = po[512]; ld[p][8] = po[1024]; ld[p][9] = po[1536]; \
        ld[p][10] = (l > 0) ? VF[m * 512 + ch] : (unsigned short)0; } } while (0)
        SCAN_LOAD(0);
        for (int it = 0; it < NCH + 2; ++it) {
            LAS float* buf = lds + (it & 1) * SBUF;
            if (it >= 2) {
#pragma unroll
                for (int p = 0; p < 4; ++p) {
                    const int tl = p * 4 + hw; const size_t m = (size_t)b * TT + (it - 2) * TC + tl;
                    const float y = buf[SB_Y * TC * 64 + tl * 64 + lane];
                    const float mean = wave_sum(y) * (1.0f / 64.0f), d = y - mean, var = wave_sum(d * d) * (1.0f / 64.0f);
                    const float o = (d * rsqrtf(var + GN_EPS) * gw + gb + buf[8 * TC * 64 + tl * 4 + 2] * buf[SB_V * TC * 64 + tl * 64 + lane]) * buf[SB_G * TC * 64 + tl * 64 + lane];
                    MIX[m * DM + 512 + ch] = (bf16_t)f2bf(o);
                }
            }
            if (it < NCH) {
#pragma unroll
                for (int p = 0; p < 4; ++p) {
                    const int tl = p * 4 + hw; const size_t m = (size_t)b * TT + it * TC + tl;
                    const float rc = bf2f(ld[p][0]), kc = bf2f(ld[p][1]), vc = bf2f(ld[p][2]), rpv = bf2f(ld[p][3]), kp = bf2f(ld[p][4]), vp = bf2f(ld[p][5]);
                    const float e = sigmoidf_(w0_c + bf2f(ld[p][6])) * 0.60653066f, av = sigmoidf_(a0_c + bf2f(ld[p][7])), gv = bf2f(ld[p][8]), vm = sigmoidf_(v0_c + bf2f(ld[p][9]));
                    const float r = rc + (rpv - rc) * mu_r, k = kc + (kp - kc) * mu_k; float v = vc + (vp - vc) * mu_v;
                    if (l == 0) VF[m * 512 + ch] = (bf16_t)f2bf(v); else { const float vf = bf2f(ld[p][10]); v = v + (vf - v) * vm; }
                    float kk = k * kk_c; const float n2 = wave_sum(kk * kk); kk = kk * rsqrtf(fmaxf(n2, 1e-24f));
                    const float k2 = k * (1.0f + (av - 1.0f) * ka_c), w = __expf(-e), bb = kk * av;
                    const float br = wave_sum(bb * r), kr = wave_sum(k2 * r), cf = wave_sum(r * k2 * rk_c);
                    buf[SB_A * TC * 64 + tl * 64 + lane] = -kk; buf[SB_Q * TC * 64 + tl * 64 + lane] = w * r; buf[SB_W * TC * 64 + tl * 64 + lane] = w;
                    buf[SB_B * TC * 64 + tl * 64 + lane] = bb; buf[SB_K * TC * 64 + tl * 64 + lane] = k2; buf[SB_V * TC * 64 + tl * 64 + lane] = v; buf[SB_G * TC * 64 + tl * 64 + lane] = gv;
                    if (lane < 3) buf[8 * TC * 64 + tl * 4 + lane] = (lane == 0) ? br : (lane == 1) ? kr : cf;
                }
                if (it + 1 < NCH) SCAN_LOAD(it + 1);
            }
            __syncthreads();
        }
#undef SCAN_LOAD
    }
}

__global__ void __launch_bounds__(512, 2) mega(Args a_unused) {
    extern __shared__ __attribute__((aligned(16))) unsigned char shm[];
    LAS unsigned char* lds = (LAS unsigned char*)shm;
    cg::grid_group grid = cg::this_grid();
    CArgs a0 = (CArgs)__builtin_amdgcn_kernarg_segment_ptr();
    const int ph_lo = a0->ph_lo, ph_hi = a0->ph_hi;
    for (int ph = ph_lo; ph < ph_hi; ++ph) {
        if (ph > ph_lo) grid.sync();
        CArgs a = a0; asm volatile("" : "+s"(a));
        bf16_t* HN = (bf16_t*)(a->ws + WS_LO);
        if (ph == NPH - 1) { norm_rows(a, 2, a->in[25], nullptr); continue; }
        const int l = ph / 9, s = ph % 9;
        if (s == 0) {
#ifndef SKIP_S0
 norm_rows(a, l == 0 ? 0 : 1, a->in[2] + (size_t)l * DM, HN); weight_prep(a, l, (LAS float*)lds);
#ifdef PROBE_A2
 __syncthreads(); weight_prep(a, l, (LAS float*)lds);
#endif
#endif
 }
        else if (s == 1 || s == 3) {
            pg8::Gemm g{s == 1 ? HN : (const bf16_t*)((unsigned char*)a->out + DO_LIN), (const bf16_t*)(a->ws + (s == 1 ? WS_WC : WS_WL)), MR, s == 1 ? NPROJ : NL, s == 1 ? DM : KL};
            pg8::StaticOrder S; S.init(MR, g.N, gridDim.x, blockIdx.x);
            pg8::EpiProj E{(bf16_t*)(a->ws + (s == 1 ? WS_R1 : WS_LO)), g.N};
#ifndef SKIP_S1
            pg8::gemm_phase(lds, g, S, E);
#endif
        }
        else if (s == 2) {
#ifndef SKIP_S2
 prep_phase(a, l);
#ifdef PROBE_C2
 __syncthreads(); prep_phase(a, l);
#endif
#endif
 }
        else if (s == 4) {
#ifndef SKIP_S4
 scan_phase(a, l, (LAS float*)lds);
#endif
 }
        else if (s == 5 || s == 8) {
            pg8::Gemm g{s == 5 ? (const bf16_t*)((unsigned char*)a->out + DO_MIX) : (const bf16_t*)(a->ws + WS_R1), (const bf16_t*)(a->ws + (s == 5 ? WS_WOUT : WS_WDN)), MR, DM, s == 5 ? DM : DFF};
            pg8::StaticOrder S; S.init(MR, DM, gridDim.x, blockIdx.x);
            pg8::EpiResid E{(float*)(a->ws + WS_H)};
#ifndef SKIP_S5
 pg8::gemm_phase(lds, g, S, E);
#endif

        }
        else if (s == 6) norm_rows(a, 1, a->in[22] + (size_t)l * DM, HN);
        else {
            pg8::Gemm g{HN, (const bf16_t*)(a->ws + WS_WGU), MR, 2 * DFF, DM}; pg8::StaticOrder S; S.init(MR, 2 * DFF, gridDim.x, blockIdx.x);
            pg8::EpiSwiglu E{(bf16_t*)(a->ws + WS_R1)};
#ifndef SKIP_S7
 pg8::gemm_phase(lds, g, S, E);
#endif

        }
    }
}

extern "C" void kernel_launch(void* const* d_in, const int* in_sizes, int n_in, void* d_out, int out_size, void* d_ws, size_t ws_size, hipStream_t stream) {
    static int grid = 0;
    if (grid == 0) {
        if (n_in != 26 || out_size != BATCH * SEQ * DM || ws_size < WS_END) { fprintf(stderr, "kernel_launch: unexpected shapes (n_in %d out %d ws %zu need %zu)\n", n_in, out_size, ws_size, (size_t)WS_END); grid = -1; return; }
        int dev = 0, cus = 0, per_cu = 0;
        hipGetDevice(&dev);
        hipDeviceGetAttribute(&cus, hipDeviceAttributeMultiprocessorCount, dev);
        if (hipFuncSetAttribute((const void*)mega, hipFuncAttributeMaxDynamicSharedMemorySize, LDS_BYTES) != hipSuccess) { fprintf(stderr, "kernel_launch: hipFuncSetAttribute failed\n"); grid = -1; return; }
        hipOccupancyMaxActiveBlocksPerMultiprocessor(&per_cu, (const void*)mega, 512, LDS_BYTES);
        if (per_cu < 1) { fprintf(stderr, "kernel_launch: occupancy query says %d blocks per CU\n", per_cu); per_cu = 1; }
        (void)hipGetLastError();
        grid = cus;
        fprintf(stderr, "kernel_launch: grid %d (per_cu %d)\n", grid, per_cu);
    }
    if (grid < 0) return;
    Args a{};
    for (int i = 0; i < 26; ++i) a.in[i] = (const float*)d_in[i];
    a.out = (float*)d_out; a.ws = (unsigned char*)d_ws;
#if MK_MULTI
    for (int ph = 0; ph < NPH; ++ph) {
        a.ph_lo = ph; a.ph_hi = ph + 1;
        void* args[] = {&a};
        hipError_t e = hipLaunchCooperativeKernel((const void*)mega, dim3(grid), dim3(512), args, LDS_BYTES, stream);
        if (e != hipSuccess) { fprintf(stderr, "cooperative launch failed: %s\n", hipGetErrorString(e)); break; }
    }
#else
    a.ph_lo = 0; a.ph_hi = NPH;
    void* args[] = {&a};
    hipError_t e = hipLaunchCooperativeKernel((const void*)mega, dim3(grid), dim3(512), args, LDS_BYTES, stream);
    if (e != hipSuccess) fprintf(stderr, "cooperative launch failed: %s (grid %d)\n", hipGetErrorString(e), grid);
#endif
}
```

```cpp
#include <hip/hip_runtime.h>
#include <hip/hip_cooperative_groups.h>
#include <cstdio>
#include <cstdint>
namespace cg = cooperative_groups;

#ifndef MK_MULTI
#define MK_MULTI 0
#endif

#define LAS __attribute__((address_space(3)))
typedef unsigned short bf16_t;
typedef short bf16x8 __attribute__((ext_vector_type(8)));
typedef float f32x4 __attribute__((ext_vector_type(4)));
typedef float f32x2 __attribute__((ext_vector_type(2)));
typedef unsigned u32x4 __attribute__((ext_vector_type(4)));
typedef unsigned u32x2 __attribute__((ext_vector_type(2)));

constexpr int DM = 1024, BATCH = 16, SEQ = 2048, DEPTH = 4, NMETA = 16, TT = SEQ + NMETA  , MR = BATCH * TT  ;
constexpr int NIN = 2336, NSHIFT = 1824, DFF = 2816, NPROJ = 2560  , KL = 384  , NL = 2048;
constexpr float RMS_EPS = 1e-6f, GN_EPS = 64e-5f;
constexpr int LDS_BYTES = 131072 + 16384;
constexpr int NPH = DEPTH * 7 + 2;

constexpr size_t WB_WC = 0;
constexpr size_t WB_WOUT = WB_WC + (size_t)NPROJ * DM * 2;
constexpr size_t WB_WGU = WB_WOUT + (size_t)DM * DM * 2;
constexpr size_t WB_WDN = WB_WGU + (size_t)2 * DFF * DM * 2;
constexpr size_t WB_WL = WB_WDN + (size_t)DM * DFF * 2;
constexpr size_t WB_SIZE = WB_WL + (size_t)NL * KL * 2;
constexpr size_t WS_WB = 4096;
constexpr size_t WS_SS = WS_WB + 2 * WB_SIZE;
constexpr size_t WS_H = WS_SS + 2 * (size_t)MR * 64;
constexpr size_t WS_R1 = WS_H + (size_t)MR * DM * 4;
constexpr size_t WS_LO = WS_R1 + (size_t)MR * DFF * 2;
constexpr size_t WS_END = WS_LO + (size_t)MR * NL * 2;
static_assert(WS_END <= 536870912, "workspace map");
constexpr size_t DO_MIX = 0;
constexpr size_t DO_VF = DO_MIX + (size_t)MR * DM * 2;
constexpr size_t DO_LIN = DO_VF + (size_t)MR * 512 * 2;
static_assert(DO_LIN + (size_t)MR * KL * 2 <= (size_t)BATCH * SEQ * DM * 4, "d_out scratch");

struct Args { const float* in[26]; float* out; unsigned char* ws; int ph_lo, ph_hi; };
typedef const __attribute__((address_space(4))) Args* CArgs;

__device__ __forceinline__ float bf2f(unsigned b) { return __uint_as_float(b << 16); }
__device__ __forceinline__ unsigned f2bf(float f) { unsigned u = __float_as_uint(f); return (u + 0x7fffu + ((u >> 16) & 1u)) >> 16; }
__device__ __forceinline__ unsigned pk2(float lo, float hi) { unsigned r; asm volatile("v_cvt_pk_bf16_f32 %0, %1, %2" : "=v"(r) : "v"(lo), "v"(hi)); return r; }
__device__ __forceinline__ float sigmoidf_(float x) { return __builtin_amdgcn_rcpf(1.0f + __builtin_amdgcn_exp2f(x * -1.44269504f)); }
template <int CTRL> __device__ __forceinline__ float dppf(float x) { return __int_as_float(__builtin_amdgcn_update_dpp(0, __float_as_int(x), CTRL, 0xF, 0xF, true)); }
__device__ __forceinline__ float allred8(float x) { x += dppf<0xB1>(x); x += dppf<0x4E>(x); x += dppf<0x141>(x); return x; }
#define DPP_ADD(r, ctl) "v_add_f32_dpp " r ", " r ", " r " " ctl " row_mask:0xf bank_mask:0xf\n\t"
__device__ __forceinline__ void allred8x4(float& a, float& b, float& c, float& d) {
    asm volatile("s_nop 1\n\t"
        DPP_ADD("%0", "quad_perm:[1,0,3,2]") DPP_ADD("%1", "quad_perm:[1,0,3,2]") DPP_ADD("%2", "quad_perm:[1,0,3,2]") DPP_ADD("%3", "quad_perm:[1,0,3,2]")
        DPP_ADD("%0", "quad_perm:[2,3,0,1]") DPP_ADD("%1", "quad_perm:[2,3,0,1]") DPP_ADD("%2", "quad_perm:[2,3,0,1]") DPP_ADD("%3", "quad_perm:[2,3,0,1]")
        DPP_ADD("%0", "row_half_mirror") DPP_ADD("%1", "row_half_mirror") DPP_ADD("%2", "row_half_mirror") DPP_ADD("%3", "row_half_mirror")
        : "+v"(a), "+v"(b), "+v"(c), "+v"(d));
}
__device__ __forceinline__ float rows_to_wave(float x) {
    const int xi = __float_as_int(x);
    return (__int_as_float(__builtin_amdgcn_readlane(xi, 0)) + __int_as_float(__builtin_amdgcn_readlane(xi, 16))) + (__int_as_float(__builtin_amdgcn_readlane(xi, 32)) + __int_as_float(__builtin_amdgcn_readlane(xi, 48)));
}
__device__ __forceinline__ float wave_sum(float x) {
    asm volatile("s_nop 1\n\t" DPP_ADD("%0", "quad_perm:[1,0,3,2]") "s_nop 1\n\t" DPP_ADD("%0", "quad_perm:[2,3,0,1]") "s_nop 1\n\t" DPP_ADD("%0", "row_half_mirror") "s_nop 1\n\t" DPP_ADD("%0", "row_mirror") : "+v"(x));
    return rows_to_wave(x);
}
__device__ __forceinline__ void wave_sum3(float& a, float& b, float& c) {
    asm volatile("s_nop 1\n\t"
        DPP_ADD("%0", "quad_perm:[1,0,3,2]") DPP_ADD("%1", "quad_perm:[1,0,3,2]") DPP_ADD("%2", "quad_perm:[1,0,3,2]")
        DPP_ADD("%0", "quad_perm:[2,3,0,1]") DPP_ADD("%1", "quad_perm:[2,3,0,1]") DPP_ADD("%2", "quad_perm:[2,3,0,1]")
        DPP_ADD("%0", "row_half_mirror") DPP_ADD("%1", "row_half_mirror") DPP_ADD("%2", "row_half_mirror")
        DPP_ADD("%0", "row_mirror") DPP_ADD("%1", "row_mirror") DPP_ADD("%2", "row_mirror")
        : "+v"(a), "+v"(b), "+v"(c));
    a = rows_to_wave(a); b = rows_to_wave(b); c = rows_to_wave(c);
}
__device__ __forceinline__ int tid_opaque() { int t = threadIdx.x; asm volatile("" : "+v"(t)); return t; }

__device__ __forceinline__ float row_rs(const float* ssp, int row) {
    const f32x4* p = (const f32x4*)(ssp + (size_t)row * 16); const f32x4 a = p[0], b = p[1], c = p[2], d = p[3];
    const f32x4 t = (a + b) + (c + d);
    return rsqrtf(((t[0] + t[1]) + (t[2] + t[3])) * (1.0f / DM) + RMS_EPS);
}
namespace pg8 {
constexpr int BM = 256, BK = 64, HALF = 128, HTB = HALF * BK * 2, STAGE_BYTES = 8 * HTB, NXCD = 8, WGM = 8;
__host__ __device__ __forceinline__ int lds_byte(int r, int c) { const int st = (r >> 4) * 2 + (c >> 5), rr = r & 15, cc = c & 31, ob = rr * 64 + cc * 2; return st * 1024 + (ob ^ (((ob >> 9) & 1) << 5)); }
__host__ __device__ __forceinline__ void stage_rc(int b, int& R, int& C) { const int st = b / 1024, sb = b % 1024, swz = sb ^ (((sb >> 9) & 1) << 5); R = (st >> 1) * 16 + swz / 64; C = (st & 1) * 32 + (swz % 64) / 2; }
__host__ __device__ __forceinline__ int perm32(int rho) { const int n = rho >> 4, i = rho & 15; return 8 * (i >> 2) + 4 * n + (i & 3); }
struct Unit { int pm, pn; };
struct Gemm { const bf16_t* A; const bf16_t* Bt; int M, N, K; };
struct StaticOrder {
    int nM, nN, nwg, G, c;
    __device__ void init(int M, int N, int G_, int c_) { nM = M / BM; nN = N / BM; nwg = nM * nN; G = G_; c = c_; }
    __device__ bool next(int i, Unit& u) const {
        const long L = (long)i * G + c; if (L >= nwg) return false;
        int wgid = (int)L; { const int q = nwg / NXCD, r = nwg % NXCD, xcd = wgid % NXCD, off = wgid / NXCD; wgid = (xcd < r ? xcd * (q + 1) : r * (q + 1) + (xcd - r) * q) + off; }
        const int nig = WGM * nN, gid = wgid / nig, fm = gid * WGM, gsz = (nM - fm) < WGM ? (nM - fm) : WGM;
        u.pm = fm + ((wgid % nig) % gsz); u.pn = (wgid % nig) / gsz; return true;
    }
};
template <class Epi>
__device__ __forceinline__ void gemm_phase(LAS unsigned char* lds, const Gemm g, const StaticOrder& S, const Epi& E) {
    int tid_ = threadIdx.x; asm volatile("" : "+v"(tid_));
    const int tid = tid_, wid = __builtin_amdgcn_readfirstlane(tid >> 6), lane = tid & 63, wr = wid >> 2, wc = wid & 3, fr = lane & 15, fq = lane >> 4;
    const int K = g.K, nt = K / BK;
    unsigned voffA[2], voffB[2];
#pragma unroll
    for (int i = 0; i < 2; ++i) { int R, C; stage_rc(tid * 16 + i * 8192, R, C); const int Rb = Epi::PERM ? ((R & ~31) + perm32(R & 31)) : R;
        voffA[i] = (unsigned)(R * K + C) * 2u; voffB[i] = (unsigned)(Rb * K + C) * 2u; }
    const size_t kstep = (size_t)(BK * 2);
    const size_t hstep = (size_t)HALF * K * 2;
    const size_t tstep = 2 * hstep;
    const unsigned ldsw = (unsigned)wid * 1024u;
    const int aoff = lds_byte(wr * 64 + fr, fq * 8), boff = lds_byte(wc * 32 + fr, fq * 8);
#define PG8_SA(b, h) (((b) * 2 + (h)) * HTB)
#define PG8_SB(b, h) ((4 + (b) * 2 + (h)) * HTB)
#define PG8_STAGE(bufoff, gbase, voff) do { _Pragma("unroll") for (int _i = 0; _i < 2; ++_i) \
        __builtin_amdgcn_global_load_lds((const unsigned*)((const char*)(gbase) + (voff)[_i]), (LAS unsigned*)(lds + (bufoff) + ldsw + _i * 8192), 16, 0, 0); } while (0)
#define PG8_LDA(dst, b, h) do { _Pragma("unroll") for (int m = 0; m < 4; ++m) _Pragma("unroll") for (int k = 0; k < 2; ++k) dst[m][k] = *(const LAS bf16x8*)(lds + PG8_SA(b, h) + aoff + m * 2048 + k * 1024); } while (0)
#define PG8_LDB(dst, b, h) do { _Pragma("unroll") for (int n = 0; n < 2; ++n) _Pragma("unroll") for (int k = 0; k < 2; ++k) dst[n][k] = *(const LAS bf16x8*)(lds + PG8_SB(b, h) + boff + n * 2048 + k * 1024); } while (0)
#define PG8_MMA(ai, bj, At, Bt) do { __builtin_amdgcn_s_setprio(1); _Pragma("unroll") for (int m = 0; m < 4; ++m) _Pragma("unroll") for (int n = 0; n < 2; ++n) _Pragma("unroll") for (int k = 0; k < 2; ++k) \
        acc[ai][bj][m][n] = __builtin_amdgcn_mfma_f32_16x16x32_bf16(Bt[n][k], At[m][k], acc[ai][bj][m][n], 0, 0, 0); __builtin_amdgcn_s_setprio(0); } while (0)
#define PG8_WAIT_V(n) asm volatile("s_waitcnt vmcnt(" #n ")" ::: "memory")
#define PG8_WAIT_L(n) asm volatile("s_waitcnt lgkmcnt(" #n ")" ::: "memory")
#define PG8_BAR __builtin_amdgcn_s_barrier()
#define PG8_SCHED __builtin_amdgcn_sched_barrier(0)
    Unit cur, nxt; int ui = 0;
    if (!S.next(0, cur)) return;
    f32x4 acc[2][2][4][2];
#pragma unroll
    for (int a = 0; a < 2; ++a)
#pragma unroll
        for (int b = 0; b < 2; ++b)
#pragma unroll
            for (int m = 0; m < 4; ++m)
#pragma unroll
                for (int n = 0; n < 2; ++n) acc[a][b][m][n] = (f32x4){0.f, 0.f, 0.f, 0.f};
    bf16x8 At[4][2], B0[2][2], B1[2][2];
    const char* cA = (const char*)g.A + (size_t)cur.pm * tstep; const char* cB = (const char*)g.Bt + (size_t)cur.pn * tstep;
    PG8_STAGE(PG8_SB(0, 0), cB, voffB); PG8_STAGE(PG8_SA(0, 0), cA, voffA); PG8_STAGE(PG8_SB(0, 1), cB + hstep, voffB); PG8_STAGE(PG8_SA(0, 1), cA + hstep, voffA);
    if (wr == 1) PG8_BAR;
    PG8_WAIT_V(4); PG8_BAR;
    PG8_STAGE(PG8_SB(1, 0), cB + kstep, voffB); PG8_STAGE(PG8_SA(1, 0), cA + kstep, voffA); PG8_STAGE(PG8_SB(1, 1), cB + hstep + kstep, voffB);
    PG8_WAIT_V(6); PG8_BAR;
    for (;;) {
        const bool has_next = S.next(ui + 1, nxt);
        const char* nA = has_next ? (const char*)g.A + (size_t)nxt.pm * tstep : cA; const char* nB = has_next ? (const char*)g.Bt + (size_t)nxt.pn * tstep : cB;
        for (int t = 0; t < nt; t += 2) {
            const bool last = (t == nt - 2);
            const char* a1 = cA + (size_t)(t + 1) * kstep;
            const char* a2 = last ? nA : cA + (size_t)(t + 2) * kstep; const char* b2 = last ? nB : cB + (size_t)(t + 2) * kstep;
            const char* a3 = a2 + kstep; const char* b3 = b2 + kstep;
            PG8_LDB(B0, 0, 0); PG8_SCHED; PG8_LDA(At, 0, 0); PG8_STAGE(PG8_SA(1, 1), a1 + hstep, voffA);
            PG8_WAIT_L(8); PG8_BAR; PG8_WAIT_L(0); PG8_MMA(0, 0, At, B0); PG8_BAR; PG8_SCHED;
            PG8_LDB(B1, 0, 1); PG8_STAGE(PG8_SB(0, 0), b2, voffB);
            PG8_BAR; PG8_WAIT_L(0); PG8_MMA(0, 1, At, B1); PG8_BAR;
            PG8_LDA(At, 0, 1); PG8_STAGE(PG8_SA(0, 0), a2, voffA);
            PG8_BAR; PG8_WAIT_L(0); PG8_MMA(1, 0, At, B0); PG8_BAR; PG8_SCHED;
            PG8_STAGE(PG8_SB(0, 1), b2 + hstep, voffB);
            PG8_WAIT_V(6); PG8_BAR; PG8_MMA(1, 1, At, B1); PG8_BAR;
            PG8_LDB(B0, 1, 0); PG8_SCHED; PG8_LDA(At, 1, 0); PG8_STAGE(PG8_SA(0, 1), a2 + hstep, voffA);
            PG8_WAIT_L(8); PG8_BAR; PG8_WAIT_L(0); PG8_MMA(0, 0, At, B0); PG8_BAR; PG8_SCHED;
            PG8_LDB(B1, 1, 1); PG8_STAGE(PG8_SB(1, 0), b3, voffB);
            PG8_BAR; PG8_WAIT_L(0); PG8_MMA(0, 1, At, B1); PG8_BAR;
            PG8_LDA(At, 1, 1); PG8_STAGE(PG8_SA(1, 0), a3, voffA);
            PG8_BAR; PG8_WAIT_L(0); PG8_MMA(1, 0, At, B0); PG8_BAR; PG8_SCHED;
            PG8_STAGE(PG8_SB(1, 1), b3 + hstep, voffB);
            PG8_WAIT_V(6); PG8_BAR; PG8_MMA(1, 1, At, B1); PG8_BAR;
        }
        E(acc, cur, ui, wr, wc, fr, fq);
        if (!has_next) break;
#pragma unroll
        for (int a = 0; a < 2; ++a)
#pragma unroll
            for (int b = 0; b < 2; ++b)
#pragma unroll
                for (int m = 0; m < 4; ++m)
#pragma unroll
                    for (int n = 0; n < 2; ++n) acc[a][b][m][n] = (f32x4){0.f, 0.f, 0.f, 0.f};
        cur = nxt; cA = nA; cB = nB; ++ui;
    }
    PG8_WAIT_V(0);
    if (wr == 0) PG8_BAR;
    PG8_BAR;
#undef PG8_SA
#undef PG8_SB
#undef PG8_STAGE
#undef PG8_LDA
#undef PG8_LDB
#undef PG8_MMA
#undef PG8_WAIT_V
#undef PG8_WAIT_L
#undef PG8_BAR
#undef PG8_SCHED
}

struct EpiProj {
    static constexpr bool PERM = true;
    bf16_t* O; int ldc; const LAS float* rst;
    __device__ __forceinline__ void operator()(const f32x4 (&acc)[2][2][4][2], const Unit& u, int ui, int wr, int wc, int fr, int fq) const {
        const int row0 = u.pm * BM + wr * 64 + fr, col0 = u.pn * BM + wc * 32 + 8 * fq;
#pragma unroll
        for (int ai = 0; ai < 2; ++ai)
#pragma unroll
            for (int m = 0; m < 4; ++m) { const int row = row0 + ai * HALF + m * 16; bf16_t* rowp = O + (size_t)row * ldc + col0;
                const float rs = rst ? rst[ui * 256 + (row & 255)] : 1.0f;
#pragma unroll
                for (int bj = 0; bj < 2; ++bj) { const f32x4 v0 = acc[ai][bj][m][0] * rs, v1 = acc[ai][bj][m][1] * rs;
                    u32x4 w; w.x = pk2(v0[0], v0[1]); w.y = pk2(v0[2], v0[3]); w.z = pk2(v1[0], v1[1]); w.w = pk2(v1[2], v1[3]);
                    *(u32x4*)(rowp + bj * HALF) = w; } }
    }
};
struct EpiResid {
    static constexpr bool PERM = false;
    float* H; bf16_t* HB; float* ssq;
    __device__ __forceinline__ void operator()(const f32x4 (&acc)[2][2][4][2], const Unit& u, int ui, int wr, int wc, int fr, int fq) const {
        const int row0 = u.pm * BM + wr * 64 + fr, col0 = u.pn * BM + wc * 32 + 4 * fq;
#pragma unroll
        for (int ai = 0; ai < 2; ++ai) {
            f32x4 hv[4][2][2];
#pragma unroll
            for (int m = 0; m < 4; ++m)
#pragma unroll
                for (int bj = 0; bj < 2; ++bj)
#pragma unroll
                    for (int n = 0; n < 2; ++n) hv[m][bj][n] = *(const f32x4*)(H + (size_t)(row0 + ai * HALF + m * 16) * DM + col0 + bj * HALF + n * 16);
            __builtin_amdgcn_sched_barrier(0);
#pragma unroll
            for (int m = 0; m < 4; ++m) { const int row = row0 + ai * HALF + m * 16; float* rowp = H + (size_t)row * DM + col0; bf16_t* rowb = HB + (size_t)row * DM + col0;
                float q = 0.f;
#pragma unroll
                for (int bj = 0; bj < 2; ++bj)
#pragma unroll
                    for (int n = 0; n < 2; ++n) { const f32x4 h = hv[m][bj][n] + acc[ai][bj][m][n]; *(f32x4*)(rowp + bj * HALF + n * 16) = h;
                        u32x2 w; w.x = pk2(h[0], h[1]); w.y = pk2(h[2], h[3]); *(u32x2*)(rowb + bj * HALF + n * 16) = w;
                        q += (h[0] * h[0] + h[1] * h[1]) + (h[2] * h[2] + h[3] * h[3]); }
                q += __shfl_xor(q, 16); q += __shfl_xor(q, 32);
                if (fq == 0) ssq[(size_t)row * 16 + u.pn * 4 + wc] = q; }
            __builtin_amdgcn_sched_barrier(0);
        }
    }
};
struct EpiSwiglu {
    static constexpr bool PERM = true;
    bf16_t* O; const LAS float* rst;
    __device__ __forceinline__ void operator()(const f32x4 (&acc)[2][2][4][2], const Unit& u, int ui, int wr, int wc, int fr, int fq) const {
        const int row0 = u.pm * BM + wr * 64 + fr, col0 = u.pn * 128 + wc * 16 + 4 * fq;
#pragma unroll
        for (int ai = 0; ai < 2; ++ai)
#pragma unroll
            for (int m = 0; m < 4; ++m) { const int row = row0 + ai * HALF + m * 16; bf16_t* rowp = O + (size_t)row * DFF + col0;
                const float rs = rst[ui * 256 + (row & 255)];
#pragma unroll
                for (int bj = 0; bj < 2; ++bj) { const f32x4 gt = acc[ai][bj][m][0] * rs, up = acc[ai][bj][m][1] * rs; float o[4];
#pragma unroll
                    for (int j = 0; j < 4; ++j) o[j] = gt[j] * sigmoidf_(gt[j]) * up[j];
                    u32x2 w; w.x = pk2(o[0], o[1]); w.y = pk2(o[2], o[3]);
                    *(u32x2*)(rowp + bj * 64) = w; } }
    }
};
}

__device__ __forceinline__ void build_rs_table(LAS float* rst, const pg8::StaticOrder& S, const float* ssp) {
    const int tid = tid_opaque();
    pg8::Unit u;
    for (int i = 0; S.next(i, u); ++i) if (tid < 256) rst[i * 256 + tid] = row_rs(ssp, u.pm * 256 + tid);
    __syncthreads();
}
constexpr int MAIN_ROWS = 32768;
template <int KIND  >
__device__ __forceinline__ void tail_tiles(const bf16_t* A, const bf16_t* Bt, int N, int K, void* Out, int ldo) {
    const int tid = tid_opaque(), wid = __builtin_amdgcn_readfirstlane(tid >> 6), lane = tid & 63, fr = lane & 15, fq = lane >> 4, wm = wid & 3, wn = wid >> 2;
    const int ntn = N / 64, ntiles = 4 * ntn;
    for (int ti = blockIdx.x; ti < ntiles; ti += gridDim.x) {
        const int tm = ti / ntn, tn = ti - tm * ntn;
        const int row = MAIN_ROWS + tm * 64 + wm * 16 + fr;
        int br0, br1;
        if (KIND == 2) { const int fglob = tn * 32 + wn * 16 + fr, pn = fglob >> 7, ft = fglob & 127; br0 = pn * 256 + ((ft >> 2) << 3) + (ft & 3); br1 = br0 + 4; }
        else { br0 = tn * 64 + wn * 32 + fr; br1 = br0 + 16; }
        const bf16_t* ap = A + (size_t)row * K + fq * 8; const bf16_t* bp0 = Bt + (size_t)br0 * K + fq * 8; const bf16_t* bp1 = Bt + (size_t)br1 * K + fq * 8;
        f32x4 acc0 = (f32x4){0.f, 0.f, 0.f, 0.f}, acc1 = (f32x4){0.f, 0.f, 0.f, 0.f};
        bf16x8 av[4], b0v[4], b1v[4], an[4], b0n[4], b1n[4];
        const int nks = K >> 7; int ks = (int)((blockIdx.x * 8u + (unsigned)wid) * 5u) % nks;
#define TT_LOAD(A_, B0_, B1_) do { _Pragma("unroll") for (int u = 0; u < 4; ++u) { A_[u] = *(const bf16x8*)(ap + ks * 128 + u * 32); B0_[u] = *(const bf16x8*)(bp0 + ks * 128 + u * 32); B1_[u] = *(const bf16x8*)(bp1 + ks * 128 + u * 32); } \
        ks = (ks + 1 == nks) ? 0 : ks + 1; __builtin_amdgcn_sched_barrier(0); } while (0)
#define TT_MMA(A_, B0_, B1_) do { _Pragma("unroll") for (int u = 0; u < 4; ++u) { acc0 = __builtin_amdgcn_mfma_f32_16x16x32_bf16(B0_[u], A_[u], acc0, 0, 0, 0); acc1 = __builtin_amdgcn_mfma_f32_16x16x32_bf16(B1_[u], A_[u], acc1, 0, 0, 0); } \
        __builtin_amdgcn_sched_barrier(0); } while (0)
        TT_LOAD(av, b0v, b1v);
        for (int i = 0; i < nks; i += 2) {
            TT_LOAD(an, b0n, b1n);
            TT_MMA(av, b0v, b1v);
            if (i + 1 < nks) { TT_LOAD(av, b0v, b1v); TT_MMA(an, b0n, b1n); }
        }
#undef TT_LOAD
#undef TT_MMA
        if (KIND == 0) {
            bf16_t* o = (bf16_t*)Out + (size_t)row * ldo + tn * 64 + wn * 32 + fq * 4;
            u32x2 w0; w0.x = pk2(acc0[0], acc0[1]); w0.y = pk2(acc0[2], acc0[3]); *(u32x2*)o = w0;
            u32x2 w1; w1.x = pk2(acc1[0], acc1[1]); w1.y = pk2(acc1[2], acc1[3]); *(u32x2*)(o + 16) = w1;
        } else if (KIND == 1) {
            float* o = (float*)Out + (size_t)row * ldo + tn * 64 + wn * 32 + fq * 4;
            *(f32x4*)o = *(f32x4*)o + acc0; *(f32x4*)(o + 16) = *(f32x4*)(o + 16) + acc1;
        } else {
            bf16_t* o = (bf16_t*)Out + (size_t)row * ldo + tn * 32 + wn * 16 + fq * 4;
            float v[4];
#pragma unroll
            for (int j = 0; j < 4; ++j) v[j] = acc0[j] * sigmoidf_(acc0[j]) * acc1[j];
            u32x2 w; w.x = pk2(v[0], v[1]); w.y = pk2(v[2], v[3]); *(u32x2*)o = w;
        }
    }
}

__device__ __forceinline__ void norm_rows(CArgs a, int mode) {
    const int tid = tid_opaque(), wid = tid >> 6, lane = tid & 63;
    float* H = (float*)(a->ws + WS_H); bf16_t* HB = (bf16_t*)(a->ws + WS_LO); float* SS = (float*)(a->ws + WS_SS);
    f32x4 gv[4];
#pragma unroll
    for (int i = 0; i < 4; ++i) gv[i] = *(const f32x4*)(a->in[25] + lane * 4 + 256 * i);
    for (int row = blockIdx.x * 8 + wid; row < MR; row += gridDim.x * 8) {
        const int b = row / TT, t = row - b * TT;
        if (mode == 2 && t < NMETA) continue;
        const float* src = (mode == 0) ? (t < NMETA ? a->in[1] + (size_t)t * DM : a->in[0] + ((size_t)b * SEQ + (t - NMETA)) * DM) : H + (size_t)row * DM;
        f32x4 v[4]; float ss = 0.f;
#pragma unroll
        for (int i = 0; i < 4; ++i) { v[i] = *(const f32x4*)(src + lane * 4 + 256 * i); ss += v[i][0] * v[i][0] + v[i][1] * v[i][1] + v[i][2] * v[i][2] + v[i][3] * v[i][3]; }
        ss = wave_sum(ss);
        if (mode == 0) {
            if (lane < 16) SS[(size_t)row * 16 + lane] = (lane == 0) ? ss : 0.f;
#pragma unroll
            for (int i = 0; i < 4; ++i) { *(f32x4*)(H + (size_t)row * DM + lane * 4 + 256 * i) = v[i];
                u32x2 w; w.x = pk2(v[i][0], v[i][1]); w.y = pk2(v[i][2], v[i][3]); *(u32x2*)(HB + (size_t)row * DM + lane * 4 + 256 * i) = w; }
        } else {
            const float rs = rsqrtf(ss * (1.0f / DM) + RMS_EPS);
            float* o = a->out + ((size_t)b * SEQ + (t - NMETA)) * DM;
#pragma unroll
            for (int i = 0; i < 4; ++i) *(f32x4*)(o + lane * 4 + 256 * i) = (v[i] * rs) * gv[i];
        }
    }
}

template <int KIND> __device__ __forceinline__ float wsrc(CArgs a, int l, int k, int n) {
    if (KIND == 0) {
        const float gk = a->in[2][(size_t)l * DM + k];
        if (n < NIN) return gk * a->in[3][((size_t)l * DM + k) * NIN + n];
        if (n < NIN + 32 && l > 0) return gk * a->in[17][((size_t)(l - 1) * DM + k) * 32 + (n - NIN)];
        return 0.f;
    } else if (KIND == 1) {
        return a->in[21][((size_t)l * DM + k) * DM + n];
    } else if (KIND == 2) {
        const int pn = n >> 8, c = n & 255, feat = pn * 128 + ((c >> 3) << 2) + (c & 3), isup = (c >> 2) & 1;
        return a->in[22][(size_t)l * DM + k] * a->in[23][((size_t)l * DM + k) * (2 * DFF) + feat + isup * DFF];
    } else if (KIND == 3) {
        return a->in[24][((size_t)l * DFF + k) * DM + n];
    } else {
        const int j = n >> 9, nn = n & 511;
        if (j == 0) return (k < 64) ? a->in[8][((size_t)l * 64 + k) * 512 + nn] : 0.f;
        if (j == 1) return (k >= 64 && k < 128) ? a->in[10][((size_t)l * 64 + (k - 64)) * 512 + nn] : 0.f;
        if (j == 2) return (k >= 128 && k < 288) ? a->in[11][((size_t)l * 160 + (k - 128)) * 512 + nn] : 0.f;
        return (k >= 288 && k < 320 && l > 0) ? a->in[20][((size_t)(l - 1) * 32 + (k - 288)) * 512 + nn] : 0.f;
    }
}
template <int KIND> __device__ __forceinline__ void conv_tile(CArgs a, int l, LAS float* tile, bf16_t* out, int ldo, int n0, int k0) {
    const int tid = tid_opaque(), kk = tid >> 6, nn = tid & 63;
#pragma unroll
    for (int i = 0; i < 8; ++i) tile[(kk + 8 * i) * 65 + nn] = wsrc<KIND>(a, l, k0 + kk + 8 * i, n0 + nn);
    __syncthreads();
    const int n = tid >> 3, kq = tid & 7;
    u32x4 w;
    w.x = pk2(tile[(kq * 8 + 0) * 65 + n], tile[(kq * 8 + 1) * 65 + n]); w.y = pk2(tile[(kq * 8 + 2) * 65 + n], tile[(kq * 8 + 3) * 65 + n]);
    w.z = pk2(tile[(kq * 8 + 4) * 65 + n], tile[(kq * 8 + 5) * 65 + n]); w.w = pk2(tile[(kq * 8 + 6) * 65 + n], tile[(kq * 8 + 7) * 65 + n]);
    *(u32x4*)(out + (size_t)(n0 + n) * ldo + k0 + kq * 8) = w;
    __syncthreads();
}
__device__ __forceinline__ void fold_tile(CArgs a, int l, LAS float* lds, bf16_t* out, int n0, int k0) {
    LAS float* P = lds; LAS float* W = lds + 64 * 128;
    const int tid = tid_opaque(), g = k0 >> 7, c0 = k0 & 127;
    const float* pw = a->in[5] + ((size_t)(l * 4 + g) * 128 + c0) * 128; const float* sc = a->in[6] + (size_t)l * 512 + g * 128;
    const float* wo = a->in[21] + ((size_t)l * DM + g * 128) * DM + n0;
    for (int i = tid; i < 64 * 128; i += 512) { const int d = i & 127; P[i] = pw[i] * sc[d]; }
    for (int i = tid; i < 128 * 64; i += 512) { const int d = i >> 6, n = i & 63; W[i] = wo[(size_t)d * DM + n]; }
    __syncthreads();
    const int n = tid & 63, cq = tid >> 6;
    float acc[8];
#pragma unroll
    for (int j = 0; j < 8; ++j) acc[j] = 0.f;
    for (int d = 0; d < 128; ++d) { const float wv = W[d * 64 + n];
#pragma unroll
        for (int j = 0; j < 8; ++j) acc[j] += P[(cq * 8 + j) * 128 + d] * wv; }
    u32x4 w; w.x = pk2(acc[0], acc[1]); w.y = pk2(acc[2], acc[3]); w.z = pk2(acc[4], acc[5]); w.w = pk2(acc[6], acc[7]);
    *(u32x4*)(out + (size_t)(n0 + n) * DM + k0 + cq * 8) = w;
    __syncthreads();
}
__device__ __forceinline__ void weight_prep(CArgs a, int l, LAS float* lds, int b0, int nb) {
    unsigned char* wb = a->ws + WS_WB + (size_t)(l & 1) * WB_SIZE;
    bf16_t* WC = (bf16_t*)(wb + WB_WC); bf16_t* WO = (bf16_t*)(wb + WB_WOUT); bf16_t* WGU = (bf16_t*)(wb + WB_WGU); bf16_t* WDN = (bf16_t*)(wb + WB_WDN); bf16_t* WL = (bf16_t*)(wb + WB_WL);
    for (int ti = (int)blockIdx.x - b0; ti < 3200; ti += nb) {
        if (ti < 128) { fold_tile(a, l, lds, WO, (ti & 15) * 64, (ti >> 4) * 64); }
        else if (ti < 256) { const int q = ti - 128; conv_tile<1>(a, l, lds, WO, DM, (q & 15) * 64, 512 + (q >> 4) * 64); }
        else if (ti < 896) { const int q = ti - 256; conv_tile<0>(a, l, lds, WC, DM, (q >> 4) * 64, (q & 15) * 64); }
        else if (ti < 2304) { const int q = ti - 896; conv_tile<2>(a, l, lds, WGU, DM, (q >> 4) * 64, (q & 15) * 64); }
        else if (ti < 3008) { const int q = ti - 2304; conv_tile<3>(a, l, lds, WDN, DFF, (q / 44) * 64, (q % 44) * 64); }
        else { const int q = ti - 3008; conv_tile<4>(a, l, lds, WL, KL, (q / 6) * 64, (q % 6) * 64); }
    }
}

__device__ __forceinline__ void unpack8(const u32x4 w, float (&x)[8]) {
    x[0] = bf2f(w.x & 0xffffu); x[1] = bf2f(w.x >> 16); x[2] = bf2f(w.y & 0xffffu); x[3] = bf2f(w.y >> 16);
    x[4] = bf2f(w.z & 0xffffu); x[5] = bf2f(w.z >> 16); x[6] = bf2f(w.w & 0xffffu); x[7] = bf2f(w.w >> 16);
}
__device__ __forceinline__ void prep_phase(CArgs a, int l) {
    const bf16_t* PROJ = (const bf16_t*)(a->ws + WS_R1);
    bf16_t* MIX = (bf16_t*)((unsigned char*)a->out + DO_MIX); bf16_t* LIN = (bf16_t*)((unsigned char*)a->out + DO_LIN);
    const int tid = tid_opaque(), gt = blockIdx.x * 512 + tid, nthr = gridDim.x * 512;
    for (int it = gt; it < (MR / 16) * 64; it += nthr) {
        const int run = it >> 6, c0 = (it & 63) * 8, row0 = run * 16, t0 = row0 % TT, win = 2 << (c0 >> 7);
        float s[8], x[8], y[8];
#pragma unroll
        for (int e = 0; e < 8; ++e) s[e] = 0.f;
        const int pre = (t0 < win) ? t0 : win;
        for (int q = 1; q <= pre; ++q) { unpack8(*(const u32x4*)(PROJ + (size_t)(row0 - q) * NPROJ + c0), x);
#pragma unroll
            for (int e = 0; e < 8; ++e) s[e] += x[e]; }
        for (int i = 0; i < 16; ++i) {
            const int row = row0 + i, t = t0 + i;
            unpack8(*(const u32x4*)(PROJ + (size_t)row * NPROJ + c0), x);
            if (t >= win) { unpack8(*(const u32x4*)(PROJ + (size_t)(row - win) * NPROJ + c0), y);
#pragma unroll
                for (int e = 0; e < 8; ++e) s[e] += x[e] - y[e]; }
            else {
#pragma unroll
                for (int e = 0; e < 8; ++e) s[e] += x[e]; }
            const float inv = 1.0f / (float)((t + 1 < win) ? t + 1 : win);
            u32x4 o; o.x = pk2(s[0] * inv - x[0], s[1] * inv - x[1]); o.y = pk2(s[2] * inv - x[2], s[3] * inv - x[3]);
            o.z = pk2(s[4] * inv - x[4], s[5] * inv - x[5]); o.w = pk2(s[6] * inv - x[6], s[7] * inv - x[7]);
            *(u32x4*)(MIX + (size_t)row * DM + c0) = o;
        }
    }
    for (int it = gt; it < MR * 48; it += nthr) {
        const int row = it / 48, cb = (it - row * 48) * 8, t = row % TT;
        u32x4 o = (u32x4){0u, 0u, 0u, 0u};
        if (cb < 320) {
            float xc[8], xp[8], mu[8], y[8];
            unpack8(*(const u32x4*)(PROJ + (size_t)row * NPROJ + 2048 + cb), xc);
            u32x4 wp = (u32x4){0u, 0u, 0u, 0u};
            if (t > 0) wp = *(const u32x4*)(PROJ + (size_t)(row - 1) * NPROJ + 2048 + cb);
            unpack8(wp, xp);
            const float* mp = (cb < 288) ? a->in[4] + (size_t)l * NSHIFT + 1536 + cb : a->in[18] + (l > 0 ? (l - 1) * 32 + (cb - 288) : 0);
            const f32x4 m0 = *(const f32x4*)mp, m1 = *(const f32x4*)(mp + 4);
            mu[0] = m0[0]; mu[1] = m0[1]; mu[2] = m0[2]; mu[3] = m0[3]; mu[4] = m1[0]; mu[5] = m1[1]; mu[6] = m1[2]; mu[7] = m1[3];
#pragma unroll
            for (int e = 0; e < 8; ++e) {
                const float sv = xc[e] + (xp[e] - xc[e]) * mu[e];
                y[e] = (cb < 64) ? 1.0f - 2.0f * __builtin_amdgcn_rcpf(1.0f + __builtin_amdgcn_exp2f(sv * 2.88539008f)) : (cb < 128) ? sv : (cb < 288) ? sigmoidf_(sv) : sv;
            }
            o.x = pk2(y[0], y[1]); o.y = pk2(y[2], y[3]); o.z = pk2(y[4], y[5]); o.w = pk2(y[6], y[7]);
        }
        *(u32x4*)(LIN + (size_t)row * KL + cb) = o;
    }
}

constexpr int TC = 16, NCH = TT / TC;
constexpr int SB_A = 0, SB_Q = 1, SB_W = 2, SB_B = 3, SB_K = 4, SB_V = 5, SB_G = 6, SB_Y = 7, SBUF = 8 * TC * 64 + TC * 4;
__device__ __forceinline__ void scan_phase(CArgs a, int l, LAS float* lds) {
    const int bid = blockIdx.x; if (bid >= BATCH * 8) return;
    const int b = bid >> 3, h = bid & 7, tid = tid_opaque(), wid = __builtin_amdgcn_readfirstlane(tid >> 6), lane = tid & 63;
    const bf16_t* PROJ = (const bf16_t*)(a->ws + WS_R1); const bf16_t* LO = (const bf16_t*)(a->ws + WS_LO);
    bf16_t* VF = (bf16_t*)((unsigned char*)a->out + DO_VF); bf16_t* MIX = (bf16_t*)((unsigned char*)a->out + DO_MIX);
    if (wid < 4) {
        __builtin_amdgcn_s_setprio(2);
        const int rp = wid * 16 + (lane >> 3) * 2, seg = lane & 7;
        f32x2 S0[4], S1[4];
#pragma unroll
        for (int j = 0; j < 4; ++j) { S0[j] = (f32x2){0.f, 0.f}; S1[j] = (f32x2){0.f, 0.f}; }
        for (int it = 0; it < NCH + 2; ++it) {
            if (it >= 1 && it <= NCH) {
                LAS float* buf = lds + ((it - 1) & 1) * SBUF;
#pragma unroll 4
                for (int tl = 0; tl < TC; ++tl) {
                    const LAS float* base = buf + tl * 64 + seg * 8;
                    const f32x4 a0 = *(const LAS f32x4*)(base + SB_A * TC * 64), a1 = *(const LAS f32x4*)(base + SB_A * TC * 64 + 4);
                    const f32x4 q0 = *(const LAS f32x4*)(base + SB_Q * TC * 64), q1 = *(const LAS f32x4*)(base + SB_Q * TC * 64 + 4);
                    const f32x4 w0 = *(const LAS f32x4*)(base + SB_W * TC * 64), w1 = *(const LAS f32x4*)(base + SB_W * TC * 64 + 4);
                    const f32x4 b0 = *(const LAS f32x4*)(base + SB_B * TC * 64), b1 = *(const LAS f32x4*)(base + SB_B * TC * 64 + 4);
                    const f32x4 k0 = *(const LAS f32x4*)(base + SB_K * TC * 64), k1 = *(const LAS f32x4*)(base + SB_K * TC * 64 + 4);
                    const f32x2 vv = *(const LAS f32x2*)(buf + SB_V * TC * 64 + tl * 64 + rp);
                    const f32x2 sc = *(const LAS f32x2*)(buf + 8 * TC * 64 + tl * 4);
                    const f32x2 av[4] = {{a0[0], a0[1]}, {a0[2], a0[3]}, {a1[0], a1[1]}, {a1[2], a1[3]}};
                    const f32x2 qv[4] = {{q0[0], q0[1]}, {q0[2], q0[3]}, {q1[0], q1[1]}, {q1[2], q1[3]}};
                    const f32x2 wv[4] = {{w0[0], w0[1]}, {w0[2], w0[3]}, {w1[0], w1[1]}, {w1[2], w1[3]}};
                    const f32x2 bv[4] = {{b0[0], b0[1]}, {b0[2], b0[3]}, {b1[0], b1[1]}, {b1[2], b1[3]}};
                    const f32x2 kv[4] = {{k0[0], k0[1]}, {k0[2], k0[3]}, {k1[0], k1[1]}, {k1[2], k1[3]}};
                    f32x2 pa0 = S0[0] * av[0], pa1 = S1[0] * av[0], pq0 = S0[0] * qv[0], pq1 = S1[0] * qv[0];
#pragma unroll
                    for (int j = 1; j < 4; ++j) { pa0 += S0[j] * av[j]; pa1 += S1[j] * av[j]; pq0 += S0[j] * qv[j]; pq1 += S1[j] * qv[j]; }
                    float sa0 = pa0.x + pa0.y, sa1 = pa1.x + pa1.y, y0 = pq0.x + pq0.y, y1 = pq1.x + pq1.y;
                    allred8x4(sa0, sa1, y0, y1);
                    const f32x2 sav0 = {sa0, sa0}, sav1 = {sa1, sa1}, vv0 = {vv.x, vv.x}, vv1 = {vv.y, vv.y};
#pragma unroll
                    for (int j = 0; j < 4; ++j) { S0[j] = S0[j] * wv[j] + sav0 * bv[j] + vv0 * kv[j]; S1[j] = S1[j] * wv[j] + sav1 * bv[j] + vv1 * kv[j]; }
                    if (seg == 0) *(LAS f32x2*)(buf + SB_Y * TC * 64 + tl * 64 + rp) = (f32x2){y0 + sa0 * sc.x + vv.x * sc.y, y1 + sa1 * sc.x + vv.y * sc.y};
                }
            }
            __syncthreads();
        }
        __builtin_amdgcn_s_setprio(0);
    } else {
        const int hw = wid - 4, ch = h * 64 + lane;
        const float mu_r = a->in[4][(size_t)l * NSHIFT + ch], mu_k = a->in[4][(size_t)l * NSHIFT + 512 + ch], mu_v = a->in[4][(size_t)l * NSHIFT + 1024 + ch];
        const float w0_c = a->in[7][l * 512 + ch], a0_c = a->in[9][l * 512 + ch], v0_c = (l > 0) ? a->in[19][(l - 1) * 512 + ch] : 0.f;
        const float kk_c = a->in[12][l * 512 + ch], ka_c = a->in[13][l * 512 + ch], rk_c = a->in[14][l * 512 + ch], gw = a->in[15][l * 512 + ch], gb = a->in[16][l * 512 + ch];
        unsigned short ld[4][11];
#define SCAN_LOAD(c) do { _Pragma("unroll") for (int p = 0; p < 4; ++p) { const int t = (c) * TC + p * 4 + hw; const size_t m = (size_t)b * TT + t; \
        const bf16_t* pr = PROJ + m * NPROJ + 512 + ch; ld[p][0] = pr[0]; ld[p][1] = pr[512]; ld[p][2] = pr[1024]; \
        if (t > 0) { ld[p][3] = pr[-NPROJ]; ld[p][4] = pr[512 - NPROJ]; ld[p][5] = pr[1024 - NPROJ]; } else { ld[p][3] = 0; ld[p][4] = 0; ld[p][5] = 0; } \
        const bf16_t* po = LO + m * NL + ch; ld[p][6] = po[0]; ld[p][7] = po[512]; ld[p][8] = po[1024]; ld[p][9] = po[1536]; \
        ld[p][10] = (l > 0) ? VF[m * 512 + ch] : (unsigned short)0; } } while (0)
        SCAN_LOAD(0);
        for (int it = 0; it < NCH + 2; ++it) {
            LAS float* buf = lds + (it & 1) * SBUF;
            if (it >= 2) {
#pragma unroll
                for (int p = 0; p < 4; ++p) {
                    const int tl = p * 4 + hw; const size_t m = (size_t)b * TT + (it - 2) * TC + tl;
                    const float y = buf[SB_Y * TC * 64 + tl * 64 + lane];
                    const float mean = wave_sum(y) * (1.0f / 64.0f), d = y - mean, var = wave_sum(d * d) * (1.0f / 64.0f);
                    const float o = (d * rsqrtf(var + GN_EPS) * gw + gb + buf[8 * TC * 64 + tl * 4 + 2] * buf[SB_V * TC * 64 + tl * 64 + lane]) * buf[SB_G * TC * 64 + tl * 64 + lane];
                    MIX[m * DM + 512 + ch] = (bf16_t)f2bf(o);
                }
            }
            if (it < NCH) {
#pragma unroll
                for (int p = 0; p < 4; ++p) {
                    const int tl = p * 4 + hw; const size_t m = (size_t)b * TT + it * TC + tl;
                    const float rc = bf2f(ld[p][0]), kc = bf2f(ld[p][1]), vc = bf2f(ld[p][2]), rpv = bf2f(ld[p][3]), kp = bf2f(ld[p][4]), vp = bf2f(ld[p][5]);
                    const float e = sigmoidf_(w0_c + bf2f(ld[p][6])) * 0.60653066f, av = sigmoidf_(a0_c + bf2f(ld[p][7])), gv = bf2f(ld[p][8]), vm = sigmoidf_(v0_c + bf2f(ld[p][9]));
                    const float r = rc + (rpv - rc) * mu_r, k = kc + (kp - kc) * mu_k; float v = vc + (vp - vc) * mu_v;
                    if (l == 0) VF[m * 512 + ch] = (bf16_t)f2bf(v); else { const float vf = bf2f(ld[p][10]); v = v + (vf - v) * vm; }
                    float kk = k * kk_c; const float n2 = wave_sum(kk * kk); kk = kk * rsqrtf(fmaxf(n2, 1e-24f));
                    const float k2 = k * (1.0f + (av - 1.0f) * ka_c), w = __expf(-e), bb = kk * av;
                    float br = bb * r, kr = k2 * r, cf = kr * rk_c; wave_sum3(br, kr, cf);
                    buf[SB_A * TC * 64 + tl * 64 + lane] = -kk; buf[SB_Q * TC * 64 + tl * 64 + lane] = w * r; buf[SB_W * TC * 64 + tl * 64 + lane] = w;
                    buf[SB_B * TC * 64 + tl * 64 + lane] = bb; buf[SB_K * TC * 64 + tl * 64 + lane] = k2; buf[SB_V * TC * 64 + tl * 64 + lane] = v; buf[SB_G * TC * 64 + tl * 64 + lane] = gv;
                    if (lane < 3) buf[8 * TC * 64 + tl * 4 + lane] = (lane == 0) ? br : (lane == 1) ? kr : cf;
                }
                if (it + 1 < NCH) SCAN_LOAD(it + 1);
            }
            __syncthreads();
        }
#undef SCAN_LOAD
    }
}

__global__ void __launch_bounds__(512, 2) mega(Args a_unused) {
    extern __shared__ __attribute__((aligned(16))) unsigned char shm[];
    LAS unsigned char* lds = (LAS unsigned char*)shm;
    cg::grid_group grid = cg::this_grid();
    CArgs a0 = (CArgs)__builtin_amdgcn_kernarg_segment_ptr();
    const int ph_lo = a0->ph_lo, ph_hi = a0->ph_hi;
    for (int ph = ph_lo; ph < ph_hi; ++ph) {
        if (ph > ph_lo) grid.sync();
        CArgs a = a0; asm volatile("" : "+s"(a));
        if (ph == 0) { norm_rows(a, 0); weight_prep(a, 0, (LAS float*)lds, 0, gridDim.x); continue; }
        if (ph == NPH - 1) { norm_rows(a, 2); continue; }
        const int l = (ph - 1) / 7, s = (ph - 1) % 7;
        bf16_t* HB = (bf16_t*)(a->ws + WS_LO); float* SS = (float*)(a->ws + WS_SS);
        const unsigned char* wb = a->ws + WS_WB + (size_t)(l & 1) * WB_SIZE;
        if (s == 0 || s == 2) {
            pg8::Gemm g{s == 0 ? HB : (const bf16_t*)((unsigned char*)a->out + DO_LIN), (const bf16_t*)(wb + (s == 0 ? WB_WC : WB_WL)), MR, s == 0 ? NPROJ : NL, s == 0 ? DM : KL};
            pg8::StaticOrder S; S.init(MR, g.N, gridDim.x, blockIdx.x);
            LAS float* rst = (LAS float*)(lds + 131072);
            if (s == 0) build_rs_table(rst, S, SS);
            pg8::EpiProj E{(bf16_t*)(a->ws + (s == 0 ? WS_R1 : WS_LO)), g.N, s == 0 ? rst : (LAS float*)nullptr};
            pg8::gemm_phase(lds, g, S, E);
        }
        else if (s == 1) prep_phase(a, l);
        else if (s == 3) {
            if (blockIdx.x < BATCH * 8) scan_phase(a, l, (LAS float*)lds);
            else if (l + 1 < DEPTH) weight_prep(a, l + 1, (LAS float*)lds, BATCH * 8, gridDim.x - BATCH * 8);
        }
        else if (s == 4 || s == 6) {
            pg8::Gemm g{s == 4 ? (const bf16_t*)((unsigned char*)a->out + DO_MIX) : (const bf16_t*)(a->ws + WS_R1), (const bf16_t*)(wb + (s == 4 ? WB_WOUT : WB_WDN)), MR, DM, s == 4 ? DM : DFF};
            pg8::StaticOrder S; S.init(MR, DM, gridDim.x, blockIdx.x);
            pg8::EpiResid E{(float*)(a->ws + WS_H), HB, SS + (s == 4 ? (size_t)MR * 16 : 0)};
            pg8::gemm_phase(lds, g, S, E);
        }
        else {
            pg8::Gemm g{HB, (const bf16_t*)(wb + WB_WGU), MR, 2 * DFF, DM}; pg8::StaticOrder S; S.init(MR, 2 * DFF, gridDim.x, blockIdx.x);
            LAS float* rst = (LAS float*)(lds + 131072); build_rs_table(rst, S, SS + (size_t)MR * 16);
            pg8::EpiSwiglu E{(bf16_t*)(a->ws + WS_R1), rst};
            pg8::gemm_phase(lds, g, S, E);
        }
    }
}

extern "C" void kernel_launch(void* const* d_in, const int* in_sizes, int n_in, void* d_out, int out_size, void* d_ws, size_t ws_size, hipStream_t stream) {
    static int grid = 0;
    if (grid == 0) {
        if (n_in != 26 || out_size != BATCH * SEQ * DM || ws_size < WS_END) { fprintf(stderr, "kernel_launch: unexpected shapes (n_in %d out %d ws %zu need %zu)\n", n_in, out_size, ws_size, (size_t)WS_END); grid = -1; return; }
        int dev = 0, cus = 0, per_cu = 0;
        hipGetDevice(&dev);
        hipDeviceGetAttribute(&cus, hipDeviceAttributeMultiprocessorCount, dev);
        if (hipFuncSetAttribute((const void*)mega, hipFuncAttributeMaxDynamicSharedMemorySize, LDS_BYTES) != hipSuccess) { fprintf(stderr, "kernel_launch: hipFuncSetAttribute failed\n"); grid = -1; return; }
        hipOccupancyMaxActiveBlocksPerMultiprocessor(&per_cu, (const void*)mega, 512, LDS_BYTES);
        if (per_cu < 1) { fprintf(stderr, "kernel_launch: occupancy query says %d blocks per CU\n", per_cu); per_cu = 1; }
        (void)hipGetLastError();
        grid = cus;
        fprintf(stderr, "kernel_launch: grid %d (per_cu %d)\n", grid, per_cu);
    }
    if (grid < 0) return;
    Args a{};
    for (int i = 0; i < 26; ++i) a.in[i] = (const float*)d_in[i];
    a.out = (float*)d_out; a.ws = (unsigned char*)d_ws;
#if MK_MULTI
    for (int ph = 0; ph < NPH; ++ph) {
        a.ph_lo = ph; a.ph_hi = ph + 1;
        void* args[] = {&a};
        hipError_t e = hipLaunchCooperativeKernel((const void*)mega, dim3(grid), dim3(512), args, LDS_BYTES, stream);
        if (e != hipSuccess) { fprintf(stderr, "cooperative launch failed: %s\n", hipGetErrorString(e)); break; }
    }
#else
    a.ph_lo = 0; a.ph_hi = NPH;
    void* args[] = {&a};
    hipError_t e = hipLaunchCooperativeKernel((const void*)mega, dim3(grid), dim3(512), args, LDS_BYTES, stream);
    if (e != hipSuccess) fprintf(stderr, "cooperative launch failed: %s (grid %d)\n", hipGetErrorString(e), grid);
#endif
}
```

```cpp
#include <hip/hip_runtime.h>
#include <hip/hip_cooperative_groups.h>
#include <cstdio>
#include <cstdint>
namespace cg = cooperative_groups;

#ifndef MK_MULTI
#define MK_MULTI 0
#endif

#define LAS __attribute__((address_space(3)))
typedef unsigned short bf16_t;
typedef short bf16x8 __attribute__((ext_vector_type(8)));
typedef float f32x4 __attribute__((ext_vector_type(4)));
typedef float f32x2 __attribute__((ext_vector_type(2)));
typedef unsigned u32x4 __attribute__((ext_vector_type(4)));
typedef unsigned u32x2 __attribute__((ext_vector_type(2)));

constexpr int DM = 1024, BATCH = 16, SEQ = 2048, DEPTH = 4, NMETA = 16, TT = SEQ + NMETA  , MR = BATCH * TT  ;
constexpr int NIN = 2336, NSHIFT = 1824, DFF = 2816, NPROJ = 2560  , KL = 384  , NL = 2048;
constexpr float RMS_EPS = 1e-6f, GN_EPS = 64e-5f;
constexpr int LDS_BYTES = 131072 + 16384;
constexpr int NPH = DEPTH * 7 + 2;

constexpr size_t WB_WC = 0;
constexpr size_t WB_WOUT = WB_WC + (size_t)NPROJ * DM * 2;
constexpr size_t WB_WGU = WB_WOUT + (size_t)DM * DM * 2;
constexpr size_t WB_WDN = WB_WGU + (size_t)2 * DFF * DM * 2;
constexpr size_t WB_WL = WB_WDN + (size_t)DM * DFF * 2;
constexpr size_t WB_SIZE = WB_WL + (size_t)NL * KL * 2;
constexpr size_t WS_WB = 4096;
constexpr size_t WS_SS = WS_WB + 2 * WB_SIZE;
constexpr size_t WS_H = WS_SS + 2 * (size_t)MR * 64;
constexpr size_t WS_R1 = WS_H + (size_t)MR * DM * 4;
constexpr size_t WS_LO = WS_R1 + (size_t)MR * DFF * 2;
constexpr size_t WS_END = WS_LO + (size_t)MR * NL * 2;
static_assert(WS_END <= 536870912, "workspace map");
constexpr size_t DO_MIX = 0;
constexpr size_t DO_VF = DO_MIX + (size_t)MR * DM * 2;
constexpr size_t DO_LIN = DO_VF + (size_t)MR * 512 * 2;
static_assert(DO_LIN + (size_t)MR * KL * 2 <= (size_t)BATCH * SEQ * DM * 4, "d_out scratch");

struct Args { const float* in[26]; float* out; unsigned char* ws; int ph_lo, ph_hi; };
typedef const __attribute__((address_space(4))) Args* CArgs;

__device__ __forceinline__ float bf2f(unsigned b) { return __uint_as_float(b << 16); }
__device__ __forceinline__ unsigned f2bf(float f) { unsigned u = __float_as_uint(f); return (u + 0x7fffu + ((u >> 16) & 1u)) >> 16; }
__device__ __forceinline__ unsigned pk2(float lo, float hi) { unsigned r; asm volatile("v_cvt_pk_bf16_f32 %0, %1, %2" : "=v"(r) : "v"(lo), "v"(hi)); return r; }
__device__ __forceinline__ float sigmoidf_(float x) { return __builtin_amdgcn_rcpf(1.0f + __builtin_amdgcn_exp2f(x * -1.44269504f)); }
template <int CTRL> __device__ __forceinline__ float dppf(float x) { return __int_as_float(__builtin_amdgcn_update_dpp(0, __float_as_int(x), CTRL, 0xF, 0xF, true)); }
__device__ __forceinline__ float allred8(float x) { x += dppf<0xB1>(x); x += dppf<0x4E>(x); x += dppf<0x141>(x); return x; }
#define DPP_ADD(r, ctl) "v_add_f32_dpp " r ", " r ", " r " " ctl " row_mask:0xf bank_mask:0xf\n\t"
__device__ __forceinline__ void allred8x4(float& a, float& b, float& c, float& d) {
    asm volatile("s_nop 1\n\t"
        DPP_ADD("%0", "quad_perm:[1,0,3,2]") DPP_ADD("%1", "quad_perm:[1,0,3,2]") DPP_ADD("%2", "quad_perm:[1,0,3,2]") DPP_ADD("%3", "quad_perm:[1,0,3,2]")
        DPP_ADD("%0", "quad_perm:[2,3,0,1]") DPP_ADD("%1", "quad_perm:[2,3,0,1]") DPP_ADD("%2", "quad_perm:[2,3,0,1]") DPP_ADD("%3", "quad_perm:[2,3,0,1]")
        DPP_ADD("%0", "row_half_mirror") DPP_ADD("%1", "row_half_mirror") DPP_ADD("%2", "row_half_mirror") DPP_ADD("%3", "row_half_mirror")
        : "+v"(a), "+v"(b), "+v"(c), "+v"(d));
}
__device__ __forceinline__ float rows_to_wave(float x) {
    const int xi = __float_as_int(x);
    return (__int_as_float(__builtin_amdgcn_readlane(xi, 0)) + __int_as_float(__builtin_amdgcn_readlane(xi, 16))) + (__int_as_float(__builtin_amdgcn_readlane(xi, 32)) + __int_as_float(__builtin_amdgcn_readlane(xi, 48)));
}
__device__ __forceinline__ float wave_sum(float x) {
    asm volatile("s_nop 1\n\t" DPP_ADD("%0", "quad_perm:[1,0,3,2]") "s_nop 1\n\t" DPP_ADD("%0", "quad_perm:[2,3,0,1]") "s_nop 1\n\t" DPP_ADD("%0", "row_half_mirror") "s_nop 1\n\t" DPP_ADD("%0", "row_mirror") : "+v"(x));
    return rows_to_wave(x);
}
__device__ __forceinline__ void wave_sum3(float& a, float& b, float& c) {
    asm volatile("s_nop 1\n\t"
        DPP_ADD("%0", "quad_perm:[1,0,3,2]") DPP_ADD("%1", "quad_perm:[1,0,3,2]") DPP_ADD("%2", "quad_perm:[1,0,3,2]")
        DPP_ADD("%0", "quad_perm:[2,3,0,1]") DPP_ADD("%1", "quad_perm:[2,3,0,1]") DPP_ADD("%2", "quad_perm:[2,3,0,1]")
        DPP_ADD("%0", "row_half_mirror") DPP_ADD("%1", "row_half_mirror") DPP_ADD("%2", "row_half_mirror")
        DPP_ADD("%0", "row_mirror") DPP_ADD("%1", "row_mirror") DPP_ADD("%2", "row_mirror")
        : "+v"(a), "+v"(b), "+v"(c));
    a = rows_to_wave(a); b = rows_to_wave(b); c = rows_to_wave(c);
}
__device__ __forceinline__ int tid_opaque() { int t = threadIdx.x; asm volatile("" : "+v"(t)); return t; }

__device__ __forceinline__ void unpack8(const u32x4 w, float (&x)[8]) {
    x[0] = bf2f(w.x & 0xffffu); x[1] = bf2f(w.x >> 16); x[2] = bf2f(w.y & 0xffffu); x[3] = bf2f(w.y >> 16);
    x[4] = bf2f(w.z & 0xffffu); x[5] = bf2f(w.z >> 16); x[6] = bf2f(w.w & 0xffffu); x[7] = bf2f(w.w >> 16);
}
__device__ __forceinline__ float row_rs(const float* ssp, int row) {
    const f32x4* p = (const f32x4*)(ssp + (size_t)row * 16); const f32x4 a = p[0], b = p[1], c = p[2], d = p[3];
    const f32x4 t = (a + b) + (c + d);
    return rsqrtf(((t[0] + t[1]) + (t[2] + t[3])) * (1.0f / DM) + RMS_EPS);
}
namespace pg8 {
constexpr int BM = 256, BK = 64, HALF = 128, HTB = HALF * BK * 2, STAGE_BYTES = 8 * HTB, NXCD = 8, WGM = 8;
__host__ __device__ __forceinline__ int lds_byte(int r, int c) { const int st = (r >> 4) * 2 + (c >> 5), rr = r & 15, cc = c & 31, ob = rr * 64 + cc * 2; return st * 1024 + (ob ^ (((ob >> 9) & 1) << 5)); }
__host__ __device__ __forceinline__ void stage_rc(int b, int& R, int& C) { const int st = b / 1024, sb = b % 1024, swz = sb ^ (((sb >> 9) & 1) << 5); R = (st >> 1) * 16 + swz / 64; C = (st & 1) * 32 + (swz % 64) / 2; }
__host__ __device__ __forceinline__ int perm32(int rho) { const int n = rho >> 4, i = rho & 15; return 8 * (i >> 2) + 4 * n + (i & 3); }
struct Unit { int pm, pn; };
struct Gemm { const bf16_t* A; const bf16_t* Bt; int M, N, K; };
struct StaticOrder {
    int nM, nN, nwg, G, c;
    __device__ void init(int M, int N, int G_, int c_) { nM = M / BM; nN = N / BM; nwg = nM * nN; G = G_; c = c_; }
    __device__ bool next(int i, Unit& u) const {
        const long L = (long)i * G + c; if (L >= nwg) return false;
        int wgid = (int)L; { const int q = nwg / NXCD, r = nwg % NXCD, xcd = wgid % NXCD, off = wgid / NXCD; wgid = (xcd < r ? xcd * (q + 1) : r * (q + 1) + (xcd - r) * q) + off; }
        const int nig = WGM * nN, gid = wgid / nig, fm = gid * WGM, gsz = (nM - fm) < WGM ? (nM - fm) : WGM;
        u.pm = fm + ((wgid % nig) % gsz); u.pn = (wgid % nig) / gsz; return true;
    }
};
template <class Epi>
__device__ __forceinline__ void gemm_phase(LAS unsigned char* lds, const Gemm g, const StaticOrder& S, const Epi& E) {
    int tid_ = threadIdx.x; asm volatile("" : "+v"(tid_));
    const int tid = tid_, wid = __builtin_amdgcn_readfirstlane(tid >> 6), lane = tid & 63, wr = wid >> 2, wc = wid & 3, fr = lane & 15, fq = lane >> 4;
    const int K = g.K, nt = K / BK;
    unsigned voffA[2], voffB[2];
#pragma unroll
    for (int i = 0; i < 2; ++i) { int R, C; stage_rc(tid * 16 + i * 8192, R, C); const int Rb = Epi::PERM ? ((R & ~31) + perm32(R & 31)) : R;
        voffA[i] = (unsigned)(R * K + C) * 2u; voffB[i] = (unsigned)(Rb * K + C) * 2u; }
    const size_t kstep = (size_t)(BK * 2);
    const size_t hstep = (size_t)HALF * K * 2;
    const size_t tstep = 2 * hstep;
    const unsigned ldsw = (unsigned)wid * 1024u;
    const int aoff = lds_byte(wr * 64 + fr, fq * 8), boff = lds_byte(wc * 32 + fr, fq * 8);
#define PG8_SA(b, h) (((b) * 2 + (h)) * HTB)
#define PG8_SB(b, h) ((4 + (b) * 2 + (h)) * HTB)
#define PG8_STAGE(bufoff, gbase, voff) do { _Pragma("unroll") for (int _i = 0; _i < 2; ++_i) \
        __builtin_amdgcn_global_load_lds((const unsigned*)((const char*)(gbase) + (voff)[_i]), (LAS unsigned*)(lds + (bufoff) + ldsw + _i * 8192), 16, 0, 0); } while (0)
#define PG8_LDA(dst, b, h) do { _Pragma("unroll") for (int m = 0; m < 4; ++m) _Pragma("unroll") for (int k = 0; k < 2; ++k) dst[m][k] = *(const LAS bf16x8*)(lds + PG8_SA(b, h) + aoff + m * 2048 + k * 1024); } while (0)
#define PG8_LDB(dst, b, h) do { _Pragma("unroll") for (int n = 0; n < 2; ++n) _Pragma("unroll") for (int k = 0; k < 2; ++k) dst[n][k] = *(const LAS bf16x8*)(lds + PG8_SB(b, h) + boff + n * 2048 + k * 1024); } while (0)
#define PG8_MMA(ai, bj, At, Bt) do { __builtin_amdgcn_s_setprio(1); _Pragma("unroll") for (int m = 0; m < 4; ++m) _Pragma("unroll") for (int n = 0; n < 2; ++n) _Pragma("unroll") for (int k = 0; k < 2; ++k) \
        acc[ai][bj][m][n] = __builtin_amdgcn_mfma_f32_16x16x32_bf16(Bt[n][k], At[m][k], acc[ai][bj][m][n], 0, 0, 0); __builtin_amdgcn_s_setprio(0); } while (0)
#define PG8_WAIT_V(n) asm volatile("s_waitcnt vmcnt(" #n ")" ::: "memory")
#define PG8_WAIT_L(n) asm volatile("s_waitcnt lgkmcnt(" #n ")" ::: "memory")
#define PG8_BAR __builtin_amdgcn_s_barrier()
#define PG8_SCHED __builtin_amdgcn_sched_barrier(0)
    Unit cur, nxt; int ui = 0;
    if (!S.next(0, cur)) return;
    f32x4 acc[2][2][4][2];
#pragma unroll
    for (int a = 0; a < 2; ++a)
#pragma unroll
        for (int b = 0; b < 2; ++b)
#pragma unroll
            for (int m = 0; m < 4; ++m)
#pragma unroll
                for (int n = 0; n < 2; ++n) acc[a][b][m][n] = (f32x4){0.f, 0.f, 0.f, 0.f};
    bf16x8 At[4][2], B0[2][2], B1[2][2];
    const char* cA = (const char*)g.A + (size_t)cur.pm * tstep; const char* cB = (const char*)g.Bt + (size_t)cur.pn * tstep;
    PG8_STAGE(PG8_SB(0, 0), cB, voffB); PG8_STAGE(PG8_SA(0, 0), cA, voffA); PG8_STAGE(PG8_SB(0, 1), cB + hstep, voffB); PG8_STAGE(PG8_SA(0, 1), cA + hstep, voffA);
    if (wr == 1) PG8_BAR;
    PG8_WAIT_V(4); PG8_BAR;
    PG8_STAGE(PG8_SB(1, 0), cB + kstep, voffB); PG8_STAGE(PG8_SA(1, 0), cA + kstep, voffA); PG8_STAGE(PG8_SB(1, 1), cB + hstep + kstep, voffB);
    PG8_WAIT_V(6); PG8_BAR;
    for (;;) {
        const bool has_next = S.next(ui + 1, nxt);
        const char* nA = has_next ? (const char*)g.A + (size_t)nxt.pm * tstep : cA; const char* nB = has_next ? (const char*)g.Bt + (size_t)nxt.pn * tstep : cB;
        for (int t = 0; t < nt; t += 2) {
            const bool last = (t == nt - 2);
            const char* a1 = cA + (size_t)(t + 1) * kstep;
            const char* a2 = last ? nA : cA + (size_t)(t + 2) * kstep; const char* b2 = last ? nB : cB + (size_t)(t + 2) * kstep;
            const char* a3 = a2 + kstep; const char* b3 = b2 + kstep;
            PG8_LDB(B0, 0, 0); PG8_SCHED; PG8_LDA(At, 0, 0); PG8_STAGE(PG8_SA(1, 1), a1 + hstep, voffA);
            PG8_WAIT_L(8); PG8_BAR; PG8_WAIT_L(0); PG8_MMA(0, 0, At, B0); PG8_BAR; PG8_SCHED;
            PG8_LDB(B1, 0, 1); PG8_STAGE(PG8_SB(0, 0), b2, voffB);
            PG8_BAR; PG8_WAIT_L(0); PG8_MMA(0, 1, At, B1); PG8_BAR;
            PG8_LDA(At, 0, 1); PG8_STAGE(PG8_SA(0, 0), a2, voffA);
            PG8_BAR; PG8_WAIT_L(0); PG8_MMA(1, 0, At, B0); PG8_BAR; PG8_SCHED;
            PG8_STAGE(PG8_SB(0, 1), b2 + hstep, voffB);
            PG8_WAIT_V(6); PG8_BAR; PG8_MMA(1, 1, At, B1); PG8_BAR;
            PG8_LDB(B0, 1, 0); PG8_SCHED; PG8_LDA(At, 1, 0); PG8_STAGE(PG8_SA(0, 1), a2 + hstep, voffA);
            PG8_WAIT_L(8); PG8_BAR; PG8_WAIT_L(0); PG8_MMA(0, 0, At, B0); PG8_BAR; PG8_SCHED;
            PG8_LDB(B1, 1, 1); PG8_STAGE(PG8_SB(1, 0), b3, voffB);
            PG8_BAR; PG8_WAIT_L(0); PG8_MMA(0, 1, At, B1); PG8_BAR;
            PG8_LDA(At, 1, 1); PG8_STAGE(PG8_SA(1, 0), a3, voffA);
            PG8_BAR; PG8_WAIT_L(0); PG8_MMA(1, 0, At, B0); PG8_BAR; PG8_SCHED;
            PG8_STAGE(PG8_SB(1, 1), b3 + hstep, voffB);
            PG8_WAIT_V(6); PG8_BAR; PG8_MMA(1, 1, At, B1); PG8_BAR;
        }
        E(acc, cur, ui, wr, wc, fr, fq);
        if (!has_next) break;
#pragma unroll
        for (int a = 0; a < 2; ++a)
#pragma unroll
            for (int b = 0; b < 2; ++b)
#pragma unroll
                for (int m = 0; m < 4; ++m)
#pragma unroll
                    for (int n = 0; n < 2; ++n) acc[a][b][m][n] = (f32x4){0.f, 0.f, 0.f, 0.f};
        cur = nxt; cA = nA; cB = nB; ++ui;
    }
    PG8_WAIT_V(0);
    if (wr == 0) PG8_BAR;
    PG8_BAR;
#undef PG8_SA
#undef PG8_SB
#undef PG8_STAGE
#undef PG8_LDA
#undef PG8_LDB
#undef PG8_MMA
#undef PG8_WAIT_V
#undef PG8_WAIT_L
#undef PG8_BAR
#undef PG8_SCHED
}

struct EpiProj {
    static constexpr bool PERM = true;
    bf16_t* O; int ldc; const LAS float* rst;
    __device__ __forceinline__ void operator()(const f32x4 (&acc)[2][2][4][2], const Unit& u, int ui, int wr, int wc, int fr, int fq) const {
        const int row0 = u.pm * BM + wr * 64 + fr, col0 = u.pn * BM + wc * 32 + 8 * fq;
#pragma unroll
        for (int ai = 0; ai < 2; ++ai)
#pragma unroll
            for (int m = 0; m < 4; ++m) { const int row = row0 + ai * HALF + m * 16; bf16_t* rowp = O + (size_t)row * ldc + col0;
                const float rs = rst ? rst[ui * 256 + (row & 255)] : 1.0f;
#pragma unroll
                for (int bj = 0; bj < 2; ++bj) { const f32x4 v0 = acc[ai][bj][m][0] * rs, v1 = acc[ai][bj][m][1] * rs;
                    u32x4 w; w.x = pk2(v0[0], v0[1]); w.y = pk2(v0[2], v0[3]); w.z = pk2(v1[0], v1[1]); w.w = pk2(v1[2], v1[3]);
                    *(u32x4*)(rowp + bj * HALF) = w; } }
    }
};
struct EpiResid {
    static constexpr bool PERM = true;
    bf16_t* HB; float* ssq;
    __device__ __forceinline__ void operator()(const f32x4 (&acc)[2][2][4][2], const Unit& u, int ui, int wr, int wc, int fr, int fq) const {
        const int row0 = u.pm * BM + wr * 64 + fr, col0 = u.pn * BM + wc * 32 + 8 * fq;
#pragma unroll
        for (int ai = 0; ai < 2; ++ai) {
            u32x4 hv[4][2];
#pragma unroll
            for (int m = 0; m < 4; ++m)
#pragma unroll
                for (int bj = 0; bj < 2; ++bj) hv[m][bj] = *(const u32x4*)(HB + (size_t)(row0 + ai * HALF + m * 16) * DM + col0 + bj * HALF);
            __builtin_amdgcn_sched_barrier(0);
#pragma unroll
            for (int m = 0; m < 4; ++m) { const int row = row0 + ai * HALF + m * 16; bf16_t* rowb = HB + (size_t)row * DM + col0;
                float q = 0.f;
#pragma unroll
                for (int bj = 0; bj < 2; ++bj) { const u32x4 hw = hv[m][bj]; const f32x4 v0 = acc[ai][bj][m][0], v1 = acc[ai][bj][m][1];
                    u32x4 w;
                    w.x = pk2(bf2f(hw.x & 0xffffu) + v0[0], bf2f(hw.x >> 16) + v0[1]); w.y = pk2(bf2f(hw.y & 0xffffu) + v0[2], bf2f(hw.y >> 16) + v0[3]);
                    w.z = pk2(bf2f(hw.z & 0xffffu) + v1[0], bf2f(hw.z >> 16) + v1[1]); w.w = pk2(bf2f(hw.w & 0xffffu) + v1[2], bf2f(hw.w >> 16) + v1[3]);
                    *(u32x4*)(rowb + bj * HALF) = w;
                    const float r0 = bf2f(w.x & 0xffffu), r1 = bf2f(w.x >> 16), r2 = bf2f(w.y & 0xffffu), r3 = bf2f(w.y >> 16), r4 = bf2f(w.z & 0xffffu), r5 = bf2f(w.z >> 16), r6 = bf2f(w.w & 0xffffu), r7 = bf2f(w.w >> 16);
                    q += ((r0 * r0 + r1 * r1) + (r2 * r2 + r3 * r3)) + ((r4 * r4 + r5 * r5) + (r6 * r6 + r7 * r7)); }
                q += __shfl_xor(q, 16); q += __shfl_xor(q, 32);
                if (fq == 0) ssq[(size_t)row * 16 + u.pn * 4 + wc] = q; }
            __builtin_amdgcn_sched_barrier(0);
        }
    }
};
struct EpiSwiglu {
    static constexpr bool PERM = true;
    bf16_t* O; const LAS float* rst;
    __device__ __forceinline__ void operator()(const f32x4 (&acc)[2][2][4][2], const Unit& u, int ui, int wr, int wc, int fr, int fq) const {
        const int row0 = u.pm * BM + wr * 64 + fr, col0 = u.pn * 128 + wc * 16 + 4 * fq;
#pragma unroll
        for (int ai = 0; ai < 2; ++ai)
#pragma unroll
            for (int m = 0; m < 4; ++m) { const int row = row0 + ai * HALF + m * 16; bf16_t* rowp = O + (size_t)row * DFF + col0;
                const float rs = rst[ui * 256 + (row & 255)];
#pragma unroll
                for (int bj = 0; bj < 2; ++bj) { const f32x4 gt = acc[ai][bj][m][0] * rs, up = acc[ai][bj][m][1] * rs; float o[4];
#pragma unroll
                    for (int j = 0; j < 4; ++j) o[j] = gt[j] * sigmoidf_(gt[j]) * up[j];
                    u32x2 w; w.x = pk2(o[0], o[1]); w.y = pk2(o[2], o[3]);
                    *(u32x2*)(rowp + bj * 64) = w; } }
    }
};
}

__device__ __forceinline__ void build_rs_table(LAS float* rst, const pg8::StaticOrder& S, const float* ssp) {
    const int tid = tid_opaque();
    pg8::Unit u;
    for (int i = 0; S.next(i, u); ++i) if (tid < 256) rst[i * 256 + tid] = row_rs(ssp, u.pm * 256 + tid);
    __syncthreads();
}
constexpr int MAIN_ROWS = 32768;
template <int KIND  >
__device__ __forceinline__ void tail_tiles(const bf16_t* A, const bf16_t* Bt, int N, int K, void* Out, int ldo) {
    const int tid = tid_opaque(), wid = __builtin_amdgcn_readfirstlane(tid >> 6), lane = tid & 63, fr = lane & 15, fq = lane >> 4, wm = wid & 3, wn = wid >> 2;
    const int ntn = N / 64, ntiles = 4 * ntn;
    for (int ti = blockIdx.x; ti < ntiles; ti += gridDim.x) {
        const int tm = ti / ntn, tn = ti - tm * ntn;
        const int row = MAIN_ROWS + tm * 64 + wm * 16 + fr;
        int br0, br1;
        if (KIND == 2) { const int fglob = tn * 32 + wn * 16 + fr, pn = fglob >> 7, ft = fglob & 127; br0 = pn * 256 + ((ft >> 2) << 3) + (ft & 3); br1 = br0 + 4; }
        else { br0 = tn * 64 + wn * 32 + fr; br1 = br0 + 16; }
        const bf16_t* ap = A + (size_t)row * K + fq * 8; const bf16_t* bp0 = Bt + (size_t)br0 * K + fq * 8; const bf16_t* bp1 = Bt + (size_t)br1 * K + fq * 8;
        f32x4 acc0 = (f32x4){0.f, 0.f, 0.f, 0.f}, acc1 = (f32x4){0.f, 0.f, 0.f, 0.f};
        bf16x8 av[4], b0v[4], b1v[4], an[4], b0n[4], b1n[4];
        const int nks = K >> 7; int ks = (int)((blockIdx.x * 8u + (unsigned)wid) * 5u) % nks;
#define TT_LOAD(A_, B0_, B1_) do { _Pragma("unroll") for (int u = 0; u < 4; ++u) { A_[u] = *(const bf16x8*)(ap + ks * 128 + u * 32); B0_[u] = *(const bf16x8*)(bp0 + ks * 128 + u * 32); B1_[u] = *(const bf16x8*)(bp1 + ks * 128 + u * 32); } \
        ks = (ks + 1 == nks) ? 0 : ks + 1; __builtin_amdgcn_sched_barrier(0); } while (0)
#define TT_MMA(A_, B0_, B1_) do { _Pragma("unroll") for (int u = 0; u < 4; ++u) { acc0 = __builtin_amdgcn_mfma_f32_16x16x32_bf16(B0_[u], A_[u], acc0, 0, 0, 0); acc1 = __builtin_amdgcn_mfma_f32_16x16x32_bf16(B1_[u], A_[u], acc1, 0, 0, 0); } \
        __builtin_amdgcn_sched_barrier(0); } while (0)
        TT_LOAD(av, b0v, b1v);
        for (int i = 0; i < nks; i += 2) {
            TT_LOAD(an, b0n, b1n);
            TT_MMA(av, b0v, b1v);
            if (i + 1 < nks) { TT_LOAD(av, b0v, b1v); TT_MMA(an, b0n, b1n); }
        }
#undef TT_LOAD
#undef TT_MMA
        if (KIND == 0) {
            bf16_t* o = (bf16_t*)Out + (size_t)row * ldo + tn * 64 + wn * 32 + fq * 4;
            u32x2 w0; w0.x = pk2(acc0[0], acc0[1]); w0.y = pk2(acc0[2], acc0[3]); *(u32x2*)o = w0;
            u32x2 w1; w1.x = pk2(acc1[0], acc1[1]); w1.y = pk2(acc1[2], acc1[3]); *(u32x2*)(o + 16) = w1;
        } else if (KIND == 1) {
            float* o = (float*)Out + (size_t)row * ldo + tn * 64 + wn * 32 + fq * 4;
            *(f32x4*)o = *(f32x4*)o + acc0; *(f32x4*)(o + 16) = *(f32x4*)(o + 16) + acc1;
        } else {
            bf16_t* o = (bf16_t*)Out + (size_t)row * ldo + tn * 32 + wn * 16 + fq * 4;
            float v[4];
#pragma unroll
            for (int j = 0; j < 4; ++j) v[j] = acc0[j] * sigmoidf_(acc0[j]) * acc1[j];
            u32x2 w; w.x = pk2(v[0], v[1]); w.y = pk2(v[2], v[3]); *(u32x2*)o = w;
        }
    }
}

__device__ __forceinline__ void norm_rows(CArgs a, int mode) {
    const int tid = tid_opaque(), wid = tid >> 6, lane = tid & 63;
    bf16_t* HB = (bf16_t*)(a->ws + WS_H); float* SS = (float*)(a->ws + WS_SS);
    for (int row = blockIdx.x * 8 + wid; row < MR; row += gridDim.x * 8) {
        const int b = row / TT, t = row - b * TT;
        if (mode == 2 && t < NMETA) continue;
        float x[16]; float ss = 0.f;
        if (mode == 0) {
            const float* src = (t < NMETA ? a->in[1] + (size_t)t * DM : a->in[0] + ((size_t)b * SEQ + (t - NMETA)) * DM);
#pragma unroll
            for (int i = 0; i < 2; ++i) { const f32x4 v0 = *(const f32x4*)(src + lane * 8 + 512 * i), v1 = *(const f32x4*)(src + lane * 8 + 512 * i + 4);
                u32x4 w; w.x = pk2(v0[0], v0[1]); w.y = pk2(v0[2], v0[3]); w.z = pk2(v1[0], v1[1]); w.w = pk2(v1[2], v1[3]);
                *(u32x4*)(HB + (size_t)row * DM + lane * 8 + 512 * i) = w;
                float r[8]; unpack8(w, r);
#pragma unroll
                for (int e = 0; e < 8; ++e) ss += r[e] * r[e]; }
            ss = wave_sum(ss);
            if (lane < 16) SS[(size_t)row * 16 + lane] = (lane == 0) ? ss : 0.f;
        } else {
#pragma unroll
            for (int i = 0; i < 2; ++i) { float r[8]; unpack8(*(const u32x4*)(HB + (size_t)row * DM + lane * 8 + 512 * i), r);
#pragma unroll
                for (int e = 0; e < 8; ++e) { x[i * 8 + e] = r[e]; ss += r[e] * r[e]; } }
            ss = wave_sum(ss);
            const float rs = rsqrtf(ss * (1.0f / DM) + RMS_EPS);
            float* o = a->out + ((size_t)b * SEQ + (t - NMETA)) * DM;
#pragma unroll
            for (int i = 0; i < 2; ++i) { const f32x4 g0 = *(const f32x4*)(a->in[25] + lane * 8 + 512 * i), g1 = *(const f32x4*)(a->in[25] + lane * 8 + 512 * i + 4);
                *(f32x4*)(o + lane * 8 + 512 * i) = (f32x4){x[i * 8] * rs * g0[0], x[i * 8 + 1] * rs * g0[1], x[i * 8 + 2] * rs * g0[2], x[i * 8 + 3] * rs * g0[3]};
                *(f32x4*)(o + lane * 8 + 512 * i + 4) = (f32x4){x[i * 8 + 4] * rs * g1[0], x[i * 8 + 5] * rs * g1[1], x[i * 8 + 6] * rs * g1[2], x[i * 8 + 7] * rs * g1[3]}; }
        }
    }
}

template <int KIND> __device__ __forceinline__ float wsrc(CArgs a, int l, int k, int n) {
    if (KIND == 0) {
        const float gk = a->in[2][(size_t)l * DM + k];
        if (n < NIN) return gk * a->in[3][((size_t)l * DM + k) * NIN + n];
        if (n < NIN + 32 && l > 0) return gk * a->in[17][((size_t)(l - 1) * DM + k) * 32 + (n - NIN)];
        return 0.f;
    } else if (KIND == 1) {
        return a->in[21][((size_t)l * DM + k) * DM + n];
    } else if (KIND == 2) {
        const int pn = n >> 8, c = n & 255, feat = pn * 128 + ((c >> 3) << 2) + (c & 3), isup = (c >> 2) & 1;
        return a->in[22][(size_t)l * DM + k] * a->in[23][((size_t)l * DM + k) * (2 * DFF) + feat + isup * DFF];
    } else if (KIND == 3) {
        return a->in[24][((size_t)l * DFF + k) * DM + n];
    } else {
        const int j = n >> 9, nn = n & 511;
        if (j == 0) return (k < 64) ? a->in[8][((size_t)l * 64 + k) * 512 + nn] : 0.f;
        if (j == 1) return (k >= 64 && k < 128) ? a->in[10][((size_t)l * 64 + (k - 64)) * 512 + nn] : 0.f;
        if (j == 2) return (k >= 128 && k < 288) ? a->in[11][((size_t)l * 160 + (k - 128)) * 512 + nn] : 0.f;
        return (k >= 288 && k < 320 && l > 0) ? a->in[20][((size_t)(l - 1) * 32 + (k - 288)) * 512 + nn] : 0.f;
    }
}
template <int KIND> __device__ __forceinline__ void conv_tile(CArgs a, int l, LAS float* tile, bf16_t* out, int ldo, int n0, int k0) {
    const int tid = tid_opaque(), kk = tid >> 6, nn = tid & 63;
#pragma unroll
    for (int i = 0; i < 8; ++i) tile[(kk + 8 * i) * 65 + nn] = wsrc<KIND>(a, l, k0 + kk + 8 * i, n0 + nn);
    __syncthreads();
    const int n = tid >> 3, kq = tid & 7;
    u32x4 w;
    w.x = pk2(tile[(kq * 8 + 0) * 65 + n], tile[(kq * 8 + 1) * 65 + n]); w.y = pk2(tile[(kq * 8 + 2) * 65 + n], tile[(kq * 8 + 3) * 65 + n]);
    w.z = pk2(tile[(kq * 8 + 4) * 65 + n], tile[(kq * 8 + 5) * 65 + n]); w.w = pk2(tile[(kq * 8 + 6) * 65 + n], tile[(kq * 8 + 7) * 65 + n]);
    *(u32x4*)(out + (size_t)(n0 + n) * ldo + k0 + kq * 8) = w;
    __syncthreads();
}
__device__ __forceinline__ void fold_tile(CArgs a, int l, LAS float* lds, bf16_t* out, int n0, int k0) {
    LAS float* P = lds; LAS float* W = lds + 64 * 128;
    const int tid = tid_opaque(), g = k0 >> 7, c0 = k0 & 127;
    const float* pw = a->in[5] + ((size_t)(l * 4 + g) * 128 + c0) * 128; const float* sc = a->in[6] + (size_t)l * 512 + g * 128;
    const float* wo = a->in[21] + ((size_t)l * DM + g * 128) * DM + n0;
    for (int i = tid; i < 64 * 128; i += 512) { const int d = i & 127; P[i] = pw[i] * sc[d]; }
    for (int i = tid; i < 128 * 64; i += 512) { const int d = i >> 6, n = i & 63; W[i] = wo[(size_t)d * DM + n]; }
    __syncthreads();
    const int n = tid & 63, cq = tid >> 6;
    float acc[8];
#pragma unroll
    for (int j = 0; j < 8; ++j) acc[j] = 0.f;
    for (int d = 0; d < 128; ++d) { const float wv = W[d * 64 + n];
#pragma unroll
        for (int j = 0; j < 8; ++j) acc[j] += P[(cq * 8 + j) * 128 + d] * wv; }
    u32x4 w; w.x = pk2(acc[0], acc[1]); w.y = pk2(acc[2], acc[3]); w.z = pk2(acc[4], acc[5]); w.w = pk2(acc[6], acc[7]);
    *(u32x4*)(out + (size_t)(n0 + n) * DM + k0 + cq * 8) = w;
    __syncthreads();
}
__device__ __forceinline__ void weight_prep(CArgs a, int l, LAS float* lds, int b0, int nb) {
    unsigned char* wb = a->ws + WS_WB + (size_t)(l & 1) * WB_SIZE;
    bf16_t* WC = (bf16_t*)(wb + WB_WC); bf16_t* WO = (bf16_t*)(wb + WB_WOUT); bf16_t* WGU = (bf16_t*)(wb + WB_WGU); bf16_t* WDN = (bf16_t*)(wb + WB_WDN); bf16_t* WL = (bf16_t*)(wb + WB_WL);
    for (int ti = (int)blockIdx.x - b0; ti < 3200; ti += nb) {
        if (ti < 128) { fold_tile(a, l, lds, WO, (ti & 15) * 64, (ti >> 4) * 64); }
        else if (ti < 256) { const int q = ti - 128; conv_tile<1>(a, l, lds, WO, DM, (q & 15) * 64, 512 + (q >> 4) * 64); }
        else if (ti < 896) { const int q = ti - 256; conv_tile<0>(a, l, lds, WC, DM, (q >> 4) * 64, (q & 15) * 64); }
        else if (ti < 2304) { const int q = ti - 896; conv_tile<2>(a, l, lds, WGU, DM, (q >> 4) * 64, (q & 15) * 64); }
        else if (ti < 3008) { const int q = ti - 2304; conv_tile<3>(a, l, lds, WDN, DFF, (q / 44) * 64, (q % 44) * 64); }
        else { const int q = ti - 3008; conv_tile<4>(a, l, lds, WL, KL, (q / 6) * 64, (q % 6) * 64); }
    }
}

__device__ __forceinline__ void prep_phase(CArgs a, int l) {
    const bf16_t* PROJ = (const bf16_t*)(a->ws + WS_R1);
    bf16_t* MIX = (bf16_t*)((unsigned char*)a->out + DO_MIX); bf16_t* LIN = (bf16_t*)((unsigned char*)a->out + DO_LIN);
    const int tid = tid_opaque(), gt = blockIdx.x * 512 + tid, nthr = gridDim.x * 512;
    for (int it = gt; it < (MR / 16) * 64; it += nthr) {
        const int run = it >> 6, c0 = (it & 63) * 8, row0 = run * 16, t0 = row0 % TT, win = 2 << (c0 >> 7);
        float s[8], x[8], y[8];
#pragma unroll
        for (int e = 0; e < 8; ++e) s[e] = 0.f;
        const int pre = (t0 < win) ? t0 : win;
        for (int q = 1; q <= pre; ++q) { unpack8(*(const u32x4*)(PROJ + (size_t)(row0 - q) * NPROJ + c0), x);
#pragma unroll
            for (int e = 0; e < 8; ++e) s[e] += x[e]; }
        for (int i = 0; i < 16; ++i) {
            const int row = row0 + i, t = t0 + i;
            unpack8(*(const u32x4*)(PROJ + (size_t)row * NPROJ + c0), x);
            if (t >= win) { unpack8(*(const u32x4*)(PROJ + (size_t)(row - win) * NPROJ + c0), y);
#pragma unroll
                for (int e = 0; e < 8; ++e) s[e] += x[e] - y[e]; }
            else {
#pragma unroll
                for (int e = 0; e < 8; ++e) s[e] += x[e]; }
            const float inv = 1.0f / (float)((t + 1 < win) ? t + 1 : win);
            u32x4 o; o.x = pk2(s[0] * inv - x[0], s[1] * inv - x[1]); o.y = pk2(s[2] * inv - x[2], s[3] * inv - x[3]);
            o.z = pk2(s[4] * inv - x[4], s[5] * inv - x[5]); o.w = pk2(s[6] * inv - x[6], s[7] * inv - x[7]);
            *(u32x4*)(MIX + (size_t)row * DM + c0) = o;
        }
    }
    for (int it = gt; it < MR * 48; it += nthr) {
        const int row = it / 48, cb = (it - row * 48) * 8, t = row % TT;
        u32x4 o = (u32x4){0u, 0u, 0u, 0u};
        if (cb < 320) {
            float xc[8], xp[8], mu[8], y[8];
            unpack8(*(const u32x4*)(PROJ + (size_t)row * NPROJ + 2048 + cb), xc);
            u32x4 wp = (u32x4){0u, 0u, 0u, 0u};
            if (t > 0) wp = *(const u32x4*)(PROJ + (size_t)(row - 1) * NPROJ + 2048 + cb);
            unpack8(wp, xp);
            const float* mp = (cb < 288) ? a->in[4] + (size_t)l * NSHIFT + 1536 + cb : a->in[18] + (l > 0 ? (l - 1) * 32 + (cb - 288) : 0);
            const f32x4 m0 = *(const f32x4*)mp, m1 = *(const f32x4*)(mp + 4);
            mu[0] = m0[0]; mu[1] = m0[1]; mu[2] = m0[2]; mu[3] = m0[3]; mu[4] = m1[0]; mu[5] = m1[1]; mu[6] = m1[2]; mu[7] = m1[3];
#pragma unroll
            for (int e = 0; e < 8; ++e) {
                const float sv = xc[e] + (xp[e] - xc[e]) * mu[e];
                y[e] = (cb < 64) ? 1.0f - 2.0f * __builtin_amdgcn_rcpf(1.0f + __builtin_amdgcn_exp2f(sv * 2.88539008f)) : (cb < 128) ? sv : (cb < 288) ? sigmoidf_(sv) : sv;
            }
            o.x = pk2(y[0], y[1]); o.y = pk2(y[2], y[3]); o.z = pk2(y[4], y[5]); o.w = pk2(y[6], y[7]);
        }
        *(u32x4*)(LIN + (size_t)row * KL + cb) = o;
    }
}

constexpr int TC = 16, NCH = TT / TC;
constexpr int SB_A = 0, SB_Q = 1, SB_W = 2, SB_B = 3, SB_K = 4, SB_V = 5, SB_G = 6, SB_Y = 7, SBUF = 8 * TC * 64 + TC * 4;
__device__ __forceinline__ void scan_phase(CArgs a, int l, LAS float* lds) {
    const int bid = blockIdx.x; if (bid >= BATCH * 8) return;
    const int b = bid >> 3, h = bid & 7, tid = tid_opaque(), wid = __builtin_amdgcn_readfirstlane(tid >> 6), lane = tid & 63;
    const bf16_t* PROJ = (const bf16_t*)(a->ws + WS_R1); const bf16_t* LO = (const bf16_t*)(a->ws + WS_LO);
    bf16_t* VF = (bf16_t*)((unsigned char*)a->out + DO_VF); bf16_t* MIX = (bf16_t*)((unsigned char*)a->out + DO_MIX);
    if (wid < 4) {
        __builtin_amdgcn_s_setprio(2);
        const int rp = wid * 16 + (lane >> 3) * 2, seg = lane & 7;
        f32x2 S0[4], S1[4];
#pragma unroll
        for (int j = 0; j < 4; ++j) { S0[j] = (f32x2){0.f, 0.f}; S1[j] = (f32x2){0.f, 0.f}; }
        for (int it = 0; it < NCH + 2; ++it) {
            if (it >= 1 && it <= NCH) {
                LAS float* buf = lds + ((it - 1) & 1) * SBUF;
#pragma unroll 4
                for (int tl = 0; tl < TC; ++tl) {
                    const LAS float* base = buf + tl * 64 + seg * 8;
                    const f32x4 a0 = *(const LAS f32x4*)(base + SB_A * TC * 64), a1 = *(const LAS f32x4*)(base + SB_A * TC * 64 + 4);
                    const f32x4 q0 = *(const LAS f32x4*)(base + SB_Q * TC * 64), q1 = *(const LAS f32x4*)(base + SB_Q * TC * 64 + 4);
                    const f32x4 w0 = *(const LAS f32x4*)(base + SB_W * TC * 64), w1 = *(const LAS f32x4*)(base + SB_W * TC * 64 + 4);
                    const f32x4 b0 = *(const LAS f32x4*)(base + SB_B * TC * 64), b1 = *(const LAS f32x4*)(base + SB_B * TC * 64 + 4);
                    const f32x4 k0 = *(const LAS f32x4*)(base + SB_K * TC * 64), k1 = *(const LAS f32x4*)(base + SB_K * TC * 64 + 4);
                    const f32x2 vv = *(const LAS f32x2*)(buf + SB_V * TC * 64 + tl * 64 + rp);
                    const f32x2 sc = *(const LAS f32x2*)(buf + 8 * TC * 64 + tl * 4);
                    const f32x2 av[4] = {{a0[0], a0[1]}, {a0[2], a0[3]}, {a1[0], a1[1]}, {a1[2], a1[3]}};
                    const f32x2 qv[4] = {{q0[0], q0[1]}, {q0[2], q0[3]}, {q1[0], q1[1]}, {q1[2], q1[3]}};
                    const f32x2 wv[4] = {{w0[0], w0[1]}, {w0[2], w0[3]}, {w1[0], w1[1]}, {w1[2], w1[3]}};
                    const f32x2 bv[4] = {{b0[0], b0[1]}, {b0[2], b0[3]}, {b1[0], b1[1]}, {b1[2], b1[3]}};
                    const f32x2 kv[4] = {{k0[0], k0[1]}, {k0[2], k0[3]}, {k1[0], k1[1]}, {k1[2], k1[3]}};
                    f32x2 pa0 = S0[0] * av[0], pa1 = S1[0] * av[0], pq0 = S0[0] * qv[0], pq1 = S1[0] * qv[0];
#pragma unroll
                    for (int j = 1; j < 4; ++j) { pa0 += S0[j] * av[j]; pa1 += S1[j] * av[j]; pq0 += S0[j] * qv[j]; pq1 += S1[j] * qv[j]; }
                    float sa0 = pa0.x + pa0.y, sa1 = pa1.x + pa1.y, y0 = pq0.x + pq0.y, y1 = pq1.x + pq1.y;
                    allred8x4(sa0, sa1, y0, y1);
                    const f32x2 sav0 = {sa0, sa0}, sav1 = {sa1, sa1}, vv0 = {vv.x, vv.x}, vv1 = {vv.y, vv.y};
#pragma unroll
                    for (int j = 0; j < 4; ++j) { S0[j] = S0[j] * wv[j] + sav0 * bv[j] + vv0 * kv[j]; S1[j] = S1[j] * wv[j] + sav1 * bv[j] + vv1 * kv[j]; }
                    if (seg == 0) *(LAS f32x2*)(buf + SB_Y * TC * 64 + tl * 64 + rp) = (f32x2){y0 + sa0 * sc.x + vv.x * sc.y, y1 + sa1 * sc.x + vv.y * sc.y};
                }
            }
            __syncthreads();
        }
        __builtin_amdgcn_s_setprio(0);
    } else {
        const int hw = wid - 4, ch = h * 64 + lane;
        const float mu_r = a->in[4][(size_t)l * NSHIFT + ch], mu_k = a->in[4][(size_t)l * NSHIFT + 512 + ch], mu_v = a->in[4][(size_t)l * NSHIFT + 1024 + ch];
        const float w0_c = a->in[7][l * 512 + ch], a0_c = a->in[9][l * 512 + ch], v0_c = (l > 0) ? a->in[19][(l - 1) * 512 + ch] : 0.f;
        const float kk_c = a->in[12][l * 512 + ch], ka_c = a->in[13][l * 512 + ch], rk_c = a->in[14][l * 512 + ch], gw = a->in[15][l * 512 + ch], gb = a->in[16][l * 512 + ch];
        unsigned short ld[4][11];
#define SCAN_LOAD(c) do { _Pragma("unroll") for (int p = 0; p < 4; ++p) { const int t = (c) * TC + p * 4 + hw; const size_t m = (size_t)b * TT + t; \
        const bf16_t* pr = PROJ + m * NPROJ + 512 + ch; ld[p][0] = pr[0]; ld[p][1] = pr[512]; ld[p][2] = pr[1024]; \
        if (t > 0) { ld[p][3] = pr[-NPROJ]; ld[p][4] = pr[512 - NPROJ]; ld[p][5] = pr[1024 - NPROJ]; } else { ld[p][3] = 0; ld[p][4] = 0; ld[p][5] = 0; } \
        const bf16_t* po = LO + m * NL + ch; ld[p][6] = po[0]; ld[p][7] = po[512]; ld[p][8] = po[1024]; ld[p][9] = po[1536]; \
        ld[p][10] = (l > 0) ? VF[m * 512 + ch] : (unsigned short)0; } } while (0)
        SCAN_LOAD(0);
        for (int it = 0; it < NCH + 2; ++it) {
            LAS float* buf = lds + (it & 1) * SBUF;
            if (it >= 2) {
#pragma unroll
                for (int p = 0; p < 4; ++p) {
                    const int tl = p * 4 + hw; const size_t m = (size_t)b * TT + (it - 2) * TC + tl;
                    const float y = buf[SB_Y * TC * 64 + tl * 64 + lane];
                    const float mean = wave_sum(y) * (1.0f / 64.0f), d = y - mean, var = wave_sum(d * d) * (1.0f / 64.0f);
                    const float o = (d * rsqrtf(var + GN_EPS) * gw + gb + buf[8 * TC * 64 + tl * 4 + 2] * buf[SB_V * TC * 64 + tl * 64 + lane]) * buf[SB_G * TC * 64 + tl * 64 + lane];
                    MIX[m * DM + 512 + ch] = (bf16_t)f2bf(o);
                }
            }
            if (it < NCH) {
#pragma unroll
                for (int p = 0; p < 4; ++p) {
                    const int tl = p * 4 + hw; const size_t m = (size_t)b * TT + it * TC + tl;
                    const float rc = bf2f(ld[p][0]), kc = bf2f(ld[p][1]), vc = bf2f(ld[p][2]), rpv = bf2f(ld[p][3]), kp = bf2f(ld[p][4]), vp = bf2f(ld[p][5]);
                    const float e = sigmoidf_(w0_c + bf2f(ld[p][6])) * 0.60653066f, av = sigmoidf_(a0_c + bf2f(ld[p][7])), gv = bf2f(ld[p][8]), vm = sigmoidf_(v0_c + bf2f(ld[p][9]));
                    const float r = rc + (rpv - rc) * mu_r, k = kc + (kp - kc) * mu_k; float v = vc + (vp - vc) * mu_v;
                    if (l == 0) VF[m * 512 + ch] = (bf16_t)f2bf(v); else { const float vf = bf2f(ld[p][10]); v = v + (vf - v) * vm; }
                    float kk = k * kk_c; const float n2 = wave_sum(kk * kk); kk = kk * rsqrtf(fmaxf(n2, 1e-24f));
                    const float k2 = k * (1.0f + (av - 1.0f) * ka_c), w = __expf(-e), bb = kk * av;
                    float br = bb * r, kr = k2 * r, cf = kr * rk_c; wave_sum3(br, kr, cf);
                    buf[SB_A * TC * 64 + tl * 64 + lane] = -kk; buf[SB_Q * TC * 64 + tl * 64 + lane] = w * r; buf[SB_W * TC * 64 + tl * 64 + lane] = w;
                    buf[SB_B * TC * 64 + tl * 64 + lane] = bb; buf[SB_K * TC * 64 + tl * 64 + lane] = k2; buf[SB_V * TC * 64 + tl * 64 + lane] = v; buf[SB_G * TC * 64 + tl * 64 + lane] = gv;
                    if (lane < 3) buf[8 * TC * 64 + tl * 4 + lane] = (lane == 0) ? br : (lane == 1) ? kr : cf;
                }
                if (it + 1 < NCH) SCAN_LOAD(it + 1);
            }
            __syncthreads();
        }
#undef SCAN_LOAD
    }
}

__global__ void __launch_bounds__(512, 2) mega(Args a_unused) {
    extern __shared__ __attribute__((aligned(16))) unsigned char shm[];
    LAS unsigned char* lds = (LAS unsigned char*)shm;
    cg::grid_group grid = cg::this_grid();
    CArgs a0 = (CArgs)__builtin_amdgcn_kernarg_segment_ptr();
    const int ph_lo = a0->ph_lo, ph_hi = a0->ph_hi;
    for (int ph = ph_lo; ph < ph_hi; ++ph) {
        if (ph > ph_lo) grid.sync();
        CArgs a = a0; asm volatile("" : "+s"(a));
        if (ph == 0) { norm_rows(a, 0); weight_prep(a, 0, (LAS float*)lds, 0, gridDim.x); continue; }
        if (ph == NPH - 1) { norm_rows(a, 2); continue; }
        const int l = (ph - 1) / 7, s = (ph - 1) % 7;
        bf16_t* HB = (bf16_t*)(a->ws + WS_H); float* SS = (float*)(a->ws + WS_SS);
        const unsigned char* wb = a->ws + WS_WB + (size_t)(l & 1) * WB_SIZE;
        if (s == 0 || s == 2) {
            pg8::Gemm g{s == 0 ? HB : (const bf16_t*)((unsigned char*)a->out + DO_LIN), (const bf16_t*)(wb + (s == 0 ? WB_WC : WB_WL)), MR, s == 0 ? NPROJ : NL, s == 0 ? DM : KL};
            pg8::StaticOrder S; S.init(MR, g.N, gridDim.x, blockIdx.x);
            LAS float* rst = (LAS float*)(lds + 131072);
            if (s == 0) build_rs_table(rst, S, SS);
            pg8::EpiProj E{(bf16_t*)(a->ws + (s == 0 ? WS_R1 : WS_LO)), g.N, s == 0 ? rst : (LAS float*)nullptr};
            pg8::gemm_phase(lds, g, S, E);
        }
        else if (s == 1) prep_phase(a, l);
        else if (s == 3) {
            if (blockIdx.x < BATCH * 8) scan_phase(a, l, (LAS float*)lds);
            else if (l + 1 < DEPTH) weight_prep(a, l + 1, (LAS float*)lds, BATCH * 8, gridDim.x - BATCH * 8);
        }
        else if (s == 4 || s == 6) {
            pg8::Gemm g{s == 4 ? (const bf16_t*)((unsigned char*)a->out + DO_MIX) : (const bf16_t*)(a->ws + WS_R1), (const bf16_t*)(wb + (s == 4 ? WB_WOUT : WB_WDN)), MR, DM, s == 4 ? DM : DFF};
            pg8::StaticOrder S; S.init(MR, DM, gridDim.x, blockIdx.x);
            pg8::EpiResid E{HB, SS + (s == 4 ? (size_t)MR * 16 : 0)};
            pg8::gemm_phase(lds, g, S, E);
        }
        else {
            pg8::Gemm g{HB, (const bf16_t*)(wb + WB_WGU), MR, 2 * DFF, DM}; pg8::StaticOrder S; S.init(MR, 2 * DFF, gridDim.x, blockIdx.x);
            LAS float* rst = (LAS float*)(lds + 131072); build_rs_table(rst, S, SS + (size_t)MR * 16);
            pg8::EpiSwiglu E{(bf16_t*)(a->ws + WS_R1), rst};
            pg8::gemm_phase(lds, g, S, E);
        }
    }
}

extern "C" void kernel_launch(void* const* d_in, const int* in_sizes, int n_in, void* d_out, int out_size, void* d_ws, size_t ws_size, hipStream_t stream) {
    static int grid = 0;
    if (grid == 0) {
        if (n_in != 26 || out_size != BATCH * SEQ * DM || ws_size < WS_END) { fprintf(stderr, "kernel_launch: unexpected shapes (n_in %d out %d ws %zu need %zu)\n", n_in, out_size, ws_size, (size_t)WS_END); grid = -1; return; }
        int dev = 0, cus = 0, per_cu = 0;
        hipGetDevice(&dev);
        hipDeviceGetAttribute(&cus, hipDeviceAttributeMultiprocessorCount, dev);
        if (hipFuncSetAttribute((const void*)mega, hipFuncAttributeMaxDynamicSharedMemorySize, LDS_BYTES) != hipSuccess) { fprintf(stderr, "kernel_launch: hipFuncSetAttribute failed\n"); grid = -1; return; }
        hipOccupancyMaxActiveBlocksPerMultiprocessor(&per_cu, (const void*)mega, 512, LDS_BYTES);
        if (per_cu < 1) { fprintf(stderr, "kernel_launch: occupancy query says %d blocks per CU\n", per_cu); per_cu = 1; }
        (void)hipGetLastError();
        grid = cus;
        fprintf(stderr, "kernel_launch: grid %d (per_cu %d)\n", grid, per_cu);
    }
    if (grid < 0) return;
    Args a{};
    for (int i = 0; i < 26; ++i) a.in[i] = (const float*)d_in[i];
    a.out = (float*)d_out; a.ws = (unsigned char*)d_ws;
#if MK_MULTI
    for (int ph = 0; ph < NPH; ++ph) {
        a.ph_lo = ph; a.ph_hi = ph + 1;
        void* args[] = {&a};
        hipError_t e = hipLaunchCooperativeKernel((const void*)mega, dim3(grid), dim3(512), args, LDS_BYTES, stream);
        if (e != hipSuccess) { fprintf(stderr, "cooperative launch failed: %s\n", hipGetErrorString(e)); break; }
    }
#else
    a.ph_lo = 0; a.ph_hi = NPH;
    void* args[] = {&a};
    hipError_t e = hipLaunchCooperativeKernel((const void*)mega, dim3(grid), dim3(512), args, LDS_BYTES, stream);
    if (e != hipSuccess) fprintf(stderr, "cooperative launch failed: %s (grid %d)\n", hipGetErrorString(e), grid);
#endif
}
```

```cpp
#include <hip/hip_runtime.h>
#include <hip/hip_cooperative_groups.h>
#include <cstdio>
#include <cstdint>
namespace cg = cooperative_groups;

#ifndef MK_MULTI
#define MK_MULTI 0
#endif

#define LAS __attribute__((address_space(3)))
typedef unsigned short bf16_t;
typedef short bf16x8 __attribute__((ext_vector_type(8)));
typedef float f32x4 __attribute__((ext_vector_type(4)));
typedef float f32x2 __attribute__((ext_vector_type(2)));
typedef unsigned u32x4 __attribute__((ext_vector_type(4)));
typedef unsigned u32x2 __attribute__((ext_vector_type(2)));

constexpr int DM = 1024, BATCH = 16, SEQ = 2048, DEPTH = 4, NMETA = 16, TT = SEQ + NMETA  , MR = BATCH * TT  ;
constexpr int NIN = 2336, NSHIFT = 1824, DFF = 2816, NPROJ = 2560  , KL = 384  , NL = 2048;
constexpr float RMS_EPS = 1e-6f, GN_EPS = 64e-5f;
constexpr int LDS_BYTES = 131072 + 16384;
constexpr int NPH = DEPTH * 7 + 2;

constexpr size_t WB_WC = 0;
constexpr size_t WB_WOUT = WB_WC + (size_t)NPROJ * DM * 2;
constexpr size_t WB_WGU = WB_WOUT + (size_t)DM * DM * 2;
constexpr size_t WB_WDN = WB_WGU + (size_t)2 * DFF * DM * 2;
constexpr size_t WB_WL = WB_WDN + (size_t)DM * DFF * 2;
constexpr size_t WB_SIZE = WB_WL + (size_t)NL * KL * 2;
constexpr size_t WS_WB = 4096;
constexpr size_t WS_SS = WS_WB + 2 * WB_SIZE;
constexpr size_t WS_H = WS_SS + 2 * (size_t)MR * 64;
constexpr size_t WS_R1 = WS_H + (size_t)MR * DM * 4;
constexpr size_t WS_LO = WS_R1 + (size_t)MR * DFF * 2;
constexpr size_t WS_END = WS_LO + (size_t)MR * NL * 2;
static_assert(WS_END <= 536870912, "workspace map");
constexpr size_t DO_MIX = 0;
constexpr size_t DO_VF = DO_MIX + (size_t)MR * DM * 2;
constexpr size_t DO_LIN = DO_VF + (size_t)MR * 512 * 2;
static_assert(DO_LIN + (size_t)MR * KL * 2 <= (size_t)BATCH * SEQ * DM * 4, "d_out scratch");

struct Args { const float* in[26]; float* out; unsigned char* ws; int ph_lo, ph_hi; };
typedef const __attribute__((address_space(4))) Args* CArgs;

__device__ __forceinline__ float bf2f(unsigned b) { return __uint_as_float(b << 16); }
__device__ __forceinline__ unsigned f2bf(float f) { unsigned u = __float_as_uint(f); return (u + 0x7fffu + ((u >> 16) & 1u)) >> 16; }
__device__ __forceinline__ unsigned pk2(float lo, float hi) { unsigned r; asm volatile("v_cvt_pk_bf16_f32 %0, %1, %2" : "=v"(r) : "v"(lo), "v"(hi)); return r; }
__device__ __forceinline__ float sigmoidf_(float x) { return __builtin_amdgcn_rcpf(1.0f + __builtin_amdgcn_exp2f(x * -1.44269504f)); }
template <int CTRL> __device__ __forceinline__ float dppf(float x) { return __int_as_float(__builtin_amdgcn_update_dpp(0, __float_as_int(x), CTRL, 0xF, 0xF, true)); }
__device__ __forceinline__ float allred8(float x) { x += dppf<0xB1>(x); x += dppf<0x4E>(x); x += dppf<0x141>(x); return x; }
#define DPP_ADD(r, ctl) "v_add_f32_dpp " r ", " r ", " r " " ctl " row_mask:0xf bank_mask:0xf\n\t"
__device__ __forceinline__ void allred8x4(float& a, float& b, float& c, float& d) {
    asm volatile("s_nop 1\n\t"
        DPP_ADD("%0", "quad_perm:[1,0,3,2]") DPP_ADD("%1", "quad_perm:[1,0,3,2]") DPP_ADD("%2", "quad_perm:[1,0,3,2]") DPP_ADD("%3", "quad_perm:[1,0,3,2]")
        DPP_ADD("%0", "quad_perm:[2,3,0,1]") DPP_ADD("%1", "quad_perm:[2,3,0,1]") DPP_ADD("%2", "quad_perm:[2,3,0,1]") DPP_ADD("%3", "quad_perm:[2,3,0,1]")
        DPP_ADD("%0", "row_half_mirror") DPP_ADD("%1", "row_half_mirror") DPP_ADD("%2", "row_half_mirror") DPP_ADD("%3", "row_half_mirror")
        : "+v"(a), "+v"(b), "+v"(c), "+v"(d));
}
__device__ __forceinline__ float rows_to_wave(float x) {
    const int xi = __float_as_int(x);
    return (__int_as_float(__builtin_amdgcn_readlane(xi, 0)) + __int_as_float(__builtin_amdgcn_readlane(xi, 16))) + (__int_as_float(__builtin_amdgcn_readlane(xi, 32)) + __int_as_float(__builtin_amdgcn_readlane(xi, 48)));
}
__device__ __forceinline__ float wave_sum(float x) {
    asm volatile("s_nop 1\n\t" DPP_ADD("%0", "quad_perm:[1,0,3,2]") "s_nop 1\n\t" DPP_ADD("%0", "quad_perm:[2,3,0,1]") "s_nop 1\n\t" DPP_ADD("%0", "row_half_mirror") "s_nop 1\n\t" DPP_ADD("%0", "row_mirror") : "+v"(x));
    return rows_to_wave(x);
}
__device__ __forceinline__ void wave_sum3(float& a, float& b, float& c) {
    asm volatile("s_nop 1\n\t"
        DPP_ADD("%0", "quad_perm:[1,0,3,2]") DPP_ADD("%1", "quad_perm:[1,0,3,2]") DPP_ADD("%2", "quad_perm:[1,0,3,2]")
        DPP_ADD("%0", "quad_perm:[2,3,0,1]") DPP_ADD("%1", "quad_perm:[2,3,0,1]") DPP_ADD("%2", "quad_perm:[2,3,0,1]")
        DPP_ADD("%0", "row_half_mirror") DPP_ADD("%1", "row_half_mirror") DPP_ADD("%2", "row_half_mirror")
        DPP_ADD("%0", "row_mirror") DPP_ADD("%1", "row_mirror") DPP_ADD("%2", "row_mirror")
        : "+v"(a), "+v"(b), "+v"(c));
    a = rows_to_wave(a); b = rows_to_wave(b); c = rows_to_wave(c);
}
__device__ __forceinline__ int tid_opaque() { int t = threadIdx.x; asm volatile("" : "+v"(t)); return t; }

__device__ __forceinline__ void unpack8(const u32x4 w, float (&x)[8]) {
    x[0] = bf2f(w.x & 0xffffu); x[1] = bf2f(w.x >> 16); x[2] = bf2f(w.y & 0xffffu); x[3] = bf2f(w.y >> 16);
    x[4] = bf2f(w.z & 0xffffu); x[5] = bf2f(w.z >> 16); x[6] = bf2f(w.w & 0xffffu); x[7] = bf2f(w.w >> 16);
}
constexpr int MAIN_ROWS = BATCH * SEQ, NROWS = MAIN_ROWS + NMETA;
__device__ __forceinline__ int row_of(int b, int t) { return t < NMETA ? MAIN_ROWS + t : b * SEQ + (t - NMETA); }
__device__ __forceinline__ float row_rs(const float* ssp, int row) {
    const f32x4* p = (const f32x4*)(ssp + (size_t)row * 16); const f32x4 a = p[0], b = p[1], c = p[2], d = p[3];
    const f32x4 t = (a + b) + (c + d);
    return rsqrtf(((t[0] + t[1]) + (t[2] + t[3])) * (1.0f / DM) + RMS_EPS);
}
namespace pg8 {
constexpr int BM = 256, BK = 64, HALF = 128, HTB = HALF * BK * 2, STAGE_BYTES = 8 * HTB, NXCD = 8, WGM = 8;
__host__ __device__ __forceinline__ int lds_byte(int r, int c) { const int st = (r >> 4) * 2 + (c >> 5), rr = r & 15, cc = c & 31, ob = rr * 64 + cc * 2; return st * 1024 + (ob ^ (((ob >> 9) & 1) << 5)); }
__host__ __device__ __forceinline__ void stage_rc(int b, int& R, int& C) { const int st = b / 1024, sb = b % 1024, swz = sb ^ (((sb >> 9) & 1) << 5); R = (st >> 1) * 16 + swz / 64; C = (st & 1) * 32 + (swz % 64) / 2; }
__host__ __device__ __forceinline__ int perm32(int rho) { const int n = rho >> 4, i = rho & 15; return 8 * (i >> 2) + 4 * n + (i & 3); }
struct Unit { int pm, pn; };
struct Gemm { const bf16_t* A; const bf16_t* Bt; int M, N, K; };
struct StaticOrder {
    int nM, nN, nwg, G, c;
    __device__ void init(int M, int N, int G_, int c_) { nM = M / BM; nN = N / BM; nwg = nM * nN; G = G_; c = c_; }
    __device__ bool next(int i, Unit& u) const {
        const long L = (long)i * G + c; if (L >= nwg) return false;
        int wgid = (int)L; { const int q = nwg / NXCD, r = nwg % NXCD, xcd = wgid % NXCD, off = wgid / NXCD; wgid = (xcd < r ? xcd * (q + 1) : r * (q + 1) + (xcd - r) * q) + off; }
        const int nig = WGM * nN, gid = wgid / nig, fm = gid * WGM, gsz = (nM - fm) < WGM ? (nM - fm) : WGM;
        u.pm = fm + ((wgid % nig) % gsz); u.pn = (wgid % nig) / gsz; return true;
    }
};
template <class Epi>
__device__ __forceinline__ void gemm_phase(LAS unsigned char* lds, const Gemm g, const StaticOrder& S, const Epi& E) {
    int tid_ = threadIdx.x; asm volatile("" : "+v"(tid_));
    const int tid = tid_, wid = __builtin_amdgcn_readfirstlane(tid >> 6), lane = tid & 63, wr = wid >> 2, wc = wid & 3, fr = lane & 15, fq = lane >> 4;
    const int K = g.K, nt = K / BK;
    unsigned voffA[2], voffB[2];
#pragma unroll
    for (int i = 0; i < 2; ++i) { int R, C; stage_rc(tid * 16 + i * 8192, R, C); const int Rb = Epi::PERM ? ((R & ~31) + perm32(R & 31)) : R;
        voffA[i] = (unsigned)(R * K + C) * 2u; voffB[i] = (unsigned)(Rb * K + C) * 2u; }
    const size_t kstep = (size_t)(BK * 2);
    const size_t hstep = (size_t)HALF * K * 2;
    const size_t tstep = 2 * hstep;
    const unsigned ldsw = (unsigned)wid * 1024u;
    const int aoff = lds_byte(wr * 64 + fr, fq * 8), boff = lds_byte(wc * 32 + fr, fq * 8);
#define PG8_SA(b, h) (((b) * 2 + (h)) * HTB)
#define PG8_SB(b, h) ((4 + (b) * 2 + (h)) * HTB)
#define PG8_STAGE(bufoff, gbase, voff) do { _Pragma("unroll") for (int _i = 0; _i < 2; ++_i) \
        __builtin_amdgcn_global_load_lds((const unsigned*)((const char*)(gbase) + (voff)[_i]), (LAS unsigned*)(lds + (bufoff) + ldsw + _i * 8192), 16, 0, 0); } while (0)
#define PG8_LDA(dst, b, h) do { _Pragma("unroll") for (int m = 0; m < 4; ++m) _Pragma("unroll") for (int k = 0; k < 2; ++k) dst[m][k] = *(const LAS bf16x8*)(lds + PG8_SA(b, h) + aoff + m * 2048 + k * 1024); } while (0)
#define PG8_LDB(dst, b, h) do { _Pragma("unroll") for (int n = 0; n < 2; ++n) _Pragma("unroll") for (int k = 0; k < 2; ++k) dst[n][k] = *(const LAS bf16x8*)(lds + PG8_SB(b, h) + boff + n * 2048 + k * 1024); } while (0)
#define PG8_MMA(ai, bj, At, Bt) do { __builtin_amdgcn_s_setprio(1); _Pragma("unroll") for (int m = 0; m < 4; ++m) _Pragma("unroll") for (int n = 0; n < 2; ++n) _Pragma("unroll") for (int k = 0; k < 2; ++k) \
        acc[ai][bj][m][n] = __builtin_amdgcn_mfma_f32_16x16x32_bf16(Bt[n][k], At[m][k], acc[ai][bj][m][n], 0, 0, 0); __builtin_amdgcn_s_setprio(0); } while (0)
#define PG8_WAIT_V(n) asm volatile("s_waitcnt vmcnt(" #n ")" ::: "memory")
#define PG8_WAIT_L(n) asm volatile("s_waitcnt lgkmcnt(" #n ")" ::: "memory")
#define PG8_BAR __builtin_amdgcn_s_barrier()
#define PG8_SCHED __builtin_amdgcn_sched_barrier(0)
    Unit cur, nxt; int ui = 0;
    if (!S.next(0, cur)) return;
    f32x4 acc[2][2][4][2];
#pragma unroll
    for (int a = 0; a < 2; ++a)
#pragma unroll
        for (int b = 0; b < 2; ++b)
#pragma unroll
            for (int m = 0; m < 4; ++m)
#pragma unroll
                for (int n = 0; n < 2; ++n) acc[a][b][m][n] = (f32x4){0.f, 0.f, 0.f, 0.f};
    bf16x8 At[4][2], B0[2][2], B1[2][2];
    const char* cA = (const char*)g.A + (size_t)cur.pm * tstep; const char* cB = (const char*)g.Bt + (size_t)cur.pn * tstep;
    PG8_STAGE(PG8_SB(0, 0), cB, voffB); PG8_STAGE(PG8_SA(0, 0), cA, voffA); PG8_STAGE(PG8_SB(0, 1), cB + hstep, voffB); PG8_STAGE(PG8_SA(0, 1), cA + hstep, voffA);
    if (wr == 1) PG8_BAR;
    PG8_WAIT_V(4); PG8_BAR;
    PG8_STAGE(PG8_SB(1, 0), cB + kstep, voffB); PG8_STAGE(PG8_SA(1, 0), cA + kstep, voffA); PG8_STAGE(PG8_SB(1, 1), cB + hstep + kstep, voffB);
    PG8_WAIT_V(6); PG8_BAR;
    for (;;) {
        const bool has_next = S.next(ui + 1, nxt);
        const char* nA = has_next ? (const char*)g.A + (size_t)nxt.pm * tstep : cA; const char* nB = has_next ? (const char*)g.Bt + (size_t)nxt.pn * tstep : cB;
        for (int t = 0; t < nt; t += 2) {
            const bool last = (t == nt - 2);
            const char* a1 = cA + (size_t)(t + 1) * kstep;
            const char* a2 = last ? nA : cA + (size_t)(t + 2) * kstep; const char* b2 = last ? nB : cB + (size_t)(t + 2) * kstep;
            const char* a3 = a2 + kstep; const char* b3 = b2 + kstep;
            PG8_LDB(B0, 0, 0); PG8_SCHED; PG8_LDA(At, 0, 0); PG8_STAGE(PG8_SA(1, 1), a1 + hstep, voffA);
            PG8_WAIT_L(8); PG8_BAR; PG8_WAIT_L(0); PG8_MMA(0, 0, At, B0); PG8_BAR; PG8_SCHED;
            PG8_LDB(B1, 0, 1); PG8_STAGE(PG8_SB(0, 0), b2, voffB);
            PG8_BAR; PG8_WAIT_L(0); PG8_MMA(0, 1, At, B1); PG8_BAR;
            PG8_LDA(At, 0, 1); PG8_STAGE(PG8_SA(0, 0), a2, voffA);
            PG8_BAR; PG8_WAIT_L(0); PG8_MMA(1, 0, At, B0); PG8_BAR; PG8_SCHED;
            PG8_STAGE(PG8_SB(0, 1), b2 + hstep, voffB);
            PG8_WAIT_V(6); PG8_BAR; PG8_MMA(1, 1, At, B1); PG8_BAR;
            PG8_LDB(B0, 1, 0); PG8_SCHED; PG8_LDA(At, 1, 0); PG8_STAGE(PG8_SA(0, 1), a2 + hstep, voffA);
            PG8_WAIT_L(8); PG8_BAR; PG8_WAIT_L(0); PG8_MMA(0, 0, At, B0); PG8_BAR; PG8_SCHED;
            PG8_LDB(B1, 1, 1); PG8_STAGE(PG8_SB(1, 0), b3, voffB);
            PG8_BAR; PG8_WAIT_L(0); PG8_MMA(0, 1, At, B1); PG8_BAR;
            PG8_LDA(At, 1, 1); PG8_STAGE(PG8_SA(1, 0), a3, voffA);
            PG8_BAR; PG8_WAIT_L(0); PG8_MMA(1, 0, At, B0); PG8_BAR; PG8_SCHED;
            PG8_STAGE(PG8_SB(1, 1), b3 + hstep, voffB);
            PG8_WAIT_V(6); PG8_BAR; PG8_MMA(1, 1, At, B1); PG8_BAR;
        }
        E(acc, cur, ui, wr, wc, fr, fq);
        if (!has_next) break;
#pragma unroll
        for (int a = 0; a < 2; ++a)
#pragma unroll
            for (int b = 0; b < 2; ++b)
#pragma unroll
                for (int m = 0; m < 4; ++m)
#pragma unroll
                    for (int n = 0; n < 2; ++n) acc[a][b][m][n] = (f32x4){0.f, 0.f, 0.f, 0.f};
        cur = nxt; cA = nA; cB = nB; ++ui;
    }
    PG8_WAIT_V(0);
    if (wr == 0) PG8_BAR;
    PG8_BAR;
#undef PG8_SA
#undef PG8_SB
#undef PG8_STAGE
#undef PG8_LDA
#undef PG8_LDB
#undef PG8_MMA
#undef PG8_WAIT_V
#undef PG8_WAIT_L
#undef PG8_BAR
#undef PG8_SCHED
}

struct EpiProj {
    static constexpr bool PERM = true;
    bf16_t* O; int ldc; const LAS float* rst;
    __device__ __forceinline__ void operator()(const f32x4 (&acc)[2][2][4][2], const Unit& u, int ui, int wr, int wc, int fr, int fq) const {
        const int row0 = u.pm * BM + wr * 64 + fr, col0 = u.pn * BM + wc * 32 + 8 * fq;
#pragma unroll
        for (int ai = 0; ai < 2; ++ai)
#pragma unroll
            for (int m = 0; m < 4; ++m) { const int row = row0 + ai * HALF + m * 16; bf16_t* rowp = O + (size_t)row * ldc + col0;
                const float rs = rst ? rst[ui * 256 + (row & 255)] : 1.0f;
#pragma unroll
                for (int bj = 0; bj < 2; ++bj) { const f32x4 v0 = acc[ai][bj][m][0] * rs, v1 = acc[ai][bj][m][1] * rs;
                    u32x4 w; w.x = pk2(v0[0], v0[1]); w.y = pk2(v0[2], v0[3]); w.z = pk2(v1[0], v1[1]); w.w = pk2(v1[2], v1[3]);
                    *(u32x4*)(rowp + bj * HALF) = w; } }
    }
};
struct EpiResid {
    static constexpr bool PERM = true;
    bf16_t* HB; float* ssq;
    __device__ __forceinline__ void operator()(const f32x4 (&acc)[2][2][4][2], const Unit& u, int ui, int wr, int wc, int fr, int fq) const {
        const int row0 = u.pm * BM + wr * 64 + fr, col0 = u.pn * BM + wc * 32 + 8 * fq;
#pragma unroll
        for (int ai = 0; ai < 2; ++ai) {
            u32x4 hv[4][2];
#pragma unroll
            for (int m = 0; m < 4; ++m)
#pragma unroll
                for (int bj = 0; bj < 2; ++bj) hv[m][bj] = *(const u32x4*)(HB + (size_t)(row0 + ai * HALF + m * 16) * DM + col0 + bj * HALF);
            __builtin_amdgcn_sched_barrier(0);
#pragma unroll
            for (int m = 0; m < 4; ++m) { const int row = row0 + ai * HALF + m * 16; bf16_t* rowb = HB + (size_t)row * DM + col0;
                float q = 0.f;
#pragma unroll
                for (int bj = 0; bj < 2; ++bj) { const u32x4 hw = hv[m][bj]; const f32x4 v0 = acc[ai][bj][m][0], v1 = acc[ai][bj][m][1];
                    u32x4 w;
                    w.x = pk2(bf2f(hw.x & 0xffffu) + v0[0], bf2f(hw.x >> 16) + v0[1]); w.y = pk2(bf2f(hw.y & 0xffffu) + v0[2], bf2f(hw.y >> 16) + v0[3]);
                    w.z = pk2(bf2f(hw.z & 0xffffu) + v1[0], bf2f(hw.z >> 16) + v1[1]); w.w = pk2(bf2f(hw.w & 0xffffu) + v1[2], bf2f(hw.w >> 16) + v1[3]);
                    *(u32x4*)(rowb + bj * HALF) = w;
                    const float r0 = bf2f(w.x & 0xffffu), r1 = bf2f(w.x >> 16), r2 = bf2f(w.y & 0xffffu), r3 = bf2f(w.y >> 16), r4 = bf2f(w.z & 0xffffu), r5 = bf2f(w.z >> 16), r6 = bf2f(w.w & 0xffffu), r7 = bf2f(w.w >> 16);
                    q += ((r0 * r0 + r1 * r1) + (r2 * r2 + r3 * r3)) + ((r4 * r4 + r5 * r5) + (r6 * r6 + r7 * r7)); }
                q += __shfl_xor(q, 16); q += __shfl_xor(q, 32);
                if (fq == 0) ssq[(size_t)row * 16 + u.pn * 4 + wc] = q; }
            __builtin_amdgcn_sched_barrier(0);
        }
    }
};
struct EpiSwiglu {
    static constexpr bool PERM = true;
    bf16_t* O; const LAS float* rst;
    __device__ __forceinline__ void operator()(const f32x4 (&acc)[2][2][4][2], const Unit& u, int ui, int wr, int wc, int fr, int fq) const {
        const int row0 = u.pm * BM + wr * 64 + fr, col0 = u.pn * 128 + wc * 16 + 4 * fq;
#pragma unroll
        for (int ai = 0; ai < 2; ++ai)
#pragma unroll
            for (int m = 0; m < 4; ++m) { const int row = row0 + ai * HALF + m * 16; bf16_t* rowp = O + (size_t)row * DFF + col0;
                const float rs = rst[ui * 256 + (row & 255)];
#pragma unroll
                for (int bj = 0; bj < 2; ++bj) { const f32x4 gt = acc[ai][bj][m][0] * rs, up = acc[ai][bj][m][1] * rs; float o[4];
#pragma unroll
                    for (int j = 0; j < 4; ++j) o[j] = gt[j] * sigmoidf_(gt[j]) * up[j];
                    u32x2 w; w.x = pk2(o[0], o[1]); w.y = pk2(o[2], o[3]);
                    *(u32x2*)(rowp + bj * 64) = w; } }
    }
};
}

__device__ __forceinline__ void build_rs_table(LAS float* rst, const pg8::StaticOrder& S, const float* ssp) {
    const int tid = tid_opaque();
    pg8::Unit u;
    for (int i = 0; S.next(i, u); ++i) if (tid < 256) rst[i * 256 + tid] = row_rs(ssp, u.pm * 256 + tid);
    __syncthreads();
}
template <int KIND, int NB>
__device__ __forceinline__ void tail16(const bf16_t* A, const bf16_t* Bt, int N, int K, bf16_t* Out, int ldo, const float* ssp, float* ssq, LAS float* red) {
    const int tid = tid_opaque(), wid = __builtin_amdgcn_readfirstlane(tid >> 6), lane = tid & 63, fr = lane & 15, fq = lane >> 4;
    const int ntile = (KIND == 2) ? N / 32 : N / (16 * NB), nks = K >> 7;
    const int row = MAIN_ROWS + fr;
    for (int tile = blockIdx.x; tile < ntile; tile += gridDim.x) {
        f32x4 acc[NB];
#pragma unroll
        for (int be = 0; be < NB; ++be) acc[be] = (f32x4){0.f, 0.f, 0.f, 0.f};
        const bf16_t* ap = A + (size_t)row * K + fq * 8;
        const bf16_t* bp[NB];
        if (KIND == 2) { const int f = tile * 16 + fr, pn = f >> 7, ft = f & 127, r0 = pn * 256 + ((ft >> 2) << 3) + (ft & 3); bp[0] = Bt + (size_t)r0 * K + fq * 8; bp[1] = Bt + (size_t)(r0 + 4) * K + fq * 8; }
        else {
#pragma unroll
            for (int be = 0; be < NB; ++be) bp[be] = Bt + (size_t)(tile * 16 * NB + be * 16 + fr) * K + fq * 8; }
        for (int ks = wid; ks < nks; ks += 8) {
            bf16x8 av[4], bv[NB][4];
#pragma unroll
            for (int u = 0; u < 4; ++u) { av[u] = *(const bf16x8*)(ap + ks * 128 + u * 32);
#pragma unroll
                for (int be = 0; be < NB; ++be) bv[be][u] = *(const bf16x8*)(bp[be] + ks * 128 + u * 32); }
            __builtin_amdgcn_sched_barrier(0);
#pragma unroll
            for (int u = 0; u < 4; ++u)
#pragma unroll
                for (int be = 0; be < NB; ++be) acc[be] = __builtin_amdgcn_mfma_f32_16x16x32_bf16(bv[be][u], av[u], acc[be], 0, 0, 0);
        }
#pragma unroll
        for (int be = 0; be < NB; ++be) *(LAS f32x4*)(red + ((wid * NB + be) * 64 + lane) * 4) = acc[be];
        __syncthreads();
        if (wid == 0) {
#pragma unroll
            for (int be = 0; be < NB; ++be) { f32x4 t = *(const LAS f32x4*)(red + (be * 64 + lane) * 4);
#pragma unroll
                for (int w = 1; w < 8; ++w) t += *(const LAS f32x4*)(red + ((w * NB + be) * 64 + lane) * 4);
                acc[be] = t; }
            if (KIND == 0) {
                const float rs = ssp ? row_rs(ssp, row) : 1.0f;
#pragma unroll
                for (int be = 0; be < NB; ++be) { u32x2 w; w.x = pk2(acc[be][0] * rs, acc[be][1] * rs); w.y = pk2(acc[be][2] * rs, acc[be][3] * rs);
                    *(u32x2*)(Out + (size_t)row * ldo + tile * 16 * NB + be * 16 + fq * 4) = w; }
            } else if (KIND == 1) {
                float q = 0.f;
#pragma unroll
                for (int be = 0; be < NB; ++be) { bf16_t* o = Out + (size_t)row * ldo + tile * 16 * NB + be * 16 + fq * 4; const u32x2 hw = *(const u32x2*)o;
                    u32x2 w; w.x = pk2(bf2f(hw.x & 0xffffu) + acc[be][0], bf2f(hw.x >> 16) + acc[be][1]); w.y = pk2(bf2f(hw.y & 0xffffu) + acc[be][2], bf2f(hw.y >> 16) + acc[be][3]);
                    *(u32x2*)o = w;
                    const float r0 = bf2f(w.x & 0xffffu), r1 = bf2f(w.x >> 16), r2 = bf2f(w.y & 0xffffu), r3 = bf2f(w.y >> 16);
                    q += (r0 * r0 + r1 * r1) + (r2 * r2 + r3 * r3); }
                q += __shfl_xor(q, 16); q += __shfl_xor(q, 32);
                if (fq == 0) ssq[(size_t)row * 16 + tile] = q;
            } else {
                const float rs = row_rs(ssp, row); float v[4];
#pragma unroll
                for (int j = 0; j < 4; ++j) { const float g = acc[0][j] * rs; v[j] = g * sigmoidf_(g) * (acc[1][j] * rs); }
                u32x2 w; w.x = pk2(v[0], v[1]); w.y = pk2(v[2], v[3]);
                *(u32x2*)(Out + (size_t)row * ldo + tile * 16 + fq * 4) = w;
            }
        }
        __syncthreads();
    }
}

__device__ __forceinline__ void norm_rows(CArgs a, int mode) {
    const int tid = tid_opaque(), wid = tid >> 6, lane = tid & 63;
    bf16_t* HB = (bf16_t*)(a->ws + WS_H); float* SS = (float*)(a->ws + WS_SS);
    for (int row = blockIdx.x * 8 + wid; row < (mode == 0 ? NROWS : MAIN_ROWS); row += gridDim.x * 8) {
        float x[16]; float ss = 0.f;
        if (mode == 0) {
            const float* src = (row >= MAIN_ROWS ? a->in[1] + (size_t)(row - MAIN_ROWS) * DM : a->in[0] + (size_t)row * DM);
#pragma unroll
            for (int i = 0; i < 2; ++i) { const f32x4 v0 = *(const f32x4*)(src + lane * 8 + 512 * i), v1 = *(const f32x4*)(src + lane * 8 + 512 * i + 4);
                u32x4 w; w.x = pk2(v0[0], v0[1]); w.y = pk2(v0[2], v0[3]); w.z = pk2(v1[0], v1[1]); w.w = pk2(v1[2], v1[3]);
                *(u32x4*)(HB + (size_t)row * DM + lane * 8 + 512 * i) = w;
                float r[8]; unpack8(w, r);
#pragma unroll
                for (int e = 0; e < 8; ++e) ss += r[e] * r[e]; }
            ss = wave_sum(ss);
            if (lane < 16) SS[(size_t)row * 16 + lane] = (lane == 0) ? ss : 0.f;
        } else {
#pragma unroll
            for (int i = 0; i < 2; ++i) { float r[8]; unpack8(*(const u32x4*)(HB + (size_t)row * DM + lane * 8 + 512 * i), r);
#pragma unroll
                for (int e = 0; e < 8; ++e) { x[i * 8 + e] = r[e]; ss += r[e] * r[e]; } }
            ss = wave_sum(ss);
            const float rs = rsqrtf(ss * (1.0f / DM) + RMS_EPS);
            float* o = a->out + (size_t)row * DM;
#pragma unroll
            for (int i = 0; i < 2; ++i) { const f32x4 g0 = *(const f32x4*)(a->in[25] + lane * 8 + 512 * i), g1 = *(const f32x4*)(a->in[25] + lane * 8 + 512 * i + 4);
                *(f32x4*)(o + lane * 8 + 512 * i) = (f32x4){x[i * 8] * rs * g0[0], x[i * 8 + 1] * rs * g0[1], x[i * 8 + 2] * rs * g0[2], x[i * 8 + 3] * rs * g0[3]};
                *(f32x4*)(o + lane * 8 + 512 * i + 4) = (f32x4){x[i * 8 + 4] * rs * g1[0], x[i * 8 + 5] * rs * g1[1], x[i * 8 + 6] * rs * g1[2], x[i * 8 + 7] * rs * g1[3]}; }
        }
    }
}

template <int KIND> __device__ __forceinline__ float wsrc(CArgs a, int l, int k, int n) {
    if (KIND == 0) {
        const float gk = a->in[2][(size_t)l * DM + k];
        if (n < NIN) return gk * a->in[3][((size_t)l * DM + k) * NIN + n];
        if (n < NIN + 32 && l > 0) return gk * a->in[17][((size_t)(l - 1) * DM + k) * 32 + (n - NIN)];
        return 0.f;
    } else if (KIND == 1) {
        return a->in[21][((size_t)l * DM + k) * DM + n];
    } else if (KIND == 2) {
        const int pn = n >> 8, c = n & 255, feat = pn * 128 + ((c >> 3) << 2) + (c & 3), isup = (c >> 2) & 1;
        return a->in[22][(size_t)l * DM + k] * a->in[23][((size_t)l * DM + k) * (2 * DFF) + feat + isup * DFF];
    } else if (KIND == 3) {
        return a->in[24][((size_t)l * DFF + k) * DM + n];
    } else {
        const int j = n >> 9, nn = n & 511;
        if (j == 0) return (k < 64) ? a->in[8][((size_t)l * 64 + k) * 512 + nn] : 0.f;
        if (j == 1) return (k >= 64 && k < 128) ? a->in[10][((size_t)l * 64 + (k - 64)) * 512 + nn] : 0.f;
        if (j == 2) return (k >= 128 && k < 288) ? a->in[11][((size_t)l * 160 + (k - 128)) * 512 + nn] : 0.f;
        return (k >= 288 && k < 320 && l > 0) ? a->in[20][((size_t)(l - 1) * 32 + (k - 288)) * 512 + nn] : 0.f;
    }
}
template <int KIND> __device__ __forceinline__ void conv_tile(CArgs a, int l, LAS float* tile, bf16_t* out, int ldo, int n0, int k0) {
    const int tid = tid_opaque(), kk = tid >> 6, nn = tid & 63;
#pragma unroll
    for (int i = 0; i < 8; ++i) tile[(kk + 8 * i) * 65 + nn] = wsrc<KIND>(a, l, k0 + kk + 8 * i, n0 + nn);
    __syncthreads();
    const int n = tid >> 3, kq = tid & 7;
    u32x4 w;
    w.x = pk2(tile[(kq * 8 + 0) * 65 + n], tile[(kq * 8 + 1) * 65 + n]); w.y = pk2(tile[(kq * 8 + 2) * 65 + n], tile[(kq * 8 + 3) * 65 + n]);
    w.z = pk2(tile[(kq * 8 + 4) * 65 + n], tile[(kq * 8 + 5) * 65 + n]); w.w = pk2(tile[(kq * 8 + 6) * 65 + n], tile[(kq * 8 + 7) * 65 + n]);
    *(u32x4*)(out + (size_t)(n0 + n) * ldo + k0 + kq * 8) = w;
    __syncthreads();
}
__device__ __forceinline__ void fold_tile(CArgs a, int l, LAS float* lds, bf16_t* out, int n0, int k0) {
    LAS float* P = lds; LAS float* W = lds + 64 * 128;
    const int tid = tid_opaque(), g = k0 >> 7, c0 = k0 & 127;
    const float* pw = a->in[5] + ((size_t)(l * 4 + g) * 128 + c0) * 128; const float* sc = a->in[6] + (size_t)l * 512 + g * 128;
    const float* wo = a->in[21] + ((size_t)l * DM + g * 128) * DM + n0;
    for (int i = tid; i < 64 * 128; i += 512) { const int d = i & 127; P[i] = pw[i] * sc[d]; }
    for (int i = tid; i < 128 * 64; i += 512) { const int d = i >> 6, n = i & 63; W[i] = wo[(size_t)d * DM + n]; }
    __syncthreads();
    const int n = tid & 63, cq = tid >> 6;
    float acc[8];
#pragma unroll
    for (int j = 0; j < 8; ++j) acc[j] = 0.f;
    for (int d = 0; d < 128; ++d) { const float wv = W[d * 64 + n];
#pragma unroll
        for (int j = 0; j < 8; ++j) acc[j] += P[(cq * 8 + j) * 128 + d] * wv; }
    u32x4 w; w.x = pk2(acc[0], acc[1]); w.y = pk2(acc[2], acc[3]); w.z = pk2(acc[4], acc[5]); w.w = pk2(acc[6], acc[7]);
    *(u32x4*)(out + (size_t)(n0 + n) * DM + k0 + cq * 8) = w;
    __syncthreads();
}
__device__ __forceinline__ void weight_prep(CArgs a, int l, LAS float* lds, int b0, int nb) {
    unsigned char* wb = a->ws + WS_WB + (size_t)(l & 1) * WB_SIZE;
    bf16_t* WC = (bf16_t*)(wb + WB_WC); bf16_t* WO = (bf16_t*)(wb + WB_WOUT); bf16_t* WGU = (bf16_t*)(wb + WB_WGU); bf16_t* WDN = (bf16_t*)(wb + WB_WDN); bf16_t* WL = (bf16_t*)(wb + WB_WL);
    for (int ti = (int)blockIdx.x - b0; ti < 3200; ti += nb) {
        if (ti < 128) { fold_tile(a, l, lds, WO, (ti & 15) * 64, (ti >> 4) * 64); }
        else if (ti < 256) { const int q = ti - 128; conv_tile<1>(a, l, lds, WO, DM, (q & 15) * 64, 512 + (q >> 4) * 64); }
        else if (ti < 896) { const int q = ti - 256; conv_tile<0>(a, l, lds, WC, DM, (q >> 4) * 64, (q & 15) * 64); }
        else if (ti < 2304) { const int q = ti - 896; conv_tile<2>(a, l, lds, WGU, DM, (q >> 4) * 64, (q & 15) * 64); }
        else if (ti < 3008) { const int q = ti - 2304; conv_tile<3>(a, l, lds, WDN, DFF, (q / 44) * 64, (q % 44) * 64); }
        else { const int q = ti - 3008; conv_tile<4>(a, l, lds, WL, KL, (q / 6) * 64, (q % 6) * 64); }
    }
}

__device__ __forceinline__ void prep_phase(CArgs a, int l) {
    const bf16_t* PROJ = (const bf16_t*)(a->ws + WS_R1);
    bf16_t* MIX = (bf16_t*)((unsigned char*)a->out + DO_MIX); bf16_t* LIN = (bf16_t*)((unsigned char*)a->out + DO_LIN);
    const int tid = tid_opaque(), gt = blockIdx.x * 512 + tid, nthr = gridDim.x * 512;
    for (int it = gt; it < (MAIN_ROWS / 16 + 1) * 64; it += nthr) {
        const int run = it >> 6, c0 = (it & 63) * 8, win = 2 << (c0 >> 7);
        const int b = run >> 7, t0 = (run < MAIN_ROWS / 16) ? NMETA + (run & 127) * 16 : 0;
        float s[8], x[8], y[8];
#pragma unroll
        for (int e = 0; e < 8; ++e) s[e] = 0.f;
        const int pre = (t0 < win) ? t0 : win;
        for (int q = 1; q <= pre; ++q) { unpack8(*(const u32x4*)(PROJ + (size_t)row_of(b, t0 - q) * NPROJ + c0), x);
#pragma unroll
            for (int e = 0; e < 8; ++e) s[e] += x[e]; }
        for (int i = 0; i < 16; ++i) {
            const int t = t0 + i, row = row_of(b, t);
            unpack8(*(const u32x4*)(PROJ + (size_t)row * NPROJ + c0), x);
            if (t >= win) { unpack8(*(const u32x4*)(PROJ + (size_t)row_of(b, t - win) * NPROJ + c0), y);
#pragma unroll
                for (int e = 0; e < 8; ++e) s[e] += x[e] - y[e]; }
            else {
#pragma unroll
                for (int e = 0; e < 8; ++e) s[e] += x[e]; }
            const float inv = 1.0f / (float)((t + 1 < win) ? t + 1 : win);
            u32x4 o; o.x = pk2(s[0] * inv - x[0], s[1] * inv - x[1]); o.y = pk2(s[2] * inv - x[2], s[3] * inv - x[3]);
            o.z = pk2(s[4] * inv - x[4], s[5] * inv - x[5]); o.w = pk2(s[6] * inv - x[6], s[7] * inv - x[7]);
            *(u32x4*)(MIX + (size_t)row * DM + c0) = o;
        }
    }
    for (int it = gt; it < NROWS * 48; it += nthr) {
        const int row = it / 48, cb = (it - row * 48) * 8;
        const int prow = (row >= MAIN_ROWS) ? (row > MAIN_ROWS ? row - 1 : -1) : ((row & (SEQ - 1)) ? row - 1 : NROWS - 1);
        u32x4 o = (u32x4){0u, 0u, 0u, 0u};
        if (cb < 320) {
            float xc[8], xp[8], mu[8], y[8];
            unpack8(*(const u32x4*)(PROJ + (size_t)row * NPROJ + 2048 + cb), xc);
            u32x4 wp = (u32x4){0u, 0u, 0u, 0u};
            if (prow >= 0) wp = *(const u32x4*)(PROJ + (size_t)prow * NPROJ + 2048 + cb);
            unpack8(wp, xp);
            const float* mp = (cb < 288) ? a->in[4] + (size_t)l * NSHIFT + 1536 + cb : a->in[18] + (l > 0 ? (l - 1) * 32 + (cb - 288) : 0);
            const f32x4 m0 = *(const f32x4*)mp, m1 = *(const f32x4*)(mp + 4);
            mu[0] = m0[0]; mu[1] = m0[1]; mu[2] = m0[2]; mu[3] = m0[3]; mu[4] = m1[0]; mu[5] = m1[1]; mu[6] = m1[2]; mu[7] = m1[3];
#pragma unroll
            for (int e = 0; e < 8; ++e) {
                const float sv = xc[e] + (xp[e] - xc[e]) * mu[e];
                y[e] = (cb < 64) ? 1.0f - 2.0f * __builtin_amdgcn_rcpf(1.0f + __builtin_amdgcn_exp2f(sv * 2.88539008f)) : (cb < 128) ? sv : (cb < 288) ? sigmoidf_(sv) : sv;
            }
            o.x = pk2(y[0], y[1]); o.y = pk2(y[2], y[3]); o.z = pk2(y[4], y[5]); o.w = pk2(y[6], y[7]);
        }
        *(u32x4*)(LIN + (size_t)row * KL + cb) = o;
    }
}

constexpr int TC = 16, NCH = TT / TC;
constexpr int SB_A = 0, SB_Q = 1, SB_W = 2, SB_B = 3, SB_K = 4, SB_V = 5, SB_G = 6, SB_Y = 7, SBUF = 8 * TC * 64 + TC * 4;
__device__ __forceinline__ void scan_phase(CArgs a, int l, LAS float* lds) {
    const int bid = blockIdx.x; if (bid >= BATCH * 8) return;
    const int b = bid >> 3, h = bid & 7, tid = tid_opaque(), wid = __builtin_amdgcn_readfirstlane(tid >> 6), lane = tid & 63;
    const bf16_t* PROJ = (const bf16_t*)(a->ws + WS_R1); const bf16_t* LO = (const bf16_t*)(a->ws + WS_LO);
    bf16_t* VF = (bf16_t*)((unsigned char*)a->out + DO_VF); bf16_t* MIX = (bf16_t*)((unsigned char*)a->out + DO_MIX);
    if (wid < 4) {
        __builtin_amdgcn_s_setprio(2);
        const int rp = wid * 16 + (lane >> 3) * 2, seg = lane & 7;
        f32x2 S0[4], S1[4];
#pragma unroll
        for (int j = 0; j < 4; ++j) { S0[j] = (f32x2){0.f, 0.f}; S1[j] = (f32x2){0.f, 0.f}; }
        for (int it = 0; it < NCH + 2; ++it) {
            if (it >= 1 && it <= NCH) {
                LAS float* buf = lds + ((it - 1) & 1) * SBUF;
#pragma unroll 4
                for (int tl = 0; tl < TC; ++tl) {
                    const LAS float* base = buf + tl * 64 + seg * 8;
                    const f32x4 a0 = *(const LAS f32x4*)(base + SB_A * TC * 64), a1 = *(const LAS f32x4*)(base + SB_A * TC * 64 + 4);
                    const f32x4 q0 = *(const LAS f32x4*)(base + SB_Q * TC * 64), q1 = *(const LAS f32x4*)(base + SB_Q * TC * 64 + 4);
                    const f32x4 w0 = *(const LAS f32x4*)(base + SB_W * TC * 64), w1 = *(const LAS f32x4*)(base + SB_W * TC * 64 + 4);
                    const f32x4 b0 = *(const LAS f32x4*)(base + SB_B * TC * 64), b1 = *(const LAS f32x4*)(base + SB_B * TC * 64 + 4);
                    const f32x4 k0 = *(const LAS f32x4*)(base + SB_K * TC * 64), k1 = *(const LAS f32x4*)(base + SB_K * TC * 64 + 4);
                    const f32x2 vv = *(const LAS f32x2*)(buf + SB_V * TC * 64 + tl * 64 + rp);
                    const f32x2 sc = *(const LAS f32x2*)(buf + 8 * TC * 64 + tl * 4);
                    const f32x2 av[4] = {{a0[0], a0[1]}, {a0[2], a0[3]}, {a1[0], a1[1]}, {a1[2], a1[3]}};
                    const f32x2 qv[4] = {{q0[0], q0[1]}, {q0[2], q0[3]}, {q1[0], q1[1]}, {q1[2], q1[3]}};
                    const f32x2 wv[4] = {{w0[0], w0[1]}, {w0[2], w0[3]}, {w1[0], w1[1]}, {w1[2], w1[3]}};
                    const f32x2 bv[4] = {{b0[0], b0[1]}, {b0[2], b0[3]}, {b1[0], b1[1]}, {b1[2], b1[3]}};
                    const f32x2 kv[4] = {{k0[0], k0[1]}, {k0[2], k0[3]}, {k1[0], k1[1]}, {k1[2], k1[3]}};
                    f32x2 pa0 = S0[0] * av[0], pa1 = S1[0] * av[0], pq0 = S0[0] * qv[0], pq1 = S1[0] * qv[0];
#pragma unroll
                    for (int j = 1; j < 4; ++j) { pa0 += S0[j] * av[j]; pa1 += S1[j] * av[j]; pq0 += S0[j] * qv[j]; pq1 += S1[j] * qv[j]; }
                    float sa0 = pa0.x + pa0.y, sa1 = pa1.x + pa1.y, y0 = pq0.x + pq0.y, y1 = pq1.x + pq1.y;
                    allred8x4(sa0, sa1, y0, y1);
                    const f32x2 sav0 = {sa0, sa0}, sav1 = {sa1, sa1}, vv0 = {vv.x, vv.x}, vv1 = {vv.y, vv.y};
#pragma unroll
                    for (int j = 0; j < 4; ++j) { S0[j] = S0[j] * wv[j] + sav0 * bv[j] + vv0 * kv[j]; S1[j] = S1[j] * wv[j] + sav1 * bv[j] + vv1 * kv[j]; }
                    if (seg == 0) *(LAS f32x2*)(buf + SB_Y * TC * 64 + tl * 64 + rp) = (f32x2){y0 + sa0 * sc.x + vv.x * sc.y, y1 + sa1 * sc.x + vv.y * sc.y};
                }
            }
            __syncthreads();
        }
        __builtin_amdgcn_s_setprio(0);
    } else {
        const int hw = wid - 4, ch = h * 64 + lane;
        const float mu_r = a->in[4][(size_t)l * NSHIFT + ch], mu_k = a->in[4][(size_t)l * NSHIFT + 512 + ch], mu_v = a->in[4][(size_t)l * NSHIFT + 1024 + ch];
        const float w0_c = a->in[7][l * 512 + ch], a0_c = a->in[9][l * 512 + ch], v0_c = (l > 0) ? a->in[19][(l - 1) * 512 + ch] : 0.f;
        const float kk_c = a->in[12][l * 512 + ch], ka_c = a->in[13][l * 512 + ch], rk_c = a->in[14][l * 512 + ch], gw = a->in[15][l * 512 + ch], gb = a->in[16][l * 512 + ch];
        unsigned short ld[4][11];
#define SCAN_LOAD(c) do { _Pragma("unroll") for (int p = 0; p < 4; ++p) { const int t = (c) * TC + p * 4 + hw; const size_t m = (size_t)row_of(b, t); \
        const bf16_t* pr = PROJ + m * NPROJ + 512 + ch; ld[p][0] = pr[0]; ld[p][1] = pr[512]; ld[p][2] = pr[1024]; \
        if (t > 0) { const bf16_t* pp = PROJ + (size_t)row_of(b, t - 1) * NPROJ + 512 + ch; ld[p][3] = pp[0]; ld[p][4] = pp[512]; ld[p][5] = pp[1024]; } else { ld[p][3] = 0; ld[p][4] = 0; ld[p][5] = 0; } \
        const bf16_t* po = LO + m * NL + ch; ld[p][6] = po[0]; ld[p][7] = po[512]; ld[p][8] = po[1024]; ld[p][9] = po[1536]; \
        ld[p][10] = (l > 0) ? VF[m * 512 + ch] : (unsigned short)0; } } while (0)
        SCAN_LOAD(0);
        for (int it = 0; it < NCH + 2; ++it) {
            LAS float* buf = lds + (it & 1) * SBUF;
            if (it >= 2) {
#pragma unroll
                for (int p = 0; p < 4; ++p) {
                    const int tl = p * 4 + hw; const size_t m = (size_t)row_of(b, (it - 2) * TC + tl);
                    const float y = buf[SB_Y * TC * 64 + tl * 64 + lane];
                    const float mean = wave_sum(y) * (1.0f / 64.0f), d = y - mean, var = wave_sum(d * d) * (1.0f / 64.0f);
                    const float o = (d * rsqrtf(var + GN_EPS) * gw + gb + buf[8 * TC * 64 + tl * 4 + 2] * buf[SB_V * TC * 64 + tl * 64 + lane]) * buf[SB_G * TC * 64 + tl * 64 + lane];
                    if (it > 2 || b == 0) MIX[m * DM + 512 + ch] = (bf16_t)f2bf(o);
                }
            }
            if (it < NCH) {
#pragma unroll
                for (int p = 0; p < 4; ++p) {
                    const int tl = p * 4 + hw; const size_t m = (size_t)row_of(b, it * TC + tl);
                    const float rc = bf2f(ld[p][0]), kc = bf2f(ld[p][1]), vc = bf2f(ld[p][2]), rpv = bf2f(ld[p][3]), kp = bf2f(ld[p][4]), vp = bf2f(ld[p][5]);
                    const float e = sigmoidf_(w0_c + bf2f(ld[p][6])) * 0.60653066f, av = sigmoidf_(a0_c + bf2f(ld[p][7])), gv = bf2f(ld[p][8]), vm = sigmoidf_(v0_c + bf2f(ld[p][9]));
                    const float r = rc + (rpv - rc) * mu_r, k = kc + (kp - kc) * mu_k; float v = vc + (vp - vc) * mu_v;
                    if (l == 0) { if (it > 0 || b == 0) VF[m * 512 + ch] = (bf16_t)f2bf(v); } else { const float vf = bf2f(ld[p][10]); v = v + (vf - v) * vm; }
                    float kk = k * kk_c; const float n2 = wave_sum(kk * kk); kk = kk * rsqrtf(fmaxf(n2, 1e-24f));
                    const float k2 = k * (1.0f + (av - 1.0f) * ka_c), w = __expf(-e), bb = kk * av;
                    float br = bb * r, kr = k2 * r, cf = kr * rk_c; wave_sum3(br, kr, cf);
                    buf[SB_A * TC * 64 + tl * 64 + lane] = -kk; buf[SB_Q * TC * 64 + tl * 64 + lane] = w * r; buf[SB_W * TC * 64 + tl * 64 + lane] = w;
                    buf[SB_B * TC * 64 + tl * 64 + lane] = bb; buf[SB_K * TC * 64 + tl * 64 + lane] = k2; buf[SB_V * TC * 64 + tl * 64 + lane] = v; buf[SB_G * TC * 64 + tl * 64 + lane] = gv;
                    if (lane < 3) buf[8 * TC * 64 + tl * 4 + lane] = (lane == 0) ? br : (lane == 1) ? kr : cf;
                }
                if (it + 1 < NCH) SCAN_LOAD(it + 1);
            }
            __syncthreads();
        }
#undef SCAN_LOAD
    }
}

__global__ void __launch_bounds__(512, 2) mega(Args a_unused) {
    extern __shared__ __attribute__((aligned(16))) unsigned char shm[];
    LAS unsigned char* lds = (LAS unsigned char*)shm;
    cg::grid_group grid = cg::this_grid();
    CArgs a0 = (CArgs)__builtin_amdgcn_kernarg_segment_ptr();
    const int ph_lo = a0->ph_lo, ph_hi = a0->ph_hi;
    for (int ph = ph_lo; ph < ph_hi; ++ph) {
        if (ph > ph_lo) grid.sync();
        CArgs a = a0; asm volatile("" : "+s"(a));
        if (ph == 0) { norm_rows(a, 0); weight_prep(a, 0, (LAS float*)lds, 0, gridDim.x); continue; }
        if (ph == NPH - 1) { norm_rows(a, 2); continue; }
        const int l = (ph - 1) / 7, s = (ph - 1) % 7;
        bf16_t* HB = (bf16_t*)(a->ws + WS_H); float* SS = (float*)(a->ws + WS_SS);
        const unsigned char* wb = a->ws + WS_WB + (size_t)(l & 1) * WB_SIZE;
        if (s == 0 || s == 2) {
            pg8::Gemm g{s == 0 ? HB : (const bf16_t*)((unsigned char*)a->out + DO_LIN), (const bf16_t*)(wb + (s == 0 ? WB_WC : WB_WL)), MR, s == 0 ? NPROJ : NL, s == 0 ? DM : KL};
            pg8::StaticOrder S; S.init(MAIN_ROWS, g.N, gridDim.x, blockIdx.x);
            LAS float* rst = (LAS float*)(lds + 131072);
            if (s == 0) build_rs_table(rst, S, SS);
            pg8::EpiProj E{(bf16_t*)(a->ws + (s == 0 ? WS_R1 : WS_LO)), g.N, s == 0 ? rst : (LAS float*)nullptr};
            pg8::gemm_phase(lds, g, S, E);
            tail16<0, 2>(g.A, g.Bt, g.N, g.K, E.O, g.N, s == 0 ? SS : nullptr, nullptr, (LAS float*)lds);
        }
        else if (s == 1) prep_phase(a, l);
        else if (s == 3) {
            if (blockIdx.x < BATCH * 8) scan_phase(a, l, (LAS float*)lds);
            else if (l + 1 < DEPTH) weight_prep(a, l + 1, (LAS float*)lds, BATCH * 8, gridDim.x - BATCH * 8);
        }
        else if (s == 4 || s == 6) {
            pg8::Gemm g{s == 4 ? (const bf16_t*)((unsigned char*)a->out + DO_MIX) : (const bf16_t*)(a->ws + WS_R1), (const bf16_t*)(wb + (s == 4 ? WB_WOUT : WB_WDN)), MR, DM, s == 4 ? DM : DFF};
            pg8::StaticOrder S; S.init(MAIN_ROWS, DM, gridDim.x, blockIdx.x);
            pg8::EpiResid E{HB, SS + (s == 4 ? (size_t)MR * 16 : 0)};
            pg8::gemm_phase(lds, g, S, E);
            tail16<1, 4>(g.A, g.Bt, g.N, g.K, HB, DM, nullptr, E.ssq, (LAS float*)lds);
        }
        else {
            pg8::Gemm g{HB, (const bf16_t*)(wb + WB_WGU), MR, 2 * DFF, DM}; pg8::StaticOrder S; S.init(MAIN_ROWS, 2 * DFF, gridDim.x, blockIdx.x);
            LAS float* rst = (LAS float*)(lds + 131072); build_rs_table(rst, S, SS + (size_t)MR * 16);
            pg8::EpiSwiglu E{(bf16_t*)(a->ws + WS_R1), rst};
            pg8::gemm_phase(lds, g, S, E);
            tail16<2, 2>(g.A, g.Bt, g.N, g.K, E.O, DFF, SS + (size_t)MR * 16, nullptr, (LAS float*)lds);
        }
    }
}

extern "C" void kernel_launch(void* const* d_in, const int* in_sizes, int n_in, void* d_out, int out_size, void* d_ws, size_t ws_size, hipStream_t stream) {
    static int grid = 0;
    if (grid == 0) {
        if (n_in != 26 || out_size != BATCH * SEQ * DM || ws_size < WS_END) { fprintf(stderr, "kernel_launch: unexpected shapes (n_in %d out %d ws %zu need %zu)\n", n_in, out_size, ws_size, (size_t)WS_END); grid = -1; return; }
        int dev = 0, cus = 0, per_cu = 0;
        hipGetDevice(&dev);
        hipDeviceGetAttribute(&cus, hipDeviceAttributeMultiprocessorCount, dev);
        if (hipFuncSetAttribute((const void*)mega, hipFuncAttributeMaxDynamicSharedMemorySize, LDS_BYTES) != hipSuccess) { fprintf(stderr, "kernel_launch: hipFuncSetAttribute failed\n"); grid = -1; return; }
        hipOccupancyMaxActiveBlocksPerMultiprocessor(&per_cu, (const void*)mega, 512, LDS_BYTES);
        if (per_cu < 1) { fprintf(stderr, "kernel_launch: occupancy query says %d blocks per CU\n", per_cu); per_cu = 1; }
        (void)hipGetLastError();
        grid = cus;
        fprintf(stderr, "kernel_launch: grid %d (per_cu %d)\n", grid, per_cu);
    }
    if (grid < 0) return;
    Args a{};
    for (int i = 0; i < 26; ++i) a.in[i] = (const float*)d_in[i];
    a.out = (float*)d_out; a.ws = (unsigned char*)d_ws;
#if MK_MULTI
    for (int ph = 0; ph < NPH; ++ph) {
        a.ph_lo = ph; a.ph_hi = ph + 1;
        void* args[] = {&a};
        hipError_t e = hipLaunchCooperativeKernel((const void*)mega, dim3(grid), dim3(512), args, LDS_BYTES, stream);
        if (e != hipSuccess) { fprintf(stderr, "cooperative launch failed: %s\n", hipGetErrorString(e)); break; }
    }
#else
    a.ph_lo = 0; a.ph_hi = NPH;
    void* args[] = {&a};
    hipError_t e = hipLaunchCooperativeKernel((const void*)mega, dim3(grid), dim3(512), args, LDS_BYTES, stream);
    if (e != hipSuccess) fprintf(stderr, "cooperative launch failed: %s (grid %d)\n", hipGetErrorString(e), grid);
#endif
}
```

```cpp
#include <hip/hip_runtime.h>
#include <hip/hip_cooperative_groups.h>
#include <cstdio>
#include <cstdint>
namespace cg = cooperative_groups;

#ifndef MK_MULTI
#define MK_MULTI 0
#endif

#define LAS __attribute__((address_space(3)))
typedef unsigned short bf16_t;
typedef short bf16x8 __attribute__((ext_vector_type(8)));
typedef float f32x4 __attribute__((ext_vector_type(4)));
typedef float f32x2 __attribute__((ext_vector_type(2)));
typedef unsigned u32x4 __attribute__((ext_vector_type(4)));
typedef unsigned u32x2 __attribute__((ext_vector_type(2)));

constexpr int DM = 1024, BATCH = 16, SEQ = 2048, DEPTH = 4, NMETA = 16, TT = SEQ + NMETA  , MR = BATCH * TT  ;
constexpr int NIN = 2336, NSHIFT = 1824, DFF = 2816, NPROJ = 2560  , KL = 384  , NL = 2048;
constexpr float RMS_EPS = 1e-6f, GN_EPS = 64e-5f;
constexpr int LDS_BYTES = 131072 + 16384;
constexpr int NPH = DEPTH * 7 + 2;

constexpr size_t WB_WC = 0;
constexpr size_t WB_WOUT = WB_WC + (size_t)NPROJ * DM * 2;
constexpr size_t WB_WGU = WB_WOUT + (size_t)DM * DM * 2;
constexpr size_t WB_WDN = WB_WGU + (size_t)2 * DFF * DM * 2;
constexpr size_t WB_WL = WB_WDN + (size_t)DM * DFF * 2;
constexpr size_t WB_LB = WB_WL + (size_t)NL * KL * 2;
constexpr size_t WB_SIZE = WB_LB + 8192;
constexpr size_t WS_WB = 4096;
constexpr size_t WS_SS = WS_WB + 2 * WB_SIZE;
constexpr size_t WS_H = WS_SS + 2 * (size_t)MR * 64;
constexpr size_t WS_R1 = WS_H + (size_t)MR * DM * 4;
constexpr size_t WS_LO = WS_R1 + (size_t)MR * DFF * 2;
constexpr size_t WS_END = WS_LO + (size_t)MR * NL * 2;
static_assert(WS_END <= 536870912, "workspace map");
constexpr size_t DO_MIX = 0;
constexpr size_t DO_VF = DO_MIX + (size_t)MR * DM * 2;
constexpr size_t DO_LIN = DO_VF + (size_t)MR * 512 * 2;
static_assert(DO_LIN + (size_t)MR * KL * 2 <= (size_t)BATCH * SEQ * DM * 4, "d_out scratch");

struct Args { const float* in[26]; float* out; unsigned char* ws; int ph_lo, ph_hi; };
typedef const __attribute__((address_space(4))) Args* CArgs;

__device__ __forceinline__ float bf2f(unsigned b) { return __uint_as_float(b << 16); }
__device__ __forceinline__ unsigned f2bf(float f) { unsigned u = __float_as_uint(f); return (u + 0x7fffu + ((u >> 16) & 1u)) >> 16; }
__device__ __forceinline__ unsigned pk2(float lo, float hi) { unsigned r; asm volatile("v_cvt_pk_bf16_f32 %0, %1, %2" : "=v"(r) : "v"(lo), "v"(hi)); return r; }
__device__ __forceinline__ float sigmoidf_(float x) { return __builtin_amdgcn_rcpf(1.0f + __builtin_amdgcn_exp2f(x * -1.44269504f)); }
template <int CTRL> __device__ __forceinline__ float dppf(float x) { return __int_as_float(__builtin_amdgcn_update_dpp(0, __float_as_int(x), CTRL, 0xF, 0xF, true)); }
__device__ __forceinline__ float allred8(float x) { x += dppf<0xB1>(x); x += dppf<0x4E>(x); x += dppf<0x141>(x); return x; }
#define DPP_ADD(r, ctl) "v_add_f32_dpp " r ", " r ", " r " " ctl " row_mask:0xf bank_mask:0xf\n\t"
__device__ __forceinline__ void allred8x4(float& a, float& b, float& c, float& d) {
    asm volatile("s_nop 1\n\t"
        DPP_ADD("%0", "quad_perm:[1,0,3,2]") DPP_ADD("%1", "quad_perm:[1,0,3,2]") DPP_ADD("%2", "quad_perm:[1,0,3,2]") DPP_ADD("%3", "quad_perm:[1,0,3,2]")
        DPP_ADD("%0", "quad_perm:[2,3,0,1]") DPP_ADD("%1", "quad_perm:[2,3,0,1]") DPP_ADD("%2", "quad_perm:[2,3,0,1]") DPP_ADD("%3", "quad_perm:[2,3,0,1]")
        DPP_ADD("%0", "row_half_mirror") DPP_ADD("%1", "row_half_mirror") DPP_ADD("%2", "row_half_mirror") DPP_ADD("%3", "row_half_mirror")
        : "+v"(a), "+v"(b), "+v"(c), "+v"(d));
}
__device__ __forceinline__ float rows_to_wave(float x) {
    const int xi = __float_as_int(x);
    return (__int_as_float(__builtin_amdgcn_readlane(xi, 0)) + __int_as_float(__builtin_amdgcn_readlane(xi, 16))) + (__int_as_float(__builtin_amdgcn_readlane(xi, 32)) + __int_as_float(__builtin_amdgcn_readlane(xi, 48)));
}
__device__ __forceinline__ float wave_sum(float x) {
    asm volatile("s_nop 1\n\t" DPP_ADD("%0", "quad_perm:[1,0,3,2]") "s_nop 1\n\t" DPP_ADD("%0", "quad_perm:[2,3,0,1]") "s_nop 1\n\t" DPP_ADD("%0", "row_half_mirror") "s_nop 1\n\t" DPP_ADD("%0", "row_mirror") : "+v"(x));
    return rows_to_wave(x);
}
__device__ __forceinline__ void wave_sum3(float& a, float& b, float& c) {
    asm volatile("s_nop 1\n\t"
        DPP_ADD("%0", "quad_perm:[1,0,3,2]") DPP_ADD("%1", "quad_perm:[1,0,3,2]") DPP_ADD("%2", "quad_perm:[1,0,3,2]")
        DPP_ADD("%0", "quad_perm:[2,3,0,1]") DPP_ADD("%1", "quad_perm:[2,3,0,1]") DPP_ADD("%2", "quad_perm:[2,3,0,1]")
        DPP_ADD("%0", "row_half_mirror") DPP_ADD("%1", "row_half_mirror") DPP_ADD("%2", "row_half_mirror")
        DPP_ADD("%0", "row_mirror") DPP_ADD("%1", "row_mirror") DPP_ADD("%2", "row_mirror")
        : "+v"(a), "+v"(b), "+v"(c));
    a = rows_to_wave(a); b = rows_to_wave(b); c = rows_to_wave(c);
}
__device__ __forceinline__ int tid_opaque() { int t = threadIdx.x; asm volatile("" : "+v"(t)); return t; }

__device__ __forceinline__ void unpack8(const u32x4 w, float (&x)[8]) {
    x[0] = bf2f(w.x & 0xffffu); x[1] = bf2f(w.x >> 16); x[2] = bf2f(w.y & 0xffffu); x[3] = bf2f(w.y >> 16);
    x[4] = bf2f(w.z & 0xffffu); x[5] = bf2f(w.z >> 16); x[6] = bf2f(w.w & 0xffffu); x[7] = bf2f(w.w >> 16);
}
constexpr int MAIN_ROWS = BATCH * SEQ, NROWS = MAIN_ROWS + NMETA;
__device__ __forceinline__ int row_of(int b, int t) { return t < NMETA ? MAIN_ROWS + t : b * SEQ + (t - NMETA); }
__device__ __forceinline__ float row_rs(const float* ssp, int row) {
    const f32x4* p = (const f32x4*)(ssp + (size_t)row * 16); const f32x4 a = p[0], b = p[1], c = p[2], d = p[3];
    const f32x4 t = (a + b) + (c + d);
    return rsqrtf(((t[0] + t[1]) + (t[2] + t[3])) * (1.0f / DM) + RMS_EPS);
}
namespace pg8 {
constexpr int BM = 256, BK = 64, HALF = 128, HTB = HALF * BK * 2, STAGE_BYTES = 8 * HTB, NXCD = 8, WGM = 8;
__host__ __device__ __forceinline__ int lds_byte(int r, int c) { const int st = (r >> 4) * 2 + (c >> 5), rr = r & 15, cc = c & 31, ob = rr * 64 + cc * 2; return st * 1024 + (ob ^ (((ob >> 9) & 1) << 5)); }
__host__ __device__ __forceinline__ void stage_rc(int b, int& R, int& C) { const int st = b / 1024, sb = b % 1024, swz = sb ^ (((sb >> 9) & 1) << 5); R = (st >> 1) * 16 + swz / 64; C = (st & 1) * 32 + (swz % 64) / 2; }
__host__ __device__ __forceinline__ int perm32(int rho) { const int n = rho >> 4, i = rho & 15; return 8 * (i >> 2) + 4 * n + (i & 3); }
struct Unit { int pm, pn; };
struct Gemm { const bf16_t* A; const bf16_t* Bt; int M, N, K; };
struct StaticOrder {
    int nM, nN, nwg, G, c;
    __device__ void init(int M, int N, int G_, int c_) { nM = M / BM; nN = N / BM; nwg = nM * nN; G = G_; c = c_; }
    __device__ bool next(int i, Unit& u) const {
        const long L = (long)i * G + c; if (L >= nwg) return false;
        int wgid = (int)L; { const int q = nwg / NXCD, r = nwg % NXCD, xcd = wgid % NXCD, off = wgid / NXCD; wgid = (xcd < r ? xcd * (q + 1) : r * (q + 1) + (xcd - r) * q) + off; }
        const int nig = WGM * nN, gid = wgid / nig, fm = gid * WGM, gsz = (nM - fm) < WGM ? (nM - fm) : WGM;
        u.pm = fm + ((wgid % nig) % gsz); u.pn = (wgid % nig) / gsz; return true;
    }
};
template <class Epi>
__device__ __forceinline__ void gemm_phase(LAS unsigned char* lds, const Gemm g, const StaticOrder& S, const Epi& E) {
    int tid_ = threadIdx.x; asm volatile("" : "+v"(tid_));
    const int tid = tid_, wid = __builtin_amdgcn_readfirstlane(tid >> 6), lane = tid & 63, wr = wid >> 2, wc = wid & 3, fr = lane & 15, fq = lane >> 4;
    const int K = g.K, nt = K / BK;
    unsigned voffA[2], voffB[2];
#pragma unroll
    for (int i = 0; i < 2; ++i) { int R, C; stage_rc(tid * 16 + i * 8192, R, C); const int Rb = Epi::PERM ? ((R & ~31) + perm32(R & 31)) : R;
        voffA[i] = (unsigned)(R * K + C) * 2u; voffB[i] = (unsigned)(Rb * K + C) * 2u; }
    const size_t kstep = (size_t)(BK * 2);
    const size_t hstep = (size_t)HALF * K * 2;
    const size_t tstep = 2 * hstep;
    const unsigned ldsw = (unsigned)wid * 1024u;
    const int aoff = lds_byte(wr * 64 + fr, fq * 8), boff = lds_byte(wc * 32 + fr, fq * 8);
#define PG8_SA(b, h) (((b) * 2 + (h)) * HTB)
#define PG8_SB(b, h) ((4 + (b) * 2 + (h)) * HTB)
#define PG8_STAGE(bufoff, gbase, voff) do { _Pragma("unroll") for (int _i = 0; _i < 2; ++_i) \
        __builtin_amdgcn_global_load_lds((const unsigned*)((const char*)(gbase) + (voff)[_i]), (LAS unsigned*)(lds + (bufoff) + ldsw + _i * 8192), 16, 0, 0); } while (0)
#define PG8_LDA(dst, b, h) do { _Pragma("unroll") for (int m = 0; m < 4; ++m) _Pragma("unroll") for (int k = 0; k < 2; ++k) dst[m][k] = *(const LAS bf16x8*)(lds + PG8_SA(b, h) + aoff + m * 2048 + k * 1024); } while (0)
#define PG8_LDB(dst, b, h) do { _Pragma("unroll") for (int n = 0; n < 2; ++n) _Pragma("unroll") for (int k = 0; k < 2; ++k) dst[n][k] = *(const LAS bf16x8*)(lds + PG8_SB(b, h) + boff + n * 2048 + k * 1024); } while (0)
#define PG8_MMA(ai, bj, At, Bt) do { __builtin_amdgcn_s_setprio(1); _Pragma("unroll") for (int m = 0; m < 4; ++m) _Pragma("unroll") for (int n = 0; n < 2; ++n) _Pragma("unroll") for (int k = 0; k < 2; ++k) \
        acc[ai][bj][m][n] = __builtin_amdgcn_mfma_f32_16x16x32_bf16(Bt[n][k], At[m][k], acc[ai][bj][m][n], 0, 0, 0); __builtin_amdgcn_s_setprio(0); } while (0)
#define PG8_WAIT_V(n) asm volatile("s_waitcnt vmcnt(" #n ")" ::: "memory")
#define PG8_WAIT_L(n) asm volatile("s_waitcnt lgkmcnt(" #n ")" ::: "memory")
#define PG8_BAR __builtin_amdgcn_s_barrier()
#define PG8_SCHED __builtin_amdgcn_sched_barrier(0)
    Unit cur, nxt; int ui = 0;
    if (!S.next(0, cur)) return;
    f32x4 acc[2][2][4][2];
#pragma unroll
    for (int a = 0; a < 2; ++a)
#pragma unroll
        for (int b = 0; b < 2; ++b)
#pragma unroll
            for (int m = 0; m < 4; ++m)
#pragma unroll
                for (int n = 0; n < 2; ++n) acc[a][b][m][n] = (f32x4){0.f, 0.f, 0.f, 0.f};
    bf16x8 At[4][2], B0[2][2], B1[2][2];
    const char* cA = (const char*)g.A + (size_t)cur.pm * tstep; const char* cB = (const char*)g.Bt + (size_t)cur.pn * tstep;
    PG8_STAGE(PG8_SB(0, 0), cB, voffB); PG8_STAGE(PG8_SA(0, 0), cA, voffA); PG8_STAGE(PG8_SB(0, 1), cB + hstep, voffB); PG8_STAGE(PG8_SA(0, 1), cA + hstep, voffA);
    if (wr == 1) PG8_BAR;
    PG8_WAIT_V(4); PG8_BAR;
    PG8_STAGE(PG8_SB(1, 0), cB + kstep, voffB); PG8_STAGE(PG8_SA(1, 0), cA + kstep, voffA); PG8_STAGE(PG8_SB(1, 1), cB + hstep + kstep, voffB);
    PG8_WAIT_V(6); PG8_BAR;
    for (;;) {
        const bool has_next = S.next(ui + 1, nxt);
        const char* nA = has_next ? (const char*)g.A + (size_t)nxt.pm * tstep : cA; const char* nB = has_next ? (const char*)g.Bt + (size_t)nxt.pn * tstep : cB;
        for (int t = 0; t < nt; t += 2) {
            const bool last = (t == nt - 2);
            const char* a1 = cA + (size_t)(t + 1) * kstep;
            const char* a2 = last ? nA : cA + (size_t)(t + 2) * kstep; const char* b2 = last ? nB : cB + (size_t)(t + 2) * kstep;
            const char* a3 = a2 + kstep; const char* b3 = b2 + kstep;
            PG8_LDB(B0, 0, 0); PG8_SCHED; PG8_LDA(At, 0, 0); PG8_STAGE(PG8_SA(1, 1), a1 + hstep, voffA);
            PG8_WAIT_L(8); PG8_BAR; PG8_WAIT_L(0); PG8_MMA(0, 0, At, B0); PG8_BAR; PG8_SCHED;
            PG8_LDB(B1, 0, 1); PG8_STAGE(PG8_SB(0, 0), b2, voffB);
            PG8_BAR; PG8_WAIT_L(0); PG8_MMA(0, 1, At, B1); PG8_BAR;
            PG8_LDA(At, 0, 1); PG8_STAGE(PG8_SA(0, 0), a2, voffA);
            PG8_BAR; PG8_WAIT_L(0); PG8_MMA(1, 0, At, B0); PG8_BAR; PG8_SCHED;
            PG8_STAGE(PG8_SB(0, 1), b2 + hstep, voffB);
            PG8_WAIT_V(6); PG8_BAR; PG8_MMA(1, 1, At, B1); PG8_BAR;
            PG8_LDB(B0, 1, 0); PG8_SCHED; PG8_LDA(At, 1, 0); PG8_STAGE(PG8_SA(0, 1), a2 + hstep, voffA);
            PG8_WAIT_L(8); PG8_BAR; PG8_WAIT_L(0); PG8_MMA(0, 0, At, B0); PG8_BAR; PG8_SCHED;
            PG8_LDB(B1, 1, 1); PG8_STAGE(PG8_SB(1, 0), b3, voffB);
            PG8_BAR; PG8_WAIT_L(0); PG8_MMA(0, 1, At, B1); PG8_BAR;
            PG8_LDA(At, 1, 1); PG8_STAGE(PG8_SA(1, 0), a3, voffA);
            PG8_BAR; PG8_WAIT_L(0); PG8_MMA(1, 0, At, B0); PG8_BAR; PG8_SCHED;
            PG8_STAGE(PG8_SB(1, 1), b3 + hstep, voffB);
            PG8_WAIT_V(6); PG8_BAR; PG8_MMA(1, 1, At, B1); PG8_BAR;
        }
        E(acc, cur, ui, wr, wc, fr, fq);
        if (!has_next) break;
#pragma unroll
        for (int a = 0; a < 2; ++a)
#pragma unroll
            for (int b = 0; b < 2; ++b)
#pragma unroll
                for (int m = 0; m < 4; ++m)
#pragma unroll
                    for (int n = 0; n < 2; ++n) acc[a][b][m][n] = (f32x4){0.f, 0.f, 0.f, 0.f};
        cur = nxt; cA = nA; cB = nB; ++ui;
    }
    PG8_WAIT_V(0);
    if (wr == 0) PG8_BAR;
    PG8_BAR;
#undef PG8_SA
#undef PG8_SB
#undef PG8_STAGE
#undef PG8_LDA
#undef PG8_LDB
#undef PG8_MMA
#undef PG8_WAIT_V
#undef PG8_WAIT_L
#undef PG8_BAR
#undef PG8_SCHED
}

struct EpiProj {
    static constexpr bool PERM = true;
    bf16_t* O; int ldc; const LAS float* rst;
    __device__ __forceinline__ void operator()(const f32x4 (&acc)[2][2][4][2], const Unit& u, int ui, int wr, int wc, int fr, int fq) const {
        const int row0 = u.pm * BM + wr * 64 + fr, col0 = u.pn * BM + wc * 32 + 8 * fq;
#pragma unroll
        for (int ai = 0; ai < 2; ++ai)
#pragma unroll
            for (int m = 0; m < 4; ++m) { const int row = row0 + ai * HALF + m * 16; bf16_t* rowp = O + (size_t)row * ldc + col0;
                const float rs = rst ? rst[ui * 256 + (row & 255)] : 1.0f;
#pragma unroll
                for (int bj = 0; bj < 2; ++bj) { const f32x4 v0 = acc[ai][bj][m][0] * rs, v1 = acc[ai][bj][m][1] * rs;
                    u32x4 w; w.x = pk2(v0[0], v0[1]); w.y = pk2(v0[2], v0[3]); w.z = pk2(v1[0], v1[1]); w.w = pk2(v1[2], v1[3]);
                    *(u32x4*)(rowp + bj * HALF) = w; } }
    }
};
struct EpiResid {
    static constexpr bool PERM = true;
    bf16_t* HB; float* ssq;
    __device__ __forceinline__ void operator()(const f32x4 (&acc)[2][2][4][2], const Unit& u, int ui, int wr, int wc, int fr, int fq) const {
        const int row0 = u.pm * BM + wr * 64 + fr, col0 = u.pn * BM + wc * 32 + 8 * fq;
#pragma unroll
        for (int ai = 0; ai < 2; ++ai) {
            u32x4 hv[4][2];
#pragma unroll
            for (int m = 0; m < 4; ++m)
#pragma unroll
                for (int bj = 0; bj < 2; ++bj) hv[m][bj] = *(const u32x4*)(HB + (size_t)(row0 + ai * HALF + m * 16) * DM + col0 + bj * HALF);
            __builtin_amdgcn_sched_barrier(0);
#pragma unroll
            for (int m = 0; m < 4; ++m) { const int row = row0 + ai * HALF + m * 16; bf16_t* rowb = HB + (size_t)row * DM + col0;
                float q = 0.f;
#pragma unroll
                for (int bj = 0; bj < 2; ++bj) { const u32x4 hw = hv[m][bj]; const f32x4 v0 = acc[ai][bj][m][0], v1 = acc[ai][bj][m][1];
                    u32x4 w;
                    w.x = pk2(bf2f(hw.x & 0xffffu) + v0[0], bf2f(hw.x >> 16) + v0[1]); w.y = pk2(bf2f(hw.y & 0xffffu) + v0[2], bf2f(hw.y >> 16) + v0[3]);
                    w.z = pk2(bf2f(hw.z & 0xffffu) + v1[0], bf2f(hw.z >> 16) + v1[1]); w.w = pk2(bf2f(hw.w & 0xffffu) + v1[2], bf2f(hw.w >> 16) + v1[3]);
                    *(u32x4*)(rowb + bj * HALF) = w;
                    const float r0 = bf2f(w.x & 0xffffu), r1 = bf2f(w.x >> 16), r2 = bf2f(w.y & 0xffffu), r3 = bf2f(w.y >> 16), r4 = bf2f(w.z & 0xffffu), r5 = bf2f(w.z >> 16), r6 = bf2f(w.w & 0xffffu), r7 = bf2f(w.w >> 16);
                    q += ((r0 * r0 + r1 * r1) + (r2 * r2 + r3 * r3)) + ((r4 * r4 + r5 * r5) + (r6 * r6 + r7 * r7)); }
                q += __shfl_xor(q, 16); q += __shfl_xor(q, 32);
                if (fq == 0) ssq[(size_t)row * 16 + u.pn * 4 + wc] = q; }
            __builtin_amdgcn_sched_barrier(0);
        }
    }
};
struct EpiLora {
    static constexpr bool PERM = true;
    bf16_t* O; const float* bias;
    __device__ __forceinline__ void operator()(const f32x4 (&acc)[2][2][4][2], const Unit& u, int ui, int wr, int wc, int fr, int fq) const {
        const int row0 = u.pm * BM + wr * 64 + fr, col0 = u.pn * BM + wc * 32 + 8 * fq, mode = u.pn >> 1;
        const float sc = (mode == 0) ? 0.60653066f : 1.0f;
#pragma unroll
        for (int bj = 0; bj < 2; ++bj) {
            const f32x4 c0 = *(const f32x4*)(bias + col0 + bj * HALF), c1 = *(const f32x4*)(bias + col0 + bj * HALF + 4);
#pragma unroll
            for (int ai = 0; ai < 2; ++ai)
#pragma unroll
                for (int m = 0; m < 4; ++m) { bf16_t* rowp = O + (size_t)(row0 + ai * HALF + m * 16) * NL + col0 + bj * HALF;
                    f32x4 v0 = acc[ai][bj][m][0] + c0, v1 = acc[ai][bj][m][1] + c1;
                    if (mode != 2) {
#pragma unroll
                        for (int j = 0; j < 4; ++j) { v0[j] = sc * sigmoidf_(v0[j]); v1[j] = sc * sigmoidf_(v1[j]); } }
                    u32x4 w; w.x = pk2(v0[0], v0[1]); w.y = pk2(v0[2], v0[3]); w.z = pk2(v1[0], v1[1]); w.w = pk2(v1[2], v1[3]);
                    *(u32x4*)rowp = w; }
        }
    }
};
struct EpiSwiglu {
    static constexpr bool PERM = true;
    bf16_t* O; const LAS float* rst;
    __device__ __forceinline__ void operator()(const f32x4 (&acc)[2][2][4][2], const Unit& u, int ui, int wr, int wc, int fr, int fq) const {
        const int row0 = u.pm * BM + wr * 64 + fr, col0 = u.pn * 128 + wc * 16 + 4 * fq;
#pragma unroll
        for (int ai = 0; ai < 2; ++ai)
#pragma unroll
            for (int m = 0; m < 4; ++m) { const int row = row0 + ai * HALF + m * 16; bf16_t* rowp = O + (size_t)row * DFF + col0;
                const float rs = rst[ui * 256 + (row & 255)];
#pragma unroll
                for (int bj = 0; bj < 2; ++bj) { const f32x4 gt = acc[ai][bj][m][0] * rs, up = acc[ai][bj][m][1] * rs; float o[4];
#pragma unroll
                    for (int j = 0; j < 4; ++j) o[j] = gt[j] * sigmoidf_(gt[j]) * up[j];
                    u32x2 w; w.x = pk2(o[0], o[1]); w.y = pk2(o[2], o[3]);
                    *(u32x2*)(rowp + bj * 64) = w; } }
    }
};
}

__device__ __forceinline__ void build_rs_table(LAS float* rst, const pg8::StaticOrder& S, const float* ssp) {
    const int tid = tid_opaque();
    pg8::Unit u;
    for (int i = 0; S.next(i, u); ++i) if (tid < 256) rst[i * 256 + tid] = row_rs(ssp, u.pm * 256 + tid);
    __syncthreads();
}
template <int KIND, int NB>
__device__ __forceinline__ void tail16(const bf16_t* A, const bf16_t* Bt, int N, int K, bf16_t* Out, int ldo, const float* ssp, float* ssq, LAS float* red, const float* lbias = nullptr) {
    const int tid = tid_opaque(), wid = __builtin_amdgcn_readfirstlane(tid >> 6), lane = tid & 63, fr = lane & 15, fq = lane >> 4;
    const int ntile = (KIND == 2) ? N / 32 : N / (16 * NB), nks = K >> 7;
    const int row = MAIN_ROWS + fr;
    for (int tile = blockIdx.x; tile < ntile; tile += gridDim.x) {
        f32x4 acc[NB];
#pragma unroll
        for (int be = 0; be < NB; ++be) acc[be] = (f32x4){0.f, 0.f, 0.f, 0.f};
        const bf16_t* ap = A + (size_t)row * K + fq * 8;
        const bf16_t* bp[NB];
        if (KIND == 2) { const int f = tile * 16 + fr, pn = f >> 7, ft = f & 127, r0 = pn * 256 + ((ft >> 2) << 3) + (ft & 3); bp[0] = Bt + (size_t)r0 * K + fq * 8; bp[1] = Bt + (size_t)(r0 + 4) * K + fq * 8; }
        else {
#pragma unroll
            for (int be = 0; be < NB; ++be) bp[be] = Bt + (size_t)(tile * 16 * NB + be * 16 + fr) * K + fq * 8; }
        for (int ks = wid; ks < nks; ks += 8) {
            bf16x8 av[4], bv[NB][4];
#pragma unroll
            for (int u = 0; u < 4; ++u) { av[u] = *(const bf16x8*)(ap + ks * 128 + u * 32);
#pragma unroll
                for (int be = 0; be < NB; ++be) bv[be][u] = *(const bf16x8*)(bp[be] + ks * 128 + u * 32); }
            __builtin_amdgcn_sched_barrier(0);
#pragma unroll
            for (int u = 0; u < 4; ++u)
#pragma unroll
                for (int be = 0; be < NB; ++be) acc[be] = __builtin_amdgcn_mfma_f32_16x16x32_bf16(bv[be][u], av[u], acc[be], 0, 0, 0);
        }
#pragma unroll
        for (int be = 0; be < NB; ++be) *(LAS f32x4*)(red + ((wid * NB + be) * 64 + lane) * 4) = acc[be];
        __syncthreads();
        if (wid == 0) {
#pragma unroll
            for (int be = 0; be < NB; ++be) { f32x4 t = *(const LAS f32x4*)(red + (be * 64 + lane) * 4);
#pragma unroll
                for (int w = 1; w < 8; ++w) t += *(const LAS f32x4*)(red + ((w * NB + be) * 64 + lane) * 4);
                acc[be] = t; }
            if (KIND == 0) {
                const float rs = ssp ? row_rs(ssp, row) : 1.0f;
#pragma unroll
                for (int be = 0; be < NB; ++be) { const int col = tile * 16 * NB + be * 16 + fq * 4; f32x4 v = acc[be] * rs;
                    if (lbias) { const int mode = col >> 9;
                        if (mode != 2) { const float sc = (mode == 0) ? 0.60653066f : 1.0f;
#pragma unroll
                            for (int j = 0; j < 4; ++j) v[j] = sc * sigmoidf_(v[j] + lbias[col + j]); } }
                    u32x2 w; w.x = pk2(v[0], v[1]); w.y = pk2(v[2], v[3]);
                    *(u32x2*)(Out + (size_t)row * ldo + col) = w; }
            } else if (KIND == 1) {
                float q = 0.f;
#pragma unroll
                for (int be = 0; be < NB; ++be) { bf16_t* o = Out + (size_t)row * ldo + tile * 16 * NB + be * 16 + fq * 4; const u32x2 hw = *(const u32x2*)o;
                    u32x2 w; w.x = pk2(bf2f(hw.x & 0xffffu) + acc[be][0], bf2f(hw.x >> 16) + acc[be][1]); w.y = pk2(bf2f(hw.y & 0xffffu) + acc[be][2], bf2f(hw.y >> 16) + acc[be][3]);
                    *(u32x2*)o = w;
                    const float r0 = bf2f(w.x & 0xffffu), r1 = bf2f(w.x >> 16), r2 = bf2f(w.y & 0xffffu), r3 = bf2f(w.y >> 16);
                    q += (r0 * r0 + r1 * r1) + (r2 * r2 + r3 * r3); }
                q += __shfl_xor(q, 16); q += __shfl_xor(q, 32);
                if (fq == 0) ssq[(size_t)row * 16 + tile] = q;
            } else {
                const float rs = row_rs(ssp, row); float v[4];
#pragma unroll
                for (int j = 0; j < 4; ++j) { const float g = acc[0][j] * rs; v[j] = g * sigmoidf_(g) * (acc[1][j] * rs); }
                u32x2 w; w.x = pk2(v[0], v[1]); w.y = pk2(v[2], v[3]);
                *(u32x2*)(Out + (size_t)row * ldo + tile * 16 + fq * 4) = w;
            }
        }
        __syncthreads();
    }
}

__device__ __forceinline__ void norm_rows(CArgs a, int mode) {
    const int tid = tid_opaque(), wid = tid >> 6, lane = tid & 63;
    bf16_t* HB = (bf16_t*)(a->ws + WS_H); float* SS = (float*)(a->ws + WS_SS);
    for (int row = blockIdx.x * 8 + wid; row < (mode == 0 ? NROWS : MAIN_ROWS); row += gridDim.x * 8) {
        float x[16]; float ss = 0.f;
        if (mode == 0) {
            const float* src = (row >= MAIN_ROWS ? a->in[1] + (size_t)(row - MAIN_ROWS) * DM : a->in[0] + (size_t)row * DM);
#pragma unroll
            for (int i = 0; i < 2; ++i) { const f32x4 v0 = *(const f32x4*)(src + lane * 8 + 512 * i), v1 = *(const f32x4*)(src + lane * 8 + 512 * i + 4);
                u32x4 w; w.x = pk2(v0[0], v0[1]); w.y = pk2(v0[2], v0[3]); w.z = pk2(v1[0], v1[1]); w.w = pk2(v1[2], v1[3]);
                *(u32x4*)(HB + (size_t)row * DM + lane * 8 + 512 * i) = w;
                float r[8]; unpack8(w, r);
#pragma unroll
                for (int e = 0; e < 8; ++e) ss += r[e] * r[e]; }
            ss = wave_sum(ss);
            if (lane < 16) SS[(size_t)row * 16 + lane] = (lane == 0) ? ss : 0.f;
        } else {
#pragma unroll
            for (int i = 0; i < 2; ++i) { float r[8]; unpack8(*(const u32x4*)(HB + (size_t)row * DM + lane * 8 + 512 * i), r);
#pragma unroll
                for (int e = 0; e < 8; ++e) { x[i * 8 + e] = r[e]; ss += r[e] * r[e]; } }
            ss = wave_sum(ss);
            const float rs = rsqrtf(ss * (1.0f / DM) + RMS_EPS);
            float* o = a->out + (size_t)row * DM;
#pragma unroll
            for (int i = 0; i < 2; ++i) { const f32x4 g0 = *(const f32x4*)(a->in[25] + lane * 8 + 512 * i), g1 = *(const f32x4*)(a->in[25] + lane * 8 + 512 * i + 4);
                *(f32x4*)(o + lane * 8 + 512 * i) = (f32x4){x[i * 8] * rs * g0[0], x[i * 8 + 1] * rs * g0[1], x[i * 8 + 2] * rs * g0[2], x[i * 8 + 3] * rs * g0[3]};
                *(f32x4*)(o + lane * 8 + 512 * i + 4) = (f32x4){x[i * 8 + 4] * rs * g1[0], x[i * 8 + 5] * rs * g1[1], x[i * 8 + 6] * rs * g1[2], x[i * 8 + 7] * rs * g1[3]}; }
        }
    }
}

template <int KIND> __device__ __forceinline__ float wsrc(CArgs a, int l, int k, int n) {
    if (KIND == 0) {
        const float gk = a->in[2][(size_t)l * DM + k];
        if (n < NIN) return gk * a->in[3][((size_t)l * DM + k) * NIN + n];
        if (n < NIN + 32 && l > 0) return gk * a->in[17][((size_t)(l - 1) * DM + k) * 32 + (n - NIN)];
        return 0.f;
    } else if (KIND == 1) {
        return a->in[21][((size_t)l * DM + k) * DM + n];
    } else if (KIND == 2) {
        const int pn = n >> 8, c = n & 255, feat = pn * 128 + ((c >> 3) << 2) + (c & 3), isup = (c >> 2) & 1;
        return a->in[22][(size_t)l * DM + k] * a->in[23][((size_t)l * DM + k) * (2 * DFF) + feat + isup * DFF];
    } else if (KIND == 3) {
        return a->in[24][((size_t)l * DFF + k) * DM + n];
    } else {
        const int j = n >> 9, nn = n & 511;
        if (j == 0) return (k < 64) ? a->in[8][((size_t)l * 64 + k) * 512 + nn] : 0.f;
        if (j == 1) return (k >= 64 && k < 128) ? a->in[10][((size_t)l * 64 + (k - 64)) * 512 + nn] : 0.f;
        if (j == 2) return (k >= 128 && k < 288) ? a->in[11][((size_t)l * 160 + (k - 128)) * 512 + nn] : 0.f;
        return (k >= 288 && k < 320 && l > 0) ? a->in[20][((size_t)(l - 1) * 32 + (k - 288)) * 512 + nn] : 0.f;
    }
}
template <int KIND> __device__ __forceinline__ void conv_tile(CArgs a, int l, LAS float* tile, bf16_t* out, int ldo, int n0, int k0) {
    const int tid = tid_opaque(), kk = tid >> 6, nn = tid & 63;
#pragma unroll
    for (int i = 0; i < 8; ++i) tile[(kk + 8 * i) * 65 + nn] = wsrc<KIND>(a, l, k0 + kk + 8 * i, n0 + nn);
    __syncthreads();
    const int n = tid >> 3, kq = tid & 7;
    u32x4 w;
    w.x = pk2(tile[(kq * 8 + 0) * 65 + n], tile[(kq * 8 + 1) * 65 + n]); w.y = pk2(tile[(kq * 8 + 2) * 65 + n], tile[(kq * 8 + 3) * 65 + n]);
    w.z = pk2(tile[(kq * 8 + 4) * 65 + n], tile[(kq * 8 + 5) * 65 + n]); w.w = pk2(tile[(kq * 8 + 6) * 65 + n], tile[(kq * 8 + 7) * 65 + n]);
    *(u32x4*)(out + (size_t)(n0 + n) * ldo + k0 + kq * 8) = w;
    __syncthreads();
}
__device__ __forceinline__ void fold_tile(CArgs a, int l, LAS float* lds, bf16_t* out, int n0, int k0) {
    LAS float* P = lds; LAS float* W = lds + 64 * 128;
    const int tid = tid_opaque(), g = k0 >> 7, c0 = k0 & 127;
    const float* pw = a->in[5] + ((size_t)(l * 4 + g) * 128 + c0) * 128; const float* sc = a->in[6] + (size_t)l * 512 + g * 128;
    const float* wo = a->in[21] + ((size_t)l * DM + g * 128) * DM + n0;
    for (int i = tid; i < 64 * 128; i += 512) { const int d = i & 127; P[i] = pw[i] * sc[d]; }
    for (int i = tid; i < 128 * 64; i += 512) { const int d = i >> 6, n = i & 63; W[i] = wo[(size_t)d * DM + n]; }
    __syncthreads();
    const int n = tid & 63, cq = tid >> 6;
    float acc[8];
#pragma unroll
    for (int j = 0; j < 8; ++j) acc[j] = 0.f;
    for (int d = 0; d < 128; ++d) { const float wv = W[d * 64 + n];
#pragma unroll
        for (int j = 0; j < 8; ++j) acc[j] += P[(cq * 8 + j) * 128 + d] * wv; }
    u32x4 w; w.x = pk2(acc[0], acc[1]); w.y = pk2(acc[2], acc[3]); w.z = pk2(acc[4], acc[5]); w.w = pk2(acc[6], acc[7]);
    *(u32x4*)(out + (size_t)(n0 + n) * DM + k0 + cq * 8) = w;
    __syncthreads();
}
__device__ __forceinline__ void weight_prep(CArgs a, int l, LAS float* lds, int b0, int nb) {
    unsigned char* wb = a->ws + WS_WB + (size_t)(l & 1) * WB_SIZE;
    bf16_t* WC = (bf16_t*)(wb + WB_WC); bf16_t* WO = (bf16_t*)(wb + WB_WOUT); bf16_t* WGU = (bf16_t*)(wb + WB_WGU); bf16_t* WDN = (bf16_t*)(wb + WB_WDN); bf16_t* WL = (bf16_t*)(wb + WB_WL);
    for (int ti = (int)blockIdx.x - b0; ti < 3201; ti += nb) {
        if (ti == 3200) { float* LB = (float*)(wb + WB_LB); const int t0 = tid_opaque();
            for (int i = t0; i < NL; i += 512) { const int j = i >> 9, nn = i & 511; LB[i] = (j == 0) ? a->in[7][l * 512 + nn] : (j == 1) ? a->in[9][l * 512 + nn] : (j == 3 && l > 0) ? a->in[19][(l - 1) * 512 + nn] : 0.f; }
            continue; }
        if (ti < 128) { fold_tile(a, l, lds, WO, (ti & 15) * 64, (ti >> 4) * 64); }
        else if (ti < 256) { const int q = ti - 128; conv_tile<1>(a, l, lds, WO, DM, (q & 15) * 64, 512 + (q >> 4) * 64); }
        else if (ti < 896) { const int q = ti - 256; conv_tile<0>(a, l, lds, WC, DM, (q >> 4) * 64, (q & 15) * 64); }
        else if (ti < 2304) { const int q = ti - 896; conv_tile<2>(a, l, lds, WGU, DM, (q >> 4) * 64, (q & 15) * 64); }
        else if (ti < 3008) { const int q = ti - 2304; conv_tile<3>(a, l, lds, WDN, DFF, (q / 44) * 64, (q % 44) * 64); }
        else { const int q = ti - 3008; conv_tile<4>(a, l, lds, WL, KL, (q / 6) * 64, (q % 6) * 64); }
    }
}

__device__ __forceinline__ void prep_phase(CArgs a, int l) {
    const bf16_t* PROJ = (const bf16_t*)(a->ws + WS_R1);
    bf16_t* MIX = (bf16_t*)((unsigned char*)a->out + DO_MIX); bf16_t* LIN = (bf16_t*)((unsigned char*)a->out + DO_LIN);
    const int tid = tid_opaque(), gt = blockIdx.x * 512 + tid, nthr = gridDim.x * 512;
    for (int it = gt; it < (MAIN_ROWS / 16 + 1) * 64; it += nthr) {
        const int run = it >> 6, c0 = (it & 63) * 8, win = 2 << (c0 >> 7);
        const int b = run >> 7, t0 = (run < MAIN_ROWS / 16) ? NMETA + (run & 127) * 16 : 0;
        float s[8], x[8], y[8];
#pragma unroll
        for (int e = 0; e < 8; ++e) s[e] = 0.f;
        const int pre = (t0 < win) ? t0 : win;
        for (int q = 1; q <= pre; ++q) { unpack8(*(const u32x4*)(PROJ + (size_t)row_of(b, t0 - q) * NPROJ + c0), x);
#pragma unroll
            for (int e = 0; e < 8; ++e) s[e] += x[e]; }
        for (int i = 0; i < 16; ++i) {
            const int t = t0 + i, row = row_of(b, t);
            unpack8(*(const u32x4*)(PROJ + (size_t)row * NPROJ + c0), x);
            if (t >= win) { unpack8(*(const u32x4*)(PROJ + (size_t)row_of(b, t - win) * NPROJ + c0), y);
#pragma unroll
                for (int e = 0; e < 8; ++e) s[e] += x[e] - y[e]; }
            else {
#pragma unroll
                for (int e = 0; e < 8; ++e) s[e] += x[e]; }
            const float inv = 1.0f / (float)((t + 1 < win) ? t + 1 : win);
            u32x4 o; o.x = pk2(s[0] * inv - x[0], s[1] * inv - x[1]); o.y = pk2(s[2] * inv - x[2], s[3] * inv - x[3]);
            o.z = pk2(s[4] * inv - x[4], s[5] * inv - x[5]); o.w = pk2(s[6] * inv - x[6], s[7] * inv - x[7]);
            *(u32x4*)(MIX + (size_t)row * DM + c0) = o;
        }
    }
    for (int it = gt; it < NROWS * 48; it += nthr) {
        const int row = it / 48, cb = (it - row * 48) * 8;
        const int prow = (row >= MAIN_ROWS) ? (row > MAIN_ROWS ? row - 1 : -1) : ((row & (SEQ - 1)) ? row - 1 : NROWS - 1);
        u32x4 o = (u32x4){0u, 0u, 0u, 0u};
        if (cb < 320) {
            float xc[8], xp[8], mu[8], y[8];
            unpack8(*(const u32x4*)(PROJ + (size_t)row * NPROJ + 2048 + cb), xc);
            u32x4 wp = (u32x4){0u, 0u, 0u, 0u};
            if (prow >= 0) wp = *(const u32x4*)(PROJ + (size_t)prow * NPROJ + 2048 + cb);
            unpack8(wp, xp);
            const float* mp = (cb < 288) ? a->in[4] + (size_t)l * NSHIFT + 1536 + cb : a->in[18] + (l > 0 ? (l - 1) * 32 + (cb - 288) : 0);
            const f32x4 m0 = *(const f32x4*)mp, m1 = *(const f32x4*)(mp + 4);
            mu[0] = m0[0]; mu[1] = m0[1]; mu[2] = m0[2]; mu[3] = m0[3]; mu[4] = m1[0]; mu[5] = m1[1]; mu[6] = m1[2]; mu[7] = m1[3];
#pragma unroll
            for (int e = 0; e < 8; ++e) {
                const float sv = xc[e] + (xp[e] - xc[e]) * mu[e];
                y[e] = (cb < 64) ? 1.0f - 2.0f * __builtin_amdgcn_rcpf(1.0f + __builtin_amdgcn_exp2f(sv * 2.88539008f)) : (cb < 128) ? sv : (cb < 288) ? sigmoidf_(sv) : sv;
            }
            o.x = pk2(y[0], y[1]); o.y = pk2(y[2], y[3]); o.z = pk2(y[4], y[5]); o.w = pk2(y[6], y[7]);
        }
        *(u32x4*)(LIN + (size_t)row * KL + cb) = o;
    }
}

constexpr int TC = 16, NCH = TT / TC;
constexpr int SB_A = 0, SB_Q = 1, SB_W = 2, SB_B = 3, SB_K = 4, SB_V = 5, SB_G = 6, SB_Y = 7, SBUF = 8 * TC * 64 + TC * 4;
__device__ __forceinline__ void scan_phase(CArgs a, int l, LAS float* lds) {
    const int bid = blockIdx.x; if (bid >= BATCH * 8) return;
    const int b = bid >> 3, h = bid & 7, tid = tid_opaque(), wid = __builtin_amdgcn_readfirstlane(tid >> 6), lane = tid & 63;
    const bf16_t* PROJ = (const bf16_t*)(a->ws + WS_R1); const bf16_t* LO = (const bf16_t*)(a->ws + WS_LO);
    bf16_t* VF = (bf16_t*)((unsigned char*)a->out + DO_VF); bf16_t* MIX = (bf16_t*)((unsigned char*)a->out + DO_MIX);
    if (wid < 4) {
        __builtin_amdgcn_s_setprio(2);
        const int rp = wid * 16 + (lane >> 3) * 2, seg = lane & 7;
        f32x2 S0[4], S1[4];
#pragma unroll
        for (int j = 0; j < 4; ++j) { S0[j] = (f32x2){0.f, 0.f}; S1[j] = (f32x2){0.f, 0.f}; }
        for (int it = 0; it < NCH + 2; ++it) {
            if (it >= 1 && it <= NCH) {
                LAS float* buf = lds + ((it - 1) & 1) * SBUF;
#pragma unroll 4
                for (int tl = 0; tl < TC; ++tl) {
                    const LAS float* base = buf + tl * 64 + seg * 8;
                    const f32x4 a0 = *(const LAS f32x4*)(base + SB_A * TC * 64), a1 = *(const LAS f32x4*)(base + SB_A * TC * 64 + 4);
                    const f32x4 q0 = *(const LAS f32x4*)(base + SB_Q * TC * 64), q1 = *(const LAS f32x4*)(base + SB_Q * TC * 64 + 4);
                    const f32x4 w0 = *(const LAS f32x4*)(base + SB_W * TC * 64), w1 = *(const LAS f32x4*)(base + SB_W * TC * 64 + 4);
                    const f32x4 b0 = *(const LAS f32x4*)(base + SB_B * TC * 64), b1 = *(const LAS f32x4*)(base + SB_B * TC * 64 + 4);
                    const f32x4 k0 = *(const LAS f32x4*)(base + SB_K * TC * 64), k1 = *(const LAS f32x4*)(base + SB_K * TC * 64 + 4);
                    const f32x2 vv = *(const LAS f32x2*)(buf + SB_V * TC * 64 + tl * 64 + rp);
                    const f32x2 sc = *(const LAS f32x2*)(buf + 8 * TC * 64 + tl * 4);
                    const f32x2 av[4] = {{a0[0], a0[1]}, {a0[2], a0[3]}, {a1[0], a1[1]}, {a1[2], a1[3]}};
                    const f32x2 qv[4] = {{q0[0], q0[1]}, {q0[2], q0[3]}, {q1[0], q1[1]}, {q1[2], q1[3]}};
                    const f32x2 wv[4] = {{w0[0], w0[1]}, {w0[2], w0[3]}, {w1[0], w1[1]}, {w1[2], w1[3]}};
                    const f32x2 bv[4] = {{b0[0], b0[1]}, {b0[2], b0[3]}, {b1[0], b1[1]}, {b1[2], b1[3]}};
                    const f32x2 kv[4] = {{k0[0], k0[1]}, {k0[2], k0[3]}, {k1[0], k1[1]}, {k1[2], k1[3]}};
                    f32x2 pa0 = S0[0] * av[0], pa1 = S1[0] * av[0], pq0 = S0[0] * qv[0], pq1 = S1[0] * qv[0];
#pragma unroll
                    for (int j = 1; j < 4; ++j) { pa0 += S0[j] * av[j]; pa1 += S1[j] * av[j]; pq0 += S0[j] * qv[j]; pq1 += S1[j] * qv[j]; }
                    float sa0 = pa0.x + pa0.y, sa1 = pa1.x + pa1.y, y0 = pq0.x + pq0.y, y1 = pq1.x + pq1.y;
                    allred8x4(sa0, sa1, y0, y1);
                    const f32x2 sav0 = {sa0, sa0}, sav1 = {sa1, sa1}, vv0 = {vv.x, vv.x}, vv1 = {vv.y, vv.y};
#pragma unroll
                    for (int j = 0; j < 4; ++j) { S0[j] = S0[j] * wv[j] + sav0 * bv[j] + vv0 * kv[j]; S1[j] = S1[j] * wv[j] + sav1 * bv[j] + vv1 * kv[j]; }
                    if (seg == 0) *(LAS f32x2*)(buf + SB_Y * TC * 64 + tl * 64 + rp) = (f32x2){y0 + sa0 * sc.x + vv.x * sc.y, y1 + sa1 * sc.x + vv.y * sc.y};
                }
            }
            __syncthreads();
        }
        __builtin_amdgcn_s_setprio(0);
    } else {
        const int hw = wid - 4, ch = h * 64 + lane;
        const float mu_r = a->in[4][(size_t)l * NSHIFT + ch], mu_k = a->in[4][(size_t)l * NSHIFT + 512 + ch], mu_v = a->in[4][(size_t)l * NSHIFT + 1024 + ch];
        const float kk_c = a->in[12][l * 512 + ch], ka_c = a->in[13][l * 512 + ch], rk_c = a->in[14][l * 512 + ch], gw = a->in[15][l * 512 + ch], gb = a->in[16][l * 512 + ch];
        unsigned short ld[4][11];
#define SCAN_LOAD(c) do { _Pragma("unroll") for (int p = 0; p < 4; ++p) { const int t = (c) * TC + p * 4 + hw; const size_t m = (size_t)row_of(b, t); \
        const bf16_t* pr = PROJ + m * NPROJ + 512 + ch; ld[p][0] = pr[0]; ld[p][1] = pr[512]; ld[p][2] = pr[1024]; \
        if (t > 0) { const bf16_t* pp = PROJ + (size_t)row_of(b, t - 1) * NPROJ + 512 + ch; ld[p][3] = pp[0]; ld[p][4] = pp[512]; ld[p][5] = pp[1024]; } else { ld[p][3] = 0; ld[p][4] = 0; ld[p][5] = 0; } \
        const bf16_t* po = LO + m * NL + ch; ld[p][6] = po[0]; ld[p][7] = po[512]; ld[p][8] = po[1024]; ld[p][9] = po[1536]; \
        ld[p][10] = (l > 0) ? VF[m * 512 + ch] : (unsigned short)0; } } while (0)
#define PK2F(i) ((f32x2){bf2f(ld[2 * pp][i]), bf2f(ld[2 * pp + 1][i])})
        SCAN_LOAD(0);
        for (int it = 0; it < NCH + 2; ++it) {
            LAS float* buf = lds + (it & 1) * SBUF;
            if (it >= 2) {
#pragma unroll
                for (int p = 0; p < 4; ++p) {
                    const int tl = p * 4 + hw; const size_t m = (size_t)row_of(b, (it - 2) * TC + tl);
                    const float y = buf[SB_Y * TC * 64 + tl * 64 + lane];
                    const float mean = wave_sum(y) * (1.0f / 64.0f), d = y - mean, var = wave_sum(d * d) * (1.0f / 64.0f);
                    const float o = (d * rsqrtf(var + GN_EPS) * gw + gb + buf[8 * TC * 64 + tl * 4 + 2] * buf[SB_V * TC * 64 + tl * 64 + lane]) * buf[SB_G * TC * 64 + tl * 64 + lane];
                    if (it > 2 || b == 0) MIX[m * DM + 512 + ch] = (bf16_t)f2bf(o);
                }
            }
            if (it < NCH) {
#pragma unroll
                for (int pp = 0; pp < 2; ++pp) {
                    const int tl0 = (2 * pp) * 4 + hw, tl1 = tl0 + 4;
                    const f32x2 rc = PK2F(0), kc = PK2F(1), vc = PK2F(2), rpv = PK2F(3), kp = PK2F(4), vp = PK2F(5);
                    const f32x2 e = PK2F(6), av = PK2F(7), gv = PK2F(8), vm = PK2F(9);
                    const f32x2 r = rc + (rpv - rc) * mu_r, k = kc + (kp - kc) * mu_k; f32x2 v = vc + (vp - vc) * mu_v;
                    if (l == 0) {
                        if (it > 0 || b == 0) { VF[(size_t)row_of(b, it * TC + tl0) * 512 + ch] = (bf16_t)f2bf(v.x); VF[(size_t)row_of(b, it * TC + tl1) * 512 + ch] = (bf16_t)f2bf(v.y); }
                    } else { const f32x2 vf = PK2F(10); v = v + (vf - v) * vm; }
                    f32x2 kk = k * kk_c; f32x2 n2 = kk * kk; float n2a = n2.x, n2b = n2.y, dum = 0.f; wave_sum3(n2a, n2b, dum);
                    kk = kk * (f32x2){rsqrtf(fmaxf(n2a, 1e-24f)), rsqrtf(fmaxf(n2b, 1e-24f))};
                    const f32x2 k2 = k * ((av - 1.0f) * ka_c + 1.0f), bb = kk * av;
                    const f32x2 w = {__builtin_amdgcn_exp2f(e.x * -1.44269504f), __builtin_amdgcn_exp2f(e.y * -1.44269504f)};
                    const f32x2 brv = bb * r, krv = k2 * r, cfv = krv * rk_c, q = w * r;
                    float br0 = brv.x, kr0 = krv.x, cf0 = cfv.x, br1 = brv.y, kr1 = krv.y, cf1 = cfv.y; wave_sum3(br0, kr0, cf0); wave_sum3(br1, kr1, cf1);
                    buf[SB_A * TC * 64 + tl0 * 64 + lane] = -kk.x; buf[SB_Q * TC * 64 + tl0 * 64 + lane] = q.x; buf[SB_W * TC * 64 + tl0 * 64 + lane] = w.x;
                    buf[SB_B * TC * 64 + tl0 * 64 + lane] = bb.x; buf[SB_K * TC * 64 + tl0 * 64 + lane] = k2.x; buf[SB_V * TC * 64 + tl0 * 64 + lane] = v.x; buf[SB_G * TC * 64 + tl0 * 64 + lane] = gv.x;
                    buf[SB_A * TC * 64 + tl1 * 64 + lane] = -kk.y; buf[SB_Q * TC * 64 + tl1 * 64 + lane] = q.y; buf[SB_W * TC * 64 + tl1 * 64 + lane] = w.y;
                    buf[SB_B * TC * 64 + tl1 * 64 + lane] = bb.y; buf[SB_K * TC * 64 + tl1 * 64 + lane] = k2.y; buf[SB_V * TC * 64 + tl1 * 64 + lane] = v.y; buf[SB_G * TC * 64 + tl1 * 64 + lane] = gv.y;
                    if (lane < 3) { buf[8 * TC * 64 + tl0 * 4 + lane] = (lane == 0) ? br0 : (lane == 1) ? kr0 : cf0; buf[8 * TC * 64 + tl1 * 4 + lane] = (lane == 0) ? br1 : (lane == 1) ? kr1 : cf1; }
                }
                if (it + 1 < NCH) SCAN_LOAD(it + 1);
            }
            __syncthreads();
        }
#undef PK2F
#undef SCAN_LOAD
    }
}

__global__ void __launch_bounds__(512, 2) mega(Args a_unused) {
    extern __shared__ __attribute__((aligned(16))) unsigned char shm[];
    LAS unsigned char* lds = (LAS unsigned char*)shm;
    cg::grid_group grid = cg::this_grid();
    CArgs a0 = (CArgs)__builtin_amdgcn_kernarg_segment_ptr();
    const int ph_lo = a0->ph_lo, ph_hi = a0->ph_hi;
    for (int ph = ph_lo; ph < ph_hi; ++ph) {
        if (ph > ph_lo) grid.sync();
        CArgs a = a0; asm volatile("" : "+s"(a));
        if (ph == 0) { norm_rows(a, 0); weight_prep(a, 0, (LAS float*)lds, 0, gridDim.x); continue; }
        if (ph == NPH - 1) { norm_rows(a, 2); continue; }
        const int l = (ph - 1) / 7, s = (ph - 1) % 7;
        bf16_t* HB = (bf16_t*)(a->ws + WS_H); float* SS = (float*)(a->ws + WS_SS);
        const unsigned char* wb = a->ws + WS_WB + (size_t)(l & 1) * WB_SIZE;
        if (s == 0) {
            pg8::Gemm g{HB, (const bf16_t*)(wb + WB_WC), MR, NPROJ, DM};
            pg8::StaticOrder S; S.init(MAIN_ROWS, g.N, gridDim.x, blockIdx.x);
            LAS float* rst = (LAS float*)(lds + 131072);
            build_rs_table(rst, S, SS);
            pg8::EpiProj E{(bf16_t*)(a->ws + WS_R1), g.N, rst};
            pg8::gemm_phase(lds, g, S, E);
            tail16<0, 2>(g.A, g.Bt, g.N, g.K, E.O, g.N, SS, nullptr, (LAS float*)lds);
        }
        else if (s == 2) {
            int kl = KL; asm volatile("" : "+s"(kl));
            pg8::Gemm g{(const bf16_t*)((unsigned char*)a->out + DO_LIN), (const bf16_t*)(wb + WB_WL), MR, NL, kl};
            pg8::StaticOrder S; S.init(MAIN_ROWS, g.N, gridDim.x, blockIdx.x);
            pg8::EpiLora E{(bf16_t*)(a->ws + WS_LO), (const float*)(wb + WB_LB)};
            pg8::gemm_phase(lds, g, S, E);
            tail16<0, 2>(g.A, g.Bt, g.N, g.K, E.O, g.N, nullptr, nullptr, (LAS float*)lds, E.bias);
        }
        else if (s == 1) prep_phase(a, l);
        else if (s == 3) {
            if (blockIdx.x < BATCH * 8) scan_phase(a, l, (LAS float*)lds);
            else if (l + 1 < DEPTH) weight_prep(a, l + 1, (LAS float*)lds, BATCH * 8, gridDim.x - BATCH * 8);
        }
        else if (s == 4 || s == 6) {
            pg8::Gemm g{s == 4 ? (const bf16_t*)((unsigned char*)a->out + DO_MIX) : (const bf16_t*)(a->ws + WS_R1), (const bf16_t*)(wb + (s == 4 ? WB_WOUT : WB_WDN)), MR, DM, s == 4 ? DM : DFF};
            pg8::StaticOrder S; S.init(MAIN_ROWS, DM, gridDim.x, blockIdx.x);
            pg8::EpiResid E{HB, SS + (s == 4 ? (size_t)MR * 16 : 0)};
            pg8::gemm_phase(lds, g, S, E);
            tail16<1, 4>(g.A, g.Bt, g.N, g.K, HB, DM, nullptr, E.ssq, (LAS float*)lds);
        }
        else {
            pg8::Gemm g{HB, (const bf16_t*)(wb + WB_WGU), MR, 2 * DFF, DM}; pg8::StaticOrder S; S.init(MAIN_ROWS, 2 * DFF, gridDim.x, blockIdx.x);
            LAS float* rst = (LAS float*)(lds + 131072); build_rs_table(rst, S, SS + (size_t)MR * 16);
            pg8::EpiSwiglu E{(bf16_t*)(a->ws + WS_R1), rst};
            pg8::gemm_phase(lds, g, S, E);
            tail16<2, 2>(g.A, g.Bt, g.N, g.K, E.O, DFF, SS + (size_t)MR * 16, nullptr, (LAS float*)lds);
        }
    }
}

extern "C" void kernel_launch(void* const* d_in, const int* in_sizes, int n_in, void* d_out, int out_size, void* d_ws, size_t ws_size, hipStream_t stream) {
    static int grid = 0;
    if (grid == 0) {
        if (n_in != 26 || out_size != BATCH * SEQ * DM || ws_size < WS_END) { fprintf(stderr, "kernel_launch: unexpected shapes (n_in %d out %d ws %zu need %zu)\n", n_in, out_size, ws_size, (size_t)WS_END); grid = -1; return; }
        int dev = 0, cus = 0, per_cu = 0;
        hipGetDevice(&dev);
        hipDeviceGetAttribute(&cus, hipDeviceAttributeMultiprocessorCount, dev);
        if (hipFuncSetAttribute((const void*)mega, hipFuncAttributeMaxDynamicSharedMemorySize, LDS_BYTES) != hipSuccess) { fprintf(stderr, "kernel_launch: hipFuncSetAttribute failed\n"); grid = -1; return; }
        hipOccupancyMaxActiveBlocksPerMultiprocessor(&per_cu, (const void*)mega, 512, LDS_BYTES);
        if (per_cu < 1) { fprintf(stderr, "kernel_launch: occupancy query says %d blocks per CU\n", per_cu); per_cu = 1; }
        (void)hipGetLastError();
        grid = cus;
        fprintf(stderr, "kernel_launch: grid %d (per_cu %d)\n", grid, per_cu);
    }
    if (grid < 0) return;
    Args a{};
    for (int i = 0; i < 26; ++i) a.in[i] = (const float*)d_in[i];
    a.out = (float*)d_out; a.ws = (unsigned char*)d_ws;
#if MK_MULTI
    for (int ph = 0; ph < NPH; ++ph) {
        a.ph_lo = ph; a.ph_hi = ph + 1;
        void* args[] = {&a};
        hipError_t e = hipLaunchCooperativeKernel((const void*)mega, dim3(grid), dim3(512), args, LDS_BYTES, stream);
        if (e != hipSuccess) { fprintf(stderr, "cooperative launch failed: %s\n", hipGetErrorString(e)); break; }
    }
#else
    a.ph_lo = 0; a.ph_hi = NPH;
    void* args[] = {&a};
    hipError_t e = hipLaunchCooperativeKernel((const void*)mega, dim3(grid), dim3(512), args, LDS_BYTES, stream);
    if (e != hipSuccess) fprintf(stderr, "cooperative launch failed: %s (grid %d)\n", hipGetErrorString(e), grid);
#endif
}
```

```cpp
#include <hip/hip_runtime.h>
#include <hip/hip_cooperative_groups.h>
#include <cstdio>
#include <cstdint>
namespace cg = cooperative_groups;

#ifndef MK_MULTI
#define MK_MULTI 0
#endif

#define LAS __attribute__((address_space(3)))
typedef unsigned short bf16_t;
typedef short bf16x8 __attribute__((ext_vector_type(8)));
typedef float f32x4 __attribute__((ext_vector_type(4)));
typedef float f32x2 __attribute__((ext_vector_type(2)));
typedef unsigned u32x4 __attribute__((ext_vector_type(4)));
typedef unsigned u32x2 __attribute__((ext_vector_type(2)));

constexpr int DM = 1024, BATCH = 16, SEQ = 2048, DEPTH = 4, NMETA = 16, TT = SEQ + NMETA  , MR = BATCH * TT  ;
constexpr int NIN = 2336, NSHIFT = 1824, DFF = 2816, NPROJ = 2560  , KL = 384  , NL = 2048;
constexpr float RMS_EPS = 1e-6f, GN_EPS = 64e-5f;
constexpr int LDS_BYTES = 131072 + 16384 + 64;
constexpr int NPH = DEPTH * 7 + 2;

constexpr size_t WB_WC = 0;
constexpr size_t WB_WOUT = WB_WC + (size_t)NPROJ * DM * 2;
constexpr size_t WB_WGU = WB_WOUT + (size_t)DM * DM * 2;
constexpr size_t WB_WDN = WB_WGU + (size_t)2 * DFF * DM * 2;
constexpr size_t WB_WL = WB_WDN + (size_t)DM * DFF * 2;
constexpr size_t WB_LB = WB_WL + (size_t)NL * KL * 2;
constexpr size_t WB_SIZE = WB_LB + 8192;
constexpr size_t WS_WB = 4096;
constexpr size_t WS_SS = WS_WB + 2 * WB_SIZE;
constexpr size_t WS_H = WS_SS + 2 * (size_t)MR * 64;
constexpr size_t WS_R1 = WS_H + (size_t)MR * DM * 4;
constexpr size_t WS_LO = WS_R1 + (size_t)MR * DFF * 2;
constexpr size_t WS_END = WS_LO + (size_t)MR * NL * 2;
constexpr size_t WS_BAR = WS_END;
constexpr size_t WS_TOTAL = WS_BAR + 16384;
static_assert(WS_TOTAL <= 536870912, "workspace map");
constexpr size_t DO_MIX = 0;
constexpr size_t DO_VF = DO_MIX + (size_t)MR * DM * 2;
constexpr size_t DO_LIN = DO_VF + (size_t)MR * 512 * 2;
static_assert(DO_LIN + (size_t)MR * KL * 2 <= (size_t)BATCH * SEQ * DM * 4, "d_out scratch");

struct Args { const float* in[26]; float* out; unsigned char* ws; int ph_lo, ph_hi; };
typedef const __attribute__((address_space(4))) Args* CArgs;

__device__ __forceinline__ float bf2f(unsigned b) { return __uint_as_float(b << 16); }
__device__ __forceinline__ unsigned f2bf(float f) { unsigned u = __float_as_uint(f); return (u + 0x7fffu + ((u >> 16) & 1u)) >> 16; }
__device__ __forceinline__ unsigned pk2(float lo, float hi) { unsigned r; asm volatile("v_cvt_pk_bf16_f32 %0, %1, %2" : "=v"(r) : "v"(lo), "v"(hi)); return r; }
__device__ __forceinline__ float sigmoidf_(float x) { return __builtin_amdgcn_rcpf(1.0f + __builtin_amdgcn_exp2f(x * -1.44269504f)); }
template <int CTRL> __device__ __forceinline__ float dppf(float x) { return __int_as_float(__builtin_amdgcn_update_dpp(0, __float_as_int(x), CTRL, 0xF, 0xF, true)); }
__device__ __forceinline__ float allred8(float x) { x += dppf<0xB1>(x); x += dppf<0x4E>(x); x += dppf<0x141>(x); return x; }
#define DPP_ADD(r, ctl) "v_add_f32_dpp " r ", " r ", " r " " ctl " row_mask:0xf bank_mask:0xf\n\t"
__device__ __forceinline__ void allred8x4(float& a, float& b, float& c, float& d) {
    asm volatile("s_nop 1\n\t"
        DPP_ADD("%0", "quad_perm:[1,0,3,2]") DPP_ADD("%1", "quad_perm:[1,0,3,2]") DPP_ADD("%2", "quad_perm:[1,0,3,2]") DPP_ADD("%3", "quad_perm:[1,0,3,2]")
        DPP_ADD("%0", "quad_perm:[2,3,0,1]") DPP_ADD("%1", "quad_perm:[2,3,0,1]") DPP_ADD("%2", "quad_perm:[2,3,0,1]") DPP_ADD("%3", "quad_perm:[2,3,0,1]")
        DPP_ADD("%0", "row_half_mirror") DPP_ADD("%1", "row_half_mirror") DPP_ADD("%2", "row_half_mirror") DPP_ADD("%3", "row_half_mirror")
        : "+v"(a), "+v"(b), "+v"(c), "+v"(d));
}
__device__ __forceinline__ float rows_to_wave(float x) {
    const int xi = __float_as_int(x);
    return (__int_as_float(__builtin_amdgcn_readlane(xi, 0)) + __int_as_float(__builtin_amdgcn_readlane(xi, 16))) + (__int_as_float(__builtin_amdgcn_readlane(xi, 32)) + __int_as_float(__builtin_amdgcn_readlane(xi, 48)));
}
__device__ __forceinline__ float wave_sum(float x) {
    asm volatile("s_nop 1\n\t" DPP_ADD("%0", "quad_perm:[1,0,3,2]") "s_nop 1\n\t" DPP_ADD("%0", "quad_perm:[2,3,0,1]") "s_nop 1\n\t" DPP_ADD("%0", "row_half_mirror") "s_nop 1\n\t" DPP_ADD("%0", "row_mirror") : "+v"(x));
    return rows_to_wave(x);
}
__device__ __forceinline__ void wave_sum3(float& a, float& b, float& c) {
    asm volatile("s_nop 1\n\t"
        DPP_ADD("%0", "quad_perm:[1,0,3,2]") DPP_ADD("%1", "quad_perm:[1,0,3,2]") DPP_ADD("%2", "quad_perm:[1,0,3,2]")
        DPP_ADD("%0", "quad_perm:[2,3,0,1]") DPP_ADD("%1", "quad_perm:[2,3,0,1]") DPP_ADD("%2", "quad_perm:[2,3,0,1]")
        DPP_ADD("%0", "row_half_mirror") DPP_ADD("%1", "row_half_mirror") DPP_ADD("%2", "row_half_mirror")
        DPP_ADD("%0", "row_mirror") DPP_ADD("%1", "row_mirror") DPP_ADD("%2", "row_mirror")
        "v_add_f32_dpp %0, %0, %0 row_bcast:15 row_mask:0xa bank_mask:0xf\n\t" "v_add_f32_dpp %1, %1, %1 row_bcast:15 row_mask:0xa bank_mask:0xf\n\t" "v_add_f32_dpp %2, %2, %2 row_bcast:15 row_mask:0xa bank_mask:0xf\n\t"
        "v_add_f32_dpp %0, %0, %0 row_bcast:31 row_mask:0xc bank_mask:0xf\n\t" "v_add_f32_dpp %1, %1, %1 row_bcast:31 row_mask:0xc bank_mask:0xf\n\t" "v_add_f32_dpp %2, %2, %2 row_bcast:31 row_mask:0xc bank_mask:0xf\n\t"
        : "+v"(a), "+v"(b), "+v"(c));
    a = __int_as_float(__builtin_amdgcn_readlane(__float_as_int(a), 63)); b = __int_as_float(__builtin_amdgcn_readlane(__float_as_int(b), 63)); c = __int_as_float(__builtin_amdgcn_readlane(__float_as_int(c), 63));
}
__device__ __forceinline__ int tid_opaque() { int t = threadIdx.x; asm volatile("" : "+v"(t)); return t; }

__device__ __forceinline__ void unpack8(const u32x4 w, float (&x)[8]) {
    x[0] = bf2f(w.x & 0xffffu); x[1] = bf2f(w.x >> 16); x[2] = bf2f(w.y & 0xffffu); x[3] = bf2f(w.y >> 16);
    x[4] = bf2f(w.z & 0xffffu); x[5] = bf2f(w.z >> 16); x[6] = bf2f(w.w & 0xffffu); x[7] = bf2f(w.w >> 16);
}
constexpr int MAIN_ROWS = BATCH * SEQ, NROWS = MAIN_ROWS + NMETA;
__device__ __forceinline__ int row_of(int b, int t) { return t < NMETA ? MAIN_ROWS + t : b * SEQ + (t - NMETA); }
__device__ __forceinline__ float row_rs(const float* ssp, int row) {
    const f32x4* p = (const f32x4*)(ssp + (size_t)row * 16); const f32x4 a = p[0], b = p[1], c = p[2], d = p[3];
    const f32x4 t = (a + b) + (c + d);
    return rsqrtf(((t[0] + t[1]) + (t[2] + t[3])) * (1.0f / DM) + RMS_EPS);
}
namespace pg8 {
constexpr int BM = 256, BK = 64, HALF = 128, HTB = HALF * BK * 2, STAGE_BYTES = 8 * HTB, NXCD = 8, WGM = 8;
__host__ __device__ __forceinline__ int lds_byte(int r, int c) { const int st = (r >> 4) * 2 + (c >> 5), rr = r & 15, cc = c & 31, ob = rr * 64 + cc * 2; return st * 1024 + (ob ^ (((ob >> 9) & 1) << 5)); }
__host__ __device__ __forceinline__ void stage_rc(int b, int& R, int& C) { const int st = b / 1024, sb = b % 1024, swz = sb ^ (((sb >> 9) & 1) << 5); R = (st >> 1) * 16 + swz / 64; C = (st & 1) * 32 + (swz % 64) / 2; }
__host__ __device__ __forceinline__ int perm32(int rho) { const int n = rho >> 4, i = rho & 15; return 8 * (i >> 2) + 4 * n + (i & 3); }
struct Unit { int pm, pn; };
struct Gemm { const bf16_t* A; const bf16_t* Bt; int M, N, K; };
struct StaticOrder {
    int nM, nN, nwg, G, c;
    __device__ void init(int M, int N, int G_, int c_) { nM = M / BM; nN = N / BM; nwg = nM * nN; G = G_; c = c_; }
    __device__ bool next(int i, Unit& u) const {
        const long L = (long)i * G + c; if (L >= nwg) return false;
        int wgid = (int)L; { const int q = nwg / NXCD, r = nwg % NXCD, xcd = wgid % NXCD, off = wgid / NXCD; wgid = (xcd < r ? xcd * (q + 1) : r * (q + 1) + (xcd - r) * q) + off; }
        const int nig = WGM * nN, gid = wgid / nig, fm = gid * WGM, gsz = (nM - fm) < WGM ? (nM - fm) : WGM;
        u.pm = fm + ((wgid % nig) % gsz); u.pn = (wgid % nig) / gsz; return true;
    }
};
template <class Epi>
__device__ __forceinline__ void gemm_phase(LAS unsigned char* lds, const Gemm g, const StaticOrder& S, const Epi& E) {
    int tid_ = threadIdx.x; asm volatile("" : "+v"(tid_));
    const int tid = tid_, wid = __builtin_amdgcn_readfirstlane(tid >> 6), lane = tid & 63, wr = wid >> 2, wc = wid & 3, fr = lane & 15, fq = lane >> 4;
    const int K = g.K, nt = K / BK;
    unsigned voffA[2], voffB[2];
#pragma unroll
    for (int i = 0; i < 2; ++i) { int R, C; stage_rc(tid * 16 + i * 8192, R, C); const int Rb = Epi::PERM ? ((R & ~31) + perm32(R & 31)) : R;
        voffA[i] = (unsigned)(R * K + C) * 2u; voffB[i] = (unsigned)(Rb * K + C) * 2u; }
    const size_t kstep = (size_t)(BK * 2);
    const size_t hstep = (size_t)HALF * K * 2;
    const size_t tstep = 2 * hstep;
    const unsigned ldsw = (unsigned)wid * 1024u;
    const int aoff = lds_byte(wr * 64 + fr, fq * 8), boff = lds_byte(wc * 32 + fr, fq * 8);
#define PG8_SA(b, h) (((b) * 2 + (h)) * HTB)
#define PG8_SB(b, h) ((4 + (b) * 2 + (h)) * HTB)
#define PG8_STAGE(bufoff, gbase, voff) do { _Pragma("unroll") for (int _i = 0; _i < 2; ++_i) \
        __builtin_amdgcn_global_load_lds((const unsigned*)((const char*)(gbase) + (voff)[_i]), (LAS unsigned*)(lds + (bufoff) + ldsw + _i * 8192), 16, 0, 0); } while (0)
#define PG8_LDA(dst, b, h) do { _Pragma("unroll") for (int m = 0; m < 4; ++m) _Pragma("unroll") for (int k = 0; k < 2; ++k) dst[m][k] = *(const LAS bf16x8*)(lds + PG8_SA(b, h) + aoff + m * 2048 + k * 1024); } while (0)
#define PG8_LDB(dst, b, h) do { _Pragma("unroll") for (int n = 0; n < 2; ++n) _Pragma("unroll") for (int k = 0; k < 2; ++k) dst[n][k] = *(const LAS bf16x8*)(lds + PG8_SB(b, h) + boff + n * 2048 + k * 1024); } while (0)
#define PG8_MMA(ai, bj, At, Bt) do { __builtin_amdgcn_s_setprio(1); _Pragma("unroll") for (int m = 0; m < 4; ++m) _Pragma("unroll") for (int n = 0; n < 2; ++n) _Pragma("unroll") for (int k = 0; k < 2; ++k) \
        acc[ai][bj][m][n] = __builtin_amdgcn_mfma_f32_16x16x32_bf16(Bt[n][k], At[m][k], acc[ai][bj][m][n], 0, 0, 0); __builtin_amdgcn_s_setprio(0); } while (0)
#define PG8_WAIT_V(n) asm volatile("s_waitcnt vmcnt(" #n ")" ::: "memory")
#define PG8_WAIT_L(n) asm volatile("s_waitcnt lgkmcnt(" #n ")" ::: "memory")
#define PG8_BAR __builtin_amdgcn_s_barrier()
#define PG8_SCHED __builtin_amdgcn_sched_barrier(0)
    Unit cur, nxt; int ui = 0;
    if (!S.next(0, cur)) return;
    f32x4 acc[2][2][4][2];
#pragma unroll
    for (int a = 0; a < 2; ++a)
#pragma unroll
        for (int b = 0; b < 2; ++b)
#pragma unroll
            for (int m = 0; m < 4; ++m)
#pragma unroll
                for (int n = 0; n < 2; ++n) acc[a][b][m][n] = (f32x4){0.f, 0.f, 0.f, 0.f};
    bf16x8 At[4][2], B0[2][2], B1[2][2];
    const char* cA = (const char*)g.A + (size_t)cur.pm * tstep; const char* cB = (const char*)g.Bt + (size_t)cur.pn * tstep;
    PG8_STAGE(PG8_SB(0, 0), cB, voffB); PG8_STAGE(PG8_SA(0, 0), cA, voffA); PG8_STAGE(PG8_SB(0, 1), cB + hstep, voffB); PG8_STAGE(PG8_SA(0, 1), cA + hstep, voffA);
    if (wr == 1) PG8_BAR;
    PG8_WAIT_V(4); PG8_BAR;
    PG8_STAGE(PG8_SB(1, 0), cB + kstep, voffB); PG8_STAGE(PG8_SA(1, 0), cA + kstep, voffA); PG8_STAGE(PG8_SB(1, 1), cB + hstep + kstep, voffB);
    PG8_WAIT_V(6); PG8_BAR;
    for (;;) {
        const bool has_next = S.next(ui + 1, nxt);
        const char* nA = has_next ? (const char*)g.A + (size_t)nxt.pm * tstep : cA; const char* nB = has_next ? (const char*)g.Bt + (size_t)nxt.pn * tstep : cB;
        for (int t = 0; t < nt; t += 2) {
            const bool last = (t == nt - 2);
            const char* a1 = cA + (size_t)(t + 1) * kstep;
            const char* a2 = last ? nA : cA + (size_t)(t + 2) * kstep; const char* b2 = last ? nB : cB + (size_t)(t + 2) * kstep;
            const char* a3 = a2 + kstep; const char* b3 = b2 + kstep;
            PG8_LDB(B0, 0, 0); PG8_SCHED; PG8_LDA(At, 0, 0); PG8_STAGE(PG8_SA(1, 1), a1 + hstep, voffA);
            PG8_WAIT_L(8); PG8_BAR; PG8_WAIT_L(0); PG8_MMA(0, 0, At, B0); PG8_BAR; PG8_SCHED;
            PG8_LDB(B1, 0, 1); PG8_STAGE(PG8_SB(0, 0), b2, voffB);
            PG8_BAR; PG8_WAIT_L(0); PG8_MMA(0, 1, At, B1); PG8_BAR;
            PG8_LDA(At, 0, 1); PG8_STAGE(PG8_SA(0, 0), a2, voffA);
            PG8_BAR; PG8_WAIT_L(0); PG8_MMA(1, 0, At, B0); PG8_BAR; PG8_SCHED;
            PG8_STAGE(PG8_SB(0, 1), b2 + hstep, voffB);
            PG8_WAIT_V(6); PG8_BAR; PG8_MMA(1, 1, At, B1); PG8_BAR;
            PG8_LDB(B0, 1, 0); PG8_SCHED; PG8_LDA(At, 1, 0); PG8_STAGE(PG8_SA(0, 1), a2 + hstep, voffA);
            PG8_WAIT_L(8); PG8_BAR; PG8_WAIT_L(0); PG8_MMA(0, 0, At, B0); PG8_BAR; PG8_SCHED;
            PG8_LDB(B1, 1, 1); PG8_STAGE(PG8_SB(1, 0), b3, voffB);
            PG8_BAR; PG8_WAIT_L(0); PG8_MMA(0, 1, At, B1); PG8_BAR;
            PG8_LDA(At, 1, 1); PG8_STAGE(PG8_SA(1, 0), a3, voffA);
            PG8_BAR; PG8_WAIT_L(0); PG8_MMA(1, 0, At, B0); PG8_BAR; PG8_SCHED;
            PG8_STAGE(PG8_SB(1, 1), b3 + hstep, voffB);
            PG8_WAIT_V(6); PG8_BAR; PG8_MMA(1, 1, At, B1); PG8_BAR;
        }
        E(acc, cur, ui, wr, wc, fr, fq);
        if (!has_next) break;
#pragma unroll
        for (int a = 0; a < 2; ++a)
#pragma unroll
            for (int b = 0; b < 2; ++b)
#pragma unroll
                for (int m = 0; m < 4; ++m)
#pragma unroll
                    for (int n = 0; n < 2; ++n) acc[a][b][m][n] = (f32x4){0.f, 0.f, 0.f, 0.f};
        cur = nxt; cA = nA; cB = nB; ++ui;
    }
    PG8_WAIT_V(0);
    if (wr == 0) PG8_BAR;
    PG8_BAR;
#undef PG8_SA
#undef PG8_SB
#undef PG8_STAGE
#undef PG8_LDA
#undef PG8_LDB
#undef PG8_MMA
#undef PG8_WAIT_V
#undef PG8_WAIT_L
#undef PG8_BAR
#undef PG8_SCHED
}

struct EpiProj {
    static constexpr bool PERM = true;
    bf16_t* O; int ldc; const LAS float* rst;
    __device__ __forceinline__ void operator()(const f32x4 (&acc)[2][2][4][2], const Unit& u, int ui, int wr, int wc, int fr, int fq) const {
        const int row0 = u.pm * BM + wr * 64 + fr, col0 = u.pn * BM + wc * 32 + 8 * fq;
#pragma unroll
        for (int ai = 0; ai < 2; ++ai)
#pragma unroll
            for (int m = 0; m < 4; ++m) { const int row = row0 + ai * HALF + m * 16; bf16_t* rowp = O + (size_t)row * ldc + col0;
                const float rs = rst ? rst[ui * 256 + (row & 255)] : 1.0f;
#pragma unroll
                for (int bj = 0; bj < 2; ++bj) { const f32x4 v0 = acc[ai][bj][m][0] * rs, v1 = acc[ai][bj][m][1] * rs;
                    u32x4 w; w.x = pk2(v0[0], v0[1]); w.y = pk2(v0[2], v0[3]); w.z = pk2(v1[0], v1[1]); w.w = pk2(v1[2], v1[3]);
                    *(u32x4*)(rowp + bj * HALF) = w; } }
    }
};
struct EpiResid {
    static constexpr bool PERM = true;
    bf16_t* HB; float* ssq;
    __device__ __forceinline__ void operator()(const f32x4 (&acc)[2][2][4][2], const Unit& u, int ui, int wr, int wc, int fr, int fq) const {
        const int row0 = u.pm * BM + wr * 64 + fr, col0 = u.pn * BM + wc * 32 + 8 * fq;
#pragma unroll
        for (int ai = 0; ai < 2; ++ai) {
            u32x4 hv[4][2];
#pragma unroll
            for (int m = 0; m < 4; ++m)
#pragma unroll
                for (int bj = 0; bj < 2; ++bj) hv[m][bj] = *(const u32x4*)(HB + (size_t)(row0 + ai * HALF + m * 16) * DM + col0 + bj * HALF);
            __builtin_amdgcn_sched_barrier(0);
#pragma unroll
            for (int m = 0; m < 4; ++m) { const int row = row0 + ai * HALF + m * 16; bf16_t* rowb = HB + (size_t)row * DM + col0;
                float q = 0.f;
#pragma unroll
                for (int bj = 0; bj < 2; ++bj) { const u32x4 hw = hv[m][bj]; const f32x4 v0 = acc[ai][bj][m][0], v1 = acc[ai][bj][m][1];
                    u32x4 w;
                    w.x = pk2(bf2f(hw.x & 0xffffu) + v0[0], bf2f(hw.x >> 16) + v0[1]); w.y = pk2(bf2f(hw.y & 0xffffu) + v0[2], bf2f(hw.y >> 16) + v0[3]);
                    w.z = pk2(bf2f(hw.z & 0xffffu) + v1[0], bf2f(hw.z >> 16) + v1[1]); w.w = pk2(bf2f(hw.w & 0xffffu) + v1[2], bf2f(hw.w >> 16) + v1[3]);
                    *(u32x4*)(rowb + bj * HALF) = w;
                    const float r0 = bf2f(w.x & 0xffffu), r1 = bf2f(w.x >> 16), r2 = bf2f(w.y & 0xffffu), r3 = bf2f(w.y >> 16), r4 = bf2f(w.z & 0xffffu), r5 = bf2f(w.z >> 16), r6 = bf2f(w.w & 0xffffu), r7 = bf2f(w.w >> 16);
                    q += ((r0 * r0 + r1 * r1) + (r2 * r2 + r3 * r3)) + ((r4 * r4 + r5 * r5) + (r6 * r6 + r7 * r7)); }
                q += __shfl_xor(q, 16); q += __shfl_xor(q, 32);
                if (fq == 0) ssq[(size_t)row * 16 + u.pn * 4 + wc] = q; }
            __builtin_amdgcn_sched_barrier(0);
        }
    }
};
struct EpiLora {
    static constexpr bool PERM = true;
    bf16_t* O; const float* bias;
    __device__ __forceinline__ void operator()(const f32x4 (&acc)[2][2][4][2], const Unit& u, int ui, int wr, int wc, int fr, int fq) const {
        const int row0 = u.pm * BM + wr * 64 + fr, col0 = u.pn * BM + wc * 32 + 8 * fq, mode = u.pn >> 1;
        const float sc = (mode == 0) ? 0.60653066f : 1.0f;
#pragma unroll
        for (int bj = 0; bj < 2; ++bj) {
            const f32x4 c0 = *(const f32x4*)(bias + col0 + bj * HALF), c1 = *(const f32x4*)(bias + col0 + bj * HALF + 4);
#pragma unroll
            for (int ai = 0; ai < 2; ++ai)
#pragma unroll
                for (int m = 0; m < 4; ++m) { bf16_t* rowp = O + (size_t)(row0 + ai * HALF + m * 16) * NL + col0 + bj * HALF;
                    f32x4 v0 = acc[ai][bj][m][0] + c0, v1 = acc[ai][bj][m][1] + c1;
                    if (mode != 2) {
#pragma unroll
                        for (int j = 0; j < 4; ++j) { v0[j] = sc * sigmoidf_(v0[j]); v1[j] = sc * sigmoidf_(v1[j]); } }
                    u32x4 w; w.x = pk2(v0[0], v0[1]); w.y = pk2(v0[2], v0[3]); w.z = pk2(v1[0], v1[1]); w.w = pk2(v1[2], v1[3]);
                    *(u32x4*)rowp = w; }
        }
    }
};
struct EpiSwiglu {
    static constexpr bool PERM = true;
    bf16_t* O; const LAS float* rst;
    __device__ __forceinline__ void operator()(const f32x4 (&acc)[2][2][4][2], const Unit& u, int ui, int wr, int wc, int fr, int fq) const {
        const int row0 = u.pm * BM + wr * 64 + fr, col0 = u.pn * 128 + wc * 16 + 4 * fq;
#pragma unroll
        for (int ai = 0; ai < 2; ++ai)
#pragma unroll
            for (int m = 0; m < 4; ++m) { const int row = row0 + ai * HALF + m * 16; bf16_t* rowp = O + (size_t)row * DFF + col0;
                const float rs = rst[ui * 256 + (row & 255)];
#pragma unroll
                for (int bj = 0; bj < 2; ++bj) { const f32x4 gt = acc[ai][bj][m][0] * rs, up = acc[ai][bj][m][1] * rs; float o[4];
#pragma unroll
                    for (int j = 0; j < 4; ++j) o[j] = gt[j] * sigmoidf_(gt[j]) * up[j];
                    u32x2 w; w.x = pk2(o[0], o[1]); w.y = pk2(o[2], o[3]);
                    *(u32x2*)(rowp + bj * 64) = w; } }
    }
};
}

__device__ __forceinline__ void build_rs_table(LAS float* rst, const pg8::StaticOrder& S, const float* ssp) {
    const int tid = tid_opaque();
    pg8::Unit u;
    for (int i = 0; S.next(i, u); ++i) if (tid < 256) rst[i * 256 + tid] = row_rs(ssp, u.pm * 256 + tid);
    __syncthreads();
}
template <int KIND, int NB>
__device__ __forceinline__ void tail16(const bf16_t* A, const bf16_t* Bt, int N, int K, bf16_t* Out, int ldo, const float* ssp, float* ssq, LAS float* red, const float* lbias = nullptr) {
    const int tid = tid_opaque(), wid = __builtin_amdgcn_readfirstlane(tid >> 6), lane = tid & 63, fr = lane & 15, fq = lane >> 4;
    const int ntile = (KIND == 2) ? N / 32 : N / (16 * NB), nks = K >> 7;
    const int row = MAIN_ROWS + fr;
    for (int tile = blockIdx.x; tile < ntile; tile += gridDim.x) {
        f32x4 acc[NB];
#pragma unroll
        for (int be = 0; be < NB; ++be) acc[be] = (f32x4){0.f, 0.f, 0.f, 0.f};
        const bf16_t* ap = A + (size_t)row * K + fq * 8;
        const bf16_t* bp[NB];
        if (KIND == 2) { const int f = tile * 16 + fr, pn = f >> 7, ft = f & 127, r0 = pn * 256 + ((ft >> 2) << 3) + (ft & 3); bp[0] = Bt + (size_t)r0 * K + fq * 8; bp[1] = Bt + (size_t)(r0 + 4) * K + fq * 8; }
        else {
#pragma unroll
            for (int be = 0; be < NB; ++be) bp[be] = Bt + (size_t)(tile * 16 * NB + be * 16 + fr) * K + fq * 8; }
        for (int ks = wid; ks < nks; ks += 8) {
            bf16x8 av[4], bv[NB][4];
#pragma unroll
            for (int u = 0; u < 4; ++u) { av[u] = *(const bf16x8*)(ap + ks * 128 + u * 32);
#pragma unroll
                for (int be = 0; be < NB; ++be) bv[be][u] = *(const bf16x8*)(bp[be] + ks * 128 + u * 32); }
            __builtin_amdgcn_sched_barrier(0);
#pragma unroll
            for (int u = 0; u < 4; ++u)
#pragma unroll
                for (int be = 0; be < NB; ++be) acc[be] = __builtin_amdgcn_mfma_f32_16x16x32_bf16(bv[be][u], av[u], acc[be], 0, 0, 0);
        }
#pragma unroll
        for (int be = 0; be < NB; ++be) *(LAS f32x4*)(red + ((wid * NB + be) * 64 + lane) * 4) = acc[be];
        __syncthreads();
        if (wid == 0) {
#pragma unroll
            for (int be = 0; be < NB; ++be) { f32x4 t = *(const LAS f32x4*)(red + (be * 64 + lane) * 4);
#pragma unroll
                for (int w = 1; w < 8; ++w) t += *(const LAS f32x4*)(red + ((w * NB + be) * 64 + lane) * 4);
                acc[be] = t; }
            if (KIND == 0) {
                const float rs = ssp ? row_rs(ssp, row) : 1.0f;
#pragma unroll
                for (int be = 0; be < NB; ++be) { const int col = tile * 16 * NB + be * 16 + fq * 4; f32x4 v = acc[be] * rs;
                    if (lbias) { const int mode = col >> 9;
                        if (mode != 2) { const float sc = (mode == 0) ? 0.60653066f : 1.0f;
#pragma unroll
                            for (int j = 0; j < 4; ++j) v[j] = sc * sigmoidf_(v[j] + lbias[col + j]); } }
                    u32x2 w; w.x = pk2(v[0], v[1]); w.y = pk2(v[2], v[3]);
                    *(u32x2*)(Out + (size_t)row * ldo + col) = w; }
            } else if (KIND == 1) {
                float q = 0.f;
#pragma unroll
                for (int be = 0; be < NB; ++be) { bf16_t* o = Out + (size_t)row * ldo + tile * 16 * NB + be * 16 + fq * 4; const u32x2 hw = *(const u32x2*)o;
                    u32x2 w; w.x = pk2(bf2f(hw.x & 0xffffu) + acc[be][0], bf2f(hw.x >> 16) + acc[be][1]); w.y = pk2(bf2f(hw.y & 0xffffu) + acc[be][2], bf2f(hw.y >> 16) + acc[be][3]);
                    *(u32x2*)o = w;
                    const float r0 = bf2f(w.x & 0xffffu), r1 = bf2f(w.x >> 16), r2 = bf2f(w.y & 0xffffu), r3 = bf2f(w.y >> 16);
                    q += (r0 * r0 + r1 * r1) + (r2 * r2 + r3 * r3); }
                q += __shfl_xor(q, 16); q += __shfl_xor(q, 32);
                if (fq == 0) ssq[(size_t)row * 16 + tile] = q;
            } else {
                const float rs = row_rs(ssp, row); float v[4];
#pragma unroll
                for (int j = 0; j < 4; ++j) { const float g = acc[0][j] * rs; v[j] = g * sigmoidf_(g) * (acc[1][j] * rs); }
                u32x2 w; w.x = pk2(v[0], v[1]); w.y = pk2(v[2], v[3]);
                *(u32x2*)(Out + (size_t)row * ldo + tile * 16 + fq * 4) = w;
            }
        }
        __syncthreads();
    }
}

__device__ __forceinline__ void norm_rows(CArgs a, int mode) {
    const int tid = tid_opaque(), wid = tid >> 6, lane = tid & 63;
    bf16_t* HB = (bf16_t*)(a->ws + WS_H); float* SS = (float*)(a->ws + WS_SS);
    for (int row = blockIdx.x * 8 + wid; row < (mode == 0 ? NROWS : MAIN_ROWS); row += gridDim.x * 8) {
        float x[16]; float ss = 0.f;
        if (mode == 0) {
            const float* src = (row >= MAIN_ROWS ? a->in[1] + (size_t)(row - MAIN_ROWS) * DM : a->in[0] + (size_t)row * DM);
#pragma unroll
            for (int i = 0; i < 2; ++i) { const f32x4 v0 = *(const f32x4*)(src + lane * 8 + 512 * i), v1 = *(const f32x4*)(src + lane * 8 + 512 * i + 4);
                u32x4 w; w.x = pk2(v0[0], v0[1]); w.y = pk2(v0[2], v0[3]); w.z = pk2(v1[0], v1[1]); w.w = pk2(v1[2], v1[3]);
                *(u32x4*)(HB + (size_t)row * DM + lane * 8 + 512 * i) = w;
                float r[8]; unpack8(w, r);
#pragma unroll
                for (int e = 0; e < 8; ++e) ss += r[e] * r[e]; }
            ss = wave_sum(ss);
            if (lane < 16) SS[(size_t)row * 16 + lane] = (lane == 0) ? ss : 0.f;
        } else {
#pragma unroll
            for (int i = 0; i < 2; ++i) { float r[8]; unpack8(*(const u32x4*)(HB + (size_t)row * DM + lane * 8 + 512 * i), r);
#pragma unroll
                for (int e = 0; e < 8; ++e) { x[i * 8 + e] = r[e]; ss += r[e] * r[e]; } }
            ss = wave_sum(ss);
            const float rs = rsqrtf(ss * (1.0f / DM) + RMS_EPS);
            float* o = a->out + (size_t)row * DM;
#pragma unroll
            for (int i = 0; i < 2; ++i) { const f32x4 g0 = *(const f32x4*)(a->in[25] + lane * 8 + 512 * i), g1 = *(const f32x4*)(a->in[25] + lane * 8 + 512 * i + 4);
                *(f32x4*)(o + lane * 8 + 512 * i) = (f32x4){x[i * 8] * rs * g0[0], x[i * 8 + 1] * rs * g0[1], x[i * 8 + 2] * rs * g0[2], x[i * 8 + 3] * rs * g0[3]};
                *(f32x4*)(o + lane * 8 + 512 * i + 4) = (f32x4){x[i * 8 + 4] * rs * g1[0], x[i * 8 + 5] * rs * g1[1], x[i * 8 + 6] * rs * g1[2], x[i * 8 + 7] * rs * g1[3]}; }
        }
    }
}

template <int KIND> __device__ __forceinline__ float wsrc(CArgs a, int l, int k, int n) {
    if (KIND == 0) {
        const float gk = a->in[2][(size_t)l * DM + k];
        if (n < NIN) return gk * a->in[3][((size_t)l * DM + k) * NIN + n];
        if (n < NIN + 32 && l > 0) return gk * a->in[17][((size_t)(l - 1) * DM + k) * 32 + (n - NIN)];
        return 0.f;
    } else if (KIND == 1) {
        return a->in[21][((size_t)l * DM + k) * DM + n];
    } else if (KIND == 2) {
        const int pn = n >> 8, c = n & 255, feat = pn * 128 + ((c >> 3) << 2) + (c & 3), isup = (c >> 2) & 1;
        return a->in[22][(size_t)l * DM + k] * a->in[23][((size_t)l * DM + k) * (2 * DFF) + feat + isup * DFF];
    } else if (KIND == 3) {
        return a->in[24][((size_t)l * DFF + k) * DM + n];
    } else {
        const int j = n >> 9, nn = n & 511;
        if (j == 0) return (k < 64) ? a->in[8][((size_t)l * 64 + k) * 512 + nn] : 0.f;
        if (j == 1) return (k >= 64 && k < 128) ? a->in[10][((size_t)l * 64 + (k - 64)) * 512 + nn] : 0.f;
        if (j == 2) return (k >= 128 && k < 288) ? a->in[11][((size_t)l * 160 + (k - 128)) * 512 + nn] : 0.f;
        return (k >= 288 && k < 320 && l > 0) ? a->in[20][((size_t)(l - 1) * 32 + (k - 288)) * 512 + nn] : 0.f;
    }
}
template <int KIND> __device__ __forceinline__ void conv_tile(CArgs a, int l, LAS float* tile, bf16_t* out, int ldo, int n0, int k0) {
    const int tid = tid_opaque(), kk = tid >> 6, nn = tid & 63;
#pragma unroll
    for (int i = 0; i < 8; ++i) tile[(kk + 8 * i) * 65 + nn] = wsrc<KIND>(a, l, k0 + kk + 8 * i, n0 + nn);
    __syncthreads();
    const int n = tid >> 3, kq = tid & 7;
    u32x4 w;
    w.x = pk2(tile[(kq * 8 + 0) * 65 + n], tile[(kq * 8 + 1) * 65 + n]); w.y = pk2(tile[(kq * 8 + 2) * 65 + n], tile[(kq * 8 + 3) * 65 + n]);
    w.z = pk2(tile[(kq * 8 + 4) * 65 + n], tile[(kq * 8 + 5) * 65 + n]); w.w = pk2(tile[(kq * 8 + 6) * 65 + n], tile[(kq * 8 + 7) * 65 + n]);
    *(u32x4*)(out + (size_t)(n0 + n) * ldo + k0 + kq * 8) = w;
    __syncthreads();
}
__device__ __forceinline__ void fold_tile(CArgs a, int l, LAS float* lds, bf16_t* out, int n0, int k0) {
    LAS float* P = lds; LAS float* W = lds + 64 * 128;
    const int tid = tid_opaque(), g = k0 >> 7, c0 = k0 & 127;
    const float* pw = a->in[5] + ((size_t)(l * 4 + g) * 128 + c0) * 128; const float* sc = a->in[6] + (size_t)l * 512 + g * 128;
    const float* wo = a->in[21] + ((size_t)l * DM + g * 128) * DM + n0;
    for (int i = tid; i < 64 * 128; i += 512) { const int d = i & 127; P[i] = pw[i] * sc[d]; }
    for (int i = tid; i < 128 * 64; i += 512) { const int d = i >> 6, n = i & 63; W[i] = wo[(size_t)d * DM + n]; }
    __syncthreads();
    const int n = tid & 63, cq = tid >> 6;
    float acc[8];
#pragma unroll
    for (int j = 0; j < 8; ++j) acc[j] = 0.f;
    for (int d = 0; d < 128; ++d) { const float wv = W[d * 64 + n];
#pragma unroll
        for (int j = 0; j < 8; ++j) acc[j] += P[(cq * 8 + j) * 128 + d] * wv; }
    u32x4 w; w.x = pk2(acc[0], acc[1]); w.y = pk2(acc[2], acc[3]); w.z = pk2(acc[4], acc[5]); w.w = pk2(acc[6], acc[7]);
    *(u32x4*)(out + (size_t)(n0 + n) * DM + k0 + cq * 8) = w;
    __syncthreads();
}
__device__ __forceinline__ void weight_prep(CArgs a, int l, LAS float* lds, int b0, int nb) {
    unsigned char* wb = a->ws + WS_WB + (size_t)(l & 1) * WB_SIZE;
    bf16_t* WC = (bf16_t*)(wb + WB_WC); bf16_t* WO = (bf16_t*)(wb + WB_WOUT); bf16_t* WGU = (bf16_t*)(wb + WB_WGU); bf16_t* WDN = (bf16_t*)(wb + WB_WDN); bf16_t* WL = (bf16_t*)(wb + WB_WL);
    for (int ti = (int)blockIdx.x - b0; ti < 3201; ti += nb) {
        if (ti == 3200) { float* LB = (float*)(wb + WB_LB); const int t0 = tid_opaque();
            for (int i = t0; i < NL; i += 512) { const int j = i >> 9, nn = i & 511; LB[i] = (j == 0) ? a->in[7][l * 512 + nn] : (j == 1) ? a->in[9][l * 512 + nn] : (j == 3 && l > 0) ? a->in[19][(l - 1) * 512 + nn] : 0.f; }
            continue; }
        if (ti < 128) { fold_tile(a, l, lds, WO, (ti & 15) * 64, (ti >> 4) * 64); }
        else if (ti < 256) { const int q = ti - 128; conv_tile<1>(a, l, lds, WO, DM, (q & 15) * 64, 512 + (q >> 4) * 64); }
        else if (ti < 896) { const int q = ti - 256; conv_tile<0>(a, l, lds, WC, DM, (q >> 4) * 64, (q & 15) * 64); }
        else if (ti < 2304) { const int q = ti - 896; conv_tile<2>(a, l, lds, WGU, DM, (q >> 4) * 64, (q & 15) * 64); }
        else if (ti < 3008) { const int q = ti - 2304; conv_tile<3>(a, l, lds, WDN, DFF, (q / 44) * 64, (q % 44) * 64); }
        else { const int q = ti - 3008; conv_tile<4>(a, l, lds, WL, KL, (q / 6) * 64, (q % 6) * 64); }
    }
}

__device__ __forceinline__ void prep_phase(CArgs a, int l) {
    const bf16_t* PROJ = (const bf16_t*)(a->ws + WS_R1);
    bf16_t* MIX = (bf16_t*)((unsigned char*)a->out + DO_MIX); bf16_t* LIN = (bf16_t*)((unsigned char*)a->out + DO_LIN);
    const int tid = tid_opaque(), gt = blockIdx.x * 512 + tid, nthr = gridDim.x * 512;
    for (int it = gt; it < (MAIN_ROWS / 16 + 1) * 64; it += nthr) {
        const int run = it >> 6, c0 = (it & 63) * 8, win = 2 << (c0 >> 7);
        const int b = run >> 7, t0 = (run < MAIN_ROWS / 16) ? NMETA + (run & 127) * 16 : 0;
        float s[8], x[8], y[8];
#pragma unroll
        for (int e = 0; e < 8; ++e) s[e] = 0.f;
        const int pre = (t0 < win) ? t0 : win;
        for (int q = 1; q <= pre; ++q) { unpack8(*(const u32x4*)(PROJ + (size_t)row_of(b, t0 - q) * NPROJ + c0), x);
#pragma unroll
            for (int e = 0; e < 8; ++e) s[e] += x[e]; }
        for (int i = 0; i < 16; ++i) {
            const int t = t0 + i, row = row_of(b, t);
            unpack8(*(const u32x4*)(PROJ + (size_t)row * NPROJ + c0), x);
            if (t >= win) { unpack8(*(const u32x4*)(PROJ + (size_t)row_of(b, t - win) * NPROJ + c0), y);
#pragma unroll
                for (int e = 0; e < 8; ++e) s[e] += x[e] - y[e]; }
            else {
#pragma unroll
                for (int e = 0; e < 8; ++e) s[e] += x[e]; }
            const float inv = 1.0f / (float)((t + 1 < win) ? t + 1 : win);
            u32x4 o; o.x = pk2(s[0] * inv - x[0], s[1] * inv - x[1]); o.y = pk2(s[2] * inv - x[2], s[3] * inv - x[3]);
            o.z = pk2(s[4] * inv - x[4], s[5] * inv - x[5]); o.w = pk2(s[6] * inv - x[6], s[7] * inv - x[7]);
            *(u32x4*)(MIX + (size_t)row * DM + c0) = o;
        }
    }
    for (int it = gt; it < NROWS * 48; it += nthr) {
        const int row = it / 48, cb = (it - row * 48) * 8;
        const int prow = (row >= MAIN_ROWS) ? (row > MAIN_ROWS ? row - 1 : -1) : ((row & (SEQ - 1)) ? row - 1 : NROWS - 1);
        u32x4 o = (u32x4){0u, 0u, 0u, 0u};
        if (cb < 320) {
            float xc[8], xp[8], mu[8], y[8];
            unpack8(*(const u32x4*)(PROJ + (size_t)row * NPROJ + 2048 + cb), xc);
            u32x4 wp = (u32x4){0u, 0u, 0u, 0u};
            if (prow >= 0) wp = *(const u32x4*)(PROJ + (size_t)prow * NPROJ + 2048 + cb);
            unpack8(wp, xp);
            const float* mp = (cb < 288) ? a->in[4] + (size_t)l * NSHIFT + 1536 + cb : a->in[18] + (l > 0 ? (l - 1) * 32 + (cb - 288) : 0);
            const f32x4 m0 = *(const f32x4*)mp, m1 = *(const f32x4*)(mp + 4);
            mu[0] = m0[0]; mu[1] = m0[1]; mu[2] = m0[2]; mu[3] = m0[3]; mu[4] = m1[0]; mu[5] = m1[1]; mu[6] = m1[2]; mu[7] = m1[3];
#pragma unroll
            for (int e = 0; e < 8; ++e) {
                const float sv = xc[e] + (xp[e] - xc[e]) * mu[e];
                y[e] = (cb < 64) ? 1.0f - 2.0f * __builtin_amdgcn_rcpf(1.0f + __builtin_amdgcn_exp2f(sv * 2.88539008f)) : (cb < 128) ? sv : (cb < 288) ? sigmoidf_(sv) : sv;
            }
            o.x = pk2(y[0], y[1]); o.y = pk2(y[2], y[3]); o.z = pk2(y[4], y[5]); o.w = pk2(y[6], y[7]);
        }
        *(u32x4*)(LIN + (size_t)row * KL + cb) = o;
    }
}

constexpr int TC = 16, NCH = TT / TC;
constexpr int SB_A = 0, SB_Q = 1, SB_W = 2, SB_B = 3, SB_K = 4, SB_V = 5, SB_G = 6, SB_Y = 7, SBUF = 8 * TC * 64 + TC * 4;
#define LDS_BARRIER() do { asm volatile("s_waitcnt lgkmcnt(0)" ::: "memory"); __builtin_amdgcn_s_barrier(); asm volatile("" ::: "memory"); } while (0)
__device__ __forceinline__ void scan_phase(CArgs a, int l, LAS float* lds) {
    const int bid = blockIdx.x; if (bid >= BATCH * 8) return;
    const int b = bid >> 3, h = bid & 7, tid = tid_opaque(), wid = __builtin_amdgcn_readfirstlane(tid >> 6), lane = tid & 63;
    const bf16_t* PROJ = (const bf16_t*)(a->ws + WS_R1); const bf16_t* LO = (const bf16_t*)(a->ws + WS_LO);
    bf16_t* VF = (bf16_t*)((unsigned char*)a->out + DO_VF); bf16_t* MIX = (bf16_t*)((unsigned char*)a->out + DO_MIX);
    if (wid < 4) {
        __builtin_amdgcn_s_setprio(2);
        const int rp = wid * 16 + (lane >> 3) * 2, seg = lane & 7;
        f32x2 S0[4], S1[4];
#pragma unroll
        for (int j = 0; j < 4; ++j) { S0[j] = (f32x2){0.f, 0.f}; S1[j] = (f32x2){0.f, 0.f}; }
        for (int it = 0; it < NCH + 2; ++it) {
            if (it >= 1 && it <= NCH) {
                LAS float* buf = lds + ((it - 1) & 1) * SBUF;
#pragma unroll 4
                for (int tl = 0; tl < TC; ++tl) {
                    const LAS float* base = buf + tl * 64 + seg * 8;
                    const f32x4 a0 = *(const LAS f32x4*)(base + SB_A * TC * 64), a1 = *(const LAS f32x4*)(base + SB_A * TC * 64 + 4);
                    const f32x4 q0 = *(const LAS f32x4*)(base + SB_Q * TC * 64), q1 = *(const LAS f32x4*)(base + SB_Q * TC * 64 + 4);
                    const f32x4 w0 = *(const LAS f32x4*)(base + SB_W * TC * 64), w1 = *(const LAS f32x4*)(base + SB_W * TC * 64 + 4);
                    const f32x4 b0 = *(const LAS f32x4*)(base + SB_B * TC * 64), b1 = *(const LAS f32x4*)(base + SB_B * TC * 64 + 4);
                    const f32x4 k0 = *(const LAS f32x4*)(base + SB_K * TC * 64), k1 = *(const LAS f32x4*)(base + SB_K * TC * 64 + 4);
                    const f32x2 vv = *(const LAS f32x2*)(buf + SB_V * TC * 64 + tl * 64 + rp);
                    const f32x2 sc = *(const LAS f32x2*)(buf + 8 * TC * 64 + tl * 4);
                    const f32x2 av[4] = {{a0[0], a0[1]}, {a0[2], a0[3]}, {a1[0], a1[1]}, {a1[2], a1[3]}};
                    const f32x2 qv[4] = {{q0[0], q0[1]}, {q0[2], q0[3]}, {q1[0], q1[1]}, {q1[2], q1[3]}};
                    const f32x2 wv[4] = {{w0[0], w0[1]}, {w0[2], w0[3]}, {w1[0], w1[1]}, {w1[2], w1[3]}};
                    const f32x2 bv[4] = {{b0[0], b0[1]}, {b0[2], b0[3]}, {b1[0], b1[1]}, {b1[2], b1[3]}};
                    const f32x2 kv[4] = {{k0[0], k0[1]}, {k0[2], k0[3]}, {k1[0], k1[1]}, {k1[2], k1[3]}};
                    f32x2 pa0 = S0[0] * av[0], pa1 = S1[0] * av[0], pq0 = S0[0] * qv[0], pq1 = S1[0] * qv[0];
#pragma unroll
                    for (int j = 1; j < 4; ++j) { pa0 += S0[j] * av[j]; pa1 += S1[j] * av[j]; pq0 += S0[j] * qv[j]; pq1 += S1[j] * qv[j]; }
                    float sa0 = pa0.x + pa0.y, sa1 = pa1.x + pa1.y, y0 = pq0.x + pq0.y, y1 = pq1.x + pq1.y;
                    allred8x4(sa0, sa1, y0, y1);
                    const f32x2 sav0 = {sa0, sa0}, sav1 = {sa1, sa1}, vv0 = {vv.x, vv.x}, vv1 = {vv.y, vv.y};
#pragma unroll
                    for (int j = 0; j < 4; ++j) { S0[j] = S0[j] * wv[j] + sav0 * bv[j] + vv0 * kv[j]; S1[j] = S1[j] * wv[j] + sav1 * bv[j] + vv1 * kv[j]; }
                    if (seg == 0) *(LAS f32x2*)(buf + SB_Y * TC * 64 + tl * 64 + rp) = (f32x2){y0 + sa0 * sc.x + vv.x * sc.y, y1 + sa1 * sc.x + vv.y * sc.y};
                }
            }
            LDS_BARRIER();
        }
        __builtin_amdgcn_s_setprio(0);
    } else {
        const int hw = wid - 4, ch = h * 64 + lane;
        const float mu_r = a->in[4][(size_t)l * NSHIFT + ch], mu_k = a->in[4][(size_t)l * NSHIFT + 512 + ch], mu_v = a->in[4][(size_t)l * NSHIFT + 1024 + ch];
        const float kk_c = a->in[12][l * 512 + ch], ka_c = a->in[13][l * 512 + ch], rk_c = a->in[14][l * 512 + ch], gw = a->in[15][l * 512 + ch], gb = a->in[16][l * 512 + ch];
        unsigned short ld[2][4][11];
#define SCAN_LOAD(c, P) do { _Pragma("unroll") for (int p = 0; p < 4; ++p) { const int t = (c) * TC + p * 4 + hw; const size_t m = (size_t)row_of(b, t); \
        const bf16_t* pr = PROJ + m * NPROJ + 512 + ch; ld[P][p][0] = pr[0]; ld[P][p][1] = pr[512]; ld[P][p][2] = pr[1024]; \
        if (t > 0) { const bf16_t* pp = PROJ + (size_t)row_of(b, t - 1) * NPROJ + 512 + ch; ld[P][p][3] = pp[0]; ld[P][p][4] = pp[512]; ld[P][p][5] = pp[1024]; } else { ld[P][p][3] = 0; ld[P][p][4] = 0; ld[P][p][5] = 0; } \
        const bf16_t* po = LO + m * NL + ch; ld[P][p][6] = po[0]; ld[P][p][7] = po[512]; ld[P][p][8] = po[1024]; ld[P][p][9] = po[1536]; \
        ld[P][p][10] = (l > 0) ? VF[m * 512 + ch] : (unsigned short)0; } } while (0)
#define PK2F(i) ((f32x2){bf2f(ld[par][2 * pp][i]), bf2f(ld[par][2 * pp + 1][i])})
        SCAN_LOAD(0, 0); SCAN_LOAD(1, 1);
        static_assert((NCH + 2) % 2 == 1, "the helper loop is unrolled by two with one trailing trip");
        for (int it2 = 0; it2 < NCH + 2; it2 += 2) {
#pragma unroll
          for (int par = 0; par < 2; ++par) { const int it = it2 + par; if (it >= NCH + 2) break;
            LAS float* buf = lds + (it & 1) * SBUF;
            if (it >= 2) {
#pragma unroll
                for (int p = 0; p < 4; ++p) {
                    const int tl = p * 4 + hw; const size_t m = (size_t)row_of(b, (it - 2) * TC + tl);
                    const float y = buf[SB_Y * TC * 64 + tl * 64 + lane];
                    float s1 = y, s2 = y * y, dum = 0.f; wave_sum3(s1, s2, dum);
                    const float mean = s1 * (1.0f / 64.0f), d = y - mean, var = fmaxf(s2 * (1.0f / 64.0f) - mean * mean, 0.f);
                    const float o = (d * rsqrtf(var + GN_EPS) * gw + gb + buf[8 * TC * 64 + tl * 4 + 2] * buf[SB_V * TC * 64 + tl * 64 + lane]) * buf[SB_G * TC * 64 + tl * 64 + lane];
                    if (it > 2 || b == 0) MIX[m * DM + 512 + ch] = (bf16_t)f2bf(o);
                }
            }
            if (it < NCH) {
#pragma unroll
                for (int pp = 0; pp < 2; ++pp) {
                    const int tl0 = (2 * pp) * 4 + hw, tl1 = tl0 + 4;
                    const f32x2 rc = PK2F(0), kc = PK2F(1), vc = PK2F(2), rpv = PK2F(3), kp = PK2F(4), vp = PK2F(5);
                    const f32x2 e = PK2F(6), av = PK2F(7), gv = PK2F(8), vm = PK2F(9);
                    const f32x2 r = rc + (rpv - rc) * mu_r, k = kc + (kp - kc) * mu_k; f32x2 v = vc + (vp - vc) * mu_v;
                    if (l == 0) {
                        if (it > 0 || b == 0) { VF[(size_t)row_of(b, it * TC + tl0) * 512 + ch] = (bf16_t)f2bf(v.x); VF[(size_t)row_of(b, it * TC + tl1) * 512 + ch] = (bf16_t)f2bf(v.y); }
                    } else { const f32x2 vf = PK2F(10); v = v + (vf - v) * vm; }
                    f32x2 kk = k * kk_c; f32x2 n2 = kk * kk; float n2a = n2.x, n2b = n2.y, dum = 0.f; wave_sum3(n2a, n2b, dum);
                    kk = kk * (f32x2){rsqrtf(fmaxf(n2a, 1e-24f)), rsqrtf(fmaxf(n2b, 1e-24f))};
                    const f32x2 k2 = k * ((av - 1.0f) * ka_c + 1.0f), bb = kk * av;
                    const f32x2 w = {__builtin_amdgcn_exp2f(e.x * -1.44269504f), __builtin_amdgcn_exp2f(e.y * -1.44269504f)};
                    const f32x2 brv = bb * r, krv = k2 * r, cfv = krv * rk_c, q = w * r;
                    float br0 = brv.x, kr0 = krv.x, cf0 = cfv.x, br1 = brv.y, kr1 = krv.y, cf1 = cfv.y; wave_sum3(br0, kr0, cf0); wave_sum3(br1, kr1, cf1);
                    buf[SB_A * TC * 64 + tl0 * 64 + lane] = -kk.x; buf[SB_Q * TC * 64 + tl0 * 64 + lane] = q.x; buf[SB_W * TC * 64 + tl0 * 64 + lane] = w.x;
                    buf[SB_B * TC * 64 + tl0 * 64 + lane] = bb.x; buf[SB_K * TC * 64 + tl0 * 64 + lane] = k2.x; buf[SB_V * TC * 64 + tl0 * 64 + lane] = v.x; buf[SB_G * TC * 64 + tl0 * 64 + lane] = gv.x;
                    buf[SB_A * TC * 64 + tl1 * 64 + lane] = -kk.y; buf[SB_Q * TC * 64 + tl1 * 64 + lane] = q.y; buf[SB_W * TC * 64 + tl1 * 64 + lane] = w.y;
                    buf[SB_B * TC * 64 + tl1 * 64 + lane] = bb.y; buf[SB_K * TC * 64 + tl1 * 64 + lane] = k2.y; buf[SB_V * TC * 64 + tl1 * 64 + lane] = v.y; buf[SB_G * TC * 64 + tl1 * 64 + lane] = gv.y;
                    if (lane < 3) { buf[8 * TC * 64 + tl0 * 4 + lane] = (lane == 0) ? br0 : (lane == 1) ? kr0 : cf0; buf[8 * TC * 64 + tl1 * 4 + lane] = (lane == 0) ? br1 : (lane == 1) ? kr1 : cf1; }
                }
                if (it + 2 < NCH) SCAN_LOAD(it + 2, par);
            }
            LDS_BARRIER();
          }
        }
#undef PK2F
#undef SCAN_LOAD
    }
}


#define XB_TMO      128
#define XB_XCNT(j)  (256  + 64 * (j))
#define XB_XSUB(j)  (1280 + 64 * (j))
#define XB_XGEN(j)  (2304 + 64 * (j))
#define XB_TOP      3328
#define XB_TOPGEN   3392
#define XCD_BAR_WORDS 3456
#define XB_SPIN_CAP (1u << 22)
__device__ __forceinline__ unsigned xb_ld(unsigned* p)              { return __hip_atomic_load(p, __ATOMIC_RELAXED, __HIP_MEMORY_SCOPE_AGENT); }
__device__ __forceinline__ unsigned xb_add(unsigned* p, unsigned v) { return __hip_atomic_fetch_add(p, v, __ATOMIC_RELAXED, __HIP_MEMORY_SCOPE_AGENT); }
__device__ __forceinline__ unsigned xb_xcc_id() { return (unsigned)__builtin_amdgcn_s_getreg((3 << 11) | 20) & 0xFu; }
#define XB_SPIN(cond, bar) do { unsigned _sp = 0; while (cond) { __builtin_amdgcn_s_sleep(1); \
    if ((++_sp & 255u) == 0u) { if (xb_ld(&(bar)[XB_TMO])) break; if (_sp > XB_SPIN_CAP) { atomicAdd(&(bar)[XB_TMO], 1u); break; } } } } while (0)
struct XcdBarrier { unsigned* bar; unsigned x; volatile LAS unsigned* st; };
__device__ __forceinline__ void xcd_barrier_complete(unsigned* bar, unsigned x, unsigned& nloc, unsigned& nx) {
    const unsigned G = gridDim.x;
    unsigned sum, cnt, mine, sp = 0u;
    for (;;) {
        sum = 0u; cnt = 0u; mine = 0u;
#pragma unroll
        for (unsigned j = 0; j < 16; ++j) { const unsigned c = xb_ld(&bar[XB_XCNT(j)]); sum += c; cnt += (c > 0u) ? 1u : 0u; mine = (j == x) ? c : mine; }
        if (sum == G) break;
        __builtin_amdgcn_s_sleep(1);
        if ((++sp & 255u) == 0u) { if (xb_ld(&bar[XB_TMO])) break; if (sp > XB_SPIN_CAP) { atomicAdd(&bar[XB_TMO], 1u); break; } }
    }
    nloc = mine > 0u ? mine : 1u; nx = cnt > 0u ? cnt : 1u;
}
__device__ __forceinline__ void xcd_barrier(const XcdBarrier& b, bool leader_thread) {
    asm volatile("s_waitcnt vmcnt(0)" ::: "memory");
    __syncthreads();
    if (leader_thread) {
        unsigned* bar = b.bar;
        __builtin_amdgcn_s_waitcnt(0);
        unsigned nloc = b.st[0], nx = b.st[1];
        if (nloc == 0u) { xcd_barrier_complete(bar, b.x, nloc, nx); b.st[0] = nloc; b.st[1] = nx; }
        const unsigned old = xb_add(&bar[XB_XSUB(b.x)], 1u);
        const unsigned gen = old / nloc;
        if (old + 1u == (gen + 1u) * nloc) {
            __builtin_amdgcn_fence(__ATOMIC_RELEASE, "agent");
            asm volatile("s_waitcnt vmcnt(0)" ::: "memory");
            const unsigned og = xb_add(&bar[XB_TOP], 1u);
            const unsigned tg = og / nx;
            if (og + 1u == (tg + 1u) * nx) xb_add(&bar[XB_TOPGEN], 1u);
            else XB_SPIN(xb_ld(&bar[XB_TOPGEN]) == tg, bar);
            __builtin_amdgcn_fence(__ATOMIC_ACQUIRE, "agent");
            xb_add(&bar[XB_XGEN(b.x)], 1u);
            asm volatile("s_waitcnt vmcnt(0)" ::: "memory");
        } else {
            XB_SPIN(xb_ld(&bar[XB_XGEN(b.x)]) == gen, bar);
            __builtin_amdgcn_fence(__ATOMIC_ACQUIRE, "agent");
            asm volatile("s_waitcnt vmcnt(0)" ::: "memory");
        }
    }
    __syncthreads();
}

__global__ void __launch_bounds__(512, 2) mega(Args a_unused) {
    extern __shared__ __attribute__((aligned(16))) unsigned char shm[];
    LAS unsigned char* lds = (LAS unsigned char*)shm;
    cg::grid_group grid = cg::this_grid();
    CArgs a0 = (CArgs)__builtin_amdgcn_kernarg_segment_ptr();
    const int ph_lo = a0->ph_lo, ph_hi = a0->ph_hi;
    XcdBarrier xbar; xbar.bar = (unsigned*)(a0->ws + WS_BAR); xbar.x = xb_xcc_id(); xbar.st = (volatile LAS unsigned*)(lds + 131072 + 16384);
    { const int t0 = tid_opaque(); if (t0 == 0) { xbar.st[0] = 0u; xbar.st[1] = 0u; (void)xb_add(&xbar.bar[XB_XCNT(xbar.x)], 1u); } __syncthreads(); }
    for (int ph = ph_lo; ph < ph_hi; ++ph) {
        if (ph > ph_lo) { if (ph == ph_lo + 1) grid.sync(); else xcd_barrier(xbar, tid_opaque() == 0); }
        CArgs a = a0; asm volatile("" : "+s"(a));
        if (ph == 0) { norm_rows(a, 0); weight_prep(a, 0, (LAS float*)lds, 0, gridDim.x); continue; }
        if (ph == NPH - 1) { norm_rows(a, 2); continue; }
        const int l = (ph - 1) / 7, s = (ph - 1) % 7;
        bf16_t* HB = (bf16_t*)(a->ws + WS_H); float* SS = (float*)(a->ws + WS_SS);
        const unsigned char* wb = a->ws + WS_WB + (size_t)(l & 1) * WB_SIZE;
        if (s == 0) {
            pg8::Gemm g{HB, (const bf16_t*)(wb + WB_WC), MR, NPROJ, DM};
            pg8::StaticOrder S; S.init(MAIN_ROWS, g.N, gridDim.x, blockIdx.x);
            LAS float* rst = (LAS float*)(lds + 131072);
            build_rs_table(rst, S, SS);
            pg8::EpiProj E{(bf16_t*)(a->ws + WS_R1), g.N, rst};
            pg8::gemm_phase(lds, g, S, E);
            tail16<0, 2>(g.A, g.Bt, g.N, g.K, E.O, g.N, SS, nullptr, (LAS float*)lds);
        }
        else if (s == 2) {
            int kl = KL; asm volatile("" : "+s"(kl));
            pg8::Gemm g{(const bf16_t*)((unsigned char*)a->out + DO_LIN), (const bf16_t*)(wb + WB_WL), MR, NL, kl};
            pg8::StaticOrder S; S.init(MAIN_ROWS, g.N, gridDim.x, blockIdx.x);
            pg8::EpiLora E{(bf16_t*)(a->ws + WS_LO), (const float*)(wb + WB_LB)};
            pg8::gemm_phase(lds, g, S, E);
            tail16<0, 2>(g.A, g.Bt, g.N, g.K, E.O, g.N, nullptr, nullptr, (LAS float*)lds, E.bias);
        }
        else if (s == 1) prep_phase(a, l);
        else if (s == 3) {
            if (blockIdx.x < BATCH * 8) scan_phase(a, l, (LAS float*)lds);
            else if (l + 1 < DEPTH) weight_prep(a, l + 1, (LAS float*)lds, BATCH * 8, gridDim.x - BATCH * 8);
        }
        else if (s == 4 || s == 6) {
            pg8::Gemm g{s == 4 ? (const bf16_t*)((unsigned char*)a->out + DO_MIX) : (const bf16_t*)(a->ws + WS_R1), (const bf16_t*)(wb + (s == 4 ? WB_WOUT : WB_WDN)), MR, DM, s == 4 ? DM : DFF};
            pg8::StaticOrder S; S.init(MAIN_ROWS, DM, gridDim.x, blockIdx.x);
            pg8::EpiResid E{HB, SS + (s == 4 ? (size_t)MR * 16 : 0)};
            pg8::gemm_phase(lds, g, S, E);
            tail16<1, 4>(g.A, g.Bt, g.N, g.K, HB, DM, nullptr, E.ssq, (LAS float*)lds);
        }
        else {
            pg8::Gemm g{HB, (const bf16_t*)(wb + WB_WGU), MR, 2 * DFF, DM}; pg8::StaticOrder S; S.init(MAIN_ROWS, 2 * DFF, gridDim.x, blockIdx.x);
            LAS float* rst = (LAS float*)(lds + 131072); build_rs_table(rst, S, SS + (size_t)MR * 16);
            pg8::EpiSwiglu E{(bf16_t*)(a->ws + WS_R1), rst};
            pg8::gemm_phase(lds, g, S, E);
            tail16<2, 2>(g.A, g.Bt, g.N, g.K, E.O, DFF, SS + (size_t)MR * 16, nullptr, (LAS float*)lds);
        }
    }
}

extern "C" void kernel_launch(void* const* d_in, const int* in_sizes, int n_in, void* d_out, int out_size, void* d_ws, size_t ws_size, hipStream_t stream) {
    static int grid = 0;
    if (grid == 0) {
        if (n_in != 26 || out_size != BATCH * SEQ * DM || ws_size < WS_TOTAL) { fprintf(stderr, "kernel_launch: unexpected shapes (n_in %d out %d ws %zu need %zu)\n", n_in, out_size, ws_size, (size_t)WS_TOTAL); grid = -1; return; }
        int dev = 0, cus = 0, per_cu = 0;
        hipGetDevice(&dev);
        hipDeviceGetAttribute(&cus, hipDeviceAttributeMultiprocessorCount, dev);
        if (hipFuncSetAttribute((const void*)mega, hipFuncAttributeMaxDynamicSharedMemorySize, LDS_BYTES) != hipSuccess) { fprintf(stderr, "kernel_launch: hipFuncSetAttribute failed\n"); grid = -1; return; }
        hipOccupancyMaxActiveBlocksPerMultiprocessor(&per_cu, (const void*)mega, 512, LDS_BYTES);
        if (per_cu < 1) { fprintf(stderr, "kernel_launch: occupancy query says %d blocks per CU\n", per_cu); per_cu = 1; }
        (void)hipGetLastError();
        grid = cus;
        fprintf(stderr, "kernel_launch: grid %d (per_cu %d)\n", grid, per_cu);
    }
    if (grid < 0) return;
    if (hipMemsetAsync((unsigned char*)d_ws + WS_BAR, 0, 16384, stream) != hipSuccess) { fprintf(stderr, "kernel_launch: hipMemsetAsync failed\n"); return; }
    Args a{};
    for (int i = 0; i < 26; ++i) a.in[i] = (const float*)d_in[i];
    a.out = (float*)d_out; a.ws = (unsigned char*)d_ws;
#if MK_MULTI
    for (int ph = 0; ph < NPH; ++ph) {
        a.ph_lo = ph; a.ph_hi = ph + 1;
        void* args[] = {&a};
        hipError_t e = hipLaunchCooperativeKernel((const void*)mega, dim3(grid), dim3(512), args, LDS_BYTES, stream);
        if (e != hipSuccess) { fprintf(stderr, "cooperative launch failed: %s\n", hipGetErrorString(e)); break; }
    }
#else
    a.ph_lo = 0; a.ph_hi = NPH;
    void* args[] = {&a};
    hipError_t e = hipLaunchCooperativeKernel((const void*)mega, dim3(grid), dim3(512), args, LDS_BYTES, stream);
    if (e != hipSuccess) fprintf(stderr, "cooperative launch failed: %s (grid %d)\n", hipGetErrorString(e), grid);
#endif
}
```

```cpp
#include <hip/hip_runtime.h>
#include <hip/hip_cooperative_groups.h>
#include <cstdio>
#include <cstdint>
namespace cg = cooperative_groups;

#ifndef MK_MULTI
#define MK_MULTI 0
#endif

#define LAS __attribute__((address_space(3)))
typedef unsigned short bf16_t;
typedef short bf16x8 __attribute__((ext_vector_type(8)));
typedef float f32x4 __attribute__((ext_vector_type(4)));
typedef float f32x2 __attribute__((ext_vector_type(2)));
typedef unsigned u32x4 __attribute__((ext_vector_type(4)));
typedef unsigned u32x2 __attribute__((ext_vector_type(2)));

constexpr int DM = 1024, BATCH = 16, SEQ = 2048, DEPTH = 4, NMETA = 16, TT = SEQ + NMETA  , MR = BATCH * TT  ;
constexpr int NIN = 2336, NSHIFT = 1824, DFF = 2816, NPROJ = 2560  , KL = 384  , NL = 2048;
constexpr float RMS_EPS = 1e-6f, GN_EPS = 64e-5f;
constexpr int LDS_BYTES = 131072 + 16384 + 64;
constexpr int NPH = DEPTH * 7 + 2;

constexpr size_t WB_WC = 0;
constexpr size_t WB_WOUT = WB_WC + (size_t)NPROJ * DM * 2;
constexpr size_t WB_WGU = WB_WOUT + (size_t)DM * DM * 2;
constexpr size_t WB_WDN = WB_WGU + (size_t)2 * DFF * DM * 2;
constexpr size_t WB_WL = WB_WDN + (size_t)DM * DFF * 2;
constexpr size_t WB_LB = WB_WL + (size_t)NL * KL * 2;
constexpr size_t WB_SIZE = WB_LB + 8192;
constexpr size_t WS_WB = 4096;
constexpr size_t WS_SS = WS_WB + 2 * WB_SIZE;
constexpr size_t WS_H = WS_SS + 2 * (size_t)MR * 64;
constexpr size_t WS_R1 = WS_H + (size_t)MR * DM * 4;
constexpr size_t WS_LO = WS_R1 + (size_t)MR * DFF * 2;
constexpr size_t WS_END = WS_LO + (size_t)MR * NL * 2;
constexpr size_t WS_BAR = WS_END;
constexpr size_t WS_TOTAL = WS_BAR + 16384;
static_assert(WS_TOTAL <= 536870912, "workspace map");
constexpr size_t DO_MIX = 0;
constexpr size_t DO_VF = DO_MIX + (size_t)MR * DM * 2;
constexpr size_t DO_LIN = DO_VF + (size_t)MR * 512 * 2;
static_assert(DO_LIN + (size_t)MR * KL * 2 <= (size_t)BATCH * SEQ * DM * 4, "d_out scratch");

struct Args { const float* in[26]; float* out; unsigned char* ws; int ph_lo, ph_hi; };
typedef const __attribute__((address_space(4))) Args* CArgs;

__device__ __forceinline__ float bf2f(unsigned b) { return __uint_as_float(b << 16); }
__device__ __forceinline__ unsigned f2bf(float f) { unsigned u = __float_as_uint(f); return (u + 0x7fffu + ((u >> 16) & 1u)) >> 16; }
__device__ __forceinline__ unsigned pk2(float lo, float hi) { unsigned r; asm volatile("v_cvt_pk_bf16_f32 %0, %1, %2" : "=v"(r) : "v"(lo), "v"(hi)); return r; }
__device__ __forceinline__ float sigmoidf_(float x) { return __builtin_amdgcn_rcpf(1.0f + __builtin_amdgcn_exp2f(x * -1.44269504f)); }
template <int CTRL> __device__ __forceinline__ float dppf(float x) { return __int_as_float(__builtin_amdgcn_update_dpp(0, __float_as_int(x), CTRL, 0xF, 0xF, true)); }
__device__ __forceinline__ float allred8(float x) { x += dppf<0xB1>(x); x += dppf<0x4E>(x); x += dppf<0x141>(x); return x; }
#define DPP_ADD(r, ctl) "v_add_f32_dpp " r ", " r ", " r " " ctl " row_mask:0xf bank_mask:0xf\n\t"
__device__ __forceinline__ void allred8x4(float& a, float& b, float& c, float& d) {
    asm volatile("s_nop 1\n\t"
        DPP_ADD("%0", "quad_perm:[1,0,3,2]") DPP_ADD("%1", "quad_perm:[1,0,3,2]") DPP_ADD("%2", "quad_perm:[1,0,3,2]") DPP_ADD("%3", "quad_perm:[1,0,3,2]")
        DPP_ADD("%0", "quad_perm:[2,3,0,1]") DPP_ADD("%1", "quad_perm:[2,3,0,1]") DPP_ADD("%2", "quad_perm:[2,3,0,1]") DPP_ADD("%3", "quad_perm:[2,3,0,1]")
        DPP_ADD("%0", "row_half_mirror") DPP_ADD("%1", "row_half_mirror") DPP_ADD("%2", "row_half_mirror") DPP_ADD("%3", "row_half_mirror")
        : "+v"(a), "+v"(b), "+v"(c), "+v"(d));
}
__device__ __forceinline__ float rows_to_wave(float x) {
    const int xi = __float_as_int(x);
    return (__int_as_float(__builtin_amdgcn_readlane(xi, 0)) + __int_as_float(__builtin_amdgcn_readlane(xi, 16))) + (__int_as_float(__builtin_amdgcn_readlane(xi, 32)) + __int_as_float(__builtin_amdgcn_readlane(xi, 48)));
}
__device__ __forceinline__ float wave_sum(float x) {
    asm volatile("s_nop 1\n\t" DPP_ADD("%0", "quad_perm:[1,0,3,2]") "s_nop 1\n\t" DPP_ADD("%0", "quad_perm:[2,3,0,1]") "s_nop 1\n\t" DPP_ADD("%0", "row_half_mirror") "s_nop 1\n\t" DPP_ADD("%0", "row_mirror") : "+v"(x));
    return rows_to_wave(x);
}
__device__ __forceinline__ void wave_sum3(float& a, float& b, float& c) {
    asm volatile("s_nop 1\n\t"
        DPP_ADD("%0", "quad_perm:[1,0,3,2]") DPP_ADD("%1", "quad_perm:[1,0,3,2]") DPP_ADD("%2", "quad_perm:[1,0,3,2]")
        DPP_ADD("%0", "quad_perm:[2,3,0,1]") DPP_ADD("%1", "quad_perm:[2,3,0,1]") DPP_ADD("%2", "quad_perm:[2,3,0,1]")
        DPP_ADD("%0", "row_half_mirror") DPP_ADD("%1", "row_half_mirror") DPP_ADD("%2", "row_half_mirror")
        DPP_ADD("%0", "row_mirror") DPP_ADD("%1", "row_mirror") DPP_ADD("%2", "row_mirror")
        "v_add_f32_dpp %0, %0, %0 row_bcast:15 row_mask:0xa bank_mask:0xf\n\t" "v_add_f32_dpp %1, %1, %1 row_bcast:15 row_mask:0xa bank_mask:0xf\n\t" "v_add_f32_dpp %2, %2, %2 row_bcast:15 row_mask:0xa bank_mask:0xf\n\t"
        "v_add_f32_dpp %0, %0, %0 row_bcast:31 row_mask:0xc bank_mask:0xf\n\t" "v_add_f32_dpp %1, %1, %1 row_bcast:31 row_mask:0xc bank_mask:0xf\n\t" "v_add_f32_dpp %2, %2, %2 row_bcast:31 row_mask:0xc bank_mask:0xf\n\t"
        : "+v"(a), "+v"(b), "+v"(c));
    a = __int_as_float(__builtin_amdgcn_readlane(__float_as_int(a), 63)); b = __int_as_float(__builtin_amdgcn_readlane(__float_as_int(b), 63)); c = __int_as_float(__builtin_amdgcn_readlane(__float_as_int(c), 63));
}
__device__ __forceinline__ int tid_opaque() { int t = threadIdx.x; asm volatile("" : "+v"(t)); return t; }

__device__ __forceinline__ void unpack8(const u32x4 w, float (&x)[8]) {
    x[0] = bf2f(w.x & 0xffffu); x[1] = bf2f(w.x >> 16); x[2] = bf2f(w.y & 0xffffu); x[3] = bf2f(w.y >> 16);
    x[4] = bf2f(w.z & 0xffffu); x[5] = bf2f(w.z >> 16); x[6] = bf2f(w.w & 0xffffu); x[7] = bf2f(w.w >> 16);
}
constexpr int MAIN_ROWS = BATCH * SEQ, NROWS = MAIN_ROWS + NMETA;
__device__ __forceinline__ int row_of(int b, int t) { return t < NMETA ? MAIN_ROWS + t : b * SEQ + (t - NMETA); }
__device__ __forceinline__ float row_rs(const float* ssp, int row) {
    const f32x4* p = (const f32x4*)(ssp + (size_t)row * 16); const f32x4 a = p[0], b = p[1], c = p[2], d = p[3];
    const f32x4 t = (a + b) + (c + d);
    return rsqrtf(((t[0] + t[1]) + (t[2] + t[3])) * (1.0f / DM) + RMS_EPS);
}
namespace pg8 {
constexpr int BM = 256, BK = 64, HALF = 128, HTB = HALF * BK * 2, STAGE_BYTES = 8 * HTB, NXCD = 8, WGM = 8;
__host__ __device__ __forceinline__ int lds_byte(int r, int c) { const int st = (r >> 4) * 2 + (c >> 5), rr = r & 15, cc = c & 31, ob = rr * 64 + cc * 2; return st * 1024 + (ob ^ (((ob >> 9) & 1) << 5)); }
__host__ __device__ __forceinline__ void stage_rc(int b, int& R, int& C) { const int st = b / 1024, sb = b % 1024, swz = sb ^ (((sb >> 9) & 1) << 5); R = (st >> 1) * 16 + swz / 64; C = (st & 1) * 32 + (swz % 64) / 2; }
__host__ __device__ __forceinline__ int perm32(int rho) { const int n = rho >> 4, i = rho & 15; return 8 * (i >> 2) + 4 * n + (i & 3); }
struct Unit { int pm, pn; };
struct Gemm { const bf16_t* A; const bf16_t* Bt; int M, N, K; };
struct StaticOrder {
    int nM, nN, nwg, G, c;
    __device__ void init(int M, int N, int G_, int c_) { nM = M / BM; nN = N / BM; nwg = nM * nN; G = G_; c = c_; }
    __device__ bool next(int i, Unit& u) const {
        const long L = (long)i * G + c; if (L >= nwg) return false;
        int wgid = (int)L; { const int q = nwg / NXCD, r = nwg % NXCD, xcd = wgid % NXCD, off = wgid / NXCD; wgid = (xcd < r ? xcd * (q + 1) : r * (q + 1) + (xcd - r) * q) + off; }
        const int nig = WGM * nN, gid = wgid / nig, fm = gid * WGM, gsz = (nM - fm) < WGM ? (nM - fm) : WGM;
        u.pm = fm + ((wgid % nig) % gsz); u.pn = (wgid % nig) / gsz; return true;
    }
};
template <class Epi>
__device__ __forceinline__ void gemm_phase(LAS unsigned char* lds, const Gemm g, const StaticOrder& S, const Epi& E) {
    int tid_ = threadIdx.x; asm volatile("" : "+v"(tid_));
    const int tid = tid_, wid = __builtin_amdgcn_readfirstlane(tid >> 6), lane = tid & 63, wr = wid >> 2, wc = wid & 3, fr = lane & 15, fq = lane >> 4;
    const int K = g.K, nt = K / BK;
    unsigned voffA[2], voffB[2];
#pragma unroll
    for (int i = 0; i < 2; ++i) { int R, C; stage_rc(tid * 16 + i * 8192, R, C); const int Rb = Epi::PERM ? ((R & ~31) + perm32(R & 31)) : R;
        voffA[i] = (unsigned)(R * K + C) * 2u; voffB[i] = (unsigned)(Rb * K + C) * 2u; }
    const size_t kstep = (size_t)(BK * 2);
    const size_t hstep = (size_t)HALF * K * 2;
    const size_t tstep = 2 * hstep;
    const unsigned ldsw = (unsigned)wid * 1024u;
    const int aoff = lds_byte(wr * 64 + fr, fq * 8), boff = lds_byte(wc * 32 + fr, fq * 8);
#define PG8_SA(b, h) (((b) * 2 + (h)) * HTB)
#define PG8_SB(b, h) ((4 + (b) * 2 + (h)) * HTB)
#define PG8_STAGE(bufoff, gbase, voff) do { _Pragma("unroll") for (int _i = 0; _i < 2; ++_i) \
        __builtin_amdgcn_global_load_lds((const unsigned*)((const char*)(gbase) + (voff)[_i]), (LAS unsigned*)(lds + (bufoff) + ldsw + _i * 8192), 16, 0, 0); } while (0)
#define PG8_LDA(dst, b, h) do { _Pragma("unroll") for (int m = 0; m < 4; ++m) _Pragma("unroll") for (int k = 0; k < 2; ++k) dst[m][k] = *(const LAS bf16x8*)(lds + PG8_SA(b, h) + aoff + m * 2048 + k * 1024); } while (0)
#define PG8_LDB(dst, b, h) do { _Pragma("unroll") for (int n = 0; n < 2; ++n) _Pragma("unroll") for (int k = 0; k < 2; ++k) dst[n][k] = *(const LAS bf16x8*)(lds + PG8_SB(b, h) + boff + n * 2048 + k * 1024); } while (0)
#define PG8_MMA(ai, bj, At, Bt) do { __builtin_amdgcn_s_setprio(1); _Pragma("unroll") for (int m = 0; m < 4; ++m) _Pragma("unroll") for (int n = 0; n < 2; ++n) _Pragma("unroll") for (int k = 0; k < 2; ++k) \
        acc[ai][bj][m][n] = __builtin_amdgcn_mfma_f32_16x16x32_bf16(Bt[n][k], At[m][k], acc[ai][bj][m][n], 0, 0, 0); __builtin_amdgcn_s_setprio(0); } while (0)
#define PG8_WAIT_V(n) asm volatile("s_waitcnt vmcnt(" #n ")" ::: "memory")
#define PG8_WAIT_L(n) asm volatile("s_waitcnt lgkmcnt(" #n ")" ::: "memory")
#define PG8_BAR __builtin_amdgcn_s_barrier()
#define PG8_SCHED __builtin_amdgcn_sched_barrier(0)
    Unit cur, nxt; int ui = 0;
    if (!S.next(0, cur)) return;
    f32x4 acc[2][2][4][2];
#pragma unroll
    for (int a = 0; a < 2; ++a)
#pragma unroll
        for (int b = 0; b < 2; ++b)
#pragma unroll
            for (int m = 0; m < 4; ++m)
#pragma unroll
                for (int n = 0; n < 2; ++n) acc[a][b][m][n] = (f32x4){0.f, 0.f, 0.f, 0.f};
    bf16x8 At[4][2], B0[2][2], B1[2][2];
    const char* cA = (const char*)g.A + (size_t)cur.pm * tstep; const char* cB = (const char*)g.Bt + (size_t)cur.pn * tstep;
    PG8_STAGE(PG8_SB(0, 0), cB, voffB); PG8_STAGE(PG8_SA(0, 0), cA, voffA); PG8_STAGE(PG8_SB(0, 1), cB + hstep, voffB); PG8_STAGE(PG8_SA(0, 1), cA + hstep, voffA);
    if (wr == 1) PG8_BAR;
    PG8_WAIT_V(4); PG8_BAR;
    PG8_STAGE(PG8_SB(1, 0), cB + kstep, voffB); PG8_STAGE(PG8_SA(1, 0), cA + kstep, voffA); PG8_STAGE(PG8_SB(1, 1), cB + hstep + kstep, voffB);
    PG8_WAIT_V(6); PG8_BAR;
    for (;;) {
        const bool has_next = S.next(ui + 1, nxt);
        const char* nA = has_next ? (const char*)g.A + (size_t)nxt.pm * tstep : cA; const char* nB = has_next ? (const char*)g.Bt + (size_t)nxt.pn * tstep : cB;
        for (int t = 0; t < nt; t += 2) {
            const bool last = (t == nt - 2);
            const char* a1 = cA + (size_t)(t + 1) * kstep;
            const char* a2 = last ? nA : cA + (size_t)(t + 2) * kstep; const char* b2 = last ? nB : cB + (size_t)(t + 2) * kstep;
            const char* a3 = a2 + kstep; const char* b3 = b2 + kstep;
            PG8_LDB(B0, 0, 0); PG8_SCHED; PG8_LDA(At, 0, 0); PG8_STAGE(PG8_SA(1, 1), a1 + hstep, voffA);
            PG8_WAIT_L(8); PG8_BAR; PG8_WAIT_L(0); PG8_MMA(0, 0, At, B0); PG8_BAR; PG8_SCHED;
            PG8_LDB(B1, 0, 1); PG8_STAGE(PG8_SB(0, 0), b2, voffB);
            PG8_BAR; PG8_WAIT_L(0); PG8_MMA(0, 1, At, B1); PG8_BAR;
            PG8_LDA(At, 0, 1); PG8_STAGE(PG8_SA(0, 0), a2, voffA);
            PG8_BAR; PG8_WAIT_L(0); PG8_MMA(1, 0, At, B0); PG8_BAR; PG8_SCHED;
            PG8_STAGE(PG8_SB(0, 1), b2 + hstep, voffB);
            PG8_WAIT_V(6); PG8_BAR; PG8_MMA(1, 1, At, B1); PG8_BAR;
            PG8_LDB(B0, 1, 0); PG8_SCHED; PG8_LDA(At, 1, 0); PG8_STAGE(PG8_SA(0, 1), a2 + hstep, voffA);
            PG8_WAIT_L(8); PG8_BAR; PG8_WAIT_L(0); PG8_MMA(0, 0, At, B0); PG8_BAR; PG8_SCHED;
            PG8_LDB(B1, 1, 1); PG8_STAGE(PG8_SB(1, 0), b3, voffB);
            PG8_BAR; PG8_WAIT_L(0); PG8_MMA(0, 1, At, B1); PG8_BAR;
            PG8_LDA(At, 1, 1); PG8_STAGE(PG8_SA(1, 0), a3, voffA);
            PG8_BAR; PG8_WAIT_L(0); PG8_MMA(1, 0, At, B0); PG8_BAR; PG8_SCHED;
            PG8_STAGE(PG8_SB(1, 1), b3 + hstep, voffB);
            PG8_WAIT_V(6); PG8_BAR; PG8_MMA(1, 1, At, B1); PG8_BAR;
        }
        E(acc, cur, ui, wr, wc, fr, fq);
        if (!has_next) break;
#pragma unroll
        for (int a = 0; a < 2; ++a)
#pragma unroll
            for (int b = 0; b < 2; ++b)
#pragma unroll
                for (int m = 0; m < 4; ++m)
#pragma unroll
                    for (int n = 0; n < 2; ++n) acc[a][b][m][n] = (f32x4){0.f, 0.f, 0.f, 0.f};
        cur = nxt; cA = nA; cB = nB; ++ui;
    }
    PG8_WAIT_V(0);
    if (wr == 0) PG8_BAR;
    PG8_BAR;
#undef PG8_SA
#undef PG8_SB
#undef PG8_STAGE
#undef PG8_LDA
#undef PG8_LDB
#undef PG8_MMA
#undef PG8_WAIT_V
#undef PG8_WAIT_L
#undef PG8_BAR
#undef PG8_SCHED
}

struct EpiProj {
    static constexpr bool PERM = true;
    bf16_t* O; int ldc; const LAS float* rst;
    __device__ __forceinline__ void operator()(const f32x4 (&acc)[2][2][4][2], const Unit& u, int ui, int wr, int wc, int fr, int fq) const {
        const int row0 = u.pm * BM + wr * 64 + fr, col0 = u.pn * BM + wc * 32 + 8 * fq;
#pragma unroll
        for (int ai = 0; ai < 2; ++ai)
#pragma unroll
            for (int m = 0; m < 4; ++m) { const int row = row0 + ai * HALF + m * 16; bf16_t* rowp = O + (size_t)row * ldc + col0;
                const float rs = rst ? rst[ui * 256 + (row & 255)] : 1.0f;
#pragma unroll
                for (int bj = 0; bj < 2; ++bj) { const f32x4 v0 = acc[ai][bj][m][0] * rs, v1 = acc[ai][bj][m][1] * rs;
                    u32x4 w; w.x = pk2(v0[0], v0[1]); w.y = pk2(v0[2], v0[3]); w.z = pk2(v1[0], v1[1]); w.w = pk2(v1[2], v1[3]);
                    *(u32x4*)(rowp + bj * HALF) = w; } }
    }
};
struct EpiResid {
    static constexpr bool PERM = true;
    bf16_t* HB; float* ssq;
    __device__ __forceinline__ void operator()(const f32x4 (&acc)[2][2][4][2], const Unit& u, int ui, int wr, int wc, int fr, int fq) const {
        const int row0 = u.pm * BM + wr * 64 + fr, col0 = u.pn * BM + wc * 32 + 8 * fq;
#pragma unroll
        for (int ai = 0; ai < 2; ++ai) {
            u32x4 hv[4][2];
#pragma unroll
            for (int m = 0; m < 4; ++m)
#pragma unroll
                for (int bj = 0; bj < 2; ++bj) hv[m][bj] = *(const u32x4*)(HB + (size_t)(row0 + ai * HALF + m * 16) * DM + col0 + bj * HALF);
            __builtin_amdgcn_sched_barrier(0);
#pragma unroll
            for (int m = 0; m < 4; ++m) { const int row = row0 + ai * HALF + m * 16; bf16_t* rowb = HB + (size_t)row * DM + col0;
                float q = 0.f;
#pragma unroll
                for (int bj = 0; bj < 2; ++bj) { const u32x4 hw = hv[m][bj]; const f32x4 v0 = acc[ai][bj][m][0], v1 = acc[ai][bj][m][1];
                    u32x4 w;
                    w.x = pk2(bf2f(hw.x & 0xffffu) + v0[0], bf2f(hw.x >> 16) + v0[1]); w.y = pk2(bf2f(hw.y & 0xffffu) + v0[2], bf2f(hw.y >> 16) + v0[3]);
                    w.z = pk2(bf2f(hw.z & 0xffffu) + v1[0], bf2f(hw.z >> 16) + v1[1]); w.w = pk2(bf2f(hw.w & 0xffffu) + v1[2], bf2f(hw.w >> 16) + v1[3]);
                    *(u32x4*)(rowb + bj * HALF) = w;
                    const float r0 = bf2f(w.x & 0xffffu), r1 = bf2f(w.x >> 16), r2 = bf2f(w.y & 0xffffu), r3 = bf2f(w.y >> 16), r4 = bf2f(w.z & 0xffffu), r5 = bf2f(w.z >> 16), r6 = bf2f(w.w & 0xffffu), r7 = bf2f(w.w >> 16);
                    q += ((r0 * r0 + r1 * r1) + (r2 * r2 + r3 * r3)) + ((r4 * r4 + r5 * r5) + (r6 * r6 + r7 * r7)); }
                q += __shfl_xor(q, 16); q += __shfl_xor(q, 32);
                if (fq == 0) ssq[(size_t)row * 16 + u.pn * 4 + wc] = q; }
            __builtin_amdgcn_sched_barrier(0);
        }
    }
};
struct EpiLora {
    static constexpr bool PERM = true;
    bf16_t* O; const float* bias;
    __device__ __forceinline__ void operator()(const f32x4 (&acc)[2][2][4][2], const Unit& u, int ui, int wr, int wc, int fr, int fq) const {
        const int row0 = u.pm * BM + wr * 64 + fr, col0 = u.pn * BM + wc * 32 + 8 * fq, mode = u.pn >> 1;
        const float sc = (mode == 0) ? 0.60653066f : 1.0f;
#pragma unroll
        for (int bj = 0; bj < 2; ++bj) {
            const f32x4 c0 = *(const f32x4*)(bias + col0 + bj * HALF), c1 = *(const f32x4*)(bias + col0 + bj * HALF + 4);
#pragma unroll
            for (int ai = 0; ai < 2; ++ai)
#pragma unroll
                for (int m = 0; m < 4; ++m) { bf16_t* rowp = O + (size_t)(row0 + ai * HALF + m * 16) * NL + col0 + bj * HALF;
                    f32x4 v0 = acc[ai][bj][m][0] + c0, v1 = acc[ai][bj][m][1] + c1;
                    if (mode != 2) {
#pragma unroll
                        for (int j = 0; j < 4; ++j) { v0[j] = sc * sigmoidf_(v0[j]); v1[j] = sc * sigmoidf_(v1[j]); } }
                    u32x4 w; w.x = pk2(v0[0], v0[1]); w.y = pk2(v0[2], v0[3]); w.z = pk2(v1[0], v1[1]); w.w = pk2(v1[2], v1[3]);
                    *(u32x4*)rowp = w; }
        }
    }
};
struct EpiSwiglu {
    static constexpr bool PERM = true;
    bf16_t* O; const LAS float* rst;
    __device__ __forceinline__ void operator()(const f32x4 (&acc)[2][2][4][2], const Unit& u, int ui, int wr, int wc, int fr, int fq) const {
        const int row0 = u.pm * BM + wr * 64 + fr, col0 = u.pn * 128 + wc * 16 + 4 * fq;
#pragma unroll
        for (int ai = 0; ai < 2; ++ai)
#pragma unroll
            for (int m = 0; m < 4; ++m) { const int row = row0 + ai * HALF + m * 16; bf16_t* rowp = O + (size_t)row * DFF + col0;
                const float rs = rst[ui * 256 + (row & 255)];
#pragma unroll
                for (int bj = 0; bj < 2; ++bj) { const f32x4 gt = acc[ai][bj][m][0] * rs, up = acc[ai][bj][m][1] * rs; float o[4];
#pragma unroll
                    for (int j = 0; j < 4; ++j) o[j] = gt[j] * sigmoidf_(gt[j]) * up[j];
                    u32x2 w; w.x = pk2(o[0], o[1]); w.y = pk2(o[2], o[3]);
                    *(u32x2*)(rowp + bj * 64) = w; } }
    }
};
}

__device__ __forceinline__ void build_rs_table(LAS float* rst, const pg8::StaticOrder& S, const float* ssp) {
    const int tid = tid_opaque();
    pg8::Unit u;
    for (int i = 0; S.next(i, u); ++i) if (tid < 256) rst[i * 256 + tid] = row_rs(ssp, u.pm * 256 + tid);
    __syncthreads();
}
template <int KIND, int NB>
__device__ __forceinline__ void tail16(const bf16_t* A, const bf16_t* Bt, int N, int K, bf16_t* Out, int ldo, const float* ssp, float* ssq, LAS float* red, const float* lbias = nullptr) {
    const int tid = tid_opaque(), wid = __builtin_amdgcn_readfirstlane(tid >> 6), lane = tid & 63, fr = lane & 15, fq = lane >> 4;
    const int ntile = (KIND == 2) ? N / 32 : N / (16 * NB), nks = K >> 7;
    const int row = MAIN_ROWS + fr;
    for (int tile = blockIdx.x; tile < ntile; tile += gridDim.x) {
        f32x4 acc[NB];
#pragma unroll
        for (int be = 0; be < NB; ++be) acc[be] = (f32x4){0.f, 0.f, 0.f, 0.f};
        const bf16_t* ap = A + (size_t)row * K + fq * 8;
        const bf16_t* bp[NB];
        if (KIND == 2) { const int f = tile * 16 + fr, pn = f >> 7, ft = f & 127, r0 = pn * 256 + ((ft >> 2) << 3) + (ft & 3); bp[0] = Bt + (size_t)r0 * K + fq * 8; bp[1] = Bt + (size_t)(r0 + 4) * K + fq * 8; }
        else {
#pragma unroll
            for (int be = 0; be < NB; ++be) bp[be] = Bt + (size_t)(tile * 16 * NB + be * 16 + fr) * K + fq * 8; }
        for (int ks = wid; ks < nks; ks += 8) {
            bf16x8 av[4], bv[NB][4];
#pragma unroll
            for (int u = 0; u < 4; ++u) { av[u] = *(const bf16x8*)(ap + ks * 128 + u * 32);
#pragma unroll
                for (int be = 0; be < NB; ++be) bv[be][u] = *(const bf16x8*)(bp[be] + ks * 128 + u * 32); }
            __builtin_amdgcn_sched_barrier(0);
#pragma unroll
            for (int u = 0; u < 4; ++u)
#pragma unroll
                for (int be = 0; be < NB; ++be) acc[be] = __builtin_amdgcn_mfma_f32_16x16x32_bf16(bv[be][u], av[u], acc[be], 0, 0, 0);
        }
#pragma unroll
        for (int be = 0; be < NB; ++be) *(LAS f32x4*)(red + ((wid * NB + be) * 64 + lane) * 4) = acc[be];
        __syncthreads();
        if (wid == 0) {
#pragma unroll
            for (int be = 0; be < NB; ++be) { f32x4 t = *(const LAS f32x4*)(red + (be * 64 + lane) * 4);
#pragma unroll
                for (int w = 1; w < 8; ++w) t += *(const LAS f32x4*)(red + ((w * NB + be) * 64 + lane) * 4);
                acc[be] = t; }
            if (KIND == 0) {
                const float rs = ssp ? row_rs(ssp, row) : 1.0f;
#pragma unroll
                for (int be = 0; be < NB; ++be) { const int col = tile * 16 * NB + be * 16 + fq * 4; f32x4 v = acc[be] * rs;
                    if (lbias) { const int mode = col >> 9;
                        if (mode != 2) { const float sc = (mode == 0) ? 0.60653066f : 1.0f;
#pragma unroll
                            for (int j = 0; j < 4; ++j) v[j] = sc * sigmoidf_(v[j] + lbias[col + j]); } }
                    u32x2 w; w.x = pk2(v[0], v[1]); w.y = pk2(v[2], v[3]);
                    *(u32x2*)(Out + (size_t)row * ldo + col) = w; }
            } else if (KIND == 1) {
                float q = 0.f;
#pragma unroll
                for (int be = 0; be < NB; ++be) { bf16_t* o = Out + (size_t)row * ldo + tile * 16 * NB + be * 16 + fq * 4; const u32x2 hw = *(const u32x2*)o;
                    u32x2 w; w.x = pk2(bf2f(hw.x & 0xffffu) + acc[be][0], bf2f(hw.x >> 16) + acc[be][1]); w.y = pk2(bf2f(hw.y & 0xffffu) + acc[be][2], bf2f(hw.y >> 16) + acc[be][3]);
                    *(u32x2*)o = w;
                    const float r0 = bf2f(w.x & 0xffffu), r1 = bf2f(w.x >> 16), r2 = bf2f(w.y & 0xffffu), r3 = bf2f(w.y >> 16);
                    q += (r0 * r0 + r1 * r1) + (r2 * r2 + r3 * r3); }
                q += __shfl_xor(q, 16); q += __shfl_xor(q, 32);
                if (fq == 0) ssq[(size_t)row * 16 + tile] = q;
            } else {
                const float rs = row_rs(ssp, row); float v[4];
#pragma unroll
                for (int j = 0; j < 4; ++j) { const float g = acc[0][j] * rs; v[j] = g * sigmoidf_(g) * (acc[1][j] * rs); }
                u32x2 w; w.x = pk2(v[0], v[1]); w.y = pk2(v[2], v[3]);
                *(u32x2*)(Out + (size_t)row * ldo + tile * 16 + fq * 4) = w;
            }
        }
        __syncthreads();
    }
}

__device__ __forceinline__ void norm_rows(CArgs a, int mode) {
    const int tid = tid_opaque(), wid = tid >> 6, lane = tid & 63;
    bf16_t* HB = (bf16_t*)(a->ws + WS_H); float* SS = (float*)(a->ws + WS_SS);
    for (int row = blockIdx.x * 8 + wid; row < (mode == 0 ? NROWS : MAIN_ROWS); row += gridDim.x * 8) {
        float x[16]; float ss = 0.f;
        if (mode == 0) {
            const float* src = (row >= MAIN_ROWS ? a->in[1] + (size_t)(row - MAIN_ROWS) * DM : a->in[0] + (size_t)row * DM);
#pragma unroll
            for (int i = 0; i < 2; ++i) { const f32x4 v0 = *(const f32x4*)(src + lane * 8 + 512 * i), v1 = *(const f32x4*)(src + lane * 8 + 512 * i + 4);
                u32x4 w; w.x = pk2(v0[0], v0[1]); w.y = pk2(v0[2], v0[3]); w.z = pk2(v1[0], v1[1]); w.w = pk2(v1[2], v1[3]);
                *(u32x4*)(HB + (size_t)row * DM + lane * 8 + 512 * i) = w;
                float r[8]; unpack8(w, r);
#pragma unroll
                for (int e = 0; e < 8; ++e) ss += r[e] * r[e]; }
            ss = wave_sum(ss);
            if (lane < 16) SS[(size_t)row * 16 + lane] = (lane == 0) ? ss : 0.f;
        } else {
#pragma unroll
            for (int i = 0; i < 2; ++i) { float r[8]; unpack8(*(const u32x4*)(HB + (size_t)row * DM + lane * 8 + 512 * i), r);
#pragma unroll
                for (int e = 0; e < 8; ++e) { x[i * 8 + e] = r[e]; ss += r[e] * r[e]; } }
            ss = wave_sum(ss);
            const float rs = rsqrtf(ss * (1.0f / DM) + RMS_EPS);
            float* o = a->out + (size_t)row * DM;
#pragma unroll
            for (int i = 0; i < 2; ++i) { const f32x4 g0 = *(const f32x4*)(a->in[25] + lane * 8 + 512 * i), g1 = *(const f32x4*)(a->in[25] + lane * 8 + 512 * i + 4);
                *(f32x4*)(o + lane * 8 + 512 * i) = (f32x4){x[i * 8] * rs * g0[0], x[i * 8 + 1] * rs * g0[1], x[i * 8 + 2] * rs * g0[2], x[i * 8 + 3] * rs * g0[3]};
                *(f32x4*)(o + lane * 8 + 512 * i + 4) = (f32x4){x[i * 8 + 4] * rs * g1[0], x[i * 8 + 5] * rs * g1[1], x[i * 8 + 6] * rs * g1[2], x[i * 8 + 7] * rs * g1[3]}; }
        }
    }
}

template <int KIND> __device__ __forceinline__ float wsrc(CArgs a, int l, int k, int n) {
    if (KIND == 0) {
        const float gk = a->in[2][(size_t)l * DM + k];
        if (n < NIN) return gk * a->in[3][((size_t)l * DM + k) * NIN + n];
        if (n < NIN + 32 && l > 0) return gk * a->in[17][((size_t)(l - 1) * DM + k) * 32 + (n - NIN)];
        return 0.f;
    } else if (KIND == 1) {
        return a->in[21][((size_t)l * DM + k) * DM + n];
    } else if (KIND == 2) {
        const int pn = n >> 8, c = n & 255, feat = pn * 128 + ((c >> 3) << 2) + (c & 3), isup = (c >> 2) & 1;
        return a->in[22][(size_t)l * DM + k] * a->in[23][((size_t)l * DM + k) * (2 * DFF) + feat + isup * DFF];
    } else if (KIND == 3) {
        return a->in[24][((size_t)l * DFF + k) * DM + n];
    } else {
        const int j = n >> 9, nn = n & 511;
        if (j == 0) return (k < 64) ? a->in[8][((size_t)l * 64 + k) * 512 + nn] : 0.f;
        if (j == 1) return (k >= 64 && k < 128) ? a->in[10][((size_t)l * 64 + (k - 64)) * 512 + nn] : 0.f;
        if (j == 2) return (k >= 128 && k < 288) ? a->in[11][((size_t)l * 160 + (k - 128)) * 512 + nn] : 0.f;
        return (k >= 288 && k < 320 && l > 0) ? a->in[20][((size_t)(l - 1) * 32 + (k - 288)) * 512 + nn] : 0.f;
    }
}
template <int KIND> __device__ __forceinline__ void conv_tile(CArgs a, int l, LAS float* tile, bf16_t* out, int ldo, int n0, int k0) {
    const int tid = tid_opaque(), kk = tid >> 6, nn = tid & 63;
#pragma unroll
    for (int i = 0; i < 8; ++i) tile[(kk + 8 * i) * 65 + nn] = wsrc<KIND>(a, l, k0 + kk + 8 * i, n0 + nn);
    __syncthreads();
    const int n = tid >> 3, kq = tid & 7;
    u32x4 w;
    w.x = pk2(tile[(kq * 8 + 0) * 65 + n], tile[(kq * 8 + 1) * 65 + n]); w.y = pk2(tile[(kq * 8 + 2) * 65 + n], tile[(kq * 8 + 3) * 65 + n]);
    w.z = pk2(tile[(kq * 8 + 4) * 65 + n], tile[(kq * 8 + 5) * 65 + n]); w.w = pk2(tile[(kq * 8 + 6) * 65 + n], tile[(kq * 8 + 7) * 65 + n]);
    *(u32x4*)(out + (size_t)(n0 + n) * ldo + k0 + kq * 8) = w;
    __syncthreads();
}
__device__ __forceinline__ void fold_tile(CArgs a, int l, LAS float* lds, bf16_t* out, int n0, int k0) {
    LAS float* P = lds; LAS float* W = lds + 64 * 128;
    const int tid = tid_opaque(), g = k0 >> 7, c0 = k0 & 127;
    const float* pw = a->in[5] + ((size_t)(l * 4 + g) * 128 + c0) * 128; const float* sc = a->in[6] + (size_t)l * 512 + g * 128;
    const float* wo = a->in[21] + ((size_t)l * DM + g * 128) * DM + n0;
    for (int i = tid; i < 64 * 128; i += 512) { const int d = i & 127; P[i] = pw[i] * sc[d]; }
    for (int i = tid; i < 128 * 64; i += 512) { const int d = i >> 6, n = i & 63; W[i] = wo[(size_t)d * DM + n]; }
    __syncthreads();
    const int n = tid & 63, cq = tid >> 6;
    float acc[8];
#pragma unroll
    for (int j = 0; j < 8; ++j) acc[j] = 0.f;
    for (int d = 0; d < 128; ++d) { const float wv = W[d * 64 + n];
#pragma unroll
        for (int j = 0; j < 8; ++j) acc[j] += P[(cq * 8 + j) * 128 + d] * wv; }
    u32x4 w; w.x = pk2(acc[0], acc[1]); w.y = pk2(acc[2], acc[3]); w.z = pk2(acc[4], acc[5]); w.w = pk2(acc[6], acc[7]);
    *(u32x4*)(out + (size_t)(n0 + n) * DM + k0 + cq * 8) = w;
    __syncthreads();
}
__device__ __forceinline__ void weight_prep(CArgs a, int l, LAS float* lds, int b0, int nb) {
    unsigned char* wb = a->ws + WS_WB + (size_t)(l & 1) * WB_SIZE;
    bf16_t* WC = (bf16_t*)(wb + WB_WC); bf16_t* WO = (bf16_t*)(wb + WB_WOUT); bf16_t* WGU = (bf16_t*)(wb + WB_WGU); bf16_t* WDN = (bf16_t*)(wb + WB_WDN); bf16_t* WL = (bf16_t*)(wb + WB_WL);
    for (int ti = (int)blockIdx.x - b0; ti < 3201; ti += nb) {
        if (ti == 3200) { float* LB = (float*)(wb + WB_LB); const int t0 = tid_opaque();
            for (int i = t0; i < NL; i += 512) { const int j = i >> 9, nn = i & 511; LB[i] = (j == 0) ? a->in[7][l * 512 + nn] : (j == 1) ? a->in[9][l * 512 + nn] : (j == 3 && l > 0) ? a->in[19][(l - 1) * 512 + nn] : 0.f; }
            continue; }
        if (ti < 128) { fold_tile(a, l, lds, WO, (ti & 15) * 64, (ti >> 4) * 64); }
        else if (ti < 256) { const int q = ti - 128; conv_tile<1>(a, l, lds, WO, DM, (q & 15) * 64, 512 + (q >> 4) * 64); }
        else if (ti < 896) { const int q = ti - 256; conv_tile<0>(a, l, lds, WC, DM, (q >> 4) * 64, (q & 15) * 64); }
        else if (ti < 2304) { const int q = ti - 896; conv_tile<2>(a, l, lds, WGU, DM, (q >> 4) * 64, (q & 15) * 64); }
        else if (ti < 3008) { const int q = ti - 2304; conv_tile<3>(a, l, lds, WDN, DFF, (q / 44) * 64, (q % 44) * 64); }
        else { const int q = ti - 3008; conv_tile<4>(a, l, lds, WL, KL, (q / 6) * 64, (q % 6) * 64); }
    }
}

__device__ __forceinline__ void prep_phase(CArgs a, int l, int part, int b0, int nb) {
    const bf16_t* PROJ = (const bf16_t*)(a->ws + WS_R1);
    bf16_t* MIX = (bf16_t*)((unsigned char*)a->out + DO_MIX); bf16_t* LIN = (bf16_t*)((unsigned char*)a->out + DO_LIN);
    const int tid = tid_opaque(), gt = ((int)blockIdx.x - b0) * 512 + tid, nthr = nb * 512;
    if (part == 1)
    for (int it = gt; it < (MAIN_ROWS / 16 + 1) * 64; it += nthr) {
        const int run = it >> 6, c0 = (it & 63) * 8, win = 2 << (c0 >> 7);
        const int b = run >> 7, t0 = (run < MAIN_ROWS / 16) ? NMETA + (run & 127) * 16 : 0;
        float s[8], x[8], y[8];
#pragma unroll
        for (int e = 0; e < 8; ++e) s[e] = 0.f;
        const int pre = (t0 < win) ? t0 : win;
        for (int q = 1; q <= pre; ++q) { unpack8(*(const u32x4*)(PROJ + (size_t)row_of(b, t0 - q) * NPROJ + c0), x);
#pragma unroll
            for (int e = 0; e < 8; ++e) s[e] += x[e]; }
        for (int i = 0; i < 16; ++i) {
            const int t = t0 + i, row = row_of(b, t);
            unpack8(*(const u32x4*)(PROJ + (size_t)row * NPROJ + c0), x);
            if (t >= win) { unpack8(*(const u32x4*)(PROJ + (size_t)row_of(b, t - win) * NPROJ + c0), y);
#pragma unroll
                for (int e = 0; e < 8; ++e) s[e] += x[e] - y[e]; }
            else {
#pragma unroll
                for (int e = 0; e < 8; ++e) s[e] += x[e]; }
            const float inv = 1.0f / (float)((t + 1 < win) ? t + 1 : win);
            u32x4 o; o.x = pk2(s[0] * inv - x[0], s[1] * inv - x[1]); o.y = pk2(s[2] * inv - x[2], s[3] * inv - x[3]);
            o.z = pk2(s[4] * inv - x[4], s[5] * inv - x[5]); o.w = pk2(s[6] * inv - x[6], s[7] * inv - x[7]);
            *(u32x4*)(MIX + (size_t)row * DM + c0) = o;
        }
    }
    if (part == 0)
    for (int it = gt; it < NROWS * 48; it += nthr) {
        const int row = it / 48, cb = (it - row * 48) * 8;
        const int prow = (row >= MAIN_ROWS) ? (row > MAIN_ROWS ? row - 1 : -1) : ((row & (SEQ - 1)) ? row - 1 : NROWS - 1);
        u32x4 o = (u32x4){0u, 0u, 0u, 0u};
        if (cb < 320) {
            float xc[8], xp[8], mu[8], y[8];
            unpack8(*(const u32x4*)(PROJ + (size_t)row * NPROJ + 2048 + cb), xc);
            u32x4 wp = (u32x4){0u, 0u, 0u, 0u};
            if (prow >= 0) wp = *(const u32x4*)(PROJ + (size_t)prow * NPROJ + 2048 + cb);
            unpack8(wp, xp);
            const float* mp = (cb < 288) ? a->in[4] + (size_t)l * NSHIFT + 1536 + cb : a->in[18] + (l > 0 ? (l - 1) * 32 + (cb - 288) : 0);
            const f32x4 m0 = *(const f32x4*)mp, m1 = *(const f32x4*)(mp + 4);
            mu[0] = m0[0]; mu[1] = m0[1]; mu[2] = m0[2]; mu[3] = m0[3]; mu[4] = m1[0]; mu[5] = m1[1]; mu[6] = m1[2]; mu[7] = m1[3];
#pragma unroll
            for (int e = 0; e < 8; ++e) {
                const float sv = xc[e] + (xp[e] - xc[e]) * mu[e];
                y[e] = (cb < 64) ? 1.0f - 2.0f * __builtin_amdgcn_rcpf(1.0f + __builtin_amdgcn_exp2f(sv * 2.88539008f)) : (cb < 128) ? sv : (cb < 288) ? sigmoidf_(sv) : sv;
            }
            o.x = pk2(y[0], y[1]); o.y = pk2(y[2], y[3]); o.z = pk2(y[4], y[5]); o.w = pk2(y[6], y[7]);
        }
        *(u32x4*)(LIN + (size_t)row * KL + cb) = o;
    }
}

constexpr int TC = 16, NCH = TT / TC;
constexpr int SB_A = 0, SB_Q = 1, SB_W = 2, SB_B = 3, SB_K = 4, SB_V = 5, SB_G = 6, SB_Y = 7, SBUF = 8 * TC * 64 + TC * 4;
#define LDS_BARRIER() do { asm volatile("s_waitcnt lgkmcnt(0)" ::: "memory"); __builtin_amdgcn_s_barrier(); asm volatile("" ::: "memory"); } while (0)
__device__ __forceinline__ void scan_phase(CArgs a, int l, LAS float* lds) {
    const int bid = blockIdx.x; if (bid >= BATCH * 8) return;
    const int b = bid >> 3, h = bid & 7, tid = tid_opaque(), wid = __builtin_amdgcn_readfirstlane(tid >> 6), lane = tid & 63;
    const bf16_t* PROJ = (const bf16_t*)(a->ws + WS_R1); const bf16_t* LO = (const bf16_t*)(a->ws + WS_LO);
    bf16_t* VF = (bf16_t*)((unsigned char*)a->out + DO_VF); bf16_t* MIX = (bf16_t*)((unsigned char*)a->out + DO_MIX);
    if (wid < 4) {
        __builtin_amdgcn_s_setprio(2);
        const int rp = wid * 16 + (lane >> 3) * 2, seg = lane & 7;
        f32x2 S0[4], S1[4];
#pragma unroll
        for (int j = 0; j < 4; ++j) { S0[j] = (f32x2){0.f, 0.f}; S1[j] = (f32x2){0.f, 0.f}; }
        for (int it = 0; it < NCH + 2; ++it) {
            if (it >= 1 && it <= NCH) {
                LAS float* buf = lds + ((it - 1) & 1) * SBUF;
#pragma unroll 16
                for (int tl = 0; tl < TC; ++tl) {
                    const LAS float* base = buf + tl * 64 + seg * 8;
                    const f32x4 a0 = *(const LAS f32x4*)(base + SB_A * TC * 64), a1 = *(const LAS f32x4*)(base + SB_A * TC * 64 + 4);
                    const f32x4 q0 = *(const LAS f32x4*)(base + SB_Q * TC * 64), q1 = *(const LAS f32x4*)(base + SB_Q * TC * 64 + 4);
                    const f32x4 w0 = *(const LAS f32x4*)(base + SB_W * TC * 64), w1 = *(const LAS f32x4*)(base + SB_W * TC * 64 + 4);
                    const f32x4 b0 = *(const LAS f32x4*)(base + SB_B * TC * 64), b1 = *(const LAS f32x4*)(base + SB_B * TC * 64 + 4);
                    const f32x4 k0 = *(const LAS f32x4*)(base + SB_K * TC * 64), k1 = *(const LAS f32x4*)(base + SB_K * TC * 64 + 4);
                    const f32x2 vv = *(const LAS f32x2*)(buf + SB_V * TC * 64 + tl * 64 + rp);
                    const f32x2 sc = *(const LAS f32x2*)(buf + 8 * TC * 64 + tl * 4);
                    const f32x2 av[4] = {{a0[0], a0[1]}, {a0[2], a0[3]}, {a1[0], a1[1]}, {a1[2], a1[3]}};
                    const f32x2 qv[4] = {{q0[0], q0[1]}, {q0[2], q0[3]}, {q1[0], q1[1]}, {q1[2], q1[3]}};
                    const f32x2 wv[4] = {{w0[0], w0[1]}, {w0[2], w0[3]}, {w1[0], w1[1]}, {w1[2], w1[3]}};
                    const f32x2 bv[4] = {{b0[0], b0[1]}, {b0[2], b0[3]}, {b1[0], b1[1]}, {b1[2], b1[3]}};
                    const f32x2 kv[4] = {{k0[0], k0[1]}, {k0[2], k0[3]}, {k1[0], k1[1]}, {k1[2], k1[3]}};
                    f32x2 pa0 = S0[0] * av[0], pa1 = S1[0] * av[0], pq0 = S0[0] * qv[0], pq1 = S1[0] * qv[0];
#pragma unroll
                    for (int j = 1; j < 4; ++j) { pa0 += S0[j] * av[j]; pa1 += S1[j] * av[j]; pq0 += S0[j] * qv[j]; pq1 += S1[j] * qv[j]; }
                    float sa0 = pa0.x + pa0.y, sa1 = pa1.x + pa1.y, y0 = pq0.x + pq0.y, y1 = pq1.x + pq1.y;
                    allred8x4(sa0, sa1, y0, y1);
                    const f32x2 sav0 = {sa0, sa0}, sav1 = {sa1, sa1}, vv0 = {vv.x, vv.x}, vv1 = {vv.y, vv.y};
#pragma unroll
                    for (int j = 0; j < 4; ++j) { S0[j] = S0[j] * wv[j] + sav0 * bv[j] + vv0 * kv[j]; S1[j] = S1[j] * wv[j] + sav1 * bv[j] + vv1 * kv[j]; }
                    *(LAS f32x2*)(buf + SB_Y * TC * 64 + tl * 64 + rp) = (f32x2){y0 + sa0 * sc.x + vv.x * sc.y, y1 + sa1 * sc.x + vv.y * sc.y};
                }
            }
            LDS_BARRIER();
        }
        __builtin_amdgcn_s_setprio(0);
    } else {
        const int hw = wid - 4, ch = h * 64 + lane;
        const float mu_r = a->in[4][(size_t)l * NSHIFT + ch], mu_k = a->in[4][(size_t)l * NSHIFT + 512 + ch], mu_v = a->in[4][(size_t)l * NSHIFT + 1024 + ch];
        const float kk_c = a->in[12][l * 512 + ch], ka_c = a->in[13][l * 512 + ch], rk_c = a->in[14][l * 512 + ch], gw = a->in[15][l * 512 + ch], gb = a->in[16][l * 512 + ch];
        unsigned short ld[2][4][11];
#define SCAN_LOAD(c, P) do { _Pragma("unroll") for (int p = 0; p < 4; ++p) { const int t = (c) * TC + p * 4 + hw; const size_t m = (size_t)row_of(b, t); \
        const bf16_t* pr = PROJ + m * NPROJ + 512 + ch; ld[P][p][0] = pr[0]; ld[P][p][1] = pr[512]; ld[P][p][2] = pr[1024]; \
        if (t > 0) { const bf16_t* pp = PROJ + (size_t)row_of(b, t - 1) * NPROJ + 512 + ch; ld[P][p][3] = pp[0]; ld[P][p][4] = pp[512]; ld[P][p][5] = pp[1024]; } else { ld[P][p][3] = 0; ld[P][p][4] = 0; ld[P][p][5] = 0; } \
        const bf16_t* po = LO + m * NL + ch; ld[P][p][6] = po[0]; ld[P][p][7] = po[512]; ld[P][p][8] = po[1024]; ld[P][p][9] = po[1536]; \
        ld[P][p][10] = (l > 0) ? VF[m * 512 + ch] : (unsigned short)0; } } while (0)
#define PK2F(i) ((f32x2){bf2f(ld[par][2 * pp][i]), bf2f(ld[par][2 * pp + 1][i])})
        SCAN_LOAD(0, 0); SCAN_LOAD(1, 1);
        static_assert((NCH + 2) % 2 == 1, "the helper loop is unrolled by two with one trailing trip");
        for (int it2 = 0; it2 < NCH + 2; it2 += 2) {
#pragma unroll
          for (int par = 0; par < 2; ++par) { const int it = it2 + par; if (it >= NCH + 2) break;
            LAS float* buf = lds + (it & 1) * SBUF;
            if (it >= 2) {
#pragma unroll
                for (int p = 0; p < 4; ++p) {
                    const int tl = p * 4 + hw; const size_t m = (size_t)row_of(b, (it - 2) * TC + tl);
                    const float y = buf[SB_Y * TC * 64 + tl * 64 + lane];
                    float s1 = y, s2 = y * y, dum = 0.f; wave_sum3(s1, s2, dum);
                    const float mean = s1 * (1.0f / 64.0f), d = y - mean, var = fmaxf(s2 * (1.0f / 64.0f) - mean * mean, 0.f);
                    const float o = (d * rsqrtf(var + GN_EPS) * gw + gb + buf[8 * TC * 64 + tl * 4 + 2] * buf[SB_V * TC * 64 + tl * 64 + lane]) * buf[SB_G * TC * 64 + tl * 64 + lane];
                    if (it > 2 || b == 0) MIX[m * DM + 512 + ch] = (bf16_t)f2bf(o);
                }
            }
            if (it < NCH) {
#pragma unroll
                for (int pp = 0; pp < 2; ++pp) {
                    const int tl0 = (2 * pp) * 4 + hw, tl1 = tl0 + 4;
                    const f32x2 rc = PK2F(0), kc = PK2F(1), vc = PK2F(2), rpv = PK2F(3), kp = PK2F(4), vp = PK2F(5);
                    const f32x2 e = PK2F(6), av = PK2F(7), gv = PK2F(8), vm = PK2F(9);
                    const f32x2 r = rc + (rpv - rc) * mu_r, k = kc + (kp - kc) * mu_k; f32x2 v = vc + (vp - vc) * mu_v;
                    if (l == 0) {
                        if (it > 0 || b == 0) { VF[(size_t)row_of(b, it * TC + tl0) * 512 + ch] = (bf16_t)f2bf(v.x); VF[(size_t)row_of(b, it * TC + tl1) * 512 + ch] = (bf16_t)f2bf(v.y); }
                    } else { const f32x2 vf = PK2F(10); v = v + (vf - v) * vm; }
                    f32x2 kk = k * kk_c; f32x2 n2 = kk * kk; float n2a = n2.x, n2b = n2.y, dum = 0.f; wave_sum3(n2a, n2b, dum);
                    kk = kk * (f32x2){rsqrtf(fmaxf(n2a, 1e-24f)), rsqrtf(fmaxf(n2b, 1e-24f))};
                    const f32x2 k2 = k * ((av - 1.0f) * ka_c + 1.0f), bb = kk * av;
                    const f32x2 w = {__builtin_amdgcn_exp2f(e.x * -1.44269504f), __builtin_amdgcn_exp2f(e.y * -1.44269504f)};
                    const f32x2 brv = bb * r, krv = k2 * r, cfv = krv * rk_c, q = w * r;
                    float br0 = brv.x, kr0 = krv.x, cf0 = cfv.x, br1 = brv.y, kr1 = krv.y, cf1 = cfv.y; wave_sum3(br0, kr0, cf0); wave_sum3(br1, kr1, cf1);
                    buf[SB_A * TC * 64 + tl0 * 64 + lane] = -kk.x; buf[SB_Q * TC * 64 + tl0 * 64 + lane] = q.x; buf[SB_W * TC * 64 + tl0 * 64 + lane] = w.x;
                    buf[SB_B * TC * 64 + tl0 * 64 + lane] = bb.x; buf[SB_K * TC * 64 + tl0 * 64 + lane] = k2.x; buf[SB_V * TC * 64 + tl0 * 64 + lane] = v.x; buf[SB_G * TC * 64 + tl0 * 64 + lane] = gv.x;
                    buf[SB_A * TC * 64 + tl1 * 64 + lane] = -kk.y; buf[SB_Q * TC * 64 + tl1 * 64 + lane] = q.y; buf[SB_W * TC * 64 + tl1 * 64 + lane] = w.y;
                    buf[SB_B * TC * 64 + tl1 * 64 + lane] = bb.y; buf[SB_K * TC * 64 + tl1 * 64 + lane] = k2.y; buf[SB_V * TC * 64 + tl1 * 64 + lane] = v.y; buf[SB_G * TC * 64 + tl1 * 64 + lane] = gv.y;
                    if (lane < 3) { buf[8 * TC * 64 + tl0 * 4 + lane] = (lane == 0) ? br0 : (lane == 1) ? kr0 : cf0; buf[8 * TC * 64 + tl1 * 4 + lane] = (lane == 0) ? br1 : (lane == 1) ? kr1 : cf1; }
                }
                if (it + 2 < NCH) SCAN_LOAD(it + 2, par);
            }
            LDS_BARRIER();
          }
        }
#undef PK2F
#undef SCAN_LOAD
    }
}


#define XB_TMO      128
#define XB_XCNT(j)  (256  + 64 * (j))
#define XB_XSUB(j)  (1280 + 64 * (j))
#define XB_XGEN(j)  (2304 + 64 * (j))
#define XB_TOP      3328
#define XB_TOPGEN   3392
#define XCD_BAR_WORDS 3456
#define XB_SPIN_CAP (1u << 22)
__device__ __forceinline__ unsigned xb_ld(unsigned* p)              { return __hip_atomic_load(p, __ATOMIC_RELAXED, __HIP_MEMORY_SCOPE_AGENT); }
__device__ __forceinline__ unsigned xb_add(unsigned* p, unsigned v) { return __hip_atomic_fetch_add(p, v, __ATOMIC_RELAXED, __HIP_MEMORY_SCOPE_AGENT); }
__device__ __forceinline__ unsigned xb_xcc_id() { return (unsigned)__builtin_amdgcn_s_getreg((3 << 11) | 20) & 0xFu; }
#define XB_SPIN(cond, bar) do { unsigned _sp = 0; while (cond) { __builtin_amdgcn_s_sleep(1); \
    if ((++_sp & 255u) == 0u) { if (xb_ld(&(bar)[XB_TMO])) break; if (_sp > XB_SPIN_CAP) { atomicAdd(&(bar)[XB_TMO], 1u); break; } } } } while (0)
struct XcdBarrier { unsigned* bar; unsigned x; volatile LAS unsigned* st; };
__device__ __forceinline__ void xcd_barrier_complete(unsigned* bar, unsigned x, unsigned& nloc, unsigned& nx) {
    const unsigned G = gridDim.x;
    unsigned sum, cnt, mine, sp = 0u;
    for (;;) {
        sum = 0u; cnt = 0u; mine = 0u;
#pragma unroll
        for (unsigned j = 0; j < 16; ++j) { const unsigned c = xb_ld(&bar[XB_XCNT(j)]); sum += c; cnt += (c > 0u) ? 1u : 0u; mine = (j == x) ? c : mine; }
        if (sum == G) break;
        __builtin_amdgcn_s_sleep(1);
        if ((++sp & 255u) == 0u) { if (xb_ld(&bar[XB_TMO])) break; if (sp > XB_SPIN_CAP) { atomicAdd(&bar[XB_TMO], 1u); break; } }
    }
    nloc = mine > 0u ? mine : 1u; nx = cnt > 0u ? cnt : 1u;
}
__device__ __forceinline__ void xcd_barrier(const XcdBarrier& b, bool leader_thread) {
    asm volatile("s_waitcnt vmcnt(0)" ::: "memory");
    __syncthreads();
    if (leader_thread) {
        unsigned* bar = b.bar;
        __builtin_amdgcn_s_waitcnt(0);
        unsigned nloc = b.st[0], nx = b.st[1];
        if (nloc == 0u) { xcd_barrier_complete(bar, b.x, nloc, nx); b.st[0] = nloc; b.st[1] = nx; }
        const unsigned old = xb_add(&bar[XB_XSUB(b.x)], 1u);
        const unsigned gen = old / nloc;
        if (old + 1u == (gen + 1u) * nloc) {
            __builtin_amdgcn_fence(__ATOMIC_RELEASE, "agent");
            asm volatile("s_waitcnt vmcnt(0)" ::: "memory");
            const unsigned og = xb_add(&bar[XB_TOP], 1u);
            const unsigned tg = og / nx;
            if (og + 1u == (tg + 1u) * nx) xb_add(&bar[XB_TOPGEN], 1u);
            else XB_SPIN(xb_ld(&bar[XB_TOPGEN]) == tg, bar);
            __builtin_amdgcn_fence(__ATOMIC_ACQUIRE, "agent");
            xb_add(&bar[XB_XGEN(b.x)], 1u);
            asm volatile("s_waitcnt vmcnt(0)" ::: "memory");
        } else {
            XB_SPIN(xb_ld(&bar[XB_XGEN(b.x)]) == gen, bar);
            __builtin_amdgcn_fence(__ATOMIC_ACQUIRE, "agent");
            asm volatile("s_waitcnt vmcnt(0)" ::: "memory");
        }
    }
    __syncthreads();
}

__global__ void __launch_bounds__(512, 2) mega(Args a_unused) {
    extern __shared__ __attribute__((aligned(16))) unsigned char shm[];
    LAS unsigned char* lds = (LAS unsigned char*)shm;
    cg::grid_group grid = cg::this_grid();
    CArgs a0 = (CArgs)__builtin_amdgcn_kernarg_segment_ptr();
    const int ph_lo = a0->ph_lo, ph_hi = a0->ph_hi;
    XcdBarrier xbar; xbar.bar = (unsigned*)(a0->ws + WS_BAR); xbar.x = xb_xcc_id(); xbar.st = (volatile LAS unsigned*)(lds + 131072 + 16384);
    { const int t0 = tid_opaque(); if (t0 == 0) { xbar.st[0] = 0u; xbar.st[1] = 0u; (void)xb_add(&xbar.bar[XB_XCNT(xbar.x)], 1u); } __syncthreads(); }
    for (int ph = ph_lo; ph < ph_hi; ++ph) {
        if (ph > ph_lo) { if (ph == ph_lo + 1) grid.sync(); else xcd_barrier(xbar, tid_opaque() == 0); }
        CArgs a = a0; asm volatile("" : "+s"(a));
        if (ph == 0) { norm_rows(a, 0); weight_prep(a, 0, (LAS float*)lds, 0, gridDim.x); continue; }
        if (ph == NPH - 1) { norm_rows(a, 2); continue; }
        const int l = (ph - 1) / 7, s = (ph - 1) % 7;
        bf16_t* HB = (bf16_t*)(a->ws + WS_H); float* SS = (float*)(a->ws + WS_SS);
        const unsigned char* wb = a->ws + WS_WB + (size_t)(l & 1) * WB_SIZE;
        if (s == 0) {
            pg8::Gemm g{HB, (const bf16_t*)(wb + WB_WC), MR, NPROJ, DM};
            pg8::StaticOrder S; S.init(MAIN_ROWS, g.N, gridDim.x, blockIdx.x);
            LAS float* rst = (LAS float*)(lds + 131072);
            build_rs_table(rst, S, SS);
            pg8::EpiProj E{(bf16_t*)(a->ws + WS_R1), g.N, rst};
            pg8::gemm_phase(lds, g, S, E);
            tail16<0, 2>(g.A, g.Bt, g.N, g.K, E.O, g.N, SS, nullptr, (LAS float*)lds);
        }
        else if (s == 2) {
            int kl = KL; asm volatile("" : "+s"(kl));
            pg8::Gemm g{(const bf16_t*)((unsigned char*)a->out + DO_LIN), (const bf16_t*)(wb + WB_WL), MR, NL, kl};
            pg8::StaticOrder S; S.init(MAIN_ROWS, g.N, gridDim.x, blockIdx.x);
            pg8::EpiLora E{(bf16_t*)(a->ws + WS_LO), (const float*)(wb + WB_LB)};
            pg8::gemm_phase(lds, g, S, E);
            tail16<0, 2>(g.A, g.Bt, g.N, g.K, E.O, g.N, nullptr, nullptr, (LAS float*)lds, E.bias);
        }
        else if (s == 1) prep_phase(a, l, 0, 0, gridDim.x);
        else if (s == 3) {
            if (blockIdx.x < BATCH * 8) scan_phase(a, l, (LAS float*)lds);
            else { prep_phase(a, l, 1, BATCH * 8, gridDim.x - BATCH * 8); if (l + 1 < DEPTH) weight_prep(a, l + 1, (LAS float*)lds, BATCH * 8, gridDim.x - BATCH * 8); }
        }
        else if (s == 4 || s == 6) {
            pg8::Gemm g{s == 4 ? (const bf16_t*)((unsigned char*)a->out + DO_MIX) : (const bf16_t*)(a->ws + WS_R1), (const bf16_t*)(wb + (s == 4 ? WB_WOUT : WB_WDN)), MR, DM, s == 4 ? DM : DFF};
            pg8::StaticOrder S; S.init(MAIN_ROWS, DM, gridDim.x, blockIdx.x);
            pg8::EpiResid E{HB, SS + (s == 4 ? (size_t)MR * 16 : 0)};
            pg8::gemm_phase(lds, g, S, E);
            tail16<1, 4>(g.A, g.Bt, g.N, g.K, HB, DM, nullptr, E.ssq, (LAS float*)lds);
        }
        else {
            pg8::Gemm g{HB, (const bf16_t*)(wb + WB_WGU), MR, 2 * DFF, DM}; pg8::StaticOrder S; S.init(MAIN_ROWS, 2 * DFF, gridDim.x, blockIdx.x);
            LAS float* rst = (LAS float*)(lds + 131072); build_rs_table(rst, S, SS + (size_t)MR * 16);
            pg8::EpiSwiglu E{(bf16_t*)(a->ws + WS_R1), rst};
            pg8::gemm_phase(lds, g, S, E);
            tail16<2, 2>(g.A, g.Bt, g.N, g.K, E.O, DFF, SS + (size_t)MR * 16, nullptr, (LAS float*)lds);
        }
    }
}

extern "C" void kernel_launch(void* const* d_in, const int* in_sizes, int n_in, void* d_out, int out_size, void* d_ws, size_t ws_size, hipStream_t stream) {
    static int grid = 0;
    if (grid == 0) {
        if (n_in != 26 || out_size != BATCH * SEQ * DM || ws_size < WS_TOTAL) { fprintf(stderr, "kernel_launch: unexpected shapes (n_in %d out %d ws %zu need %zu)\n", n_in, out_size, ws_size, (size_t)WS_TOTAL); grid = -1; return; }
        int dev = 0, cus = 0, per_cu = 0;
        hipGetDevice(&dev);
        hipDeviceGetAttribute(&cus, hipDeviceAttributeMultiprocessorCount, dev);
        if (hipFuncSetAttribute((const void*)mega, hipFuncAttributeMaxDynamicSharedMemorySize, LDS_BYTES) != hipSuccess) { fprintf(stderr, "kernel_launch: hipFuncSetAttribute failed\n"); grid = -1; return; }
        hipOccupancyMaxActiveBlocksPerMultiprocessor(&per_cu, (const void*)mega, 512, LDS_BYTES);
        if (per_cu < 1) { fprintf(stderr, "kernel_launch: occupancy query says %d blocks per CU\n", per_cu); per_cu = 1; }
        (void)hipGetLastError();
        grid = cus;
        fprintf(stderr, "kernel_launch: grid %d (per_cu %d)\n", grid, per_cu);
    }
    if (grid < 0) return;
    if (hipMemsetAsync((unsigned char*)d_ws + WS_BAR, 0, 16384, stream) != hipSuccess) { fprintf(stderr, "kernel_launch: hipMemsetAsync failed\n"); return; }
    Args a{};
    for (int i = 0; i < 26; ++i) a.in[i] = (const float*)d_in[i];
    a.out = (float*)d_out; a.ws = (unsigned char*)d_ws;
#if MK_MULTI
    for (int ph = 0; ph < NPH; ++ph) {
        a.ph_lo = ph; a.ph_hi = ph + 1;
        void* args[] = {&a};
        hipError_t e = hipLaunchCooperativeKernel((const void*)mega, dim3(grid), dim3(512), args, LDS_BYTES, stream);
        if (e != hipSuccess) { fprintf(stderr, "cooperative launch failed: %s\n", hipGetErrorString(e)); break; }
    }
#else
    a.ph_lo = 0; a.ph_hi = NPH;
    void* args[] = {&a};
    hipError_t e = hipLaunchCooperativeKernel((const void*)mega, dim3(grid), dim3(512), args, LDS_BYTES, stream);
    if (e != hipSuccess) fprintf(stderr, "cooperative launch failed: %s (grid %d)\n", hipGetErrorString(e), grid);
#endif
}
```

```cpp
#include <hip/hip_runtime.h>
#include <hip/hip_cooperative_groups.h>
#include <cstdio>
#include <cstdint>
namespace cg = cooperative_groups;

#ifndef MK_MULTI
#define MK_MULTI 0
#endif

#define LAS __attribute__((address_space(3)))
typedef unsigned short bf16_t;
typedef short bf16x8 __attribute__((ext_vector_type(8)));
typedef float f32x4 __attribute__((ext_vector_type(4)));
typedef float f32x2 __attribute__((ext_vector_type(2)));
typedef unsigned u32x4 __attribute__((ext_vector_type(4)));
typedef unsigned u32x2 __attribute__((ext_vector_type(2)));

constexpr int DM = 1024, BATCH = 16, SEQ = 2048, DEPTH = 4, NMETA = 16, TT = SEQ + NMETA  , MR = BATCH * TT  ;
constexpr int NIN = 2336, NSHIFT = 1824, DFF = 2816, NPROJ = 2560  , KL = 384  , NL = 2048;
constexpr float RMS_EPS = 1e-6f, GN_EPS = 64e-5f;
constexpr int LDS_BYTES = 131072 + 16384 + 64;
constexpr int NPH = DEPTH * 7 + 2;

constexpr size_t WB_WC = 0;
constexpr size_t WB_WOUT = WB_WC + (size_t)NPROJ * DM * 2;
constexpr size_t WB_WGU = WB_WOUT + (size_t)DM * DM * 2;
constexpr size_t WB_WDN = WB_WGU + (size_t)2 * DFF * DM * 2;
constexpr size_t WB_WL = WB_WDN + (size_t)DM * DFF * 2;
constexpr size_t WB_LB = WB_WL + (size_t)NL * KL * 2;
constexpr size_t WB_SIZE = WB_LB + 8192;
constexpr size_t WS_WB = 4096;
constexpr size_t WS_SS = WS_WB + 2 * WB_SIZE;
constexpr size_t WS_H = WS_SS + 2 * (size_t)MR * 64;
constexpr size_t WS_R1 = WS_H + (size_t)MR * DM * 4;
constexpr size_t WS_LO = WS_R1 + (size_t)MR * DFF * 2;
constexpr size_t WS_END = WS_LO + (size_t)MR * NL * 2;
constexpr size_t WS_BAR = WS_END;
constexpr size_t WS_TOTAL = WS_BAR + 16384;
static_assert(WS_TOTAL <= 536870912, "workspace map");
constexpr size_t DO_MIX = 0;
constexpr size_t DO_VF = DO_MIX + (size_t)MR * DM * 2;
constexpr size_t DO_LIN = DO_VF + (size_t)MR * 512 * 2;
static_assert(DO_LIN + (size_t)MR * KL * 2 <= (size_t)BATCH * SEQ * DM * 4, "d_out scratch");

struct Args { const float* in[26]; float* out; unsigned char* ws; int ph_lo, ph_hi; };
typedef const __attribute__((address_space(4))) Args* CArgs;

__device__ __forceinline__ float bf2f(unsigned b) { return __uint_as_float(b << 16); }
__device__ __forceinline__ unsigned f2bf(float f) { unsigned u = __float_as_uint(f); return (u + 0x7fffu + ((u >> 16) & 1u)) >> 16; }
__device__ __forceinline__ unsigned pk2(float lo, float hi) { unsigned r; asm volatile("v_cvt_pk_bf16_f32 %0, %1, %2" : "=v"(r) : "v"(lo), "v"(hi)); return r; }
__device__ __forceinline__ float sigmoidf_(float x) { return __builtin_amdgcn_rcpf(1.0f + __builtin_amdgcn_exp2f(x * -1.44269504f)); }
template <int CTRL> __device__ __forceinline__ float dppf(float x) { return __int_as_float(__builtin_amdgcn_update_dpp(0, __float_as_int(x), CTRL, 0xF, 0xF, true)); }
__device__ __forceinline__ float allred8(float x) { x += dppf<0xB1>(x); x += dppf<0x4E>(x); x += dppf<0x141>(x); return x; }
#define DPP_ADD(r, ctl) "v_add_f32_dpp " r ", " r ", " r " " ctl " row_mask:0xf bank_mask:0xf\n\t"
__device__ __forceinline__ void allred8x4(float& a, float& b, float& c, float& d) {
    asm volatile("s_nop 1\n\t"
        DPP_ADD("%0", "quad_perm:[1,0,3,2]") DPP_ADD("%1", "quad_perm:[1,0,3,2]") DPP_ADD("%2", "quad_perm:[1,0,3,2]") DPP_ADD("%3", "quad_perm:[1,0,3,2]")
        DPP_ADD("%0", "quad_perm:[2,3,0,1]") DPP_ADD("%1", "quad_perm:[2,3,0,1]") DPP_ADD("%2", "quad_perm:[2,3,0,1]") DPP_ADD("%3", "quad_perm:[2,3,0,1]")
        DPP_ADD("%0", "row_half_mirror") DPP_ADD("%1", "row_half_mirror") DPP_ADD("%2", "row_half_mirror") DPP_ADD("%3", "row_half_mirror")
        : "+v"(a), "+v"(b), "+v"(c), "+v"(d));
}
__device__ __forceinline__ float rows_to_wave(float x) {
    const int xi = __float_as_int(x);
    return (__int_as_float(__builtin_amdgcn_readlane(xi, 0)) + __int_as_float(__builtin_amdgcn_readlane(xi, 16))) + (__int_as_float(__builtin_amdgcn_readlane(xi, 32)) + __int_as_float(__builtin_amdgcn_readlane(xi, 48)));
}
__device__ __forceinline__ float wave_sum(float x) {
    asm volatile("s_nop 1\n\t" DPP_ADD("%0", "quad_perm:[1,0,3,2]") "s_nop 1\n\t" DPP_ADD("%0", "quad_perm:[2,3,0,1]") "s_nop 1\n\t" DPP_ADD("%0", "row_half_mirror") "s_nop 1\n\t" DPP_ADD("%0", "row_mirror") : "+v"(x));
    return rows_to_wave(x);
}
__device__ __forceinline__ void wave_sum3(float& a, float& b, float& c) {
    asm volatile("s_nop 1\n\t"
        DPP_ADD("%0", "quad_perm:[1,0,3,2]") DPP_ADD("%1", "quad_perm:[1,0,3,2]") DPP_ADD("%2", "quad_perm:[1,0,3,2]")
        DPP_ADD("%0", "quad_perm:[2,3,0,1]") DPP_ADD("%1", "quad_perm:[2,3,0,1]") DPP_ADD("%2", "quad_perm:[2,3,0,1]")
        DPP_ADD("%0", "row_half_mirror") DPP_ADD("%1", "row_half_mirror") DPP_ADD("%2", "row_half_mirror")
        DPP_ADD("%0", "row_mirror") DPP_ADD("%1", "row_mirror") DPP_ADD("%2", "row_mirror")
        "v_add_f32_dpp %0, %0, %0 row_bcast:15 row_mask:0xa bank_mask:0xf\n\t" "v_add_f32_dpp %1, %1, %1 row_bcast:15 row_mask:0xa bank_mask:0xf\n\t" "v_add_f32_dpp %2, %2, %2 row_bcast:15 row_mask:0xa bank_mask:0xf\n\t"
        "v_add_f32_dpp %0, %0, %0 row_bcast:31 row_mask:0xc bank_mask:0xf\n\t" "v_add_f32_dpp %1, %1, %1 row_bcast:31 row_mask:0xc bank_mask:0xf\n\t" "v_add_f32_dpp %2, %2, %2 row_bcast:31 row_mask:0xc bank_mask:0xf\n\t"
        : "+v"(a), "+v"(b), "+v"(c));
    a = __int_as_float(__builtin_amdgcn_readlane(__float_as_int(a), 63)); b = __int_as_float(__builtin_amdgcn_readlane(__float_as_int(b), 63)); c = __int_as_float(__builtin_amdgcn_readlane(__float_as_int(c), 63));
}
__device__ __forceinline__ int tid_opaque() { int t = threadIdx.x; asm volatile("" : "+v"(t)); return t; }

__device__ __forceinline__ void unpack8(const u32x4 w, float (&x)[8]) {
    x[0] = bf2f(w.x & 0xffffu); x[1] = bf2f(w.x >> 16); x[2] = bf2f(w.y & 0xffffu); x[3] = bf2f(w.y >> 16);
    x[4] = bf2f(w.z & 0xffffu); x[5] = bf2f(w.z >> 16); x[6] = bf2f(w.w & 0xffffu); x[7] = bf2f(w.w >> 16);
}
constexpr int MAIN_ROWS = BATCH * SEQ, NROWS = MAIN_ROWS + NMETA;
__device__ __forceinline__ int row_of(int b, int t) { return t < NMETA ? MAIN_ROWS + t : b * SEQ + (t - NMETA); }
__device__ __forceinline__ float row_rs(const float* ssp, int row) {
    const f32x4* p = (const f32x4*)(ssp + (size_t)row * 16); const f32x4 a = p[0], b = p[1], c = p[2], d = p[3];
    const f32x4 t = (a + b) + (c + d);
    return rsqrtf(((t[0] + t[1]) + (t[2] + t[3])) * (1.0f / DM) + RMS_EPS);
}
namespace pg8 {
constexpr int BM = 256, BK = 64, HALF = 128, HTB = HALF * BK * 2, STAGE_BYTES = 8 * HTB, NXCD = 8, WGM = 8;
__host__ __device__ __forceinline__ int lds_byte(int r, int c) { const int st = (r >> 4) * 2 + (c >> 5), rr = r & 15, cc = c & 31, ob = rr * 64 + cc * 2; return st * 1024 + (ob ^ (((ob >> 9) & 1) << 5)); }
__host__ __device__ __forceinline__ void stage_rc(int b, int& R, int& C) { const int st = b / 1024, sb = b % 1024, swz = sb ^ (((sb >> 9) & 1) << 5); R = (st >> 1) * 16 + swz / 64; C = (st & 1) * 32 + (swz % 64) / 2; }
__host__ __device__ __forceinline__ int perm32(int rho) { const int n = rho >> 4, i = rho & 15; return 8 * (i >> 2) + 4 * n + (i & 3); }
struct Unit { int pm, pn; };
struct Gemm { const bf16_t* A; const bf16_t* Bt; int M, N, K; };
struct StaticOrder {
    int nM, nN, nwg, G, c;
    __device__ void init(int M, int N, int G_, int c_) { nM = M / BM; nN = N / BM; nwg = nM * nN; G = G_; c = c_; }
    __device__ bool next(int i, Unit& u) const {
        const long L = (long)i * G + c; if (L >= nwg) return false;
        int wgid = (int)L; { const int q = nwg / NXCD, r = nwg % NXCD, xcd = wgid % NXCD, off = wgid / NXCD; wgid = (xcd < r ? xcd * (q + 1) : r * (q + 1) + (xcd - r) * q) + off; }
        const int nig = WGM * nN, gid = wgid / nig, fm = gid * WGM, gsz = (nM - fm) < WGM ? (nM - fm) : WGM;
        u.pm = fm + ((wgid % nig) % gsz); u.pn = (wgid % nig) / gsz; return true;
    }
};
template <class Epi>
__device__ __forceinline__ void gemm_phase(LAS unsigned char* lds, const Gemm g, const StaticOrder& S, const Epi& E) {
    int tid_ = threadIdx.x; asm volatile("" : "+v"(tid_));
    const int tid = tid_, wid = __builtin_amdgcn_readfirstlane(tid >> 6), lane = tid & 63, wr = wid >> 2, wc = wid & 3, fr = lane & 15, fq = lane >> 4;
    const int K = g.K, nt = K / BK;
    unsigned voffA[2], voffB[2];
#pragma unroll
    for (int i = 0; i < 2; ++i) { int R, C; stage_rc(tid * 16 + i * 8192, R, C); const int Rb = Epi::PERM ? ((R & ~31) + perm32(R & 31)) : R;
        voffA[i] = (unsigned)(R * K + C) * 2u; voffB[i] = (unsigned)(Rb * K + C) * 2u; }
    const size_t kstep = (size_t)(BK * 2);
    const size_t hstep = (size_t)HALF * K * 2;
    const size_t tstep = 2 * hstep;
    const unsigned ldsw = (unsigned)wid * 1024u;
    const int aoff = lds_byte(wr * 64 + fr, fq * 8), boff = lds_byte(wc * 32 + fr, fq * 8);
#define PG8_SA(b, h) (((b) * 2 + (h)) * HTB)
#define PG8_SB(b, h) ((4 + (b) * 2 + (h)) * HTB)
#define PG8_STAGE(bufoff, gbase, voff) do { _Pragma("unroll") for (int _i = 0; _i < 2; ++_i) \
        __builtin_amdgcn_global_load_lds((const unsigned*)((const char*)(gbase) + (voff)[_i]), (LAS unsigned*)(lds + (bufoff) + ldsw + _i * 8192), 16, 0, 0); } while (0)
#define PG8_LDA(dst, b, h) do { _Pragma("unroll") for (int m = 0; m < 4; ++m) _Pragma("unroll") for (int k = 0; k < 2; ++k) dst[m][k] = *(const LAS bf16x8*)(lds + PG8_SA(b, h) + aoff + m * 2048 + k * 1024); } while (0)
#define PG8_LDB(dst, b, h) do { _Pragma("unroll") for (int n = 0; n < 2; ++n) _Pragma("unroll") for (int k = 0; k < 2; ++k) dst[n][k] = *(const LAS bf16x8*)(lds + PG8_SB(b, h) + boff + n * 2048 + k * 1024); } while (0)
#define PG8_MMA(ai, bj, At, Bt) do { __builtin_amdgcn_s_setprio(1); _Pragma("unroll") for (int m = 0; m < 4; ++m) _Pragma("unroll") for (int n = 0; n < 2; ++n) _Pragma("unroll") for (int k = 0; k < 2; ++k) \
        acc[ai][bj][m][n] = __builtin_amdgcn_mfma_f32_16x16x32_bf16(Bt[n][k], At[m][k], acc[ai][bj][m][n], 0, 0, 0); __builtin_amdgcn_s_setprio(0); } while (0)
#define PG8_WAIT_V(n) asm volatile("s_waitcnt vmcnt(" #n ")" ::: "memory")
#define PG8_WAIT_L(n) asm volatile("s_waitcnt lgkmcnt(" #n ")" ::: "memory")
#define PG8_BAR __builtin_amdgcn_s_barrier()
#define PG8_SCHED __builtin_amdgcn_sched_barrier(0)
    Unit cur, nxt; int ui = 0;
    if (!S.next(0, cur)) return;
    f32x4 acc[2][2][4][2];
#pragma unroll
    for (int a = 0; a < 2; ++a)
#pragma unroll
        for (int b = 0; b < 2; ++b)
#pragma unroll
            for (int m = 0; m < 4; ++m)
#pragma unroll
                for (int n = 0; n < 2; ++n) acc[a][b][m][n] = (f32x4){0.f, 0.f, 0.f, 0.f};
    bf16x8 At[4][2], B0[2][2], B1[2][2];
    const char* cA = (const char*)g.A + (size_t)cur.pm * tstep; const char* cB = (const char*)g.Bt + (size_t)cur.pn * tstep;
    PG8_STAGE(PG8_SB(0, 0), cB, voffB); PG8_STAGE(PG8_SB(0, 1), cB + hstep, voffB); PG8_STAGE(PG8_SA(0, 0), cA, voffA); PG8_STAGE(PG8_SA(0, 1), cA + hstep, voffA);
    if (wr == 1) PG8_BAR;
    PG8_WAIT_V(2); PG8_BAR;
    PG8_STAGE(PG8_SB(1, 0), cB + kstep, voffB); PG8_STAGE(PG8_SA(1, 0), cA + kstep, voffA); PG8_STAGE(PG8_SB(1, 1), cB + hstep + kstep, voffB);
    PG8_WAIT_V(6); PG8_BAR;
    for (;;) {
        const bool has_next = S.next(ui + 1, nxt);
        const char* nA = has_next ? (const char*)g.A + (size_t)nxt.pm * tstep : cA; const char* nB = has_next ? (const char*)g.Bt + (size_t)nxt.pn * tstep : cB;
        for (int t = 0; t < nt; t += 2) {
            const bool last = (t == nt - 2);
            const char* a1 = cA + (size_t)(t + 1) * kstep;
            const char* a2 = last ? nA : cA + (size_t)(t + 2) * kstep; const char* b2 = last ? nB : cB + (size_t)(t + 2) * kstep;
            const char* a3 = a2 + kstep; const char* b3 = b2 + kstep;
            PG8_LDB(B0, 0, 0); PG8_LDB(B1, 0, 1); PG8_SCHED; PG8_LDA(At, 0, 0); PG8_STAGE(PG8_SA(1, 1), a1 + hstep, voffA);
            PG8_WAIT_V(8); PG8_WAIT_L(0); PG8_BAR; PG8_MMA(0, 0, At, B0); PG8_MMA(0, 1, At, B1); PG8_BAR; PG8_SCHED;
            PG8_LDA(At, 0, 1); PG8_STAGE(PG8_SB(0, 0), b2, voffB); PG8_STAGE(PG8_SB(0, 1), b2 + hstep, voffB); PG8_STAGE(PG8_SA(0, 0), a2, voffA);
            PG8_WAIT_V(8); PG8_WAIT_L(0); PG8_BAR; PG8_MMA(1, 0, At, B0); PG8_MMA(1, 1, At, B1); PG8_BAR; PG8_SCHED;
            PG8_LDB(B0, 1, 0); PG8_LDB(B1, 1, 1); PG8_SCHED; PG8_LDA(At, 1, 0); PG8_STAGE(PG8_SA(0, 1), a2 + hstep, voffA);
            PG8_WAIT_V(8); PG8_WAIT_L(0); PG8_BAR; PG8_MMA(0, 0, At, B0); PG8_MMA(0, 1, At, B1); PG8_BAR; PG8_SCHED;
            PG8_LDA(At, 1, 1); PG8_STAGE(PG8_SB(1, 0), b3, voffB); PG8_STAGE(PG8_SB(1, 1), b3 + hstep, voffB); PG8_STAGE(PG8_SA(1, 0), a3, voffA);
            PG8_WAIT_V(8); PG8_WAIT_L(0); PG8_BAR; PG8_MMA(1, 0, At, B0); PG8_MMA(1, 1, At, B1); PG8_BAR; PG8_SCHED;
        }
        if (wr == 0) PG8_BAR;
        E(acc, cur, ui, wr, wc, fr, fq);
        if (!has_next) break;
#pragma unroll
        for (int a = 0; a < 2; ++a)
#pragma unroll
            for (int b = 0; b < 2; ++b)
#pragma unroll
                for (int m = 0; m < 4; ++m)
#pragma unroll
                    for (int n = 0; n < 2; ++n) acc[a][b][m][n] = (f32x4){0.f, 0.f, 0.f, 0.f};
        cur = nxt; cA = nA; cB = nB; ++ui;
        if (wr == 1) PG8_BAR;
    }
    PG8_WAIT_V(0);
    PG8_BAR;
#undef PG8_SA
#undef PG8_SB
#undef PG8_STAGE
#undef PG8_LDA
#undef PG8_LDB
#undef PG8_MMA
#undef PG8_WAIT_V
#undef PG8_WAIT_L
#undef PG8_BAR
#undef PG8_SCHED
}

struct EpiProj {
    static constexpr bool PERM = true;
    bf16_t* O; int ldc; const LAS float* rst;
    __device__ __forceinline__ void operator()(const f32x4 (&acc)[2][2][4][2], const Unit& u, int ui, int wr, int wc, int fr, int fq) const {
        const int row0 = u.pm * BM + wr * 64 + fr, col0 = u.pn * BM + wc * 32 + 8 * fq;
#pragma unroll
        for (int ai = 0; ai < 2; ++ai)
#pragma unroll
            for (int m = 0; m < 4; ++m) { const int row = row0 + ai * HALF + m * 16; bf16_t* rowp = O + (size_t)row * ldc + col0;
                const float rs = rst ? rst[ui * 256 + (row & 255)] : 1.0f;
#pragma unroll
                for (int bj = 0; bj < 2; ++bj) { const f32x4 v0 = acc[ai][bj][m][0] * rs, v1 = acc[ai][bj][m][1] * rs;
                    u32x4 w; w.x = pk2(v0[0], v0[1]); w.y = pk2(v0[2], v0[3]); w.z = pk2(v1[0], v1[1]); w.w = pk2(v1[2], v1[3]);
                    *(u32x4*)(rowp + bj * HALF) = w; } }
    }
};
struct EpiResid {
    static constexpr bool PERM = true;
    bf16_t* HB; float* ssq;
    __device__ __forceinline__ void operator()(const f32x4 (&acc)[2][2][4][2], const Unit& u, int ui, int wr, int wc, int fr, int fq) const {
        const int row0 = u.pm * BM + wr * 64 + fr, col0 = u.pn * BM + wc * 32 + 8 * fq;
#pragma unroll
        for (int ai = 0; ai < 2; ++ai) {
            u32x4 hv[4][2];
#pragma unroll
            for (int m = 0; m < 4; ++m)
#pragma unroll
                for (int bj = 0; bj < 2; ++bj) hv[m][bj] = *(const u32x4*)(HB + (size_t)(row0 + ai * HALF + m * 16) * DM + col0 + bj * HALF);
            __builtin_amdgcn_sched_barrier(0);
#pragma unroll
            for (int m = 0; m < 4; ++m) { const int row = row0 + ai * HALF + m * 16; bf16_t* rowb = HB + (size_t)row * DM + col0;
                float q = 0.f;
#pragma unroll
                for (int bj = 0; bj < 2; ++bj) { const u32x4 hw = hv[m][bj]; const f32x4 v0 = acc[ai][bj][m][0], v1 = acc[ai][bj][m][1];
                    u32x4 w;
                    w.x = pk2(bf2f(hw.x & 0xffffu) + v0[0], bf2f(hw.x >> 16) + v0[1]); w.y = pk2(bf2f(hw.y & 0xffffu) + v0[2], bf2f(hw.y >> 16) + v0[3]);
                    w.z = pk2(bf2f(hw.z & 0xffffu) + v1[0], bf2f(hw.z >> 16) + v1[1]); w.w = pk2(bf2f(hw.w & 0xffffu) + v1[2], bf2f(hw.w >> 16) + v1[3]);
                    *(u32x4*)(rowb + bj * HALF) = w;
                    const float r0 = bf2f(w.x & 0xffffu), r1 = bf2f(w.x >> 16), r2 = bf2f(w.y & 0xffffu), r3 = bf2f(w.y >> 16), r4 = bf2f(w.z & 0xffffu), r5 = bf2f(w.z >> 16), r6 = bf2f(w.w & 0xffffu), r7 = bf2f(w.w >> 16);
                    q += ((r0 * r0 + r1 * r1) + (r2 * r2 + r3 * r3)) + ((r4 * r4 + r5 * r5) + (r6 * r6 + r7 * r7)); }
                q += __shfl_xor(q, 16); q += __shfl_xor(q, 32);
                if (fq == 0) ssq[(size_t)row * 16 + u.pn * 4 + wc] = q; }
            __builtin_amdgcn_sched_barrier(0);
        }
    }
};
struct EpiLora {
    static constexpr bool PERM = true;
    bf16_t* O; const float* bias;
    __device__ __forceinline__ void operator()(const f32x4 (&acc)[2][2][4][2], const Unit& u, int ui, int wr, int wc, int fr, int fq) const {
        const int row0 = u.pm * BM + wr * 64 + fr, col0 = u.pn * BM + wc * 32 + 8 * fq, mode = u.pn >> 1;
        const float sc = (mode == 0) ? 0.60653066f : 1.0f;
#pragma unroll
        for (int bj = 0; bj < 2; ++bj) {
            const f32x4 c0 = *(const f32x4*)(bias + col0 + bj * HALF), c1 = *(const f32x4*)(bias + col0 + bj * HALF + 4);
#pragma unroll
            for (int ai = 0; ai < 2; ++ai)
#pragma unroll
                for (int m = 0; m < 4; ++m) { bf16_t* rowp = O + (size_t)(row0 + ai * HALF + m * 16) * NL + col0 + bj * HALF;
                    f32x4 v0 = acc[ai][bj][m][0] + c0, v1 = acc[ai][bj][m][1] + c1;
                    if (mode != 2) {
#pragma unroll
                        for (int j = 0; j < 4; ++j) { v0[j] = sc * sigmoidf_(v0[j]); v1[j] = sc * sigmoidf_(v1[j]); } }
                    u32x4 w; w.x = pk2(v0[0], v0[1]); w.y = pk2(v0[2], v0[3]); w.z = pk2(v1[0], v1[1]); w.w = pk2(v1[2], v1[3]);
                    *(u32x4*)rowp = w; }
        }
    }
};
struct EpiSwiglu {
    static constexpr bool PERM = true;
    bf16_t* O; const LAS float* rst;
    __device__ __forceinline__ void operator()(const f32x4 (&acc)[2][2][4][2], const Unit& u, int ui, int wr, int wc, int fr, int fq) const {
        const int row0 = u.pm * BM + wr * 64 + fr, col0 = u.pn * 128 + wc * 16 + 4 * fq;
#pragma unroll
        for (int ai = 0; ai < 2; ++ai)
#pragma unroll
            for (int m = 0; m < 4; ++m) { const int row = row0 + ai * HALF + m * 16; bf16_t* rowp = O + (size_t)row * DFF + col0;
                const float rs = rst[ui * 256 + (row & 255)];
#pragma unroll
                for (int bj = 0; bj < 2; ++bj) { const f32x4 gt = acc[ai][bj][m][0] * rs, up = acc[ai][bj][m][1] * rs; float o[4];
#pragma unroll
                    for (int j = 0; j < 4; ++j) o[j] = gt[j] * sigmoidf_(gt[j]) * up[j];
                    u32x2 w; w.x = pk2(o[0], o[1]); w.y = pk2(o[2], o[3]);
                    *(u32x2*)(rowp + bj * 64) = w; } }
    }
};
}

__device__ __forceinline__ void build_rs_table(LAS float* rst, const pg8::StaticOrder& S, const float* ssp) {
    const int tid = tid_opaque();
    pg8::Unit u;
    for (int i = 0; S.next(i, u); ++i) if (tid < 256) rst[i * 256 + tid] = row_rs(ssp, u.pm * 256 + tid);
    __syncthreads();
}
template <int KIND, int NB>
__device__ __forceinline__ void tail16(const bf16_t* A, const bf16_t* Bt, int N, int K, bf16_t* Out, int ldo, const float* ssp, float* ssq, LAS float* red, const float* lbias = nullptr) {
    const int tid = tid_opaque(), wid = __builtin_amdgcn_readfirstlane(tid >> 6), lane = tid & 63, fr = lane & 15, fq = lane >> 4;
    const int ntile = (KIND == 2) ? N / 32 : N / (16 * NB), nks = K >> 7;
    const int row = MAIN_ROWS + fr;
    for (int tile = blockIdx.x; tile < ntile; tile += gridDim.x) {
        f32x4 acc[NB];
#pragma unroll
        for (int be = 0; be < NB; ++be) acc[be] = (f32x4){0.f, 0.f, 0.f, 0.f};
        const bf16_t* ap = A + (size_t)row * K + fq * 8;
        const bf16_t* bp[NB];
        if (KIND == 2) { const int f = tile * 16 + fr, pn = f >> 7, ft = f & 127, r0 = pn * 256 + ((ft >> 2) << 3) + (ft & 3); bp[0] = Bt + (size_t)r0 * K + fq * 8; bp[1] = Bt + (size_t)(r0 + 4) * K + fq * 8; }
        else {
#pragma unroll
            for (int be = 0; be < NB; ++be) bp[be] = Bt + (size_t)(tile * 16 * NB + be * 16 + fr) * K + fq * 8; }
        for (int ks = wid; ks < nks; ks += 8) {
            bf16x8 av[4], bv[NB][4];
#pragma unroll
            for (int u = 0; u < 4; ++u) { av[u] = *(const bf16x8*)(ap + ks * 128 + u * 32);
#pragma unroll
                for (int be = 0; be < NB; ++be) bv[be][u] = *(const bf16x8*)(bp[be] + ks * 128 + u * 32); }
            __builtin_amdgcn_sched_barrier(0);
#pragma unroll
            for (int u = 0; u < 4; ++u)
#pragma unroll
                for (int be = 0; be < NB; ++be) acc[be] = __builtin_amdgcn_mfma_f32_16x16x32_bf16(bv[be][u], av[u], acc[be], 0, 0, 0);
        }
#pragma unroll
        for (int be = 0; be < NB; ++be) *(LAS f32x4*)(red + ((wid * NB + be) * 64 + lane) * 4) = acc[be];
        __syncthreads();
        if (wid == 0) {
#pragma unroll
            for (int be = 0; be < NB; ++be) { f32x4 t = *(const LAS f32x4*)(red + (be * 64 + lane) * 4);
#pragma unroll
                for (int w = 1; w < 8; ++w) t += *(const LAS f32x4*)(red + ((w * NB + be) * 64 + lane) * 4);
                acc[be] = t; }
            if (KIND == 0) {
                const float rs = ssp ? row_rs(ssp, row) : 1.0f;
#pragma unroll
                for (int be = 0; be < NB; ++be) { const int col = tile * 16 * NB + be * 16 + fq * 4; f32x4 v = acc[be] * rs;
                    if (lbias) { const int mode = col >> 9;
                        if (mode != 2) { const float sc = (mode == 0) ? 0.60653066f : 1.0f;
#pragma unroll
                            for (int j = 0; j < 4; ++j) v[j] = sc * sigmoidf_(v[j] + lbias[col + j]); } }
                    u32x2 w; w.x = pk2(v[0], v[1]); w.y = pk2(v[2], v[3]);
                    *(u32x2*)(Out + (size_t)row * ldo + col) = w; }
            } else if (KIND == 1) {
                float q = 0.f;
#pragma unroll
                for (int be = 0; be < NB; ++be) { bf16_t* o = Out + (size_t)row * ldo + tile * 16 * NB + be * 16 + fq * 4; const u32x2 hw = *(const u32x2*)o;
                    u32x2 w; w.x = pk2(bf2f(hw.x & 0xffffu) + acc[be][0], bf2f(hw.x >> 16) + acc[be][1]); w.y = pk2(bf2f(hw.y & 0xffffu) + acc[be][2], bf2f(hw.y >> 16) + acc[be][3]);
                    *(u32x2*)o = w;
                    const float r0 = bf2f(w.x & 0xffffu), r1 = bf2f(w.x >> 16), r2 = bf2f(w.y & 0xffffu), r3 = bf2f(w.y >> 16);
                    q += (r0 * r0 + r1 * r1) + (r2 * r2 + r3 * r3); }
                q += __shfl_xor(q, 16); q += __shfl_xor(q, 32);
                if (fq == 0) ssq[(size_t)row * 16 + tile] = q;
            } else {
                const float rs = row_rs(ssp, row); float v[4];
#pragma unroll
                for (int j = 0; j < 4; ++j) { const float g = acc[0][j] * rs; v[j] = g * sigmoidf_(g) * (acc[1][j] * rs); }
                u32x2 w; w.x = pk2(v[0], v[1]); w.y = pk2(v[2], v[3]);
                *(u32x2*)(Out + (size_t)row * ldo + tile * 16 + fq * 4) = w;
            }
        }
        __syncthreads();
    }
}

__device__ __forceinline__ void norm_rows(CArgs a, int mode) {
    const int tid = tid_opaque(), wid = tid >> 6, lane = tid & 63;
    bf16_t* HB = (bf16_t*)(a->ws + WS_H); float* SS = (float*)(a->ws + WS_SS);
    for (int row = blockIdx.x * 8 + wid; row < (mode == 0 ? NROWS : MAIN_ROWS); row += gridDim.x * 8) {
        float x[16]; float ss = 0.f;
        if (mode == 0) {
            const float* src = (row >= MAIN_ROWS ? a->in[1] + (size_t)(row - MAIN_ROWS) * DM : a->in[0] + (size_t)row * DM);
#pragma unroll
            for (int i = 0; i < 2; ++i) { const f32x4 v0 = *(const f32x4*)(src + lane * 8 + 512 * i), v1 = *(const f32x4*)(src + lane * 8 + 512 * i + 4);
                u32x4 w; w.x = pk2(v0[0], v0[1]); w.y = pk2(v0[2], v0[3]); w.z = pk2(v1[0], v1[1]); w.w = pk2(v1[2], v1[3]);
                *(u32x4*)(HB + (size_t)row * DM + lane * 8 + 512 * i) = w;
                float r[8]; unpack8(w, r);
#pragma unroll
                for (int e = 0; e < 8; ++e) ss += r[e] * r[e]; }
            ss = wave_sum(ss);
            if (lane < 16) SS[(size_t)row * 16 + lane] = (lane == 0) ? ss : 0.f;
        } else {
#pragma unroll
            for (int i = 0; i < 2; ++i) { float r[8]; unpack8(*(const u32x4*)(HB + (size_t)row * DM + lane * 8 + 512 * i), r);
#pragma unroll
                for (int e = 0; e < 8; ++e) { x[i * 8 + e] = r[e]; ss += r[e] * r[e]; } }
            ss = wave_sum(ss);
            const float rs = rsqrtf(ss * (1.0f / DM) + RMS_EPS);
            float* o = a->out + (size_t)row * DM;
#pragma unroll
            for (int i = 0; i < 2; ++i) { const f32x4 g0 = *(const f32x4*)(a->in[25] + lane * 8 + 512 * i), g1 = *(const f32x4*)(a->in[25] + lane * 8 + 512 * i + 4);
                *(f32x4*)(o + lane * 8 + 512 * i) = (f32x4){x[i * 8] * rs * g0[0], x[i * 8 + 1] * rs * g0[1], x[i * 8 + 2] * rs * g0[2], x[i * 8 + 3] * rs * g0[3]};
                *(f32x4*)(o + lane * 8 + 512 * i + 4) = (f32x4){x[i * 8 + 4] * rs * g1[0], x[i * 8 + 5] * rs * g1[1], x[i * 8 + 6] * rs * g1[2], x[i * 8 + 7] * rs * g1[3]}; }
        }
    }
}

template <int KIND> __device__ __forceinline__ float wsrc(CArgs a, int l, int k, int n) {
    if (KIND == 0) {
        const float gk = a->in[2][(size_t)l * DM + k];
        if (n < NIN) return gk * a->in[3][((size_t)l * DM + k) * NIN + n];
        if (n < NIN + 32 && l > 0) return gk * a->in[17][((size_t)(l - 1) * DM + k) * 32 + (n - NIN)];
        return 0.f;
    } else if (KIND == 1) {
        return a->in[21][((size_t)l * DM + k) * DM + n];
    } else if (KIND == 2) {
        const int pn = n >> 8, c = n & 255, feat = pn * 128 + ((c >> 3) << 2) + (c & 3), isup = (c >> 2) & 1;
        return a->in[22][(size_t)l * DM + k] * a->in[23][((size_t)l * DM + k) * (2 * DFF) + feat + isup * DFF];
    } else if (KIND == 3) {
        return a->in[24][((size_t)l * DFF + k) * DM + n];
    } else {
        const int j = n >> 9, nn = n & 511;
        if (j == 0) return (k < 64) ? a->in[8][((size_t)l * 64 + k) * 512 + nn] : 0.f;
        if (j == 1) return (k >= 64 && k < 128) ? a->in[10][((size_t)l * 64 + (k - 64)) * 512 + nn] : 0.f;
        if (j == 2) return (k >= 128 && k < 288) ? a->in[11][((size_t)l * 160 + (k - 128)) * 512 + nn] : 0.f;
        return (k >= 288 && k < 320 && l > 0) ? a->in[20][((size_t)(l - 1) * 32 + (k - 288)) * 512 + nn] : 0.f;
    }
}
template <int KIND> __device__ __forceinline__ void conv_tile(CArgs a, int l, LAS float* tile, bf16_t* out, int ldo, int n0, int k0) {
    const int tid = tid_opaque(), kk = tid >> 6, nn = tid & 63;
#pragma unroll
    for (int i = 0; i < 8; ++i) tile[(kk + 8 * i) * 65 + nn] = wsrc<KIND>(a, l, k0 + kk + 8 * i, n0 + nn);
    __syncthreads();
    const int n = tid >> 3, kq = tid & 7;
    u32x4 w;
    w.x = pk2(tile[(kq * 8 + 0) * 65 + n], tile[(kq * 8 + 1) * 65 + n]); w.y = pk2(tile[(kq * 8 + 2) * 65 + n], tile[(kq * 8 + 3) * 65 + n]);
    w.z = pk2(tile[(kq * 8 + 4) * 65 + n], tile[(kq * 8 + 5) * 65 + n]); w.w = pk2(tile[(kq * 8 + 6) * 65 + n], tile[(kq * 8 + 7) * 65 + n]);
    *(u32x4*)(out + (size_t)(n0 + n) * ldo + k0 + kq * 8) = w;
    __syncthreads();
}
__device__ __forceinline__ void fold_tile(CArgs a, int l, LAS float* lds, bf16_t* out, int n0, int k0) {
    LAS float* P = lds; LAS float* W = lds + 64 * 128;
    const int tid = tid_opaque(), g = k0 >> 7, c0 = k0 & 127;
    const float* pw = a->in[5] + ((size_t)(l * 4 + g) * 128 + c0) * 128; const float* sc = a->in[6] + (size_t)l * 512 + g * 128;
    const float* wo = a->in[21] + ((size_t)l * DM + g * 128) * DM + n0;
    for (int i = tid; i < 64 * 128; i += 512) { const int d = i & 127; P[i] = pw[i] * sc[d]; }
    for (int i = tid; i < 128 * 64; i += 512) { const int d = i >> 6, n = i & 63; W[i] = wo[(size_t)d * DM + n]; }
    __syncthreads();
    const int n = tid & 63, cq = tid >> 6;
    float acc[8];
#pragma unroll
    for (int j = 0; j < 8; ++j) acc[j] = 0.f;
    for (int d = 0; d < 128; ++d) { const float wv = W[d * 64 + n];
#pragma unroll
        for (int j = 0; j < 8; ++j) acc[j] += P[(cq * 8 + j) * 128 + d] * wv; }
    u32x4 w; w.x = pk2(acc[0], acc[1]); w.y = pk2(acc[2], acc[3]); w.z = pk2(acc[4], acc[5]); w.w = pk2(acc[6], acc[7]);
    *(u32x4*)(out + (size_t)(n0 + n) * DM + k0 + cq * 8) = w;
    __syncthreads();
}
__device__ __forceinline__ void weight_prep(CArgs a, int l, LAS float* lds, int b0, int nb) {
    unsigned char* wb = a->ws + WS_WB + (size_t)(l & 1) * WB_SIZE;
    bf16_t* WC = (bf16_t*)(wb + WB_WC); bf16_t* WO = (bf16_t*)(wb + WB_WOUT); bf16_t* WGU = (bf16_t*)(wb + WB_WGU); bf16_t* WDN = (bf16_t*)(wb + WB_WDN); bf16_t* WL = (bf16_t*)(wb + WB_WL);
    for (int ti = (int)blockIdx.x - b0; ti < 3201; ti += nb) {
        if (ti == 3200) { float* LB = (float*)(wb + WB_LB); const int t0 = tid_opaque();
            for (int i = t0; i < NL; i += 512) { const int j = i >> 9, nn = i & 511; LB[i] = (j == 0) ? a->in[7][l * 512 + nn] : (j == 1) ? a->in[9][l * 512 + nn] : (j == 3 && l > 0) ? a->in[19][(l - 1) * 512 + nn] : 0.f; }
            continue; }
        if (ti < 128) { fold_tile(a, l, lds, WO, (ti & 15) * 64, (ti >> 4) * 64); }
        else if (ti < 256) { const int q = ti - 128; conv_tile<1>(a, l, lds, WO, DM, (q & 15) * 64, 512 + (q >> 4) * 64); }
        else if (ti < 896) { const int q = ti - 256; conv_tile<0>(a, l, lds, WC, DM, (q >> 4) * 64, (q & 15) * 64); }
        else if (ti < 2304) { const int q = ti - 896; conv_tile<2>(a, l, lds, WGU, DM, (q >> 4) * 64, (q & 15) * 64); }
        else if (ti < 3008) { const int q = ti - 2304; conv_tile<3>(a, l, lds, WDN, DFF, (q / 44) * 64, (q % 44) * 64); }
        else { const int q = ti - 3008; conv_tile<4>(a, l, lds, WL, KL, (q / 6) * 64, (q % 6) * 64); }
    }
}

__device__ __forceinline__ void prep_phase(CArgs a, int l, int part, int b0, int nb) {
    const bf16_t* PROJ = (const bf16_t*)(a->ws + WS_R1);
    bf16_t* MIX = (bf16_t*)((unsigned char*)a->out + DO_MIX); bf16_t* LIN = (bf16_t*)((unsigned char*)a->out + DO_LIN);
    const int tid = tid_opaque(), gt = ((int)blockIdx.x - b0) * 512 + tid, nthr = nb * 512;
    if (part == 1)
    for (int it = gt; it < (MAIN_ROWS / 16 + 1) * 64; it += nthr) {
        const int run = it >> 6, c0 = (it & 63) * 8, win = 2 << (c0 >> 7);
        const int b = run >> 7, t0 = (run < MAIN_ROWS / 16) ? NMETA + (run & 127) * 16 : 0;
        float s[8], x[8], y[8];
#pragma unroll
        for (int e = 0; e < 8; ++e) s[e] = 0.f;
        const int pre = (t0 < win) ? t0 : win;
        for (int q = 1; q <= pre; ++q) { unpack8(*(const u32x4*)(PROJ + (size_t)row_of(b, t0 - q) * NPROJ + c0), x);
#pragma unroll
            for (int e = 0; e < 8; ++e) s[e] += x[e]; }
        for (int i = 0; i < 16; ++i) {
            const int t = t0 + i, row = row_of(b, t);
            unpack8(*(const u32x4*)(PROJ + (size_t)row * NPROJ + c0), x);
            if (t >= win) { unpack8(*(const u32x4*)(PROJ + (size_t)row_of(b, t - win) * NPROJ + c0), y);
#pragma unroll
                for (int e = 0; e < 8; ++e) s[e] += x[e] - y[e]; }
            else {
#pragma unroll
                for (int e = 0; e < 8; ++e) s[e] += x[e]; }
            const float inv = 1.0f / (float)((t + 1 < win) ? t + 1 : win);
            u32x4 o; o.x = pk2(s[0] * inv - x[0], s[1] * inv - x[1]); o.y = pk2(s[2] * inv - x[2], s[3] * inv - x[3]);
            o.z = pk2(s[4] * inv - x[4], s[5] * inv - x[5]); o.w = pk2(s[6] * inv - x[6], s[7] * inv - x[7]);
            *(u32x4*)(MIX + (size_t)row * DM + c0) = o;
        }
    }
    if (part == 0)
    for (int it = gt; it < NROWS * 48; it += nthr) {
        const int row = it / 48, cb = (it - row * 48) * 8;
        const int prow = (row >= MAIN_ROWS) ? (row > MAIN_ROWS ? row - 1 : -1) : ((row & (SEQ - 1)) ? row - 1 : NROWS - 1);
        u32x4 o = (u32x4){0u, 0u, 0u, 0u};
        if (cb < 320) {
            float xc[8], xp[8], mu[8], y[8];
            unpack8(*(const u32x4*)(PROJ + (size_t)row * NPROJ + 2048 + cb), xc);
            u32x4 wp = (u32x4){0u, 0u, 0u, 0u};
            if (prow >= 0) wp = *(const u32x4*)(PROJ + (size_t)prow * NPROJ + 2048 + cb);
            unpack8(wp, xp);
            const float* mp = (cb < 288) ? a->in[4] + (size_t)l * NSHIFT + 1536 + cb : a->in[18] + (l > 0 ? (l - 1) * 32 + (cb - 288) : 0);
            const f32x4 m0 = *(const f32x4*)mp, m1 = *(const f32x4*)(mp + 4);
            mu[0] = m0[0]; mu[1] = m0[1]; mu[2] = m0[2]; mu[3] = m0[3]; mu[4] = m1[0]; mu[5] = m1[1]; mu[6] = m1[2]; mu[7] = m1[3];
#pragma unroll
            for (int e = 0; e < 8; ++e) {
                const float sv = xc[e] + (xp[e] - xc[e]) * mu[e];
                y[e] = (cb < 64) ? 1.0f - 2.0f * __builtin_amdgcn_rcpf(1.0f + __builtin_amdgcn_exp2f(sv * 2.88539008f)) : (cb < 128) ? sv : (cb < 288) ? sigmoidf_(sv) : sv;
            }
            o.x = pk2(y[0], y[1]); o.y = pk2(y[2], y[3]); o.z = pk2(y[4], y[5]); o.w = pk2(y[6], y[7]);
        }
        *(u32x4*)(LIN + (size_t)row * KL + cb) = o;
    }
}

constexpr int TC = 16, NCH = TT / TC;
constexpr int SB_A = 0, SB_Q = 1, SB_W = 2, SB_B = 3, SB_K = 4, SB_V = 5, SB_G = 6, SB_Y = 7, SBUF = 8 * TC * 64 + TC * 4;
#define LDS_BARRIER() do { asm volatile("s_waitcnt lgkmcnt(0)" ::: "memory"); __builtin_amdgcn_s_barrier(); asm volatile("" ::: "memory"); } while (0)
__device__ __forceinline__ void scan_phase(CArgs a, int l, LAS float* lds) {
    const int bid = blockIdx.x; if (bid >= BATCH * 8) return;
    const int b = bid >> 3, h = bid & 7, tid = tid_opaque(), wid = __builtin_amdgcn_readfirstlane(tid >> 6), lane = tid & 63;
    const bf16_t* PROJ = (const bf16_t*)(a->ws + WS_R1); const bf16_t* LO = (const bf16_t*)(a->ws + WS_LO);
    bf16_t* VF = (bf16_t*)((unsigned char*)a->out + DO_VF); bf16_t* MIX = (bf16_t*)((unsigned char*)a->out + DO_MIX);
    if (wid < 4) {
        __builtin_amdgcn_s_setprio(2);
        const int rp = wid * 16 + (lane >> 3) * 2, seg = lane & 7;
        f32x2 S0[4], S1[4];
#pragma unroll
        for (int j = 0; j < 4; ++j) { S0[j] = (f32x2){0.f, 0.f}; S1[j] = (f32x2){0.f, 0.f}; }
        for (int it = 0; it < NCH + 2; ++it) {
            if (it >= 1 && it <= NCH) {
                LAS float* buf = lds + ((it - 1) & 1) * SBUF;
#pragma unroll 16
                for (int tl = 0; tl < TC; ++tl) {
                    const LAS float* base = buf + tl * 64 + seg * 8;
                    const f32x4 a0 = *(const LAS f32x4*)(base + SB_A * TC * 64), a1 = *(const LAS f32x4*)(base + SB_A * TC * 64 + 4);
                    const f32x4 q0 = *(const LAS f32x4*)(base + SB_Q * TC * 64), q1 = *(const LAS f32x4*)(base + SB_Q * TC * 64 + 4);
                    const f32x4 w0 = *(const LAS f32x4*)(base + SB_W * TC * 64), w1 = *(const LAS f32x4*)(base + SB_W * TC * 64 + 4);
                    const f32x4 b0 = *(const LAS f32x4*)(base + SB_B * TC * 64), b1 = *(const LAS f32x4*)(base + SB_B * TC * 64 + 4);
                    const f32x4 k0 = *(const LAS f32x4*)(base + SB_K * TC * 64), k1 = *(const LAS f32x4*)(base + SB_K * TC * 64 + 4);
                    const f32x2 vv = *(const LAS f32x2*)(buf + SB_V * TC * 64 + tl * 64 + rp);
                    const f32x2 sc = *(const LAS f32x2*)(buf + 8 * TC * 64 + tl * 4);
                    const f32x2 av[4] = {{a0[0], a0[1]}, {a0[2], a0[3]}, {a1[0], a1[1]}, {a1[2], a1[3]}};
                    const f32x2 qv[4] = {{q0[0], q0[1]}, {q0[2], q0[3]}, {q1[0], q1[1]}, {q1[2], q1[3]}};
                    const f32x2 wv[4] = {{w0[0], w0[1]}, {w0[2], w0[3]}, {w1[0], w1[1]}, {w1[2], w1[3]}};
                    const f32x2 bv[4] = {{b0[0], b0[1]}, {b0[2], b0[3]}, {b1[0], b1[1]}, {b1[2], b1[3]}};
                    const f32x2 kv[4] = {{k0[0], k0[1]}, {k0[2], k0[3]}, {k1[0], k1[1]}, {k1[2], k1[3]}};
                    f32x2 pa0 = S0[0] * av[0], pa1 = S1[0] * av[0], pq0 = S0[0] * qv[0], pq1 = S1[0] * qv[0];
#pragma unroll
                    for (int j = 1; j < 4; ++j) { pa0 += S0[j] * av[j]; pa1 += S1[j] * av[j]; pq0 += S0[j] * qv[j]; pq1 += S1[j] * qv[j]; }
                    float sa0 = pa0.x + pa0.y, sa1 = pa1.x + pa1.y, y0 = pq0.x + pq0.y, y1 = pq1.x + pq1.y;
                    allred8x4(sa0, sa1, y0, y1);
                    const f32x2 sav0 = {sa0, sa0}, sav1 = {sa1, sa1}, vv0 = {vv.x, vv.x}, vv1 = {vv.y, vv.y};
#pragma unroll
                    for (int j = 0; j < 4; ++j) { S0[j] = S0[j] * wv[j] + sav0 * bv[j] + vv0 * kv[j]; S1[j] = S1[j] * wv[j] + sav1 * bv[j] + vv1 * kv[j]; }
                    *(LAS f32x2*)(buf + SB_Y * TC * 64 + tl * 64 + rp) = (f32x2){y0 + sa0 * sc.x + vv.x * sc.y, y1 + sa1 * sc.x + vv.y * sc.y};
                }
            }
            LDS_BARRIER();
        }
        __builtin_amdgcn_s_setprio(0);
    } else {
        const int hw = wid - 4, ch = h * 64 + lane;
        const float mu_r = a->in[4][(size_t)l * NSHIFT + ch], mu_k = a->in[4][(size_t)l * NSHIFT + 512 + ch], mu_v = a->in[4][(size_t)l * NSHIFT + 1024 + ch];
        const float kk_c = a->in[12][l * 512 + ch], ka_c = a->in[13][l * 512 + ch], rk_c = a->in[14][l * 512 + ch], gw = a->in[15][l * 512 + ch], gb = a->in[16][l * 512 + ch];
        unsigned short ld[2][4][11];
#define SCAN_LOAD(c, P) do { _Pragma("unroll") for (int p = 0; p < 4; ++p) { const int t = (c) * TC + p * 4 + hw; const size_t m = (size_t)row_of(b, t); \
        const bf16_t* pr = PROJ + m * NPROJ + 512 + ch; ld[P][p][0] = pr[0]; ld[P][p][1] = pr[512]; ld[P][p][2] = pr[1024]; \
        if (t > 0) { const bf16_t* pp = PROJ + (size_t)row_of(b, t - 1) * NPROJ + 512 + ch; ld[P][p][3] = pp[0]; ld[P][p][4] = pp[512]; ld[P][p][5] = pp[1024]; } else { ld[P][p][3] = 0; ld[P][p][4] = 0; ld[P][p][5] = 0; } \
        const bf16_t* po = LO + m * NL + ch; ld[P][p][6] = po[0]; ld[P][p][7] = po[512]; ld[P][p][8] = po[1024]; ld[P][p][9] = po[1536]; \
        ld[P][p][10] = (l > 0) ? VF[m * 512 + ch] : (unsigned short)0; } } while (0)
#define PK2F(i) ((f32x2){bf2f(ld[par][2 * pp][i]), bf2f(ld[par][2 * pp + 1][i])})
        SCAN_LOAD(0, 0); SCAN_LOAD(1, 1);
        static_assert((NCH + 2) % 2 == 1, "the helper loop is unrolled by two with one trailing trip");
        for (int it2 = 0; it2 < NCH + 2; it2 += 2) {
#pragma unroll
          for (int par = 0; par < 2; ++par) { const int it = it2 + par; if (it >= NCH + 2) break;
            LAS float* buf = lds + (it & 1) * SBUF;
            if (it >= 2) {
#pragma unroll
                for (int p = 0; p < 4; ++p) {
                    const int tl = p * 4 + hw; const size_t m = (size_t)row_of(b, (it - 2) * TC + tl);
                    const float y = buf[SB_Y * TC * 64 + tl * 64 + lane];
                    float s1 = y, s2 = y * y, dum = 0.f; wave_sum3(s1, s2, dum);
                    const float mean = s1 * (1.0f / 64.0f), d = y - mean, var = fmaxf(s2 * (1.0f / 64.0f) - mean * mean, 0.f);
                    const float o = (d * rsqrtf(var + GN_EPS) * gw + gb + buf[8 * TC * 64 + tl * 4 + 2] * buf[SB_V * TC * 64 + tl * 64 + lane]) * buf[SB_G * TC * 64 + tl * 64 + lane];
                    if (it > 2 || b == 0) MIX[m * DM + 512 + ch] = (bf16_t)f2bf(o);
                }
            }
            if (it < NCH) {
#pragma unroll
                for (int pp = 0; pp < 2; ++pp) {
                    const int tl0 = (2 * pp) * 4 + hw, tl1 = tl0 + 4;
                    const f32x2 rc = PK2F(0), kc = PK2F(1), vc = PK2F(2), rpv = PK2F(3), kp = PK2F(4), vp = PK2F(5);
                    const f32x2 e = PK2F(6), av = PK2F(7), gv = PK2F(8), vm = PK2F(9);
                    const f32x2 r = rc + (rpv - rc) * mu_r, k = kc + (kp - kc) * mu_k; f32x2 v = vc + (vp - vc) * mu_v;
                    if (l == 0) {
                        if (it > 0 || b == 0) { VF[(size_t)row_of(b, it * TC + tl0) * 512 + ch] = (bf16_t)f2bf(v.x); VF[(size_t)row_of(b, it * TC + tl1) * 512 + ch] = (bf16_t)f2bf(v.y); }
                    } else { const f32x2 vf = PK2F(10); v = v + (vf - v) * vm; }
                    f32x2 kk = k * kk_c; f32x2 n2 = kk * kk; float n2a = n2.x, n2b = n2.y, dum = 0.f; wave_sum3(n2a, n2b, dum);
                    kk = kk * (f32x2){rsqrtf(fmaxf(n2a, 1e-24f)), rsqrtf(fmaxf(n2b, 1e-24f))};
                    const f32x2 k2 = k * ((av - 1.0f) * ka_c + 1.0f), bb = kk * av;
                    const f32x2 w = {__builtin_amdgcn_exp2f(e.x * -1.44269504f), __builtin_amdgcn_exp2f(e.y * -1.44269504f)};
                    const f32x2 brv = bb * r, krv = k2 * r, cfv = krv * rk_c, q = w * r;
                    float br0 = brv.x, kr0 = krv.x, cf0 = cfv.x, br1 = brv.y, kr1 = krv.y, cf1 = cfv.y; wave_sum3(br0, kr0, cf0); wave_sum3(br1, kr1, cf1);
                    buf[SB_A * TC * 64 + tl0 * 64 + lane] = -kk.x; buf[SB_Q * TC * 64 + tl0 * 64 + lane] = q.x; buf[SB_W * TC * 64 + tl0 * 64 + lane] = w.x;
                    buf[SB_B * TC * 64 + tl0 * 64 + lane] = bb.x; buf[SB_K * TC * 64 + tl0 * 64 + lane] = k2.x; buf[SB_V * TC * 64 + tl0 * 64 + lane] = v.x; buf[SB_G * TC * 64 + tl0 * 64 + lane] = gv.x;
                    buf[SB_A * TC * 64 + tl1 * 64 + lane] = -kk.y; buf[SB_Q * TC * 64 + tl1 * 64 + lane] = q.y; buf[SB_W * TC * 64 + tl1 * 64 + lane] = w.y;
                    buf[SB_B * TC * 64 + tl1 * 64 + lane] = bb.y; buf[SB_K * TC * 64 + tl1 * 64 + lane] = k2.y; buf[SB_V * TC * 64 + tl1 * 64 + lane] = v.y; buf[SB_G * TC * 64 + tl1 * 64 + lane] = gv.y;
                    if (lane < 3) { buf[8 * TC * 64 + tl0 * 4 + lane] = (lane == 0) ? br0 : (lane == 1) ? kr0 : cf0; buf[8 * TC * 64 + tl1 * 4 + lane] = (lane == 0) ? br1 : (lane == 1) ? kr1 : cf1; }
                }
                if (it + 2 < NCH) SCAN_LOAD(it + 2, par);
            }
            LDS_BARRIER();
          }
        }
#undef PK2F
#undef SCAN_LOAD
    }
}


#define XB_TMO      128
#define XB_XCNT(j)  (256  + 64 * (j))
#define XB_XSUB(j)  (1280 + 64 * (j))
#define XB_XGEN(j)  (2304 + 64 * (j))
#define XB_TOP      3328
#define XB_TOPGEN   3392
#define XCD_BAR_WORDS 3456
#define XB_SPIN_CAP (1u << 22)
__device__ __forceinline__ unsigned xb_ld(unsigned* p)              { return __hip_atomic_load(p, __ATOMIC_RELAXED, __HIP_MEMORY_SCOPE_AGENT); }
__device__ __forceinline__ unsigned xb_add(unsigned* p, unsigned v) { return __hip_atomic_fetch_add(p, v, __ATOMIC_RELAXED, __HIP_MEMORY_SCOPE_AGENT); }
__device__ __forceinline__ unsigned xb_xcc_id() { return (unsigned)__builtin_amdgcn_s_getreg((3 << 11) | 20) & 0xFu; }
#define XB_SPIN(cond, bar) do { unsigned _sp = 0; while (cond) { __builtin_amdgcn_s_sleep(1); \
    if ((++_sp & 255u) == 0u) { if (xb_ld(&(bar)[XB_TMO])) break; if (_sp > XB_SPIN_CAP) { atomicAdd(&(bar)[XB_TMO], 1u); break; } } } } while (0)
struct XcdBarrier { unsigned* bar; unsigned x; volatile LAS unsigned* st; };
__device__ __forceinline__ void xcd_barrier_complete(unsigned* bar, unsigned x, unsigned& nloc, unsigned& nx) {
    const unsigned G = gridDim.x;
    unsigned sum, cnt, mine, sp = 0u;
    for (;;) {
        sum = 0u; cnt = 0u; mine = 0u;
#pragma unroll
        for (unsigned j = 0; j < 16; ++j) { const unsigned c = xb_ld(&bar[XB_XCNT(j)]); sum += c; cnt += (c > 0u) ? 1u : 0u; mine = (j == x) ? c : mine; }
        if (sum == G) break;
        __builtin_amdgcn_s_sleep(1);
        if ((++sp & 255u) == 0u) { if (xb_ld(&bar[XB_TMO])) break; if (sp > XB_SPIN_CAP) { atomicAdd(&bar[XB_TMO], 1u); break; } }
    }
    nloc = mine > 0u ? mine : 1u; nx = cnt > 0u ? cnt : 1u;
}
__device__ __forceinline__ void xcd_barrier(const XcdBarrier& b, bool leader_thread) {
    asm volatile("s_waitcnt vmcnt(0)" ::: "memory");
    __syncthreads();
    if (leader_thread) {
        unsigned* bar = b.bar;
        __builtin_amdgcn_s_waitcnt(0);
        unsigned nloc = b.st[0], nx = b.st[1];
        if (nloc == 0u) { xcd_barrier_complete(bar, b.x, nloc, nx); b.st[0] = nloc; b.st[1] = nx; }
        const unsigned old = xb_add(&bar[XB_XSUB(b.x)], 1u);
        const unsigned gen = old / nloc;
        if (old + 1u == (gen + 1u) * nloc) {
            __builtin_amdgcn_fence(__ATOMIC_RELEASE, "agent");
            asm volatile("s_waitcnt vmcnt(0)" ::: "memory");
            const unsigned og = xb_add(&bar[XB_TOP], 1u);
            const unsigned tg = og / nx;
            if (og + 1u == (tg + 1u) * nx) xb_add(&bar[XB_TOPGEN], 1u);
            else XB_SPIN(xb_ld(&bar[XB_TOPGEN]) == tg, bar);
            __builtin_amdgcn_fence(__ATOMIC_ACQUIRE, "agent");
            xb_add(&bar[XB_XGEN(b.x)], 1u);
            asm volatile("s_waitcnt vmcnt(0)" ::: "memory");
        } else {
            XB_SPIN(xb_ld(&bar[XB_XGEN(b.x)]) == gen, bar);
            __builtin_amdgcn_fence(__ATOMIC_ACQUIRE, "agent");
            asm volatile("s_waitcnt vmcnt(0)" ::: "memory");
        }
    }
    __syncthreads();
}

__global__ void __launch_bounds__(512, 2) mega(Args a_unused) {
    extern __shared__ __attribute__((aligned(16))) unsigned char shm[];
    LAS unsigned char* lds = (LAS unsigned char*)shm;
    cg::grid_group grid = cg::this_grid();
    CArgs a0 = (CArgs)__builtin_amdgcn_kernarg_segment_ptr();
    const int ph_lo = a0->ph_lo, ph_hi = a0->ph_hi;
    XcdBarrier xbar; xbar.bar = (unsigned*)(a0->ws + WS_BAR); xbar.x = xb_xcc_id(); xbar.st = (volatile LAS unsigned*)(lds + 131072 + 16384);
    { const int t0 = tid_opaque(); if (t0 == 0) { xbar.st[0] = 0u; xbar.st[1] = 0u; (void)xb_add(&xbar.bar[XB_XCNT(xbar.x)], 1u); } __syncthreads(); }
    for (int ph = ph_lo; ph < ph_hi; ++ph) {
        if (ph > ph_lo) { if (ph == ph_lo + 1) grid.sync(); else xcd_barrier(xbar, tid_opaque() == 0); }
        CArgs a = a0; asm volatile("" : "+s"(a));
        if (ph == 0) { norm_rows(a, 0); weight_prep(a, 0, (LAS float*)lds, 0, gridDim.x); continue; }
        if (ph == NPH - 1) { norm_rows(a, 2); continue; }
        const int l = (ph - 1) / 7, s = (ph - 1) % 7;
        bf16_t* HB = (bf16_t*)(a->ws + WS_H); float* SS = (float*)(a->ws + WS_SS);
        const unsigned char* wb = a->ws + WS_WB + (size_t)(l & 1) * WB_SIZE;
        if (s == 0) {
            pg8::Gemm g{HB, (const bf16_t*)(wb + WB_WC), MR, NPROJ, DM};
            pg8::StaticOrder S; S.init(MAIN_ROWS, g.N, gridDim.x, blockIdx.x);
            LAS float* rst = (LAS float*)(lds + 131072);
            build_rs_table(rst, S, SS);
            pg8::EpiProj E{(bf16_t*)(a->ws + WS_R1), g.N, rst};
            pg8::gemm_phase(lds, g, S, E);
            tail16<0, 2>(g.A, g.Bt, g.N, g.K, E.O, g.N, SS, nullptr, (LAS float*)lds);
        }
        else if (s == 2) {
            int kl = KL; asm volatile("" : "+s"(kl));
            pg8::Gemm g{(const bf16_t*)((unsigned char*)a->out + DO_LIN), (const bf16_t*)(wb + WB_WL), MR, NL, kl};
            pg8::StaticOrder S; S.init(MAIN_ROWS, g.N, gridDim.x, blockIdx.x);
            pg8::EpiLora E{(bf16_t*)(a->ws + WS_LO), (const float*)(wb + WB_LB)};
            pg8::gemm_phase(lds, g, S, E);
            tail16<0, 2>(g.A, g.Bt, g.N, g.K, E.O, g.N, nullptr, nullptr, (LAS float*)lds, E.bias);
        }
        else if (s == 1) prep_phase(a, l, 0, 0, gridDim.x);
        else if (s == 3) {
            if (blockIdx.x < BATCH * 8) scan_phase(a, l, (LAS float*)lds);
            else { prep_phase(a, l, 1, BATCH * 8, gridDim.x - BATCH * 8); if (l + 1 < DEPTH) weight_prep(a, l + 1, (LAS float*)lds, BATCH * 8, gridDim.x - BATCH * 8); }
        }
        else if (s == 4 || s == 6) {
            pg8::Gemm g{s == 4 ? (const bf16_t*)((unsigned char*)a->out + DO_MIX) : (const bf16_t*)(a->ws + WS_R1), (const bf16_t*)(wb + (s == 4 ? WB_WOUT : WB_WDN)), MR, DM, s == 4 ? DM : DFF};
            pg8::StaticOrder S; S.init(MAIN_ROWS, DM, gridDim.x, blockIdx.x);
            pg8::EpiResid E{HB, SS + (s == 4 ? (size_t)MR * 16 : 0)};
            pg8::gemm_phase(lds, g, S, E);
            tail16<1, 4>(g.A, g.Bt, g.N, g.K, HB, DM, nullptr, E.ssq, (LAS float*)lds);
        }
        else {
            pg8::Gemm g{HB, (const bf16_t*)(wb + WB_WGU), MR, 2 * DFF, DM}; pg8::StaticOrder S; S.init(MAIN_ROWS, 2 * DFF, gridDim.x, blockIdx.x);
            LAS float* rst = (LAS float*)(lds + 131072); build_rs_table(rst, S, SS + (size_t)MR * 16);
            pg8::EpiSwiglu E{(bf16_t*)(a->ws + WS_R1), rst};
            pg8::gemm_phase(lds, g, S, E);
            tail16<2, 2>(g.A, g.Bt, g.N, g.K, E.O, DFF, SS + (size_t)MR * 16, nullptr, (LAS float*)lds);
        }
    }
}

extern "C" void kernel_launch(void* const* d_in, const int* in_sizes, int n_in, void* d_out, int out_size, void* d_ws, size_t ws_size, hipStream_t stream) {
    static int grid = 0;
    if (grid == 0) {
        if (n_in != 26 || out_size != BATCH * SEQ * DM || ws_size < WS_TOTAL) { fprintf(stderr, "kernel_launch: unexpected shapes (n_in %d out %d ws %zu need %zu)\n", n_in, out_size, ws_size, (size_t)WS_TOTAL); grid = -1; return; }
        int dev = 0, cus = 0, per_cu = 0;
        hipGetDevice(&dev);
        hipDeviceGetAttribute(&cus, hipDeviceAttributeMultiprocessorCount, dev);
        if (hipFuncSetAttribute((const void*)mega, hipFuncAttributeMaxDynamicSharedMemorySize, LDS_BYTES) != hipSuccess) { fprintf(stderr, "kernel_launch: hipFuncSetAttribute failed\n"); grid = -1; return; }
        hipOccupancyMaxActiveBlocksPerMultiprocessor(&per_cu, (const void*)mega, 512, LDS_BYTES);
        if (per_cu < 1) { fprintf(stderr, "kernel_launch: occupancy query says %d blocks per CU\n", per_cu); per_cu = 1; }
        (void)hipGetLastError();
        grid = cus;
        fprintf(stderr, "kernel_launch: grid %d (per_cu %d)\n", grid, per_cu);
    }
    if (grid < 0) return;
    if (hipMemsetAsync((unsigned char*)d_ws + WS_BAR, 0, 16384, stream) != hipSuccess) { fprintf(stderr, "kernel_launch: hipMemsetAsync failed\n"); return; }
    Args a{};
    for (int i = 0; i < 26; ++i) a.in[i] = (const float*)d_in[i];
    a.out = (float*)d_out; a.ws = (unsigned char*)d_ws;
#if MK_MULTI
    for (int ph = 0; ph < NPH; ++ph) {
        a.ph_lo = ph; a.ph_hi = ph + 1;
        void* args[] = {&a};
        hipError_t e = hipLaunchCooperativeKernel((const void*)mega, dim3(grid), dim3(512), args, LDS_BYTES, stream);
        if (e != hipSuccess) { fprintf(stderr, "cooperative launch failed: %s\n", hipGetErrorString(e)); break; }
    }
#else
    a.ph_lo = 0; a.ph_hi = NPH;
    void* args[] = {&a};
    hipError_t e = hipLaunchCooperativeKernel((const void*)mega, dim3(grid), dim3(512), args, LDS_BYTES, stream);
    if (e != hipSuccess) fprintf(stderr, "cooperative launch failed: %s (grid %d)\n", hipGetErrorString(e), grid);
#endif
}
```

```cpp
#include <hip/hip_runtime.h>
#include <hip/hip_cooperative_groups.h>
#include <cstdio>
#include <cstdint>
namespace cg = cooperative_groups;

#ifndef MK_MULTI
#define MK_MULTI 0
#endif

#define LAS __attribute__((address_space(3)))
typedef unsigned short bf16_t;
typedef short bf16x8 __attribute__((ext_vector_type(8)));
typedef float f32x4 __attribute__((ext_vector_type(4)));
typedef float f32x2 __attribute__((ext_vector_type(2)));
typedef unsigned u32x4 __attribute__((ext_vector_type(4)));
typedef unsigned u32x2 __attribute__((ext_vector_type(2)));

constexpr int DM = 1024, BATCH = 16, SEQ = 2048, DEPTH = 4, NMETA = 16, TT = SEQ + NMETA  , MR = BATCH * TT  ;
constexpr int NIN = 2336, NSHIFT = 1824, DFF = 2816, NPROJ = 2560  , KL = 384  , NL = 2048;
constexpr float RMS_EPS = 1e-6f, GN_EPS = 64e-5f;
constexpr int LDS_BYTES = 131072 + 16384 + 64;
constexpr int NPH = DEPTH * 7 + 2;

constexpr size_t WB_WC = 0;
constexpr size_t WB_WOUT = WB_WC + (size_t)NPROJ * DM * 2;
constexpr size_t WB_WGU = WB_WOUT + (size_t)DM * DM * 2;
constexpr size_t WB_WDN = WB_WGU + (size_t)2 * DFF * DM * 2;
constexpr size_t WB_WL = WB_WDN + (size_t)DM * DFF * 2;
constexpr size_t WB_LB = WB_WL + (size_t)NL * KL * 2;
constexpr size_t WB_SIZE = WB_LB + 8192;
constexpr size_t WS_WB = 4096;
constexpr size_t WS_SS = WS_WB + 2 * WB_SIZE;
constexpr size_t WS_H = WS_SS + 2 * (size_t)MR * 64;
constexpr size_t WS_R1 = WS_H + (size_t)MR * DM * 4;
constexpr size_t WS_LO = WS_R1 + (size_t)MR * DFF * 2;
constexpr size_t WS_END = WS_LO + (size_t)MR * NL * 2;
constexpr size_t WS_BAR = WS_END;
constexpr size_t WS_TOTAL = WS_BAR + 16384;
static_assert(WS_TOTAL <= 536870912, "workspace map");
constexpr size_t DO_MIX = 0;
constexpr size_t DO_VF = DO_MIX + (size_t)MR * DM * 2;
constexpr size_t DO_LIN = DO_VF + (size_t)MR * 512 * 2;
static_assert(DO_LIN + (size_t)MR * KL * 2 <= (size_t)BATCH * SEQ * DM * 4, "d_out scratch");

struct Args { const float* in[26]; float* out; unsigned char* ws; int ph_lo, ph_hi; };
typedef const __attribute__((address_space(4))) Args* CArgs;

__device__ __forceinline__ float bf2f(unsigned b) { return __uint_as_float(b << 16); }
__device__ __forceinline__ unsigned f2bf(float f) { unsigned u = __float_as_uint(f); return (u + 0x7fffu + ((u >> 16) & 1u)) >> 16; }
__device__ __forceinline__ unsigned pk2(float lo, float hi) { unsigned r; asm volatile("v_cvt_pk_bf16_f32 %0, %1, %2" : "=v"(r) : "v"(lo), "v"(hi)); return r; }
__device__ __forceinline__ float sigmoidf_(float x) { return __builtin_amdgcn_rcpf(1.0f + __builtin_amdgcn_exp2f(x * -1.44269504f)); }
template <int CTRL> __device__ __forceinline__ float dppf(float x) { return __int_as_float(__builtin_amdgcn_update_dpp(0, __float_as_int(x), CTRL, 0xF, 0xF, true)); }
#define DPP_ADD(r, ctl) "v_add_f32_dpp " r ", " r ", " r " " ctl " row_mask:0xf bank_mask:0xf\n\t"
__device__ __forceinline__ void allred8x4(float& a, float& b, float& c, float& d) {
    asm volatile("s_nop 1\n\t"
        DPP_ADD("%0", "quad_perm:[1,0,3,2]") DPP_ADD("%1", "quad_perm:[1,0,3,2]") DPP_ADD("%2", "quad_perm:[1,0,3,2]") DPP_ADD("%3", "quad_perm:[1,0,3,2]")
        DPP_ADD("%0", "quad_perm:[2,3,0,1]") DPP_ADD("%1", "quad_perm:[2,3,0,1]") DPP_ADD("%2", "quad_perm:[2,3,0,1]") DPP_ADD("%3", "quad_perm:[2,3,0,1]")
        DPP_ADD("%0", "row_half_mirror") DPP_ADD("%1", "row_half_mirror") DPP_ADD("%2", "row_half_mirror") DPP_ADD("%3", "row_half_mirror")
        : "+v"(a), "+v"(b), "+v"(c), "+v"(d));
}
__device__ __forceinline__ float rows_to_wave(float x) {
    const int xi = __float_as_int(x);
    return (__int_as_float(__builtin_amdgcn_readlane(xi, 0)) + __int_as_float(__builtin_amdgcn_readlane(xi, 16))) + (__int_as_float(__builtin_amdgcn_readlane(xi, 32)) + __int_as_float(__builtin_amdgcn_readlane(xi, 48)));
}
__device__ __forceinline__ float wave_sum(float x) {
    asm volatile("s_nop 1\n\t" DPP_ADD("%0", "quad_perm:[1,0,3,2]") "s_nop 1\n\t" DPP_ADD("%0", "quad_perm:[2,3,0,1]") "s_nop 1\n\t" DPP_ADD("%0", "row_half_mirror") "s_nop 1\n\t" DPP_ADD("%0", "row_mirror") : "+v"(x));
    return rows_to_wave(x);
}
__device__ __forceinline__ void wave_sum3(float& a, float& b, float& c) {
    asm volatile("s_nop 1\n\t"
        DPP_ADD("%0", "quad_perm:[1,0,3,2]") DPP_ADD("%1", "quad_perm:[1,0,3,2]") DPP_ADD("%2", "quad_perm:[1,0,3,2]")
        DPP_ADD("%0", "quad_perm:[2,3,0,1]") DPP_ADD("%1", "quad_perm:[2,3,0,1]") DPP_ADD("%2", "quad_perm:[2,3,0,1]")
        DPP_ADD("%0", "row_half_mirror") DPP_ADD("%1", "row_half_mirror") DPP_ADD("%2", "row_half_mirror")
        DPP_ADD("%0", "row_mirror") DPP_ADD("%1", "row_mirror") DPP_ADD("%2", "row_mirror")
        "v_add_f32_dpp %0, %0, %0 row_bcast:15 row_mask:0xa bank_mask:0xf\n\t" "v_add_f32_dpp %1, %1, %1 row_bcast:15 row_mask:0xa bank_mask:0xf\n\t" "v_add_f32_dpp %2, %2, %2 row_bcast:15 row_mask:0xa bank_mask:0xf\n\t"
        "v_add_f32_dpp %0, %0, %0 row_bcast:31 row_mask:0xc bank_mask:0xf\n\t" "v_add_f32_dpp %1, %1, %1 row_bcast:31 row_mask:0xc bank_mask:0xf\n\t" "v_add_f32_dpp %2, %2, %2 row_bcast:31 row_mask:0xc bank_mask:0xf\n\t"
        : "+v"(a), "+v"(b), "+v"(c));
    a = __int_as_float(__builtin_amdgcn_readlane(__float_as_int(a), 63)); b = __int_as_float(__builtin_amdgcn_readlane(__float_as_int(b), 63)); c = __int_as_float(__builtin_amdgcn_readlane(__float_as_int(c), 63));
}
__device__ __forceinline__ int tid_opaque() { int t = threadIdx.x; asm volatile("" : "+v"(t)); return t; }

__device__ __forceinline__ void unpack8(const u32x4 w, float (&x)[8]) {
    x[0] = bf2f(w.x & 0xffffu); x[1] = bf2f(w.x >> 16); x[2] = bf2f(w.y & 0xffffu); x[3] = bf2f(w.y >> 16);
    x[4] = bf2f(w.z & 0xffffu); x[5] = bf2f(w.z >> 16); x[6] = bf2f(w.w & 0xffffu); x[7] = bf2f(w.w >> 16);
}
constexpr int MAIN_ROWS = BATCH * SEQ, NROWS = MAIN_ROWS + NMETA;
__device__ __forceinline__ int row_of(int b, int t) { return t < NMETA ? MAIN_ROWS + t : b * SEQ + (t - NMETA); }
__device__ __forceinline__ float row_rs(const float* ssp, int row) {
    const f32x4* p = (const f32x4*)(ssp + (size_t)row * 16); const f32x4 a = p[0], b = p[1], c = p[2], d = p[3];
    const f32x4 t = (a + b) + (c + d);
    return rsqrtf(((t[0] + t[1]) + (t[2] + t[3])) * (1.0f / DM) + RMS_EPS);
}
namespace pg8 {
constexpr int BM = 256, BK = 64, HALF = 128, HTB = HALF * BK * 2, STAGE_BYTES = 8 * HTB, NXCD = 8, WGM = 8;
__host__ __device__ __forceinline__ int lds_byte(int r, int c) { const int st = (r >> 4) * 2 + (c >> 5), rr = r & 15, cc = c & 31, ob = rr * 64 + cc * 2; return st * 1024 + (ob ^ (((ob >> 9) & 1) << 5)); }
__host__ __device__ __forceinline__ void stage_rc(int b, int& R, int& C) { const int st = b / 1024, sb = b % 1024, swz = sb ^ (((sb >> 9) & 1) << 5); R = (st >> 1) * 16 + swz / 64; C = (st & 1) * 32 + (swz % 64) / 2; }
__host__ __device__ __forceinline__ int perm32(int rho) { const int n = rho >> 4, i = rho & 15; return 8 * (i >> 2) + 4 * n + (i & 3); }
struct Unit { int pm, pn; };
struct Gemm { const bf16_t* A; const bf16_t* Bt; int M, N, K; };
struct StaticOrder {
    int nM, nN, nwg, G, c;
    __device__ void init(int M, int N, int G_, int c_) { nM = M / BM; nN = N / BM; nwg = nM * nN; G = G_; c = c_; }
    __device__ bool next(int i, Unit& u) const {
        const long L = (long)i * G + c; if (L >= nwg) return false;
        int wgid = (int)L; { const int q = nwg / NXCD, r = nwg % NXCD, xcd = wgid % NXCD, off = wgid / NXCD; wgid = (xcd < r ? xcd * (q + 1) : r * (q + 1) + (xcd - r) * q) + off; }
        const int nig = WGM * nN, gid = wgid / nig, fm = gid * WGM, gsz = (nM - fm) < WGM ? (nM - fm) : WGM;
        u.pm = fm + ((wgid % nig) % gsz); u.pn = (wgid % nig) / gsz; return true;
    }
};
template <class Epi>
__device__ __forceinline__ void gemm_phase(LAS unsigned char* lds, const Gemm g, const StaticOrder& S, const Epi& E) {
    int tid_ = threadIdx.x; asm volatile("" : "+v"(tid_));
    const int tid = tid_, wid = __builtin_amdgcn_readfirstlane(tid >> 6), lane = tid & 63, wr = wid >> 2, wc = wid & 3, fr = lane & 15, fq = lane >> 4;
    const int K = g.K, nt = K / BK;
    unsigned voffA[2], voffB[2];
#pragma unroll
    for (int i = 0; i < 2; ++i) { int R, C; stage_rc(tid * 16 + i * 8192, R, C); const int Rb = Epi::PERM ? ((R & ~31) + perm32(R & 31)) : R;
        voffA[i] = (unsigned)(R * K + C) * 2u; voffB[i] = (unsigned)(Rb * K + C) * 2u; }
    const size_t kstep = (size_t)(BK * 2);
    const size_t hstep = (size_t)HALF * K * 2;
    const size_t tstep = 2 * hstep;
    const unsigned ldsw = (unsigned)wid * 1024u;
    const int aoff = lds_byte(wr * 64 + fr, fq * 8), boff = lds_byte(wc * 32 + fr, fq * 8);
#define PG8_SA(b, h) (((b) * 2 + (h)) * HTB)
#define PG8_SB(b, h) ((4 + (b) * 2 + (h)) * HTB)
#define PG8_STAGE(bufoff, gbase, voff) do { _Pragma("unroll") for (int _i = 0; _i < 2; ++_i) \
        __builtin_amdgcn_global_load_lds((const unsigned*)((const char*)(gbase) + (voff)[_i]), (LAS unsigned*)(lds + (bufoff) + ldsw + _i * 8192), 16, 0, 0); } while (0)
#define PG8_LDA(dst, b, h) do { _Pragma("unroll") for (int m = 0; m < 4; ++m) _Pragma("unroll") for (int k = 0; k < 2; ++k) dst[m][k] = *(const LAS bf16x8*)(lds + PG8_SA(b, h) + aoff + m * 2048 + k * 1024); } while (0)
#define PG8_LDB(dst, b, h) do { _Pragma("unroll") for (int n = 0; n < 2; ++n) _Pragma("unroll") for (int k = 0; k < 2; ++k) dst[n][k] = *(const LAS bf16x8*)(lds + PG8_SB(b, h) + boff + n * 2048 + k * 1024); } while (0)
#define PG8_MMA(ai, bj, At, Bt) do { __builtin_amdgcn_s_setprio(1); _Pragma("unroll") for (int m = 0; m < 4; ++m) _Pragma("unroll") for (int n = 0; n < 2; ++n) _Pragma("unroll") for (int k = 0; k < 2; ++k) \
        acc[ai][bj][m][n] = __builtin_amdgcn_mfma_f32_16x16x32_bf16(Bt[n][k], At[m][k], acc[ai][bj][m][n], 0, 0, 0); __builtin_amdgcn_s_setprio(0); } while (0)
#define PG8_WAIT_V(n) asm volatile("s_waitcnt vmcnt(" #n ")" ::: "memory")
#define PG8_WAIT_L(n) asm volatile("s_waitcnt lgkmcnt(" #n ")" ::: "memory")
#define PG8_BAR __builtin_amdgcn_s_barrier()
#define PG8_SCHED __builtin_amdgcn_sched_barrier(0)
    Unit cur, nxt; int ui = 0;
    if (!S.next(0, cur)) return;
    f32x4 acc[2][2][4][2];
#pragma unroll
    for (int a = 0; a < 2; ++a)
#pragma unroll
        for (int b = 0; b < 2; ++b)
#pragma unroll
            for (int m = 0; m < 4; ++m)
#pragma unroll
                for (int n = 0; n < 2; ++n) acc[a][b][m][n] = (f32x4){0.f, 0.f, 0.f, 0.f};
    bf16x8 At[4][2], B0[2][2], B1[2][2];
    const char* cA = (const char*)g.A + (size_t)cur.pm * tstep; const char* cB = (const char*)g.Bt + (size_t)cur.pn * tstep;
    PG8_STAGE(PG8_SB(0, 0), cB, voffB); PG8_STAGE(PG8_SB(0, 1), cB + hstep, voffB); PG8_STAGE(PG8_SA(0, 0), cA, voffA); PG8_STAGE(PG8_SA(0, 1), cA + hstep, voffA);
    if (wr == 1) PG8_BAR;
    PG8_WAIT_V(2); PG8_BAR;
    PG8_STAGE(PG8_SB(1, 0), cB + kstep, voffB); PG8_STAGE(PG8_SA(1, 0), cA + kstep, voffA); PG8_STAGE(PG8_SB(1, 1), cB + hstep + kstep, voffB);
    PG8_WAIT_V(6); PG8_BAR;
    for (;;) {
        const bool has_next = S.next(ui + 1, nxt);
        const char* nA = has_next ? (const char*)g.A + (size_t)nxt.pm * tstep : cA; const char* nB = has_next ? (const char*)g.Bt + (size_t)nxt.pn * tstep : cB;
        for (int t = 0; t < nt; t += 2) {
            const bool last = (t == nt - 2);
            const char* a1 = cA + (size_t)(t + 1) * kstep;
            const char* a2 = last ? nA : cA + (size_t)(t + 2) * kstep; const char* b2 = last ? nB : cB + (size_t)(t + 2) * kstep;
            const char* a3 = a2 + kstep; const char* b3 = b2 + kstep;
            PG8_LDB(B0, 0, 0); PG8_LDB(B1, 0, 1); PG8_SCHED; PG8_LDA(At, 0, 0); PG8_STAGE(PG8_SA(1, 1), a1 + hstep, voffA);
            PG8_WAIT_V(8); PG8_WAIT_L(0); PG8_BAR; PG8_MMA(0, 0, At, B0); PG8_MMA(0, 1, At, B1); PG8_BAR; PG8_SCHED;
            PG8_LDA(At, 0, 1); PG8_STAGE(PG8_SB(0, 0), b2, voffB); PG8_STAGE(PG8_SB(0, 1), b2 + hstep, voffB); PG8_STAGE(PG8_SA(0, 0), a2, voffA);
            PG8_WAIT_V(8); PG8_WAIT_L(0); PG8_BAR; PG8_MMA(1, 0, At, B0); PG8_MMA(1, 1, At, B1); PG8_BAR; PG8_SCHED;
            PG8_LDB(B0, 1, 0); PG8_LDB(B1, 1, 1); PG8_SCHED; PG8_LDA(At, 1, 0); PG8_STAGE(PG8_SA(0, 1), a2 + hstep, voffA);
            PG8_WAIT_V(8); PG8_WAIT_L(0); PG8_BAR; PG8_MMA(0, 0, At, B0); PG8_MMA(0, 1, At, B1); PG8_BAR; PG8_SCHED;
            PG8_LDA(At, 1, 1); PG8_STAGE(PG8_SB(1, 0), b3, voffB); PG8_STAGE(PG8_SB(1, 1), b3 + hstep, voffB); PG8_STAGE(PG8_SA(1, 0), a3, voffA);
            PG8_WAIT_V(8); PG8_WAIT_L(0); PG8_BAR; PG8_MMA(1, 0, At, B0); PG8_MMA(1, 1, At, B1); PG8_BAR; PG8_SCHED;
        }
        if (wr == 0) PG8_BAR;
        E(acc, cur, ui, wr, wc, fr, fq);
        if (!has_next) break;
#pragma unroll
        for (int a = 0; a < 2; ++a)
#pragma unroll
            for (int b = 0; b < 2; ++b)
#pragma unroll
                for (int m = 0; m < 4; ++m)
#pragma unroll
                    for (int n = 0; n < 2; ++n) acc[a][b][m][n] = (f32x4){0.f, 0.f, 0.f, 0.f};
        cur = nxt; cA = nA; cB = nB; ++ui;
        if (wr == 1) PG8_BAR;
    }
    PG8_WAIT_V(0);
    PG8_BAR;
#undef PG8_SA
#undef PG8_SB
#undef PG8_STAGE
#undef PG8_LDA
#undef PG8_LDB
#undef PG8_MMA
#undef PG8_WAIT_V
#undef PG8_WAIT_L
#undef PG8_BAR
#undef PG8_SCHED
}

struct EpiProj {
    static constexpr bool PERM = true;
    bf16_t* O; int ldc; const LAS float* rst;
    __device__ __forceinline__ void operator()(const f32x4 (&acc)[2][2][4][2], const Unit& u, int ui, int wr, int wc, int fr, int fq) const {
        const int row0 = u.pm * BM + wr * 64 + fr, col0 = u.pn * BM + wc * 32 + 8 * fq;
#pragma unroll
        for (int ai = 0; ai < 2; ++ai)
#pragma unroll
            for (int m = 0; m < 4; ++m) { const int row = row0 + ai * HALF + m * 16; bf16_t* rowp = O + (size_t)row * ldc + col0;
                const float rs = rst ? rst[ui * 256 + (row & 255)] : 1.0f;
#pragma unroll
                for (int bj = 0; bj < 2; ++bj) { const f32x4 v0 = acc[ai][bj][m][0] * rs, v1 = acc[ai][bj][m][1] * rs;
                    u32x4 w; w.x = pk2(v0[0], v0[1]); w.y = pk2(v0[2], v0[3]); w.z = pk2(v1[0], v1[1]); w.w = pk2(v1[2], v1[3]);
                    *(u32x4*)(rowp + bj * HALF) = w; } }
    }
};
struct EpiResid {
    static constexpr bool PERM = true;
    bf16_t* HB; float* ssq;
    __device__ __forceinline__ void operator()(const f32x4 (&acc)[2][2][4][2], const Unit& u, int ui, int wr, int wc, int fr, int fq) const {
        const int row0 = u.pm * BM + wr * 64 + fr, col0 = u.pn * BM + wc * 32 + 8 * fq;
#pragma unroll
        for (int ai = 0; ai < 2; ++ai) {
            u32x4 hv[4][2];
#pragma unroll
            for (int m = 0; m < 4; ++m)
#pragma unroll
                for (int bj = 0; bj < 2; ++bj) hv[m][bj] = *(const u32x4*)(HB + (size_t)(row0 + ai * HALF + m * 16) * DM + col0 + bj * HALF);
            __builtin_amdgcn_sched_barrier(0);
#pragma unroll
            for (int m = 0; m < 4; ++m) { const int row = row0 + ai * HALF + m * 16; bf16_t* rowb = HB + (size_t)row * DM + col0;
                float q = 0.f;
#pragma unroll
                for (int bj = 0; bj < 2; ++bj) { const u32x4 hw = hv[m][bj]; const f32x4 v0 = acc[ai][bj][m][0], v1 = acc[ai][bj][m][1];
                    u32x4 w;
                    w.x = pk2(bf2f(hw.x & 0xffffu) + v0[0], bf2f(hw.x >> 16) + v0[1]); w.y = pk2(bf2f(hw.y & 0xffffu) + v0[2], bf2f(hw.y >> 16) + v0[3]);
                    w.z = pk2(bf2f(hw.z & 0xffffu) + v1[0], bf2f(hw.z >> 16) + v1[1]); w.w = pk2(bf2f(hw.w & 0xffffu) + v1[2], bf2f(hw.w >> 16) + v1[3]);
                    *(u32x4*)(rowb + bj * HALF) = w;
                    const float r0 = bf2f(w.x & 0xffffu), r1 = bf2f(w.x >> 16), r2 = bf2f(w.y & 0xffffu), r3 = bf2f(w.y >> 16), r4 = bf2f(w.z & 0xffffu), r5 = bf2f(w.z >> 16), r6 = bf2f(w.w & 0xffffu), r7 = bf2f(w.w >> 16);
                    q += ((r0 * r0 + r1 * r1) + (r2 * r2 + r3 * r3)) + ((r4 * r4 + r5 * r5) + (r6 * r6 + r7 * r7)); }
                q += __shfl_xor(q, 16); q += __shfl_xor(q, 32);
                if (fq == 0) ssq[(size_t)row * 16 + u.pn * 4 + wc] = q; }
            __builtin_amdgcn_sched_barrier(0);
        }
    }
};
struct EpiLora {
    static constexpr bool PERM = true;
    bf16_t* O; const float* bias;
    __device__ __forceinline__ void operator()(const f32x4 (&acc)[2][2][4][2], const Unit& u, int ui, int wr, int wc, int fr, int fq) const {
        const int row0 = u.pm * BM + wr * 64 + fr, col0 = u.pn * BM + wc * 32 + 8 * fq, mode = u.pn >> 1;
        const float sc = (mode == 0) ? 0.60653066f : 1.0f;
#pragma unroll
        for (int bj = 0; bj < 2; ++bj) {
            const f32x4 c0 = *(const f32x4*)(bias + col0 + bj * HALF), c1 = *(const f32x4*)(bias + col0 + bj * HALF + 4);
#pragma unroll
            for (int ai = 0; ai < 2; ++ai)
#pragma unroll
                for (int m = 0; m < 4; ++m) { bf16_t* rowp = O + (size_t)(row0 + ai * HALF + m * 16) * NL + col0 + bj * HALF;
                    f32x4 v0 = acc[ai][bj][m][0] + c0, v1 = acc[ai][bj][m][1] + c1;
                    if (mode != 2) {
#pragma unroll
                        for (int j = 0; j < 4; ++j) { v0[j] = sc * sigmoidf_(v0[j]); v1[j] = sc * sigmoidf_(v1[j]); } }
                    u32x4 w; w.x = pk2(v0[0], v0[1]); w.y = pk2(v0[2], v0[3]); w.z = pk2(v1[0], v1[1]); w.w = pk2(v1[2], v1[3]);
                    *(u32x4*)rowp = w; }
        }
    }
};
struct EpiSwiglu {
    static constexpr bool PERM = true;
    bf16_t* O; const LAS float* rst;
    __device__ __forceinline__ void operator()(const f32x4 (&acc)[2][2][4][2], const Unit& u, int ui, int wr, int wc, int fr, int fq) const {
        const int row0 = u.pm * BM + wr * 64 + fr, col0 = u.pn * 128 + wc * 16 + 4 * fq;
#pragma unroll
        for (int ai = 0; ai < 2; ++ai)
#pragma unroll
            for (int m = 0; m < 4; ++m) { const int row = row0 + ai * HALF + m * 16; bf16_t* rowp = O + (size_t)row * DFF + col0;
                const float rs = rst[ui * 256 + (row & 255)];
#pragma unroll
                for (int bj = 0; bj < 2; ++bj) { const f32x4 gt = acc[ai][bj][m][0] * rs, up = acc[ai][bj][m][1] * rs; float o[4];
#pragma unroll
                    for (int j = 0; j < 4; ++j) o[j] = gt[j] * sigmoidf_(gt[j]) * up[j];
                    u32x2 w; w.x = pk2(o[0], o[1]); w.y = pk2(o[2], o[3]);
                    *(u32x2*)(rowp + bj * 64) = w; } }
    }
};
}

__device__ __forceinline__ void build_rs_table(LAS float* rst, const pg8::StaticOrder& S, const float* ssp) {
    const int tid = tid_opaque();
    pg8::Unit u;
    for (int i = 0; S.next(i, u); ++i) if (tid < 256) rst[i * 256 + tid] = row_rs(ssp, u.pm * 256 + tid);
    __syncthreads();
}
template <int KIND, int NB>
__device__ __forceinline__ void tail16(const bf16_t* A, const bf16_t* Bt, int N, int K, bf16_t* Out, int ldo, const float* ssp, float* ssq, LAS float* red, const float* lbias = nullptr) {
    const int tid = tid_opaque(), wid = __builtin_amdgcn_readfirstlane(tid >> 6), lane = tid & 63, fr = lane & 15, fq = lane >> 4;
    const int ntile = (KIND == 2) ? N / 32 : N / (16 * NB), nks = K >> 7;
    const int row = MAIN_ROWS + fr;
    for (int tile = blockIdx.x; tile < ntile; tile += gridDim.x) {
        f32x4 acc[NB];
#pragma unroll
        for (int be = 0; be < NB; ++be) acc[be] = (f32x4){0.f, 0.f, 0.f, 0.f};
        const bf16_t* ap = A + (size_t)row * K + fq * 8;
        const bf16_t* bp[NB];
        if (KIND == 2) { const int f = tile * 16 + fr, pn = f >> 7, ft = f & 127, r0 = pn * 256 + ((ft >> 2) << 3) + (ft & 3); bp[0] = Bt + (size_t)r0 * K + fq * 8; bp[1] = Bt + (size_t)(r0 + 4) * K + fq * 8; }
        else {
#pragma unroll
            for (int be = 0; be < NB; ++be) bp[be] = Bt + (size_t)(tile * 16 * NB + be * 16 + fr) * K + fq * 8; }
        for (int ks = wid; ks < nks; ks += 8) {
            bf16x8 av[4], bv[NB][4];
#pragma unroll
            for (int u = 0; u < 4; ++u) { av[u] = *(const bf16x8*)(ap + ks * 128 + u * 32);
#pragma unroll
                for (int be = 0; be < NB; ++be) bv[be][u] = *(const bf16x8*)(bp[be] + ks * 128 + u * 32); }
            __builtin_amdgcn_sched_barrier(0);
#pragma unroll
            for (int u = 0; u < 4; ++u)
#pragma unroll
                for (int be = 0; be < NB; ++be) acc[be] = __builtin_amdgcn_mfma_f32_16x16x32_bf16(bv[be][u], av[u], acc[be], 0, 0, 0);
        }
#pragma unroll
        for (int be = 0; be < NB; ++be) *(LAS f32x4*)(red + ((wid * NB + be) * 64 + lane) * 4) = acc[be];
        __syncthreads();
        if (wid == 0) {
#pragma unroll
            for (int be = 0; be < NB; ++be) { f32x4 t = *(const LAS f32x4*)(red + (be * 64 + lane) * 4);
#pragma unroll
                for (int w = 1; w < 8; ++w) t += *(const LAS f32x4*)(red + ((w * NB + be) * 64 + lane) * 4);
                acc[be] = t; }
            if (KIND == 0) {
                const float rs = ssp ? row_rs(ssp, row) : 1.0f;
#pragma unroll
                for (int be = 0; be < NB; ++be) { const int col = tile * 16 * NB + be * 16 + fq * 4; f32x4 v = acc[be] * rs;
                    if (lbias) { const int mode = col >> 9;
                        if (mode != 2) { const float sc = (mode == 0) ? 0.60653066f : 1.0f;
#pragma unroll
                            for (int j = 0; j < 4; ++j) v[j] = sc * sigmoidf_(v[j] + lbias[col + j]); } }
                    u32x2 w; w.x = pk2(v[0], v[1]); w.y = pk2(v[2], v[3]);
                    *(u32x2*)(Out + (size_t)row * ldo + col) = w; }
            } else if (KIND == 1) {
                float q = 0.f;
#pragma unroll
                for (int be = 0; be < NB; ++be) { bf16_t* o = Out + (size_t)row * ldo + tile * 16 * NB + be * 16 + fq * 4; const u32x2 hw = *(const u32x2*)o;
                    u32x2 w; w.x = pk2(bf2f(hw.x & 0xffffu) + acc[be][0], bf2f(hw.x >> 16) + acc[be][1]); w.y = pk2(bf2f(hw.y & 0xffffu) + acc[be][2], bf2f(hw.y >> 16) + acc[be][3]);
                    *(u32x2*)o = w;
                    const float r0 = bf2f(w.x & 0xffffu), r1 = bf2f(w.x >> 16), r2 = bf2f(w.y & 0xffffu), r3 = bf2f(w.y >> 16);
                    q += (r0 * r0 + r1 * r1) + (r2 * r2 + r3 * r3); }
                q += __shfl_xor(q, 16); q += __shfl_xor(q, 32);
                if (fq == 0) ssq[(size_t)row * 16 + tile] = q;
            } else {
                const float rs = row_rs(ssp, row); float v[4];
#pragma unroll
                for (int j = 0; j < 4; ++j) { const float g = acc[0][j] * rs; v[j] = g * sigmoidf_(g) * (acc[1][j] * rs); }
                u32x2 w; w.x = pk2(v[0], v[1]); w.y = pk2(v[2], v[3]);
                *(u32x2*)(Out + (size_t)row * ldo + tile * 16 + fq * 4) = w;
            }
        }
        __syncthreads();
    }
}

__device__ __forceinline__ void norm_rows(CArgs a, int mode) {
    const int tid = tid_opaque(), wid = tid >> 6, lane = tid & 63;
    bf16_t* HB = (bf16_t*)(a->ws + WS_H); float* SS = (float*)(a->ws + WS_SS);
    for (int row = blockIdx.x * 8 + wid; row < (mode == 0 ? NROWS : MAIN_ROWS); row += gridDim.x * 8) {
        float x[16]; float ss = 0.f;
        if (mode == 0) {
            const float* src = (row >= MAIN_ROWS ? a->in[1] + (size_t)(row - MAIN_ROWS) * DM : a->in[0] + (size_t)row * DM);
#pragma unroll
            for (int i = 0; i < 2; ++i) { const f32x4 v0 = *(const f32x4*)(src + lane * 8 + 512 * i), v1 = *(const f32x4*)(src + lane * 8 + 512 * i + 4);
                u32x4 w; w.x = pk2(v0[0], v0[1]); w.y = pk2(v0[2], v0[3]); w.z = pk2(v1[0], v1[1]); w.w = pk2(v1[2], v1[3]);
                *(u32x4*)(HB + (size_t)row * DM + lane * 8 + 512 * i) = w;
                float r[8]; unpack8(w, r);
#pragma unroll
                for (int e = 0; e < 8; ++e) ss += r[e] * r[e]; }
            ss = wave_sum(ss);
            if (lane < 16) SS[(size_t)row * 16 + lane] = (lane == 0) ? ss : 0.f;
        } else {
#pragma unroll
            for (int i = 0; i < 2; ++i) { float r[8]; unpack8(*(const u32x4*)(HB + (size_t)row * DM + lane * 8 + 512 * i), r);
#pragma unroll
                for (int e = 0; e < 8; ++e) { x[i * 8 + e] = r[e]; ss += r[e] * r[e]; } }
            ss = wave_sum(ss);
            const float rs = rsqrtf(ss * (1.0f / DM) + RMS_EPS);
            float* o = a->out + (size_t)row * DM;
#pragma unroll
            for (int i = 0; i < 2; ++i) { const f32x4 g0 = *(const f32x4*)(a->in[25] + lane * 8 + 512 * i), g1 = *(const f32x4*)(a->in[25] + lane * 8 + 512 * i + 4);
                *(f32x4*)(o + lane * 8 + 512 * i) = (f32x4){x[i * 8] * rs * g0[0], x[i * 8 + 1] * rs * g0[1], x[i * 8 + 2] * rs * g0[2], x[i * 8 + 3] * rs * g0[3]};
                *(f32x4*)(o + lane * 8 + 512 * i + 4) = (f32x4){x[i * 8 + 4] * rs * g1[0], x[i * 8 + 5] * rs * g1[1], x[i * 8 + 6] * rs * g1[2], x[i * 8 + 7] * rs * g1[3]}; }
        }
    }
}

template <int KIND> __device__ __forceinline__ float wsrc(CArgs a, int l, int k, int n) {
    if (KIND == 0) {
        const float gk = a->in[2][(size_t)l * DM + k];
        if (n < NIN) return gk * a->in[3][((size_t)l * DM + k) * NIN + n];
        if (n < NIN + 32 && l > 0) return gk * a->in[17][((size_t)(l - 1) * DM + k) * 32 + (n - NIN)];
        return 0.f;
    } else if (KIND == 1) {
        return a->in[21][((size_t)l * DM + k) * DM + n];
    } else if (KIND == 2) {
        const int pn = n >> 8, c = n & 255, feat = pn * 128 + ((c >> 3) << 2) + (c & 3), isup = (c >> 2) & 1;
        return a->in[22][(size_t)l * DM + k] * a->in[23][((size_t)l * DM + k) * (2 * DFF) + feat + isup * DFF];
    } else if (KIND == 3) {
        return a->in[24][((size_t)l * DFF + k) * DM + n];
    } else {
        const int j = n >> 9, nn = n & 511;
        if (j == 0) return (k < 64) ? a->in[8][((size_t)l * 64 + k) * 512 + nn] : 0.f;
        if (j == 1) return (k >= 64 && k < 128) ? a->in[10][((size_t)l * 64 + (k - 64)) * 512 + nn] : 0.f;
        if (j == 2) return (k >= 128 && k < 288) ? a->in[11][((size_t)l * 160 + (k - 128)) * 512 + nn] : 0.f;
        return (k >= 288 && k < 320 && l > 0) ? a->in[20][((size_t)(l - 1) * 32 + (k - 288)) * 512 + nn] : 0.f;
    }
}
template <int KIND> __device__ __forceinline__ void conv_tile(CArgs a, int l, LAS float* tile, bf16_t* out, int ldo, int n0, int k0) {
    const int tid = tid_opaque(), kk = tid >> 6, nn = tid & 63;
#pragma unroll
    for (int i = 0; i < 8; ++i) tile[(kk + 8 * i) * 65 + nn] = wsrc<KIND>(a, l, k0 + kk + 8 * i, n0 + nn);
    __syncthreads();
    const int n = tid >> 3, kq = tid & 7;
    u32x4 w;
    w.x = pk2(tile[(kq * 8 + 0) * 65 + n], tile[(kq * 8 + 1) * 65 + n]); w.y = pk2(tile[(kq * 8 + 2) * 65 + n], tile[(kq * 8 + 3) * 65 + n]);
    w.z = pk2(tile[(kq * 8 + 4) * 65 + n], tile[(kq * 8 + 5) * 65 + n]); w.w = pk2(tile[(kq * 8 + 6) * 65 + n], tile[(kq * 8 + 7) * 65 + n]);
    *(u32x4*)(out + (size_t)(n0 + n) * ldo + k0 + kq * 8) = w;
    __syncthreads();
}
__device__ __forceinline__ void fold_tile(CArgs a, int l, LAS float* lds, bf16_t* out, int n0, int k0) {
    LAS float* P = lds; LAS float* W = lds + 64 * 128;
    const int tid = tid_opaque(), g = k0 >> 7, c0 = k0 & 127;
    const float* pw = a->in[5] + ((size_t)(l * 4 + g) * 128 + c0) * 128; const float* sc = a->in[6] + (size_t)l * 512 + g * 128;
    const float* wo = a->in[21] + ((size_t)l * DM + g * 128) * DM + n0;
    for (int i = tid; i < 64 * 128; i += 512) { const int d = i & 127; P[i] = pw[i] * sc[d]; }
    for (int i = tid; i < 128 * 64; i += 512) { const int d = i >> 6, n = i & 63; W[i] = wo[(size_t)d * DM + n]; }
    __syncthreads();
    const int n = tid & 63, cq = tid >> 6;
    float acc[8];
#pragma unroll
    for (int j = 0; j < 8; ++j) acc[j] = 0.f;
    for (int d = 0; d < 128; ++d) { const float wv = W[d * 64 + n];
#pragma unroll
        for (int j = 0; j < 8; ++j) acc[j] += P[(cq * 8 + j) * 128 + d] * wv; }
    u32x4 w; w.x = pk2(acc[0], acc[1]); w.y = pk2(acc[2], acc[3]); w.z = pk2(acc[4], acc[5]); w.w = pk2(acc[6], acc[7]);
    *(u32x4*)(out + (size_t)(n0 + n) * DM + k0 + cq * 8) = w;
    __syncthreads();
}
constexpr int WT_EARLY = 833, WT_ALL = 3201;
__device__ __forceinline__ void weight_prep(CArgs a, int lA, int vlo, int vhi, int lB, LAS float* lds, int b0, int nb) {
    const int nA = vhi - vlo, ntot = nA + (lB >= 0 ? WT_ALL : 0);
    for (int it = (int)blockIdx.x - b0; it < ntot; it += nb) {
        const int l = (it < nA) ? lA : lB, v = (it < nA) ? vlo + it : it - nA;
        unsigned char* wb = a->ws + WS_WB + (size_t)(l & 1) * WB_SIZE;
        bf16_t* WC = (bf16_t*)(wb + WB_WC); bf16_t* WO = (bf16_t*)(wb + WB_WOUT); bf16_t* WGU = (bf16_t*)(wb + WB_WGU); bf16_t* WDN = (bf16_t*)(wb + WB_WDN); bf16_t* WL = (bf16_t*)(wb + WB_WL);
        if (v < 640) { conv_tile<0>(a, l, lds, WC, DM, (v >> 4) * 64, (v & 15) * 64); }
        else if (v < 832) { const int q = v - 640; conv_tile<4>(a, l, lds, WL, KL, (q / 6) * 64, (q % 6) * 64); }
        else if (v == 832) { float* LB = (float*)(wb + WB_LB); const int t0 = tid_opaque();
            for (int i = t0; i < NL; i += 512) { const int j = i >> 9, nn = i & 511; LB[i] = (j == 0) ? a->in[7][l * 512 + nn] : (j == 1) ? a->in[9][l * 512 + nn] : (j == 3 && l > 0) ? a->in[19][(l - 1) * 512 + nn] : 0.f; } }
        else if (v < 961) { const int q = v - 833; fold_tile(a, l, lds, WO, (q & 15) * 64, (q >> 4) * 64); }
        else if (v < 1089) { const int q = v - 961; conv_tile<1>(a, l, lds, WO, DM, (q & 15) * 64, 512 + (q >> 4) * 64); }
        else if (v < 2497) { const int q = v - 1089; conv_tile<2>(a, l, lds, WGU, DM, (q >> 4) * 64, (q & 15) * 64); }
        else { const int q = v - 2497; conv_tile<3>(a, l, lds, WDN, DFF, (q / 44) * 64, (q % 44) * 64); }
    }
}

__device__ __forceinline__ void prep_phase(CArgs a, int l, int part, int b0, int nb) {
    const bf16_t* PROJ = (const bf16_t*)(a->ws + WS_R1);
    bf16_t* MIX = (bf16_t*)((unsigned char*)a->out + DO_MIX); bf16_t* LIN = (bf16_t*)((unsigned char*)a->out + DO_LIN);
    const int tid = tid_opaque(), gt = ((int)blockIdx.x - b0) * 512 + tid, nthr = nb * 512;
    if (part == 1)
    for (int it = gt; it < (MAIN_ROWS / 16 + 1) * 64; it += nthr) {
        const int run = it >> 6, c0 = (it & 63) * 8, win = 2 << (c0 >> 7);
        const int b = run >> 7, t0 = (run < MAIN_ROWS / 16) ? NMETA + (run & 127) * 16 : 0;
        float s[8], x[8], y[8];
#pragma unroll
        for (int e = 0; e < 8; ++e) s[e] = 0.f;
        const int pre = (t0 < win) ? t0 : win;
        for (int q = 1; q <= pre; ++q) { unpack8(*(const u32x4*)(PROJ + (size_t)row_of(b, t0 - q) * NPROJ + c0), x);
#pragma unroll
            for (int e = 0; e < 8; ++e) s[e] += x[e]; }
        for (int i = 0; i < 16; ++i) {
            const int t = t0 + i, row = row_of(b, t);
            unpack8(*(const u32x4*)(PROJ + (size_t)row * NPROJ + c0), x);
            if (t >= win) { unpack8(*(const u32x4*)(PROJ + (size_t)row_of(b, t - win) * NPROJ + c0), y);
#pragma unroll
                for (int e = 0; e < 8; ++e) s[e] += x[e] - y[e]; }
            else {
#pragma unroll
                for (int e = 0; e < 8; ++e) s[e] += x[e]; }
            const float inv = 1.0f / (float)((t + 1 < win) ? t + 1 : win);
            u32x4 o; o.x = pk2(s[0] * inv - x[0], s[1] * inv - x[1]); o.y = pk2(s[2] * inv - x[2], s[3] * inv - x[3]);
            o.z = pk2(s[4] * inv - x[4], s[5] * inv - x[5]); o.w = pk2(s[6] * inv - x[6], s[7] * inv - x[7]);
            *(u32x4*)(MIX + (size_t)row * DM + c0) = o;
        }
    }
    if (part == 0)
    for (int it = gt; it < NROWS * 48; it += nthr) {
        const int row = it / 48, cb = (it - row * 48) * 8;
        const int prow = (row >= MAIN_ROWS) ? (row > MAIN_ROWS ? row - 1 : -1) : ((row & (SEQ - 1)) ? row - 1 : NROWS - 1);
        u32x4 o = (u32x4){0u, 0u, 0u, 0u};
        if (cb < 320) {
            float xc[8], xp[8], mu[8], y[8];
            unpack8(*(const u32x4*)(PROJ + (size_t)row * NPROJ + 2048 + cb), xc);
            u32x4 wp = (u32x4){0u, 0u, 0u, 0u};
            if (prow >= 0) wp = *(const u32x4*)(PROJ + (size_t)prow * NPROJ + 2048 + cb);
            unpack8(wp, xp);
            const float* mp = (cb < 288) ? a->in[4] + (size_t)l * NSHIFT + 1536 + cb : a->in[18] + (l > 0 ? (l - 1) * 32 + (cb - 288) : 0);
            const f32x4 m0 = *(const f32x4*)mp, m1 = *(const f32x4*)(mp + 4);
            mu[0] = m0[0]; mu[1] = m0[1]; mu[2] = m0[2]; mu[3] = m0[3]; mu[4] = m1[0]; mu[5] = m1[1]; mu[6] = m1[2]; mu[7] = m1[3];
#pragma unroll
            for (int e = 0; e < 8; ++e) {
                const float sv = xc[e] + (xp[e] - xc[e]) * mu[e];
                y[e] = (cb < 64) ? 1.0f - 2.0f * __builtin_amdgcn_rcpf(1.0f + __builtin_amdgcn_exp2f(sv * 2.88539008f)) : (cb < 128) ? sv : (cb < 288) ? sigmoidf_(sv) : sv;
            }
            o.x = pk2(y[0], y[1]); o.y = pk2(y[2], y[3]); o.z = pk2(y[4], y[5]); o.w = pk2(y[6], y[7]);
        }
        *(u32x4*)(LIN + (size_t)row * KL + cb) = o;
    }
}

constexpr int TC = 16, NCH = TT / TC;
constexpr int SB_A = 0, SB_Q = 1, SB_W = 2, SB_B = 3, SB_K = 4, SB_V = 5, SB_G = 6, SB_Y = 7, SBUF = 8 * TC * 64 + TC * 4;
#define LDS_BARRIER() do { asm volatile("s_waitcnt lgkmcnt(0)" ::: "memory"); __builtin_amdgcn_s_barrier(); asm volatile("" ::: "memory"); } while (0)
__device__ __forceinline__ void scan_phase(CArgs a, int l, LAS float* lds) {
    const int bid = blockIdx.x; if (bid >= BATCH * 8) return;
    const int b = bid >> 3, h = bid & 7, tid = tid_opaque(), wid = __builtin_amdgcn_readfirstlane(tid >> 6), lane = tid & 63;
    const bf16_t* PROJ = (const bf16_t*)(a->ws + WS_R1); const bf16_t* LO = (const bf16_t*)(a->ws + WS_LO);
    bf16_t* VF = (bf16_t*)((unsigned char*)a->out + DO_VF); bf16_t* MIX = (bf16_t*)((unsigned char*)a->out + DO_MIX);
    if (wid < 4) {
        __builtin_amdgcn_s_setprio(2);
        const int rp = wid * 16 + (lane >> 3) * 2, seg = lane & 7;
        f32x2 S0[4], S1[4];
#pragma unroll
        for (int j = 0; j < 4; ++j) { S0[j] = (f32x2){0.f, 0.f}; S1[j] = (f32x2){0.f, 0.f}; }
        for (int it = 0; it < NCH + 2; ++it) {
            if (it >= 1 && it <= NCH) {
                LAS float* buf = lds + ((it - 1) & 1) * SBUF;
#pragma unroll 16
                for (int tl = 0; tl < TC; ++tl) {
                    const LAS float* base = buf + tl * 64 + seg * 8;
                    const f32x4 a0 = *(const LAS f32x4*)(base + SB_A * TC * 64), a1 = *(const LAS f32x4*)(base + SB_A * TC * 64 + 4);
                    const f32x4 q0 = *(const LAS f32x4*)(base + SB_Q * TC * 64), q1 = *(const LAS f32x4*)(base + SB_Q * TC * 64 + 4);
                    const f32x4 w0 = *(const LAS f32x4*)(base + SB_W * TC * 64), w1 = *(const LAS f32x4*)(base + SB_W * TC * 64 + 4);
                    const f32x4 b0 = *(const LAS f32x4*)(base + SB_B * TC * 64), b1 = *(const LAS f32x4*)(base + SB_B * TC * 64 + 4);
                    const f32x4 k0 = *(const LAS f32x4*)(base + SB_K * TC * 64), k1 = *(const LAS f32x4*)(base + SB_K * TC * 64 + 4);
                    const f32x2 vv = *(const LAS f32x2*)(buf + SB_V * TC * 64 + tl * 64 + rp);
                    const f32x2 sc = *(const LAS f32x2*)(buf + 8 * TC * 64 + tl * 4);
                    const f32x2 av[4] = {{a0[0], a0[1]}, {a0[2], a0[3]}, {a1[0], a1[1]}, {a1[2], a1[3]}};
                    const f32x2 qv[4] = {{q0[0], q0[1]}, {q0[2], q0[3]}, {q1[0], q1[1]}, {q1[2], q1[3]}};
                    const f32x2 wv[4] = {{w0[0], w0[1]}, {w0[2], w0[3]}, {w1[0], w1[1]}, {w1[2], w1[3]}};
                    const f32x2 bv[4] = {{b0[0], b0[1]}, {b0[2], b0[3]}, {b1[0], b1[1]}, {b1[2], b1[3]}};
                    const f32x2 kv[4] = {{k0[0], k0[1]}, {k0[2], k0[3]}, {k1[0], k1[1]}, {k1[2], k1[3]}};
                    f32x2 pa0 = S0[0] * av[0], pa1 = S1[0] * av[0], pq0 = S0[0] * qv[0], pq1 = S1[0] * qv[0];
#pragma unroll
                    for (int j = 1; j < 4; ++j) { pa0 += S0[j] * av[j]; pa1 += S1[j] * av[j]; pq0 += S0[j] * qv[j]; pq1 += S1[j] * qv[j]; }
                    float sa0 = pa0.x + pa0.y, sa1 = pa1.x + pa1.y, y0 = pq0.x + pq0.y, y1 = pq1.x + pq1.y;
                    allred8x4(sa0, sa1, y0, y1);
                    const f32x2 sav0 = {sa0, sa0}, sav1 = {sa1, sa1}, vv0 = {vv.x, vv.x}, vv1 = {vv.y, vv.y};
#pragma unroll
                    for (int j = 0; j < 4; ++j) { S0[j] = S0[j] * wv[j] + sav0 * bv[j] + vv0 * kv[j]; S1[j] = S1[j] * wv[j] + sav1 * bv[j] + vv1 * kv[j]; }
                    *(LAS f32x2*)(buf + SB_Y * TC * 64 + tl * 64 + rp) = (f32x2){y0 + sa0 * sc.x + vv.x * sc.y, y1 + sa1 * sc.x + vv.y * sc.y};
                }
            }
            LDS_BARRIER();
        }
        __builtin_amdgcn_s_setprio(0);
    } else {
        const int hw = wid - 4, ch = h * 64 + lane;
        const float mu_r = a->in[4][(size_t)l * NSHIFT + ch], mu_k = a->in[4][(size_t)l * NSHIFT + 512 + ch], mu_v = a->in[4][(size_t)l * NSHIFT + 1024 + ch];
        const float kk_c = a->in[12][l * 512 + ch], ka_c = a->in[13][l * 512 + ch], rk_c = a->in[14][l * 512 + ch], gw = a->in[15][l * 512 + ch], gb = a->in[16][l * 512 + ch];
        unsigned short ld[2][4][11];
#define SCAN_LOAD(c, P) do { _Pragma("unroll") for (int p = 0; p < 4; ++p) { const int t = (c) * TC + p * 4 + hw; const size_t m = (size_t)row_of(b, t); \
        const bf16_t* pr = PROJ + m * NPROJ + 512 + ch; ld[P][p][0] = pr[0]; ld[P][p][1] = pr[512]; ld[P][p][2] = pr[1024]; \
        if (t > 0) { const bf16_t* pp = PROJ + (size_t)row_of(b, t - 1) * NPROJ + 512 + ch; ld[P][p][3] = pp[0]; ld[P][p][4] = pp[512]; ld[P][p][5] = pp[1024]; } else { ld[P][p][3] = 0; ld[P][p][4] = 0; ld[P][p][5] = 0; } \
        const bf16_t* po = LO + m * NL + ch; ld[P][p][6] = po[0]; ld[P][p][7] = po[512]; ld[P][p][8] = po[1024]; ld[P][p][9] = po[1536]; \
        ld[P][p][10] = (l > 0) ? VF[m * 512 + ch] : (unsigned short)0; } } while (0)
#define PK2F(i) ((f32x2){bf2f(ld[par][2 * pp][i]), bf2f(ld[par][2 * pp + 1][i])})
        SCAN_LOAD(0, 0); SCAN_LOAD(1, 1);
        static_assert((NCH + 2) % 2 == 1, "the helper loop is unrolled by two with one trailing trip");
        for (int it2 = 0; it2 < NCH + 2; it2 += 2) {
#pragma unroll
          for (int par = 0; par < 2; ++par) { const int it = it2 + par; if (it >= NCH + 2) break;
            LAS float* buf = lds + (it & 1) * SBUF;
            if (it >= 2) {
#pragma unroll
                for (int p = 0; p < 4; ++p) {
                    const int tl = p * 4 + hw; const size_t m = (size_t)row_of(b, (it - 2) * TC + tl);
                    const float y = buf[SB_Y * TC * 64 + tl * 64 + lane];
                    float s1 = y, s2 = y * y, dum = 0.f; wave_sum3(s1, s2, dum);
                    const float mean = s1 * (1.0f / 64.0f), d = y - mean, var = fmaxf(s2 * (1.0f / 64.0f) - mean * mean, 0.f);
                    const float o = (d * rsqrtf(var + GN_EPS) * gw + gb + buf[8 * TC * 64 + tl * 4 + 2] * buf[SB_V * TC * 64 + tl * 64 + lane]) * buf[SB_G * TC * 64 + tl * 64 + lane];
                    if (it > 2 || b == 0) MIX[m * DM + 512 + ch] = (bf16_t)f2bf(o);
                }
            }
            if (it < NCH) {
#pragma unroll
                for (int pp = 0; pp < 2; ++pp) {
                    const int tl0 = (2 * pp) * 4 + hw, tl1 = tl0 + 4;
                    const f32x2 rc = PK2F(0), kc = PK2F(1), vc = PK2F(2), rpv = PK2F(3), kp = PK2F(4), vp = PK2F(5);
                    const f32x2 e = PK2F(6), av = PK2F(7), gv = PK2F(8), vm = PK2F(9);
                    const f32x2 r = rc + (rpv - rc) * mu_r, k = kc + (kp - kc) * mu_k; f32x2 v = vc + (vp - vc) * mu_v;
                    if (l == 0) {
                        if (it > 0 || b == 0) { VF[(size_t)row_of(b, it * TC + tl0) * 512 + ch] = (bf16_t)f2bf(v.x); VF[(size_t)row_of(b, it * TC + tl1) * 512 + ch] = (bf16_t)f2bf(v.y); }
                    } else { const f32x2 vf = PK2F(10); v = v + (vf - v) * vm; }
                    f32x2 kk = k * kk_c; f32x2 n2 = kk * kk; float n2a = n2.x, n2b = n2.y, dum = 0.f; wave_sum3(n2a, n2b, dum);
                    kk = kk * (f32x2){rsqrtf(fmaxf(n2a, 1e-24f)), rsqrtf(fmaxf(n2b, 1e-24f))};
                    const f32x2 k2 = k * ((av - 1.0f) * ka_c + 1.0f), bb = kk * av;
                    const f32x2 w = {__builtin_amdgcn_exp2f(e.x * -1.44269504f), __builtin_amdgcn_exp2f(e.y * -1.44269504f)};
                    const f32x2 brv = bb * r, krv = k2 * r, cfv = krv * rk_c, q = w * r;
                    float br0 = brv.x, kr0 = krv.x, cf0 = cfv.x, br1 = brv.y, kr1 = krv.y, cf1 = cfv.y; wave_sum3(br0, kr0, cf0); wave_sum3(br1, kr1, cf1);
                    buf[SB_A * TC * 64 + tl0 * 64 + lane] = -kk.x; buf[SB_Q * TC * 64 + tl0 * 64 + lane] = q.x; buf[SB_W * TC * 64 + tl0 * 64 + lane] = w.x;
                    buf[SB_B * TC * 64 + tl0 * 64 + lane] = bb.x; buf[SB_K * TC * 64 + tl0 * 64 + lane] = k2.x; buf[SB_V * TC * 64 + tl0 * 64 + lane] = v.x; buf[SB_G * TC * 64 + tl0 * 64 + lane] = gv.x;
                    buf[SB_A * TC * 64 + tl1 * 64 + lane] = -kk.y; buf[SB_Q * TC * 64 + tl1 * 64 + lane] = q.y; buf[SB_W * TC * 64 + tl1 * 64 + lane] = w.y;
                    buf[SB_B * TC * 64 + tl1 * 64 + lane] = bb.y; buf[SB_K * TC * 64 + tl1 * 64 + lane] = k2.y; buf[SB_V * TC * 64 + tl1 * 64 + lane] = v.y; buf[SB_G * TC * 64 + tl1 * 64 + lane] = gv.y;
                    if (lane < 3) { buf[8 * TC * 64 + tl0 * 4 + lane] = (lane == 0) ? br0 : (lane == 1) ? kr0 : cf0; buf[8 * TC * 64 + tl1 * 4 + lane] = (lane == 0) ? br1 : (lane == 1) ? kr1 : cf1; }
                }
                if (it + 2 < NCH) SCAN_LOAD(it + 2, par);
            }
            LDS_BARRIER();
          }
        }
#undef PK2F
#undef SCAN_LOAD
    }
}


#define XB_TMO      128
#define XB_XCNT(j)  (256  + 64 * (j))
#define XB_XSUB(j)  (1280 + 64 * (j))
#define XB_XGEN(j)  (2304 + 64 * (j))
#define XB_TOP      3328
#define XB_TOPGEN   3392
#define XCD_BAR_WORDS 3456
#define XB_SPIN_CAP (1u << 22)
__device__ __forceinline__ unsigned xb_ld(unsigned* p)              { return __hip_atomic_load(p, __ATOMIC_RELAXED, __HIP_MEMORY_SCOPE_AGENT); }
__device__ __forceinline__ unsigned xb_add(unsigned* p, unsigned v) { return __hip_atomic_fetch_add(p, v, __ATOMIC_RELAXED, __HIP_MEMORY_SCOPE_AGENT); }
__device__ __forceinline__ unsigned xb_xcc_id() { return (unsigned)__builtin_amdgcn_s_getreg((3 << 11) | 20) & 0xFu; }
#define XB_SPIN(cond, bar) do { unsigned _sp = 0; while (cond) { __builtin_amdgcn_s_sleep(1); \
    if ((++_sp & 255u) == 0u) { if (xb_ld(&(bar)[XB_TMO])) break; if (_sp > XB_SPIN_CAP) { atomicAdd(&(bar)[XB_TMO], 1u); break; } } } } while (0)
struct XcdBarrier { unsigned* bar; unsigned x; volatile LAS unsigned* st; };
__device__ __forceinline__ void xcd_barrier_complete(unsigned* bar, unsigned x, unsigned& nloc, unsigned& nx) {
    const unsigned G = gridDim.x;
    unsigned sum, cnt, mine, sp = 0u;
    for (;;) {
        sum = 0u; cnt = 0u; mine = 0u;
#pragma unroll
        for (unsigned j = 0; j < 16; ++j) { const unsigned c = xb_ld(&bar[XB_XCNT(j)]); sum += c; cnt += (c > 0u) ? 1u : 0u; mine = (j == x) ? c : mine; }
        if (sum == G) break;
        __builtin_amdgcn_s_sleep(1);
        if ((++sp & 255u) == 0u) { if (xb_ld(&bar[XB_TMO])) break; if (sp > XB_SPIN_CAP) { atomicAdd(&bar[XB_TMO], 1u); break; } }
    }
    nloc = mine > 0u ? mine : 1u; nx = cnt > 0u ? cnt : 1u;
}
__device__ __forceinline__ void xcd_barrier(const XcdBarrier& b, bool leader_thread) {
    asm volatile("s_waitcnt vmcnt(0)" ::: "memory");
    __syncthreads();
    if (leader_thread) {
        unsigned* bar = b.bar;
        __builtin_amdgcn_s_waitcnt(0);
        unsigned nloc = b.st[0], nx = b.st[1];
        if (nloc == 0u) { xcd_barrier_complete(bar, b.x, nloc, nx); b.st[0] = nloc; b.st[1] = nx; }
        const unsigned old = xb_add(&bar[XB_XSUB(b.x)], 1u);
        const unsigned gen = old / nloc;
        if (old + 1u == (gen + 1u) * nloc) {
            __builtin_amdgcn_fence(__ATOMIC_RELEASE, "agent");
            asm volatile("s_waitcnt vmcnt(0)" ::: "memory");
            const unsigned og = xb_add(&bar[XB_TOP], 1u);
            const unsigned tg = og / nx;
            if (og + 1u == (tg + 1u) * nx) xb_add(&bar[XB_TOPGEN], 1u);
            else XB_SPIN(xb_ld(&bar[XB_TOPGEN]) == tg, bar);
            __builtin_amdgcn_fence(__ATOMIC_ACQUIRE, "agent");
            xb_add(&bar[XB_XGEN(b.x)], 1u);
            asm volatile("s_waitcnt vmcnt(0)" ::: "memory");
        } else {
            XB_SPIN(xb_ld(&bar[XB_XGEN(b.x)]) == gen, bar);
            __builtin_amdgcn_fence(__ATOMIC_ACQUIRE, "agent");
            asm volatile("s_waitcnt vmcnt(0)" ::: "memory");
        }
    }
    __syncthreads();
}

__global__ void __launch_bounds__(512, 2) mega(Args a_unused) {
    extern __shared__ __attribute__((aligned(16))) unsigned char shm[];
    LAS unsigned char* lds = (LAS unsigned char*)shm;
    cg::grid_group grid = cg::this_grid();
    CArgs a0 = (CArgs)__builtin_amdgcn_kernarg_segment_ptr();
    const int ph_lo = a0->ph_lo, ph_hi = a0->ph_hi;
    XcdBarrier xbar; xbar.bar = (unsigned*)(a0->ws + WS_BAR); xbar.x = xb_xcc_id(); xbar.st = (volatile LAS unsigned*)(lds + 131072 + 16384);
    { const int t0 = tid_opaque(); if (t0 == 0) { xbar.st[0] = 0u; xbar.st[1] = 0u; (void)xb_add(&xbar.bar[XB_XCNT(xbar.x)], 1u); } __syncthreads(); }
    for (int ph = ph_lo; ph < ph_hi; ++ph) {
        if (ph > ph_lo) { if (ph == ph_lo + 1) grid.sync(); else xcd_barrier(xbar, tid_opaque() == 0); }
        CArgs a = a0; asm volatile("" : "+s"(a));
        if (ph == 0) { norm_rows(a, 0); weight_prep(a, 0, 0, WT_EARLY, -1, (LAS float*)lds, 0, gridDim.x); continue; }
        if (ph == NPH - 1) { norm_rows(a, 2); continue; }
        const int l = (ph - 1) / 7, s = (ph - 1) % 7;
        bf16_t* HB = (bf16_t*)(a->ws + WS_H); float* SS = (float*)(a->ws + WS_SS);
        const unsigned char* wb = a->ws + WS_WB + (size_t)(l & 1) * WB_SIZE;
        if (s == 0) {
            pg8::Gemm g{HB, (const bf16_t*)(wb + WB_WC), MR, NPROJ, DM};
            pg8::StaticOrder S; S.init(MAIN_ROWS, g.N, gridDim.x, blockIdx.x);
            LAS float* rst = (LAS float*)(lds + 131072);
            build_rs_table(rst, S, SS);
            pg8::EpiProj E{(bf16_t*)(a->ws + WS_R1), g.N, rst};
            pg8::gemm_phase(lds, g, S, E);
            tail16<0, 2>(g.A, g.Bt, g.N, g.K, E.O, g.N, SS, nullptr, (LAS float*)lds);
        }
        else if (s == 2) {
            int kl = KL; asm volatile("" : "+s"(kl));
            pg8::Gemm g{(const bf16_t*)((unsigned char*)a->out + DO_LIN), (const bf16_t*)(wb + WB_WL), MR, NL, kl};
            pg8::StaticOrder S; S.init(MAIN_ROWS, g.N, gridDim.x, blockIdx.x);
            pg8::EpiLora E{(bf16_t*)(a->ws + WS_LO), (const float*)(wb + WB_LB)};
            pg8::gemm_phase(lds, g, S, E);
            tail16<0, 2>(g.A, g.Bt, g.N, g.K, E.O, g.N, nullptr, nullptr, (LAS float*)lds, E.bias);
        }
        else if (s == 1) prep_phase(a, l, 0, 0, gridDim.x);
        else if (s == 3) {
            if (blockIdx.x < BATCH * 8) scan_phase(a, l, (LAS float*)lds);
            else { prep_phase(a, l, 1, BATCH * 8, gridDim.x - BATCH * 8); weight_prep(a, 0, WT_EARLY, l == 0 ? WT_ALL : WT_EARLY, l + 1 < DEPTH ? l + 1 : -1, (LAS float*)lds, BATCH * 8, gridDim.x - BATCH * 8); }
        }
        else if (s == 4 || s == 6) {
            pg8::Gemm g{s == 4 ? (const bf16_t*)((unsigned char*)a->out + DO_MIX) : (const bf16_t*)(a->ws + WS_R1), (const bf16_t*)(wb + (s == 4 ? WB_WOUT : WB_WDN)), MR, DM, s == 4 ? DM : DFF};
            pg8::StaticOrder S; S.init(MAIN_ROWS, DM, gridDim.x, blockIdx.x);
            pg8::EpiResid E{HB, SS + (s == 4 ? (size_t)MR * 16 : 0)};
            pg8::gemm_phase(lds, g, S, E);
            tail16<1, 4>(g.A, g.Bt, g.N, g.K, HB, DM, nullptr, E.ssq, (LAS float*)lds);
        }
        else {
            pg8::Gemm g{HB, (const bf16_t*)(wb + WB_WGU), MR, 2 * DFF, DM}; pg8::StaticOrder S; S.init(MAIN_ROWS, 2 * DFF, gridDim.x, blockIdx.x);
            LAS float* rst = (LAS float*)(lds + 131072); build_rs_table(rst, S, SS + (size_t)MR * 16);
            pg8::EpiSwiglu E{(bf16_t*)(a->ws + WS_R1), rst};
            pg8::gemm_phase(lds, g, S, E);
            tail16<2, 2>(g.A, g.Bt, g.N, g.K, E.O, DFF, SS + (size_t)MR * 16, nullptr, (LAS float*)lds);
        }
    }
}

extern "C" void kernel_launch(void* const* d_in, const int* in_sizes, int n_in, void* d_out, int out_size, void* d_ws, size_t ws_size, hipStream_t stream) {
    static int grid = 0;
    if (grid == 0) {
        if (n_in != 26 || out_size != BATCH * SEQ * DM || ws_size < WS_TOTAL) { fprintf(stderr, "kernel_launch: unexpected shapes (n_in %d out %d ws %zu need %zu)\n", n_in, out_size, ws_size, (size_t)WS_TOTAL); grid = -1; return; }
        int dev = 0, cus = 0, per_cu = 0;
        hipGetDevice(&dev);
        hipDeviceGetAttribute(&cus, hipDeviceAttributeMultiprocessorCount, dev);
        if (hipFuncSetAttribute((const void*)mega, hipFuncAttributeMaxDynamicSharedMemorySize, LDS_BYTES) != hipSuccess) { fprintf(stderr, "kernel_launch: hipFuncSetAttribute failed\n"); grid = -1; return; }
        hipOccupancyMaxActiveBlocksPerMultiprocessor(&per_cu, (const void*)mega, 512, LDS_BYTES);
        if (per_cu < 1) { fprintf(stderr, "kernel_launch: occupancy query says %d blocks per CU\n", per_cu); per_cu = 1; }
        (void)hipGetLastError();
        grid = cus;
        fprintf(stderr, "kernel_launch: grid %d (per_cu %d)\n", grid, per_cu);
    }
    if (grid < 0) return;
    if (hipMemsetAsync((unsigned char*)d_ws + WS_BAR, 0, 16384, stream) != hipSuccess) { fprintf(stderr, "kernel_launch: hipMemsetAsync failed\n"); return; }
    Args a{};
    for (int i = 0; i < 26; ++i) a.in[i] = (const float*)d_in[i];
    a.out = (float*)d_out; a.ws = (unsigned char*)d_ws;
#if MK_MULTI
    for (int ph = 0; ph < NPH; ++ph) {
        a.ph_lo = ph; a.ph_hi = ph + 1;
        void* args[] = {&a};
        hipError_t e = hipLaunchCooperativeKernel((const void*)mega, dim3(grid), dim3(512), args, LDS_BYTES, stream);
        if (e != hipSuccess) { fprintf(stderr, "cooperative launch failed: %s\n", hipGetErrorString(e)); break; }
    }
#else
    a.ph_lo = 0; a.ph_hi = NPH;
    void* args[] = {&a};
    hipError_t e = hipLaunchCooperativeKernel((const void*)mega, dim3(grid), dim3(512), args, LDS_BYTES, stream);
    if (e != hipSuccess) fprintf(stderr, "cooperative launch failed: %s (grid %d)\n", hipGetErrorString(e), grid);
#endif
}
```

```cpp
#include <hip/hip_runtime.h>
#include <hip/hip_cooperative_groups.h>
#include <cstdio>
#include <cstdint>
namespace cg = cooperative_groups;

#ifndef MK_MULTI
#define MK_MULTI 0
#endif

#define LAS __attribute__((address_space(3)))
typedef unsigned short bf16_t;
typedef short bf16x8 __attribute__((ext_vector_type(8)));
typedef float f32x4 __attribute__((ext_vector_type(4)));
typedef float f32x2 __attribute__((ext_vector_type(2)));
typedef unsigned u32x4 __attribute__((ext_vector_type(4)));
typedef unsigned u32x2 __attribute__((ext_vector_type(2)));

constexpr int DM = 1024, BATCH = 16, SEQ = 2048, DEPTH = 4, NMETA = 16, TT = SEQ + NMETA  , MR = BATCH * TT  ;
constexpr int NIN = 2336, NSHIFT = 1824, DFF = 2816, NPROJ = 2560  , KL = 384  , NL = 2048;
constexpr float RMS_EPS = 1e-6f, GN_EPS = 64e-5f;
constexpr int LDS_BYTES = 131072 + 16384 + 64;
constexpr int NPH = DEPTH * 7 + 2;

constexpr size_t WB_WC = 0;
constexpr size_t WB_WOUT = WB_WC + (size_t)NPROJ * DM * 2;
constexpr size_t WB_WGU = WB_WOUT + (size_t)DM * DM * 2;
constexpr size_t WB_WDN = WB_WGU + (size_t)2 * DFF * DM * 2;
constexpr size_t WB_WL = WB_WDN + (size_t)DM * DFF * 2;
constexpr size_t WB_LB = WB_WL + (size_t)NL * KL * 2;
constexpr size_t WB_SIZE = WB_LB + 8192;
constexpr size_t WS_WB = 4096;
constexpr size_t WS_SS = WS_WB + 2 * WB_SIZE;
constexpr size_t WS_H = WS_SS + 2 * (size_t)MR * 64;
constexpr size_t WS_R1 = WS_H + (size_t)MR * DM * 4;
constexpr size_t WS_LO = WS_R1 + (size_t)MR * DFF * 2;
constexpr size_t WS_END = WS_LO + (size_t)MR * NL * 2;
constexpr size_t WS_BAR = WS_END;
constexpr size_t WS_TOTAL = WS_BAR + 16384;
static_assert(WS_TOTAL <= 536870912, "workspace map");
constexpr size_t DO_MIX = 0;
constexpr size_t DO_VF = DO_MIX + (size_t)MR * DM * 2;
constexpr size_t DO_LIN = DO_VF + (size_t)MR * 512 * 2;
static_assert(DO_LIN + (size_t)MR * KL * 2 <= (size_t)BATCH * SEQ * DM * 4, "d_out scratch");

struct Args { const float* in[26]; float* out; unsigned char* ws; int ph_lo, ph_hi; };
typedef const __attribute__((address_space(4))) Args* CArgs;

__device__ __forceinline__ float bf2f(unsigned b) { return __uint_as_float(b << 16); }
__device__ __forceinline__ unsigned f2bf(float f) { unsigned u = __float_as_uint(f); return (u + 0x7fffu + ((u >> 16) & 1u)) >> 16; }
__device__ __forceinline__ unsigned pk2(float lo, float hi) { unsigned r; asm volatile("v_cvt_pk_bf16_f32 %0, %1, %2" : "=v"(r) : "v"(lo), "v"(hi)); return r; }
__device__ __forceinline__ float sigmoidf_(float x) { return __builtin_amdgcn_rcpf(1.0f + __builtin_amdgcn_exp2f(x * -1.44269504f)); }
template <int CTRL> __device__ __forceinline__ float dppf(float x) { return __int_as_float(__builtin_amdgcn_update_dpp(0, __float_as_int(x), CTRL, 0xF, 0xF, true)); }
#define DPP_ADD(r, ctl) "v_add_f32_dpp " r ", " r ", " r " " ctl " row_mask:0xf bank_mask:0xf\n\t"
__device__ __forceinline__ void allred8x4(float& a, float& b, float& c, float& d) {
    asm volatile("s_nop 1\n\t"
        DPP_ADD("%0", "quad_perm:[1,0,3,2]") DPP_ADD("%1", "quad_perm:[1,0,3,2]") DPP_ADD("%2", "quad_perm:[1,0,3,2]") DPP_ADD("%3", "quad_perm:[1,0,3,2]")
        DPP_ADD("%0", "quad_perm:[2,3,0,1]") DPP_ADD("%1", "quad_perm:[2,3,0,1]") DPP_ADD("%2", "quad_perm:[2,3,0,1]") DPP_ADD("%3", "quad_perm:[2,3,0,1]")
        DPP_ADD("%0", "row_half_mirror") DPP_ADD("%1", "row_half_mirror") DPP_ADD("%2", "row_half_mirror") DPP_ADD("%3", "row_half_mirror")
        : "+v"(a), "+v"(b), "+v"(c), "+v"(d));
}
__device__ __forceinline__ float rows_to_wave(float x) {
    const int xi = __float_as_int(x);
    return (__int_as_float(__builtin_amdgcn_readlane(xi, 0)) + __int_as_float(__builtin_amdgcn_readlane(xi, 16))) + (__int_as_float(__builtin_amdgcn_readlane(xi, 32)) + __int_as_float(__builtin_amdgcn_readlane(xi, 48)));
}
__device__ __forceinline__ float wave_sum(float x) {
    asm volatile("s_nop 1\n\t" DPP_ADD("%0", "quad_perm:[1,0,3,2]") "s_nop 1\n\t" DPP_ADD("%0", "quad_perm:[2,3,0,1]") "s_nop 1\n\t" DPP_ADD("%0", "row_half_mirror") "s_nop 1\n\t" DPP_ADD("%0", "row_mirror") : "+v"(x));
    return rows_to_wave(x);
}
__device__ __forceinline__ void wave_sum3(float& a, float& b, float& c) {
    asm volatile("s_nop 1\n\t"
        DPP_ADD("%0", "quad_perm:[1,0,3,2]") DPP_ADD("%1", "quad_perm:[1,0,3,2]") DPP_ADD("%2", "quad_perm:[1,0,3,2]")
        DPP_ADD("%0", "quad_perm:[2,3,0,1]") DPP_ADD("%1", "quad_perm:[2,3,0,1]") DPP_ADD("%2", "quad_perm:[2,3,0,1]")
        DPP_ADD("%0", "row_half_mirror") DPP_ADD("%1", "row_half_mirror") DPP_ADD("%2", "row_half_mirror")
        DPP_ADD("%0", "row_mirror") DPP_ADD("%1", "row_mirror") DPP_ADD("%2", "row_mirror")
        "v_add_f32_dpp %0, %0, %0 row_bcast:15 row_mask:0xa bank_mask:0xf\n\t" "v_add_f32_dpp %1, %1, %1 row_bcast:15 row_mask:0xa bank_mask:0xf\n\t" "v_add_f32_dpp %2, %2, %2 row_bcast:15 row_mask:0xa bank_mask:0xf\n\t"
        "v_add_f32_dpp %0, %0, %0 row_bcast:31 row_mask:0xc bank_mask:0xf\n\t" "v_add_f32_dpp %1, %1, %1 row_bcast:31 row_mask:0xc bank_mask:0xf\n\t" "v_add_f32_dpp %2, %2, %2 row_bcast:31 row_mask:0xc bank_mask:0xf\n\t"
        : "+v"(a), "+v"(b), "+v"(c));
    a = __int_as_float(__builtin_amdgcn_readlane(__float_as_int(a), 63)); b = __int_as_float(__builtin_amdgcn_readlane(__float_as_int(b), 63)); c = __int_as_float(__builtin_amdgcn_readlane(__float_as_int(c), 63));
}
__device__ __forceinline__ int tid_opaque() { int t = threadIdx.x; asm volatile("" : "+v"(t)); return t; }

__device__ __forceinline__ void unpack8(const u32x4 w, float (&x)[8]) {
    x[0] = bf2f(w.x & 0xffffu); x[1] = bf2f(w.x >> 16); x[2] = bf2f(w.y & 0xffffu); x[3] = bf2f(w.y >> 16);
    x[4] = bf2f(w.z & 0xffffu); x[5] = bf2f(w.z >> 16); x[6] = bf2f(w.w & 0xffffu); x[7] = bf2f(w.w >> 16);
}
constexpr int MAIN_ROWS = BATCH * SEQ, NROWS = MAIN_ROWS + NMETA;
__device__ __forceinline__ int row_of(int b, int t) { return t < NMETA ? MAIN_ROWS + t : b * SEQ + (t - NMETA); }
__device__ __forceinline__ float row_rs(const float* ssp, int row) {
    const f32x4* p = (const f32x4*)(ssp + (size_t)row * 16); const f32x4 a = p[0], b = p[1], c = p[2], d = p[3];
    const f32x4 t = (a + b) + (c + d);
    return rsqrtf(((t[0] + t[1]) + (t[2] + t[3])) * (1.0f / DM) + RMS_EPS);
}
namespace pg8 {
constexpr int BM = 256, BK = 64, HALF = 128, HTB = HALF * BK * 2, STAGE_BYTES = 8 * HTB, NXCD = 8, WGM = 8;
__host__ __device__ __forceinline__ int lds_byte(int r, int c) { const int st = (r >> 4) * 2 + (c >> 5), rr = r & 15, cc = c & 31, ob = rr * 64 + cc * 2; return st * 1024 + (ob ^ (((ob >> 9) & 1) << 5)); }
__host__ __device__ __forceinline__ void stage_rc(int b, int& R, int& C) { const int st = b / 1024, sb = b % 1024, swz = sb ^ (((sb >> 9) & 1) << 5); R = (st >> 1) * 16 + swz / 64; C = (st & 1) * 32 + (swz % 64) / 2; }
__host__ __device__ __forceinline__ int perm32(int rho) { const int n = rho >> 4, i = rho & 15; return 8 * (i >> 2) + 4 * n + (i & 3); }
struct Unit { int pm, pn; };
struct Gemm { const bf16_t* A; const bf16_t* Bt; int M, N, K; };
struct StaticOrder {
    int nM, nN, nwg, G, c;
    __device__ void init(int M, int N, int G_, int c_) { nM = M / BM; nN = N / BM; nwg = nM * nN; G = G_; c = c_; }
    __device__ bool next(int i, Unit& u) const {
        const long L = (long)i * G + c; if (L >= nwg) return false;
        int wgid = (int)L; { const int q = nwg / NXCD, r = nwg % NXCD, xcd = wgid % NXCD, off = wgid / NXCD; wgid = (xcd < r ? xcd * (q + 1) : r * (q + 1) + (xcd - r) * q) + off; }
        const int nig = WGM * nN, gid = wgid / nig, fm = gid * WGM, gsz = (nM - fm) < WGM ? (nM - fm) : WGM;
        u.pm = fm + ((wgid % nig) % gsz); u.pn = (wgid % nig) / gsz; return true;
    }
};
template <class Epi>
__device__ __forceinline__ void gemm_phase(LAS unsigned char* lds, const Gemm g, const StaticOrder& S, const Epi& E) {
    int tid_ = threadIdx.x; asm volatile("" : "+v"(tid_));
    const int tid = tid_, wid = __builtin_amdgcn_readfirstlane(tid >> 6), lane = tid & 63, wr = wid >> 2, wc = wid & 3, fr = lane & 15, fq = lane >> 4;
    const int K = g.K, nt = K / BK;
    unsigned voffA[2], voffB[2];
#pragma unroll
    for (int i = 0; i < 2; ++i) { int R, C; stage_rc(tid * 16 + i * 8192, R, C); const int Rb = Epi::PERM ? ((R & ~31) + perm32(R & 31)) : R;
        voffA[i] = (unsigned)(R * K + C) * 2u; voffB[i] = (unsigned)(Rb * K + C) * 2u; }
    const size_t kstep = (size_t)(BK * 2);
    const size_t hstep = (size_t)HALF * K * 2;
    const size_t tstep = 2 * hstep;
    const unsigned ldsw = (unsigned)wid * 1024u;
    const int aoff = lds_byte(wr * 64 + fr, fq * 8), boff = lds_byte(wc * 32 + fr, fq * 8);
#define PG8_SA(b, h) (((b) * 2 + (h)) * HTB)
#define PG8_SB(b, h) ((4 + (b) * 2 + (h)) * HTB)
#define PG8_STAGE(bufoff, gbase, voff) do { _Pragma("unroll") for (int _i = 0; _i < 2; ++_i) \
        __builtin_amdgcn_global_load_lds((const unsigned*)((const char*)(gbase) + (voff)[_i]), (LAS unsigned*)(lds + (bufoff) + ldsw + _i * 8192), 16, 0, 0); } while (0)
#define PG8_LDA(dst, b, h) do { _Pragma("unroll") for (int m = 0; m < 4; ++m) _Pragma("unroll") for (int k = 0; k < 2; ++k) dst[m][k] = *(const LAS bf16x8*)(lds + PG8_SA(b, h) + aoff + m * 2048 + k * 1024); } while (0)
#define PG8_LDB(dst, b, h) do { _Pragma("unroll") for (int n = 0; n < 2; ++n) _Pragma("unroll") for (int k = 0; k < 2; ++k) dst[n][k] = *(const LAS bf16x8*)(lds + PG8_SB(b, h) + boff + n * 2048 + k * 1024); } while (0)
#define PG8_MMA(ai, bj, At, Bt) do { __builtin_amdgcn_s_setprio(1); _Pragma("unroll") for (int m = 0; m < 4; ++m) _Pragma("unroll") for (int n = 0; n < 2; ++n) _Pragma("unroll") for (int k = 0; k < 2; ++k) \
        acc[ai][bj][m][n] = __builtin_amdgcn_mfma_f32_16x16x32_bf16(Bt[n][k], At[m][k], acc[ai][bj][m][n], 0, 0, 0); __builtin_amdgcn_s_setprio(0); } while (0)
#define PG8_WAIT_V(n) asm volatile("s_waitcnt vmcnt(" #n ")" ::: "memory")
#define PG8_WAIT_L(n) asm volatile("s_waitcnt lgkmcnt(" #n ")" ::: "memory")
#define PG8_BAR __builtin_amdgcn_s_barrier()
#define PG8_SCHED __builtin_amdgcn_sched_barrier(0)
    Unit cur, nxt; int ui = 0;
    if (!S.next(0, cur)) return;
    f32x4 acc[2][2][4][2];
#pragma unroll
    for (int a = 0; a < 2; ++a)
#pragma unroll
        for (int b = 0; b < 2; ++b)
#pragma unroll
            for (int m = 0; m < 4; ++m)
#pragma unroll
                for (int n = 0; n < 2; ++n) acc[a][b][m][n] = (f32x4){0.f, 0.f, 0.f, 0.f};
    bf16x8 At[4][2], B0[2][2], B1[2][2];
    const char* cA = (const char*)g.A + (size_t)cur.pm * tstep; const char* cB = (const char*)g.Bt + (size_t)cur.pn * tstep;
    PG8_STAGE(PG8_SB(0, 0), cB, voffB); PG8_STAGE(PG8_SB(0, 1), cB + hstep, voffB); PG8_STAGE(PG8_SA(0, 0), cA, voffA); PG8_STAGE(PG8_SA(0, 1), cA + hstep, voffA);
    if (wr == 1) PG8_BAR;
    PG8_WAIT_V(2); PG8_BAR;
    PG8_STAGE(PG8_SB(1, 0), cB + kstep, voffB); PG8_STAGE(PG8_SA(1, 0), cA + kstep, voffA); PG8_STAGE(PG8_SB(1, 1), cB + hstep + kstep, voffB);
    PG8_WAIT_V(6); PG8_BAR;
    for (;;) {
        const bool has_next = S.next(ui + 1, nxt);
        const char* nA = has_next ? (const char*)g.A + (size_t)nxt.pm * tstep : cA; const char* nB = has_next ? (const char*)g.Bt + (size_t)nxt.pn * tstep : cB;
        for (int t = 0; t < nt; t += 2) {
            const bool last = (t == nt - 2);
            const char* a1 = cA + (size_t)(t + 1) * kstep;
            const char* a2 = last ? nA : cA + (size_t)(t + 2) * kstep; const char* b2 = last ? nB : cB + (size_t)(t + 2) * kstep;
            const char* a3 = a2 + kstep; const char* b3 = b2 + kstep;
            PG8_LDB(B0, 0, 0); PG8_LDB(B1, 0, 1); PG8_SCHED; PG8_LDA(At, 0, 0); PG8_STAGE(PG8_SA(1, 1), a1 + hstep, voffA);
            PG8_WAIT_V(8); PG8_WAIT_L(0); PG8_BAR; PG8_MMA(0, 0, At, B0); PG8_MMA(0, 1, At, B1); PG8_BAR; PG8_SCHED;
            PG8_LDA(At, 0, 1); PG8_STAGE(PG8_SB(0, 0), b2, voffB); PG8_STAGE(PG8_SB(0, 1), b2 + hstep, voffB); PG8_STAGE(PG8_SA(0, 0), a2, voffA);
            PG8_WAIT_V(8); PG8_WAIT_L(0); PG8_BAR; PG8_MMA(1, 0, At, B0); PG8_MMA(1, 1, At, B1); PG8_BAR; PG8_SCHED;
            PG8_LDB(B0, 1, 0); PG8_LDB(B1, 1, 1); PG8_SCHED; PG8_LDA(At, 1, 0); PG8_STAGE(PG8_SA(0, 1), a2 + hstep, voffA);
            PG8_WAIT_V(8); PG8_WAIT_L(0); PG8_BAR; PG8_MMA(0, 0, At, B0); PG8_MMA(0, 1, At, B1); PG8_BAR; PG8_SCHED;
            PG8_LDA(At, 1, 1); PG8_STAGE(PG8_SB(1, 0), b3, voffB); PG8_STAGE(PG8_SB(1, 1), b3 + hstep, voffB); PG8_STAGE(PG8_SA(1, 0), a3, voffA);
            PG8_WAIT_V(8); PG8_WAIT_L(0); PG8_BAR; PG8_MMA(1, 0, At, B0); PG8_MMA(1, 1, At, B1); PG8_BAR; PG8_SCHED;
        }
        if (wr == 0) PG8_BAR;
        E(acc, cur, ui, wr, wc, fr, fq);
        if (!has_next) break;
#pragma unroll
        for (int a = 0; a < 2; ++a)
#pragma unroll
            for (int b = 0; b < 2; ++b)
#pragma unroll
                for (int m = 0; m < 4; ++m)
#pragma unroll
                    for (int n = 0; n < 2; ++n) acc[a][b][m][n] = (f32x4){0.f, 0.f, 0.f, 0.f};
        cur = nxt; cA = nA; cB = nB; ++ui;
        if (wr == 1) PG8_BAR;
    }
    PG8_WAIT_V(0);
    PG8_BAR;
#undef PG8_SA
#undef PG8_SB
#undef PG8_STAGE
#undef PG8_LDA
#undef PG8_LDB
#undef PG8_MMA
#undef PG8_WAIT_V
#undef PG8_WAIT_L
#undef PG8_BAR
#undef PG8_SCHED
}

struct EpiProj {
    static constexpr bool PERM = true;
    bf16_t* O; int ldc; const LAS float* rst;
    __device__ __forceinline__ void operator()(const f32x4 (&acc)[2][2][4][2], const Unit& u, int ui, int wr, int wc, int fr, int fq) const {
        const int row0 = u.pm * BM + wr * 64 + fr, col0 = u.pn * BM + wc * 32 + 8 * fq;
#pragma unroll
        for (int ai = 0; ai < 2; ++ai)
#pragma unroll
            for (int m = 0; m < 4; ++m) { const int row = row0 + ai * HALF + m * 16; bf16_t* rowp = O + (size_t)row * ldc + col0;
                const float rs = rst ? rst[ui * 256 + (row & 255)] : 1.0f;
#pragma unroll
                for (int bj = 0; bj < 2; ++bj) { const f32x4 v0 = acc[ai][bj][m][0] * rs, v1 = acc[ai][bj][m][1] * rs;
                    u32x4 w; w.x = pk2(v0[0], v0[1]); w.y = pk2(v0[2], v0[3]); w.z = pk2(v1[0], v1[1]); w.w = pk2(v1[2], v1[3]);
                    *(u32x4*)(rowp + bj * HALF) = w; } }
    }
};
struct EpiResid {
    static constexpr bool PERM = true;
    bf16_t* HB; float* ssq;
    __device__ __forceinline__ void operator()(const f32x4 (&acc)[2][2][4][2], const Unit& u, int ui, int wr, int wc, int fr, int fq) const {
        const int row0 = u.pm * BM + wr * 64 + fr, col0 = u.pn * BM + wc * 32 + 8 * fq;
#pragma unroll
        for (int ai = 0; ai < 2; ++ai) {
            u32x4 hv[4][2];
#pragma unroll
            for (int m = 0; m < 4; ++m)
#pragma unroll
                for (int bj = 0; bj < 2; ++bj) hv[m][bj] = *(const u32x4*)(HB + (size_t)(row0 + ai * HALF + m * 16) * DM + col0 + bj * HALF);
            __builtin_amdgcn_sched_barrier(0);
#pragma unroll
            for (int m = 0; m < 4; ++m) { const int row = row0 + ai * HALF + m * 16; bf16_t* rowb = HB + (size_t)row * DM + col0;
                float q = 0.f;
#pragma unroll
                for (int bj = 0; bj < 2; ++bj) { const u32x4 hw = hv[m][bj]; const f32x4 v0 = acc[ai][bj][m][0], v1 = acc[ai][bj][m][1];
                    u32x4 w;
                    w.x = pk2(bf2f(hw.x & 0xffffu) + v0[0], bf2f(hw.x >> 16) + v0[1]); w.y = pk2(bf2f(hw.y & 0xffffu) + v0[2], bf2f(hw.y >> 16) + v0[3]);
                    w.z = pk2(bf2f(hw.z & 0xffffu) + v1[0], bf2f(hw.z >> 16) + v1[1]); w.w = pk2(bf2f(hw.w & 0xffffu) + v1[2], bf2f(hw.w >> 16) + v1[3]);
                    *(u32x4*)(rowb + bj * HALF) = w;
                    const float r0 = bf2f(w.x & 0xffffu), r1 = bf2f(w.x >> 16), r2 = bf2f(w.y & 0xffffu), r3 = bf2f(w.y >> 16), r4 = bf2f(w.z & 0xffffu), r5 = bf2f(w.z >> 16), r6 = bf2f(w.w & 0xffffu), r7 = bf2f(w.w >> 16);
                    q += ((r0 * r0 + r1 * r1) + (r2 * r2 + r3 * r3)) + ((r4 * r4 + r5 * r5) + (r6 * r6 + r7 * r7)); }
                q += __shfl_xor(q, 16); q += __shfl_xor(q, 32);
                if (fq == 0) ssq[(size_t)row * 16 + u.pn * 4 + wc] = q; }
            __builtin_amdgcn_sched_barrier(0);
        }
    }
};
struct EpiLora {
    static constexpr bool PERM = true;
    bf16_t* O; const float* bias;
    __device__ __forceinline__ void operator()(const f32x4 (&acc)[2][2][4][2], const Unit& u, int ui, int wr, int wc, int fr, int fq) const {
        const int row0 = u.pm * BM + wr * 64 + fr, col0 = u.pn * BM + wc * 32 + 8 * fq, mode = u.pn >> 1;
        const float sc = (mode == 0) ? 0.60653066f : 1.0f;
#pragma unroll
        for (int bj = 0; bj < 2; ++bj) {
            const f32x4 c0 = *(const f32x4*)(bias + col0 + bj * HALF), c1 = *(const f32x4*)(bias + col0 + bj * HALF + 4);
#pragma unroll
            for (int ai = 0; ai < 2; ++ai)
#pragma unroll
                for (int m = 0; m < 4; ++m) { bf16_t* rowp = O + (size_t)(row0 + ai * HALF + m * 16) * NL + col0 + bj * HALF;
                    f32x4 v0 = acc[ai][bj][m][0] + c0, v1 = acc[ai][bj][m][1] + c1;
                    if (mode != 2) {
#pragma unroll
                        for (int j = 0; j < 4; ++j) { v0[j] = sc * sigmoidf_(v0[j]); v1[j] = sc * sigmoidf_(v1[j]); } }
                    u32x4 w; w.x = pk2(v0[0], v0[1]); w.y = pk2(v0[2], v0[3]); w.z = pk2(v1[0], v1[1]); w.w = pk2(v1[2], v1[3]);
                    *(u32x4*)rowp = w; }
        }
    }
};
struct EpiSwiglu {
    static constexpr bool PERM = true;
    bf16_t* O; const LAS float* rst;
    __device__ __forceinline__ void operator()(const f32x4 (&acc)[2][2][4][2], const Unit& u, int ui, int wr, int wc, int fr, int fq) const {
        const int row0 = u.pm * BM + wr * 64 + fr, col0 = u.pn * 128 + wc * 16 + 4 * fq;
#pragma unroll
        for (int ai = 0; ai < 2; ++ai)
#pragma unroll
            for (int m = 0; m < 4; ++m) { const int row = row0 + ai * HALF + m * 16; bf16_t* rowp = O + (size_t)row * DFF + col0;
                const float rs = rst[ui * 256 + (row & 255)];
#pragma unroll
                for (int bj = 0; bj < 2; ++bj) { const f32x4 gt = acc[ai][bj][m][0] * rs, up = acc[ai][bj][m][1] * rs; float o[4];
#pragma unroll
                    for (int j = 0; j < 4; ++j) o[j] = gt[j] * sigmoidf_(gt[j]) * up[j];
                    u32x2 w; w.x = pk2(o[0], o[1]); w.y = pk2(o[2], o[3]);
                    *(u32x2*)(rowp + bj * 64) = w; } }
    }
};
}

__device__ __forceinline__ void build_rs_table(LAS float* rst, const pg8::StaticOrder& S, const float* ssp) {
    const int tid = tid_opaque();
    pg8::Unit u;
    for (int i = 0; S.next(i, u); ++i) if (tid < 256) rst[i * 256 + tid] = row_rs(ssp, u.pm * 256 + tid);
    __syncthreads();
}
template <int KIND, int NB>
__device__ __forceinline__ void tail16(const bf16_t* A, const bf16_t* Bt, int N, int K, bf16_t* Out, int ldo, const float* ssp, float* ssq, LAS float* red, const float* lbias = nullptr) {
    const int tid = tid_opaque(), wid = __builtin_amdgcn_readfirstlane(tid >> 6), lane = tid & 63, fr = lane & 15, fq = lane >> 4;
    const int ntile = (KIND == 2) ? N / 32 : N / (16 * NB), nks = K >> 7;
    const int row = MAIN_ROWS + fr;
    for (int tile = blockIdx.x; tile < ntile; tile += gridDim.x) {
        f32x4 acc[NB];
#pragma unroll
        for (int be = 0; be < NB; ++be) acc[be] = (f32x4){0.f, 0.f, 0.f, 0.f};
        const bf16_t* ap = A + (size_t)row * K + fq * 8;
        const bf16_t* bp[NB];
        if (KIND == 2) { const int f = tile * 16 + fr, pn = f >> 7, ft = f & 127, r0 = pn * 256 + ((ft >> 2) << 3) + (ft & 3); bp[0] = Bt + (size_t)r0 * K + fq * 8; bp[1] = Bt + (size_t)(r0 + 4) * K + fq * 8; }
        else {
#pragma unroll
            for (int be = 0; be < NB; ++be) bp[be] = Bt + (size_t)(tile * 16 * NB + be * 16 + fr) * K + fq * 8; }
        for (int ks = wid; ks < nks; ks += 8) {
            bf16x8 av[4], bv[NB][4];
#pragma unroll
            for (int u = 0; u < 4; ++u) { av[u] = *(const bf16x8*)(ap + ks * 128 + u * 32);
#pragma unroll
                for (int be = 0; be < NB; ++be) bv[be][u] = *(const bf16x8*)(bp[be] + ks * 128 + u * 32); }
            __builtin_amdgcn_sched_barrier(0);
#pragma unroll
            for (int u = 0; u < 4; ++u)
#pragma unroll
                for (int be = 0; be < NB; ++be) acc[be] = __builtin_amdgcn_mfma_f32_16x16x32_bf16(bv[be][u], av[u], acc[be], 0, 0, 0);
        }
#pragma unroll
        for (int be = 0; be < NB; ++be) *(LAS f32x4*)(red + ((wid * NB + be) * 64 + lane) * 4) = acc[be];
        __syncthreads();
        if (wid == 0) {
#pragma unroll
            for (int be = 0; be < NB; ++be) { f32x4 t = *(const LAS f32x4*)(red + (be * 64 + lane) * 4);
#pragma unroll
                for (int w = 1; w < 8; ++w) t += *(const LAS f32x4*)(red + ((w * NB + be) * 64 + lane) * 4);
                acc[be] = t; }
            if (KIND == 0) {
                const float rs = ssp ? row_rs(ssp, row) : 1.0f;
#pragma unroll
                for (int be = 0; be < NB; ++be) { const int col = tile * 16 * NB + be * 16 + fq * 4; f32x4 v = acc[be] * rs;
                    if (lbias) { const int mode = col >> 9;
                        if (mode != 2) { const float sc = (mode == 0) ? 0.60653066f : 1.0f;
#pragma unroll
                            for (int j = 0; j < 4; ++j) v[j] = sc * sigmoidf_(v[j] + lbias[col + j]); } }
                    u32x2 w; w.x = pk2(v[0], v[1]); w.y = pk2(v[2], v[3]);
                    *(u32x2*)(Out + (size_t)row * ldo + col) = w; }
            } else if (KIND == 1) {
                float q = 0.f;
#pragma unroll
                for (int be = 0; be < NB; ++be) { bf16_t* o = Out + (size_t)row * ldo + tile * 16 * NB + be * 16 + fq * 4; const u32x2 hw = *(const u32x2*)o;
                    u32x2 w; w.x = pk2(bf2f(hw.x & 0xffffu) + acc[be][0], bf2f(hw.x >> 16) + acc[be][1]); w.y = pk2(bf2f(hw.y & 0xffffu) + acc[be][2], bf2f(hw.y >> 16) + acc[be][3]);
                    *(u32x2*)o = w;
                    const float r0 = bf2f(w.x & 0xffffu), r1 = bf2f(w.x >> 16), r2 = bf2f(w.y & 0xffffu), r3 = bf2f(w.y >> 16);
                    q += (r0 * r0 + r1 * r1) + (r2 * r2 + r3 * r3); }
                q += __shfl_xor(q, 16); q += __shfl_xor(q, 32);
                if (fq == 0) ssq[(size_t)row * 16 + tile] = q;
            } else {
                const float rs = row_rs(ssp, row); float v[4];
#pragma unroll
                for (int j = 0; j < 4; ++j) { const float g = acc[0][j] * rs; v[j] = g * sigmoidf_(g) * (acc[1][j] * rs); }
                u32x2 w; w.x = pk2(v[0], v[1]); w.y = pk2(v[2], v[3]);
                *(u32x2*)(Out + (size_t)row * ldo + tile * 16 + fq * 4) = w;
            }
        }
        __syncthreads();
    }
}

__device__ __forceinline__ void norm_rows(CArgs a, int mode) {
    const int tid = tid_opaque(), wid = tid >> 6, lane = tid & 63;
    bf16_t* HB = (bf16_t*)(a->ws + WS_H); float* SS = (float*)(a->ws + WS_SS);
    for (int row = blockIdx.x * 8 + wid; row < (mode == 0 ? NROWS : MAIN_ROWS); row += gridDim.x * 8) {
        float x[16]; float ss = 0.f;
        if (mode == 0) {
            const float* src = (row >= MAIN_ROWS ? a->in[1] + (size_t)(row - MAIN_ROWS) * DM : a->in[0] + (size_t)row * DM);
#pragma unroll
            for (int i = 0; i < 2; ++i) { const f32x4 v0 = *(const f32x4*)(src + lane * 8 + 512 * i), v1 = *(const f32x4*)(src + lane * 8 + 512 * i + 4);
                u32x4 w; w.x = pk2(v0[0], v0[1]); w.y = pk2(v0[2], v0[3]); w.z = pk2(v1[0], v1[1]); w.w = pk2(v1[2], v1[3]);
                *(u32x4*)(HB + (size_t)row * DM + lane * 8 + 512 * i) = w;
                float r[8]; unpack8(w, r);
#pragma unroll
                for (int e = 0; e < 8; ++e) ss += r[e] * r[e]; }
            ss = wave_sum(ss);
            if (lane < 16) SS[(size_t)row * 16 + lane] = (lane == 0) ? ss : 0.f;
        } else {
#pragma unroll
            for (int i = 0; i < 2; ++i) { float r[8]; unpack8(*(const u32x4*)(HB + (size_t)row * DM + lane * 8 + 512 * i), r);
#pragma unroll
                for (int e = 0; e < 8; ++e) { x[i * 8 + e] = r[e]; ss += r[e] * r[e]; } }
            ss = wave_sum(ss);
            const float rs = rsqrtf(ss * (1.0f / DM) + RMS_EPS);
            float* o = a->out + (size_t)row * DM;
#pragma unroll
            for (int i = 0; i < 2; ++i) { const f32x4 g0 = *(const f32x4*)(a->in[25] + lane * 8 + 512 * i), g1 = *(const f32x4*)(a->in[25] + lane * 8 + 512 * i + 4);
                *(f32x4*)(o + lane * 8 + 512 * i) = (f32x4){x[i * 8] * rs * g0[0], x[i * 8 + 1] * rs * g0[1], x[i * 8 + 2] * rs * g0[2], x[i * 8 + 3] * rs * g0[3]};
                *(f32x4*)(o + lane * 8 + 512 * i + 4) = (f32x4){x[i * 8 + 4] * rs * g1[0], x[i * 8 + 5] * rs * g1[1], x[i * 8 + 6] * rs * g1[2], x[i * 8 + 7] * rs * g1[3]}; }
        }
    }
}

template <int KIND> __device__ __forceinline__ float wsrc(CArgs a, int l, int k, int n) {
    if (KIND == 0) {
        const float gk = a->in[2][(size_t)l * DM + k];
        if (n < NIN) return gk * a->in[3][((size_t)l * DM + k) * NIN + n];
        if (n < NIN + 32 && l > 0) return gk * a->in[17][((size_t)(l - 1) * DM + k) * 32 + (n - NIN)];
        return 0.f;
    } else if (KIND == 1) {
        return a->in[21][((size_t)l * DM + k) * DM + n];
    } else if (KIND == 2) {
        const int pn = n >> 8, c = n & 255, feat = pn * 128 + ((c >> 3) << 2) + (c & 3), isup = (c >> 2) & 1;
        return a->in[22][(size_t)l * DM + k] * a->in[23][((size_t)l * DM + k) * (2 * DFF) + feat + isup * DFF];
    } else if (KIND == 3) {
        return a->in[24][((size_t)l * DFF + k) * DM + n];
    } else {
        const int j = n >> 9, nn = n & 511;
        if (j == 0) return (k < 64) ? a->in[8][((size_t)l * 64 + k) * 512 + nn] : 0.f;
        if (j == 1) return (k >= 64 && k < 128) ? a->in[10][((size_t)l * 64 + (k - 64)) * 512 + nn] : 0.f;
        if (j == 2) return (k >= 128 && k < 288) ? a->in[11][((size_t)l * 160 + (k - 128)) * 512 + nn] : 0.f;
        return (k >= 288 && k < 320 && l > 0) ? a->in[20][((size_t)(l - 1) * 32 + (k - 288)) * 512 + nn] : 0.f;
    }
}
template <int KIND> __device__ __forceinline__ void conv_tile(CArgs a, int l, LAS float* tile, bf16_t* out, int ldo, int n0, int k0) {
    const int tid = tid_opaque(), kk = tid >> 6, nn = tid & 63;
#pragma unroll
    for (int i = 0; i < 8; ++i) tile[(kk + 8 * i) * 65 + nn] = wsrc<KIND>(a, l, k0 + kk + 8 * i, n0 + nn);
    __syncthreads();
    const int n = tid >> 3, kq = tid & 7;
    u32x4 w;
    w.x = pk2(tile[(kq * 8 + 0) * 65 + n], tile[(kq * 8 + 1) * 65 + n]); w.y = pk2(tile[(kq * 8 + 2) * 65 + n], tile[(kq * 8 + 3) * 65 + n]);
    w.z = pk2(tile[(kq * 8 + 4) * 65 + n], tile[(kq * 8 + 5) * 65 + n]); w.w = pk2(tile[(kq * 8 + 6) * 65 + n], tile[(kq * 8 + 7) * 65 + n]);
    *(u32x4*)(out + (size_t)(n0 + n) * ldo + k0 + kq * 8) = w;
    __syncthreads();
}
__device__ __forceinline__ void fold_tile(CArgs a, int l, LAS float* lds, bf16_t* out, int n0, int k0) {
    LAS float* P = lds; LAS float* W = lds + 64 * 128;
    const int tid = tid_opaque(), g = k0 >> 7, c0 = k0 & 127;
    const float* pw = a->in[5] + ((size_t)(l * 4 + g) * 128 + c0) * 128; const float* sc = a->in[6] + (size_t)l * 512 + g * 128;
    const float* wo = a->in[21] + ((size_t)l * DM + g * 128) * DM + n0;
    for (int i = tid; i < 64 * 128; i += 512) { const int d = i & 127; P[i] = pw[i] * sc[d]; }
    for (int i = tid; i < 128 * 64; i += 512) { const int d = i >> 6, n = i & 63; W[i] = wo[(size_t)d * DM + n]; }
    __syncthreads();
    const int n = tid & 63, cq = tid >> 6;
    float acc[8];
#pragma unroll
    for (int j = 0; j < 8; ++j) acc[j] = 0.f;
    for (int d = 0; d < 128; ++d) { const float wv = W[d * 64 + n];
#pragma unroll
        for (int j = 0; j < 8; ++j) acc[j] += P[(cq * 8 + j) * 128 + d] * wv; }
    u32x4 w; w.x = pk2(acc[0], acc[1]); w.y = pk2(acc[2], acc[3]); w.z = pk2(acc[4], acc[5]); w.w = pk2(acc[6], acc[7]);
    *(u32x4*)(out + (size_t)(n0 + n) * DM + k0 + cq * 8) = w;
    __syncthreads();
}
constexpr int WT_EARLY = 833, WT_ALL = 3201;
__device__ __forceinline__ void weight_prep(CArgs a, int lA, int vlo, int vhi, int lB, LAS float* lds, int b0, int nb) {
    const int nA = vhi - vlo, ntot = nA + (lB >= 0 ? WT_ALL : 0);
    for (int it = (int)blockIdx.x - b0; it < ntot; it += nb) {
        const int l = (it < nA) ? lA : lB, v = (it < nA) ? vlo + it : it - nA;
        unsigned char* wb = a->ws + WS_WB + (size_t)(l & 1) * WB_SIZE;
        bf16_t* WC = (bf16_t*)(wb + WB_WC); bf16_t* WO = (bf16_t*)(wb + WB_WOUT); bf16_t* WGU = (bf16_t*)(wb + WB_WGU); bf16_t* WDN = (bf16_t*)(wb + WB_WDN); bf16_t* WL = (bf16_t*)(wb + WB_WL);
        if (v < 640) { conv_tile<0>(a, l, lds, WC, DM, (v >> 4) * 64, (v & 15) * 64); }
        else if (v < 832) { const int q = v - 640; conv_tile<4>(a, l, lds, WL, KL, (q / 6) * 64, (q % 6) * 64); }
        else if (v == 832) { float* LB = (float*)(wb + WB_LB); const int t0 = tid_opaque();
            for (int i = t0; i < NL; i += 512) { const int j = i >> 9, nn = i & 511; LB[i] = (j == 0) ? a->in[7][l * 512 + nn] : (j == 1) ? a->in[9][l * 512 + nn] : (j == 3 && l > 0) ? a->in[19][(l - 1) * 512 + nn] : 0.f; } }
        else if (v < 961) { const int q = v - 833; fold_tile(a, l, lds, WO, (q & 15) * 64, (q >> 4) * 64); }
        else if (v < 1089) { const int q = v - 961; conv_tile<1>(a, l, lds, WO, DM, (q & 15) * 64, 512 + (q >> 4) * 64); }
        else if (v < 2497) { const int q = v - 1089; conv_tile<2>(a, l, lds, WGU, DM, (q >> 4) * 64, (q & 15) * 64); }
        else { const int q = v - 2497; conv_tile<3>(a, l, lds, WDN, DFF, (q / 44) * 64, (q % 44) * 64); }
    }
}

__device__ __forceinline__ void prep_phase(CArgs a, int l, int part, int b0, int nb) {
    const bf16_t* PROJ = (const bf16_t*)(a->ws + WS_R1);
    bf16_t* MIX = (bf16_t*)((unsigned char*)a->out + DO_MIX); bf16_t* LIN = (bf16_t*)((unsigned char*)a->out + DO_LIN);
    const int tid = tid_opaque(), gt = ((int)blockIdx.x - b0) * 512 + tid, nthr = nb * 512;
    if (part == 1)
    for (int it = gt; it < (MAIN_ROWS / 16 + 1) * 64; it += nthr) {
        const int run = it >> 6, c0 = (it & 63) * 8, win = 2 << (c0 >> 7);
        const int b = run >> 7, t0 = (run < MAIN_ROWS / 16) ? NMETA + (run & 127) * 16 : 0;
        float s[8], x[8], y[8];
#pragma unroll
        for (int e = 0; e < 8; ++e) s[e] = 0.f;
        const int pre = (t0 < win) ? t0 : win;
        for (int q = 1; q <= pre; ++q) { unpack8(*(const u32x4*)(PROJ + (size_t)row_of(b, t0 - q) * NPROJ + c0), x);
#pragma unroll
            for (int e = 0; e < 8; ++e) s[e] += x[e]; }
        for (int i = 0; i < 16; ++i) {
            const int t = t0 + i, row = row_of(b, t);
            unpack8(*(const u32x4*)(PROJ + (size_t)row * NPROJ + c0), x);
            if (t >= win) { unpack8(*(const u32x4*)(PROJ + (size_t)row_of(b, t - win) * NPROJ + c0), y);
#pragma unroll
                for (int e = 0; e < 8; ++e) s[e] += x[e] - y[e]; }
            else {
#pragma unroll
                for (int e = 0; e < 8; ++e) s[e] += x[e]; }
            const float inv = 1.0f / (float)((t + 1 < win) ? t + 1 : win);
            u32x4 o; o.x = pk2(s[0] * inv - x[0], s[1] * inv - x[1]); o.y = pk2(s[2] * inv - x[2], s[3] * inv - x[3]);
            o.z = pk2(s[4] * inv - x[4], s[5] * inv - x[5]); o.w = pk2(s[6] * inv - x[6], s[7] * inv - x[7]);
            *(u32x4*)(MIX + (size_t)row * DM + c0) = o;
        }
    }
    if (part == 0)
    for (int it = gt; it < NROWS * 48; it += nthr) {
        const int row = it / 48, cb = (it - row * 48) * 8;
        const int prow = (row >= MAIN_ROWS) ? (row > MAIN_ROWS ? row - 1 : -1) : ((row & (SEQ - 1)) ? row - 1 : NROWS - 1);
        u32x4 o = (u32x4){0u, 0u, 0u, 0u};
        if (cb < 320) {
            float xc[8], xp[8], mu[8], y[8];
            unpack8(*(const u32x4*)(PROJ + (size_t)row * NPROJ + 2048 + cb), xc);
            u32x4 wp = (u32x4){0u, 0u, 0u, 0u};
            if (prow >= 0) wp = *(const u32x4*)(PROJ + (size_t)prow * NPROJ + 2048 + cb);
            unpack8(wp, xp);
            const float* mp = (cb < 288) ? a->in[4] + (size_t)l * NSHIFT + 1536 + cb : a->in[18] + (l > 0 ? (l - 1) * 32 + (cb - 288) : 0);
            const f32x4 m0 = *(const f32x4*)mp, m1 = *(const f32x4*)(mp + 4);
            mu[0] = m0[0]; mu[1] = m0[1]; mu[2] = m0[2]; mu[3] = m0[3]; mu[4] = m1[0]; mu[5] = m1[1]; mu[6] = m1[2]; mu[7] = m1[3];
#pragma unroll
            for (int e = 0; e < 8; ++e) {
                const float sv = xc[e] + (xp[e] - xc[e]) * mu[e];
                y[e] = (cb < 64) ? 1.0f - 2.0f * __builtin_amdgcn_rcpf(1.0f + __builtin_amdgcn_exp2f(sv * 2.88539008f)) : (cb < 128) ? sv : (cb < 288) ? sigmoidf_(sv) : sv;
            }
            o.x = pk2(y[0], y[1]); o.y = pk2(y[2], y[3]); o.z = pk2(y[4], y[5]); o.w = pk2(y[6], y[7]);
        }
        *(u32x4*)(LIN + (size_t)row * KL + cb) = o;
    }
}

constexpr int TC = 16, NCH = TT / TC;
constexpr int SB_A = 0, SB_Q = 1, SB_W = 2, SB_B = 3, SB_K = 4, SB_V = 5, SB_G = 6, SB_Y = 7, SBUF = 8 * TC * 64 + TC * 4;
#define LDS_BARRIER() do { asm volatile("s_waitcnt lgkmcnt(0)" ::: "memory"); __builtin_amdgcn_s_barrier(); asm volatile("" ::: "memory"); } while (0)
__device__ __forceinline__ void scan_phase(CArgs a, int l, LAS float* lds) {
    const int bid = blockIdx.x; if (bid >= BATCH * 8) return;
    const int b = bid >> 3, h = bid & 7, tid = tid_opaque(), wid = __builtin_amdgcn_readfirstlane(tid >> 6), lane = tid & 63;
    const bf16_t* PROJ = (const bf16_t*)(a->ws + WS_R1); const bf16_t* LO = (const bf16_t*)(a->ws + WS_LO);
    bf16_t* VF = (bf16_t*)((unsigned char*)a->out + DO_VF); bf16_t* MIX = (bf16_t*)((unsigned char*)a->out + DO_MIX);
    if (wid < 4) {
        __builtin_amdgcn_s_setprio(2);
        const int rp = wid * 16 + (lane >> 3) * 2, seg = lane & 7;
        f32x2 S0[4], S1[4];
#pragma unroll
        for (int j = 0; j < 4; ++j) { S0[j] = (f32x2){0.f, 0.f}; S1[j] = (f32x2){0.f, 0.f}; }
        for (int it = 0; it < NCH + 2; ++it) {
            if (it >= 1 && it <= NCH) {
                LAS float* buf = lds + ((it - 1) & 1) * SBUF;
#pragma unroll 16
                for (int tl = 0; tl < TC; ++tl) {
                    const LAS float* base = buf + tl * 64 + seg * 8;
                    const f32x4 a0 = *(const LAS f32x4*)(base + SB_A * TC * 64), a1 = *(const LAS f32x4*)(base + SB_A * TC * 64 + 4);
                    const f32x4 q0 = *(const LAS f32x4*)(base + SB_Q * TC * 64), q1 = *(const LAS f32x4*)(base + SB_Q * TC * 64 + 4);
                    const f32x4 w0 = *(const LAS f32x4*)(base + SB_W * TC * 64), w1 = *(const LAS f32x4*)(base + SB_W * TC * 64 + 4);
                    const f32x4 b0 = *(const LAS f32x4*)(base + SB_B * TC * 64), b1 = *(const LAS f32x4*)(base + SB_B * TC * 64 + 4);
                    const f32x4 k0 = *(const LAS f32x4*)(base + SB_K * TC * 64), k1 = *(const LAS f32x4*)(base + SB_K * TC * 64 + 4);
                    const f32x2 vv = *(const LAS f32x2*)(buf + SB_V * TC * 64 + tl * 64 + rp);
                    const f32x2 sc = *(const LAS f32x2*)(buf + 8 * TC * 64 + tl * 4);
                    const f32x2 av[4] = {{a0[0], a0[1]}, {a0[2], a0[3]}, {a1[0], a1[1]}, {a1[2], a1[3]}};
                    const f32x2 qv[4] = {{q0[0], q0[1]}, {q0[2], q0[3]}, {q1[0], q1[1]}, {q1[2], q1[3]}};
                    const f32x2 wv[4] = {{w0[0], w0[1]}, {w0[2], w0[3]}, {w1[0], w1[1]}, {w1[2], w1[3]}};
                    const f32x2 bv[4] = {{b0[0], b0[1]}, {b0[2], b0[3]}, {b1[0], b1[1]}, {b1[2], b1[3]}};
                    const f32x2 kv[4] = {{k0[0], k0[1]}, {k0[2], k0[3]}, {k1[0], k1[1]}, {k1[2], k1[3]}};
                    f32x2 pa0 = S0[0] * av[0], pa1 = S1[0] * av[0], pq0 = S0[0] * qv[0], pq1 = S1[0] * qv[0];
#pragma unroll
                    for (int j = 1; j < 4; ++j) { pa0 += S0[j] * av[j]; pa1 += S1[j] * av[j]; pq0 += S0[j] * qv[j]; pq1 += S1[j] * qv[j]; }
                    float sa0 = pa0.x + pa0.y, sa1 = pa1.x + pa1.y, y0 = pq0.x + pq0.y, y1 = pq1.x + pq1.y;
                    allred8x4(sa0, sa1, y0, y1);
                    const f32x2 sav0 = {sa0, sa0}, sav1 = {sa1, sa1}, vv0 = {vv.x, vv.x}, vv1 = {vv.y, vv.y};
#pragma unroll
                    for (int j = 0; j < 4; ++j) { S0[j] = S0[j] * wv[j] + sav0 * bv[j] + vv0 * kv[j]; S1[j] = S1[j] * wv[j] + sav1 * bv[j] + vv1 * kv[j]; }
                    *(LAS f32x2*)(buf + SB_Y * TC * 64 + tl * 64 + rp) = (f32x2){y0 + sa0 * sc.x + vv.x * sc.y, y1 + sa1 * sc.x + vv.y * sc.y};
                }
            }
            LDS_BARRIER();
        }
        __builtin_amdgcn_s_setprio(0);
    } else {
        const int hw = wid - 4, ch = h * 64 + lane;
        const float mu_r = a->in[4][(size_t)l * NSHIFT + ch], mu_k = a->in[4][(size_t)l * NSHIFT + 512 + ch], mu_v = a->in[4][(size_t)l * NSHIFT + 1024 + ch];
        const float kk_c = a->in[12][l * 512 + ch], ka_c = a->in[13][l * 512 + ch], rk_c = a->in[14][l * 512 + ch], gw = a->in[15][l * 512 + ch], gb = a->in[16][l * 512 + ch];
        unsigned short ld[2][4][11];
#define SCAN_LOAD(c, P) do { _Pragma("unroll") for (int p = 0; p < 4; ++p) { const int t = (c) * TC + p * 4 + hw; const size_t m = (size_t)row_of(b, t); \
        const bf16_t* pr = PROJ + m * NPROJ + 512 + ch; ld[P][p][0] = pr[0]; ld[P][p][1] = pr[512]; ld[P][p][2] = pr[1024]; \
        if (t > 0) { const bf16_t* pp = PROJ + (size_t)row_of(b, t - 1) * NPROJ + 512 + ch; ld[P][p][3] = pp[0]; ld[P][p][4] = pp[512]; ld[P][p][5] = pp[1024]; } else { ld[P][p][3] = 0; ld[P][p][4] = 0; ld[P][p][5] = 0; } \
        const bf16_t* po = LO + m * NL + ch; ld[P][p][6] = po[0]; ld[P][p][7] = po[512]; ld[P][p][8] = po[1024]; ld[P][p][9] = po[1536]; \
        ld[P][p][10] = (l > 0) ? VF[m * 512 + ch] : (unsigned short)0; } } while (0)
#define PK2F(i) ((f32x2){bf2f(ld[par][2 * pp][i]), bf2f(ld[par][2 * pp + 1][i])})
        SCAN_LOAD(0, 0); SCAN_LOAD(1, 1);
        static_assert((NCH + 2) % 2 == 1, "the helper loop is unrolled by two with one trailing trip");
        for (int it2 = 0; it2 < NCH + 2; it2 += 2) {
#pragma unroll
          for (int par = 0; par < 2; ++par) { const int it = it2 + par; if (it >= NCH + 2) break;
            LAS float* buf = lds + (it & 1) * SBUF;
            if (it >= 2) {
#pragma unroll
                for (int p = 0; p < 4; ++p) {
                    const int tl = p * 4 + hw; const size_t m = (size_t)row_of(b, (it - 2) * TC + tl);
                    const float y = buf[SB_Y * TC * 64 + tl * 64 + lane];
                    float s1 = y, s2 = y * y, dum = 0.f; wave_sum3(s1, s2, dum);
                    const float mean = s1 * (1.0f / 64.0f), d = y - mean, var = fmaxf(s2 * (1.0f / 64.0f) - mean * mean, 0.f);
                    const float o = (d * rsqrtf(var + GN_EPS) * gw + gb + buf[8 * TC * 64 + tl * 4 + 2] * buf[SB_V * TC * 64 + tl * 64 + lane]) * buf[SB_G * TC * 64 + tl * 64 + lane];
                    if (it > 2 || b == 0) MIX[m * DM + 512 + ch] = (bf16_t)f2bf(o);
                }
            }
            if (it < NCH) {
#pragma unroll
                for (int pp = 0; pp < 2; ++pp) {
                    const int tl0 = (2 * pp) * 4 + hw, tl1 = tl0 + 4;
                    const f32x2 rc = PK2F(0), kc = PK2F(1), vc = PK2F(2), rpv = PK2F(3), kp = PK2F(4), vp = PK2F(5);
                    const f32x2 e = PK2F(6), av = PK2F(7), gv = PK2F(8), vm = PK2F(9);
                    const f32x2 r = rc + (rpv - rc) * mu_r, k = kc + (kp - kc) * mu_k; f32x2 v = vc + (vp - vc) * mu_v;
                    if (l == 0) {
                        if (it > 0 || b == 0) { VF[(size_t)row_of(b, it * TC + tl0) * 512 + ch] = (bf16_t)f2bf(v.x); VF[(size_t)row_of(b, it * TC + tl1) * 512 + ch] = (bf16_t)f2bf(v.y); }
                    } else { const f32x2 vf = PK2F(10); v = v + (vf - v) * vm; }
                    f32x2 kk = k * kk_c; f32x2 n2 = kk * kk; float n2a = n2.x, n2b = n2.y, dum = 0.f; wave_sum3(n2a, n2b, dum);
                    kk = kk * (f32x2){rsqrtf(fmaxf(n2a, 1e-24f)), rsqrtf(fmaxf(n2b, 1e-24f))};
                    const f32x2 k2 = k * ((av - 1.0f) * ka_c + 1.0f), bb = kk * av;
                    const f32x2 w = {__builtin_amdgcn_exp2f(e.x * -1.44269504f), __builtin_amdgcn_exp2f(e.y * -1.44269504f)};
                    const f32x2 brv = bb * r, krv = k2 * r, cfv = krv * rk_c, q = w * r;
                    float br0 = brv.x, kr0 = krv.x, cf0 = cfv.x, br1 = brv.y, kr1 = krv.y, cf1 = cfv.y; wave_sum3(br0, kr0, cf0); wave_sum3(br1, kr1, cf1);
                    buf[SB_A * TC * 64 + tl0 * 64 + lane] = -kk.x; buf[SB_Q * TC * 64 + tl0 * 64 + lane] = q.x; buf[SB_W * TC * 64 + tl0 * 64 + lane] = w.x;
                    buf[SB_B * TC * 64 + tl0 * 64 + lane] = bb.x; buf[SB_K * TC * 64 + tl0 * 64 + lane] = k2.x; buf[SB_V * TC * 64 + tl0 * 64 + lane] = v.x; buf[SB_G * TC * 64 + tl0 * 64 + lane] = gv.x;
                    buf[SB_A * TC * 64 + tl1 * 64 + lane] = -kk.y; buf[SB_Q * TC * 64 + tl1 * 64 + lane] = q.y; buf[SB_W * TC * 64 + tl1 * 64 + lane] = w.y;
                    buf[SB_B * TC * 64 + tl1 * 64 + lane] = bb.y; buf[SB_K * TC * 64 + tl1 * 64 + lane] = k2.y; buf[SB_V * TC * 64 + tl1 * 64 + lane] = v.y; buf[SB_G * TC * 64 + tl1 * 64 + lane] = gv.y;
                    if (lane < 3) { buf[8 * TC * 64 + tl0 * 4 + lane] = (lane == 0) ? br0 : (lane == 1) ? kr0 : cf0; buf[8 * TC * 64 + tl1 * 4 + lane] = (lane == 0) ? br1 : (lane == 1) ? kr1 : cf1; }
                }
                if (it + 2 < NCH) SCAN_LOAD(it + 2, par);
            }
            LDS_BARRIER();
          }
        }
#undef PK2F
#undef SCAN_LOAD
    }
}


#define XB_TMO      128
#define XB_XCNT(j)  (256  + 64 * (j))
#define XB_XSUB(j)  (1280 + 64 * (j))
#define XB_XGEN(j)  (2304 + 64 * (j))
#define XB_TOP      3328
#define XB_TOPGEN   3392
#define XCD_BAR_WORDS 3456
#define XB_SPIN_CAP (1u << 22)
__device__ __forceinline__ unsigned xb_ld(unsigned* p)              { return __hip_atomic_load(p, __ATOMIC_RELAXED, __HIP_MEMORY_SCOPE_AGENT); }
__device__ __forceinline__ unsigned xb_add(unsigned* p, unsigned v) { return __hip_atomic_fetch_add(p, v, __ATOMIC_RELAXED, __HIP_MEMORY_SCOPE_AGENT); }
__device__ __forceinline__ unsigned xb_xcc_id() { return (unsigned)__builtin_amdgcn_s_getreg((3 << 11) | 20) & 0xFu; }
#define XB_SPIN(cond, bar) do { unsigned _sp = 0; while (cond) { __builtin_amdgcn_s_sleep(1); \
    if ((++_sp & 255u) == 0u) { if (xb_ld(&(bar)[XB_TMO])) break; if (_sp > XB_SPIN_CAP) { atomicAdd(&(bar)[XB_TMO], 1u); break; } } } } while (0)
struct XcdBarrier { unsigned* bar; unsigned x; volatile LAS unsigned* st; };
__device__ __forceinline__ void xcd_barrier_complete(unsigned* bar, unsigned x, unsigned& nloc, unsigned& nx) {
    const unsigned G = gridDim.x;
    unsigned sum, cnt, mine, sp = 0u;
    for (;;) {
        sum = 0u; cnt = 0u; mine = 0u;
#pragma unroll
        for (unsigned j = 0; j < 16; ++j) { const unsigned c = xb_ld(&bar[XB_XCNT(j)]); sum += c; cnt += (c > 0u) ? 1u : 0u; mine = (j == x) ? c : mine; }
        if (sum == G) break;
        __builtin_amdgcn_s_sleep(1);
        if ((++sp & 255u) == 0u) { if (xb_ld(&bar[XB_TMO])) break; if (sp > XB_SPIN_CAP) { atomicAdd(&bar[XB_TMO], 1u); break; } }
    }
    nloc = mine > 0u ? mine : 1u; nx = cnt > 0u ? cnt : 1u;
}
__device__ __forceinline__ void xcd_barrier(const XcdBarrier& b, bool leader_thread) {
    asm volatile("s_waitcnt vmcnt(0)" ::: "memory");
    __syncthreads();
    if (leader_thread) {
        unsigned* bar = b.bar;
        __builtin_amdgcn_s_waitcnt(0);
        unsigned nloc = b.st[0], nx = b.st[1];
        if (nloc == 0u) { xcd_barrier_complete(bar, b.x, nloc, nx); b.st[0] = nloc; b.st[1] = nx; }
        const unsigned old = xb_add(&bar[XB_XSUB(b.x)], 1u);
        const unsigned gen = old / nloc;
        if (old + 1u == (gen + 1u) * nloc) {
            __builtin_amdgcn_fence(__ATOMIC_RELEASE, "agent");
            asm volatile("s_waitcnt vmcnt(0)" ::: "memory");
            const unsigned og = xb_add(&bar[XB_TOP], 1u);
            const unsigned tg = og / nx;
            if (og + 1u == (tg + 1u) * nx) xb_add(&bar[XB_TOPGEN], 1u);
            else XB_SPIN(xb_ld(&bar[XB_TOPGEN]) == tg, bar);
            __builtin_amdgcn_fence(__ATOMIC_ACQUIRE, "agent");
            xb_add(&bar[XB_XGEN(b.x)], 1u);
            asm volatile("s_waitcnt vmcnt(0)" ::: "memory");
        } else {
            XB_SPIN(xb_ld(&bar[XB_XGEN(b.x)]) == gen, bar);
            __builtin_amdgcn_fence(__ATOMIC_ACQUIRE, "agent");
            asm volatile("s_waitcnt vmcnt(0)" ::: "memory");
        }
    }
    __syncthreads();
}

__global__ void __launch_bounds__(512, 2) mega(Args a_unused) {
    extern __shared__ __attribute__((aligned(16))) unsigned char shm[];
    LAS unsigned char* lds = (LAS unsigned char*)shm;
    cg::grid_group grid = cg::this_grid();
    CArgs a0 = (CArgs)__builtin_amdgcn_kernarg_segment_ptr();
    const int ph_lo = a0->ph_lo, ph_hi = a0->ph_hi;
    XcdBarrier xbar; xbar.bar = (unsigned*)(a0->ws + WS_BAR); xbar.x = xb_xcc_id(); xbar.st = (volatile LAS unsigned*)(lds + 131072 + 16384);
    { const int t0 = tid_opaque(); if (t0 == 0) { xbar.st[0] = 0u; xbar.st[1] = 0u; } __syncthreads(); }
    for (int ph = ph_lo; ph < ph_hi; ++ph) {
        if (ph > ph_lo) {
            if (ph == ph_lo + 1) { grid.sync(); if (tid_opaque() == 0) (void)xb_add(&xbar.bar[XB_XCNT(xbar.x)], 1u); }
            else xcd_barrier(xbar, tid_opaque() == 0);
        }
        CArgs a = a0; asm volatile("" : "+s"(a));
        if (ph == 0) {
            if (blockIdx.x == 0) { const int t0 = tid_opaque(); for (int i = t0; i < XCD_BAR_WORDS; i += 512) __hip_atomic_store((unsigned*)(a->ws + WS_BAR) + i, 0u, __ATOMIC_RELAXED, __HIP_MEMORY_SCOPE_AGENT); }
            norm_rows(a, 0); weight_prep(a, 0, 0, WT_EARLY, -1, (LAS float*)lds, 0, gridDim.x); continue; }
        if (ph == NPH - 1) { norm_rows(a, 2); continue; }
        const int l = (ph - 1) / 7, s = (ph - 1) % 7;
        bf16_t* HB = (bf16_t*)(a->ws + WS_H); float* SS = (float*)(a->ws + WS_SS);
        const unsigned char* wb = a->ws + WS_WB + (size_t)(l & 1) * WB_SIZE;
        if (s == 0) {
            pg8::Gemm g{HB, (const bf16_t*)(wb + WB_WC), MR, NPROJ, DM};
            pg8::StaticOrder S; S.init(MAIN_ROWS, g.N, gridDim.x, blockIdx.x);
            LAS float* rst = (LAS float*)(lds + 131072);
            build_rs_table(rst, S, SS);
            pg8::EpiProj E{(bf16_t*)(a->ws + WS_R1), g.N, rst};
            pg8::gemm_phase(lds, g, S, E);
            tail16<0, 2>(g.A, g.Bt, g.N, g.K, E.O, g.N, SS, nullptr, (LAS float*)lds);
        }
        else if (s == 2) {
            int kl = KL; asm volatile("" : "+s"(kl));
            pg8::Gemm g{(const bf16_t*)((unsigned char*)a->out + DO_LIN), (const bf16_t*)(wb + WB_WL), MR, NL, kl};
            pg8::StaticOrder S; S.init(MAIN_ROWS, g.N, gridDim.x, blockIdx.x);
            pg8::EpiLora E{(bf16_t*)(a->ws + WS_LO), (const float*)(wb + WB_LB)};
            pg8::gemm_phase(lds, g, S, E);
            tail16<0, 2>(g.A, g.Bt, g.N, g.K, E.O, g.N, nullptr, nullptr, (LAS float*)lds, E.bias);
        }
        else if (s == 1) prep_phase(a, l, 0, 0, gridDim.x);
        else if (s == 3) {
            if (blockIdx.x < BATCH * 8) scan_phase(a, l, (LAS float*)lds);
            else { prep_phase(a, l, 1, BATCH * 8, gridDim.x - BATCH * 8); weight_prep(a, 0, WT_EARLY, l == 0 ? WT_ALL : WT_EARLY, l + 1 < DEPTH ? l + 1 : -1, (LAS float*)lds, BATCH * 8, gridDim.x - BATCH * 8); }
        }
        else if (s == 4 || s == 6) {
            pg8::Gemm g{s == 4 ? (const bf16_t*)((unsigned char*)a->out + DO_MIX) : (const bf16_t*)(a->ws + WS_R1), (const bf16_t*)(wb + (s == 4 ? WB_WOUT : WB_WDN)), MR, DM, s == 4 ? DM : DFF};
            pg8::StaticOrder S; S.init(MAIN_ROWS, DM, gridDim.x, blockIdx.x);
            pg8::EpiResid E{HB, SS + (s == 4 ? (size_t)MR * 16 : 0)};
            pg8::gemm_phase(lds, g, S, E);
            tail16<1, 4>(g.A, g.Bt, g.N, g.K, HB, DM, nullptr, E.ssq, (LAS float*)lds);
        }
        else {
            pg8::Gemm g{HB, (const bf16_t*)(wb + WB_WGU), MR, 2 * DFF, DM}; pg8::StaticOrder S; S.init(MAIN_ROWS, 2 * DFF, gridDim.x, blockIdx.x);
            LAS float* rst = (LAS float*)(lds + 131072); build_rs_table(rst, S, SS + (size_t)MR * 16);
            pg8::EpiSwiglu E{(bf16_t*)(a->ws + WS_R1), rst};
            pg8::gemm_phase(lds, g, S, E);
            tail16<2, 2>(g.A, g.Bt, g.N, g.K, E.O, DFF, SS + (size_t)MR * 16, nullptr, (LAS float*)lds);
        }
    }
}

extern "C" void kernel_launch(void* const* d_in, const int* in_sizes, int n_in, void* d_out, int out_size, void* d_ws, size_t ws_size, hipStream_t stream) {
    static int grid = 0;
    if (grid == 0) {
        if (n_in != 26 || out_size != BATCH * SEQ * DM || ws_size < WS_TOTAL) { fprintf(stderr, "kernel_launch: unexpected shapes (n_in %d out %d ws %zu need %zu)\n", n_in, out_size, ws_size, (size_t)WS_TOTAL); grid = -1; return; }
        int dev = 0, cus = 0, per_cu = 0;
        hipGetDevice(&dev);
        hipDeviceGetAttribute(&cus, hipDeviceAttributeMultiprocessorCount, dev);
        if (hipFuncSetAttribute((const void*)mega, hipFuncAttributeMaxDynamicSharedMemorySize, LDS_BYTES) != hipSuccess) { fprintf(stderr, "kernel_launch: hipFuncSetAttribute failed\n"); grid = -1; return; }
        hipOccupancyMaxActiveBlocksPerMultiprocessor(&per_cu, (const void*)mega, 512, LDS_BYTES);
        if (per_cu < 1) { fprintf(stderr, "kernel_launch: occupancy query says %d blocks per CU\n", per_cu); per_cu = 1; }
        (void)hipGetLastError();
        grid = cus;
        fprintf(stderr, "kernel_launch: grid %d (per_cu %d)\n", grid, per_cu);
    }
    if (grid < 0) return;
    Args a{};
    for (int i = 0; i < 26; ++i) a.in[i] = (const float*)d_in[i];
    a.out = (float*)d_out; a.ws = (unsigned char*)d_ws;
#if MK_MULTI
    for (int ph = 0; ph < NPH; ++ph) {
        a.ph_lo = ph; a.ph_hi = ph + 1;
        void* args[] = {&a};
        hipError_t e = hipLaunchCooperativeKernel((const void*)mega, dim3(grid), dim3(512), args, LDS_BYTES, stream);
        if (e != hipSuccess) { fprintf(stderr, "cooperative launch failed: %s\n", hipGetErrorString(e)); break; }
    }
#else
    a.ph_lo = 0; a.ph_hi = NPH;
    void* args[] = {&a};
    hipError_t e = hipLaunchCooperativeKernel((const void*)mega, dim3(grid), dim3(512), args, LDS_BYTES, stream);
    if (e != hipSuccess) fprintf(stderr, "cooperative launch failed: %s (grid %d)\n", hipGetErrorString(e), grid);
#endif
}
```

```cpp
#include <hip/hip_runtime.h>
#include <hip/hip_cooperative_groups.h>
#include <cstdio>
#include <cstdint>
namespace cg = cooperative_groups;

#ifndef MK_MULTI
#define MK_MULTI 0
#endif

#define LAS __attribute__((address_space(3)))
typedef unsigned short bf16_t;
typedef short bf16x8 __attribute__((ext_vector_type(8)));
typedef float f32x4 __attribute__((ext_vector_type(4)));
typedef float f32x2 __attribute__((ext_vector_type(2)));
typedef unsigned u32x4 __attribute__((ext_vector_type(4)));
typedef unsigned u32x2 __attribute__((ext_vector_type(2)));

constexpr int DM = 1024, BATCH = 16, SEQ = 2048, DEPTH = 4, NMETA = 16, TT = SEQ + NMETA  , MR = BATCH * TT  ;
constexpr int NIN = 2336, NSHIFT = 1824, DFF = 2816, NPROJ = 2560  , KL = 384  , NL = 2048;
constexpr float RMS_EPS = 1e-6f, GN_EPS = 64e-5f;
constexpr int LDS_BYTES = 131072 + 16384 + 64;
constexpr int NPH = DEPTH * 7 + 2;

constexpr size_t WB_WC = 0;
constexpr size_t WB_WOUT = WB_WC + (size_t)NPROJ * DM * 2;
constexpr size_t WB_WGU = WB_WOUT + (size_t)DM * DM * 2;
constexpr size_t WB_WDN = WB_WGU + (size_t)2 * DFF * DM * 2;
constexpr size_t WB_WL = WB_WDN + (size_t)DM * DFF * 2;
constexpr size_t WB_LB = WB_WL + (size_t)NL * KL * 2;
constexpr size_t WB_SIZE = WB_LB + 8192;
constexpr size_t WS_WB = 4096;
constexpr size_t WS_SS = WS_WB + 2 * WB_SIZE;
constexpr size_t WS_H = WS_SS + 2 * (size_t)MR * 64;
constexpr size_t WS_R1 = WS_H + (size_t)MR * DM * 4;
constexpr size_t WS_LO = WS_R1 + (size_t)MR * DFF * 2;
constexpr size_t WS_END = WS_LO + (size_t)MR * NL * 2;
constexpr size_t WS_BAR = WS_END;
constexpr size_t WS_TOTAL = WS_BAR + 16384;
static_assert(WS_TOTAL <= 536870912, "workspace map");
constexpr size_t DO_MIX = 0;
constexpr size_t DO_VF = DO_MIX + (size_t)MR * DM * 2;
constexpr size_t DO_LIN = DO_VF + (size_t)MR * 512 * 2;
static_assert(DO_LIN + (size_t)MR * KL * 2 <= (size_t)BATCH * SEQ * DM * 4, "d_out scratch");

struct Args { const float* in[26]; float* out; unsigned char* ws; int ph_lo, ph_hi; };
typedef const __attribute__((address_space(4))) Args* CArgs;

__device__ __forceinline__ float bf2f(unsigned b) { return __uint_as_float(b << 16); }
__device__ __forceinline__ unsigned f2bf(float f) { unsigned u = __float_as_uint(f); return (u + 0x7fffu + ((u >> 16) & 1u)) >> 16; }
__device__ __forceinline__ unsigned pk2(float lo, float hi) { unsigned r; asm volatile("v_cvt_pk_bf16_f32 %0, %1, %2" : "=v"(r) : "v"(lo), "v"(hi)); return r; }
__device__ __forceinline__ float sigmoidf_(float x) { return __builtin_amdgcn_rcpf(1.0f + __builtin_amdgcn_exp2f(x * -1.44269504f)); }
template <int CTRL> __device__ __forceinline__ float dppf(float x) { return __int_as_float(__builtin_amdgcn_update_dpp(0, __float_as_int(x), CTRL, 0xF, 0xF, true)); }
#define DPP_ADD(r, ctl) "v_add_f32_dpp " r ", " r ", " r " " ctl " row_mask:0xf bank_mask:0xf\n\t"
__device__ __forceinline__ void allred8x4(float& a, float& b, float& c, float& d) {
    asm volatile("s_nop 1\n\t"
        DPP_ADD("%0", "quad_perm:[1,0,3,2]") DPP_ADD("%1", "quad_perm:[1,0,3,2]") DPP_ADD("%2", "quad_perm:[1,0,3,2]") DPP_ADD("%3", "quad_perm:[1,0,3,2]")
        DPP_ADD("%0", "quad_perm:[2,3,0,1]") DPP_ADD("%1", "quad_perm:[2,3,0,1]") DPP_ADD("%2", "quad_perm:[2,3,0,1]") DPP_ADD("%3", "quad_perm:[2,3,0,1]")
        DPP_ADD("%0", "row_half_mirror") DPP_ADD("%1", "row_half_mirror") DPP_ADD("%2", "row_half_mirror") DPP_ADD("%3", "row_half_mirror")
        : "+v"(a), "+v"(b), "+v"(c), "+v"(d));
}
__device__ __forceinline__ float rows_to_wave(float x) {
    const int xi = __float_as_int(x);
    return (__int_as_float(__builtin_amdgcn_readlane(xi, 0)) + __int_as_float(__builtin_amdgcn_readlane(xi, 16))) + (__int_as_float(__builtin_amdgcn_readlane(xi, 32)) + __int_as_float(__builtin_amdgcn_readlane(xi, 48)));
}
__device__ __forceinline__ float wave_sum(float x) {
    asm volatile("s_nop 1\n\t" DPP_ADD("%0", "quad_perm:[1,0,3,2]") "s_nop 1\n\t" DPP_ADD("%0", "quad_perm:[2,3,0,1]") "s_nop 1\n\t" DPP_ADD("%0", "row_half_mirror") "s_nop 1\n\t" DPP_ADD("%0", "row_mirror") : "+v"(x));
    return rows_to_wave(x);
}
__device__ __forceinline__ void wave_sum3(float& a, float& b, float& c) {
    asm volatile("s_nop 1\n\t"
        DPP_ADD("%0", "quad_perm:[1,0,3,2]") DPP_ADD("%1", "quad_perm:[1,0,3,2]") DPP_ADD("%2", "quad_perm:[1,0,3,2]")
        DPP_ADD("%0", "quad_perm:[2,3,0,1]") DPP_ADD("%1", "quad_perm:[2,3,0,1]") DPP_ADD("%2", "quad_perm:[2,3,0,1]")
        DPP_ADD("%0", "row_half_mirror") DPP_ADD("%1", "row_half_mirror") DPP_ADD("%2", "row_half_mirror")
        DPP_ADD("%0", "row_mirror") DPP_ADD("%1", "row_mirror") DPP_ADD("%2", "row_mirror")
        "v_add_f32_dpp %0, %0, %0 row_bcast:15 row_mask:0xa bank_mask:0xf\n\t" "v_add_f32_dpp %1, %1, %1 row_bcast:15 row_mask:0xa bank_mask:0xf\n\t" "v_add_f32_dpp %2, %2, %2 row_bcast:15 row_mask:0xa bank_mask:0xf\n\t"
        "v_add_f32_dpp %0, %0, %0 row_bcast:31 row_mask:0xc bank_mask:0xf\n\t" "v_add_f32_dpp %1, %1, %1 row_bcast:31 row_mask:0xc bank_mask:0xf\n\t" "v_add_f32_dpp %2, %2, %2 row_bcast:31 row_mask:0xc bank_mask:0xf\n\t"
        : "+v"(a), "+v"(b), "+v"(c));
    a = __int_as_float(__builtin_amdgcn_readlane(__float_as_int(a), 63)); b = __int_as_float(__builtin_amdgcn_readlane(__float_as_int(b), 63)); c = __int_as_float(__builtin_amdgcn_readlane(__float_as_int(c), 63));
}
__device__ __forceinline__ int tid_opaque() { int t = threadIdx.x; asm volatile("" : "+v"(t)); return t; }

__device__ __forceinline__ void unpack8(const u32x4 w, float (&x)[8]) {
    x[0] = bf2f(w.x & 0xffffu); x[1] = bf2f(w.x >> 16); x[2] = bf2f(w.y & 0xffffu); x[3] = bf2f(w.y >> 16);
    x[4] = bf2f(w.z & 0xffffu); x[5] = bf2f(w.z >> 16); x[6] = bf2f(w.w & 0xffffu); x[7] = bf2f(w.w >> 16);
}
constexpr int MAIN_ROWS = BATCH * SEQ, NROWS = MAIN_ROWS + NMETA;
__device__ __forceinline__ int row_of(int b, int t) { return t < NMETA ? MAIN_ROWS + t : b * SEQ + (t - NMETA); }
__device__ __forceinline__ float row_rs(const float* ssp, int row) {
    const f32x4* p = (const f32x4*)(ssp + (size_t)row * 16); const f32x4 a = p[0], b = p[1], c = p[2], d = p[3];
    const f32x4 t = (a + b) + (c + d);
    return rsqrtf(((t[0] + t[1]) + (t[2] + t[3])) * (1.0f / DM) + RMS_EPS);
}
namespace pg8 {
constexpr int BM = 256, BK = 64, HALF = 128, HTB = HALF * BK * 2, STAGE_BYTES = 8 * HTB, NXCD = 8, WGM = 8;
__host__ __device__ __forceinline__ int lds_byte(int r, int c) { const int st = (r >> 4) * 2 + (c >> 5), rr = r & 15, cc = c & 31, ob = rr * 64 + cc * 2; return st * 1024 + (ob ^ (((ob >> 9) & 1) << 5)); }
__host__ __device__ __forceinline__ void stage_rc(int b, int& R, int& C) { const int st = b / 1024, sb = b % 1024, swz = sb ^ (((sb >> 9) & 1) << 5); R = (st >> 1) * 16 + swz / 64; C = (st & 1) * 32 + (swz % 64) / 2; }
__host__ __device__ __forceinline__ int perm32(int rho) { const int n = rho >> 4, i = rho & 15; return 8 * (i >> 2) + 4 * n + (i & 3); }
struct Unit { int pm, pn; };
struct Gemm { const bf16_t* A; const bf16_t* Bt; int M, N, K; };
struct StaticOrder {
    int nM, nN, nwg, G, c;
    __device__ void init(int M, int N, int G_, int c_) { nM = M / BM; nN = N / BM; nwg = nM * nN; G = G_; c = c_; }
    __device__ bool next(int i, Unit& u) const {
        const long L = (long)i * G + c; if (L >= nwg) return false;
        int wgid = (int)L; { const int q = nwg / NXCD, r = nwg % NXCD, xcd = wgid % NXCD, off = wgid / NXCD; wgid = (xcd < r ? xcd * (q + 1) : r * (q + 1) + (xcd - r) * q) + off; }
        const int nig = WGM * nN, gid = wgid / nig, fm = gid * WGM, gsz = (nM - fm) < WGM ? (nM - fm) : WGM;
        u.pm = fm + ((wgid % nig) % gsz); u.pn = (wgid % nig) / gsz; return true;
    }
};
template <class Epi>
__device__ __forceinline__ void gemm_phase(LAS unsigned char* lds, const Gemm g, const StaticOrder& S, const Epi& E) {
    int tid_ = threadIdx.x; asm volatile("" : "+v"(tid_));
    const int tid = tid_, wid = __builtin_amdgcn_readfirstlane(tid >> 6), lane = tid & 63, wr = wid >> 2, wc = wid & 3, fr = lane & 15, fq = lane >> 4;
    const int K = g.K, nt = K / BK;
    unsigned voffA[2], voffB[2];
#pragma unroll
    for (int i = 0; i < 2; ++i) { int R, C; stage_rc(tid * 16 + i * 8192, R, C); const int Rb = Epi::PERM ? ((R & ~31) + perm32(R & 31)) : R;
        voffA[i] = (unsigned)(R * K + C) * 2u; voffB[i] = (unsigned)(Rb * K + C) * 2u; }
    const size_t kstep = (size_t)(BK * 2);
    const size_t hstep = (size_t)HALF * K * 2;
    const size_t tstep = 2 * hstep;
    const unsigned ldsw = (unsigned)wid * 1024u;
    const int aoff = lds_byte(wr * 64 + fr, fq * 8), boff = lds_byte(wc * 32 + fr, fq * 8);
#define PG8_SA(b, h) (((b) * 2 + (h)) * HTB)
#define PG8_SB(b, h) ((4 + (b) * 2 + (h)) * HTB)
#define PG8_STAGE(bufoff, gbase, voff) do { _Pragma("unroll") for (int _i = 0; _i < 2; ++_i) \
        __builtin_amdgcn_global_load_lds((const unsigned*)((const char*)(gbase) + (voff)[_i]), (LAS unsigned*)(lds + (bufoff) + ldsw + _i * 8192), 16, 0, 0); } while (0)
#define PG8_LDA(dst, b, h) do { _Pragma("unroll") for (int m = 0; m < 4; ++m) _Pragma("unroll") for (int k = 0; k < 2; ++k) dst[m][k] = *(const LAS bf16x8*)(lds + PG8_SA(b, h) + aoff + m * 2048 + k * 1024); } while (0)
#define PG8_LDB(dst, b, h) do { _Pragma("unroll") for (int n = 0; n < 2; ++n) _Pragma("unroll") for (int k = 0; k < 2; ++k) dst[n][k] = *(const LAS bf16x8*)(lds + PG8_SB(b, h) + boff + n * 2048 + k * 1024); } while (0)
#define PG8_MMA(ai, bj, At, Bt) do { __builtin_amdgcn_s_setprio(1); _Pragma("unroll") for (int m = 0; m < 4; ++m) _Pragma("unroll") for (int n = 0; n < 2; ++n) _Pragma("unroll") for (int k = 0; k < 2; ++k) \
        acc[ai][bj][m][n] = __builtin_amdgcn_mfma_f32_16x16x32_bf16(Bt[n][k], At[m][k], acc[ai][bj][m][n], 0, 0, 0); __builtin_amdgcn_s_setprio(0); } while (0)
#define PG8_WAIT_V(n) asm volatile("s_waitcnt vmcnt(" #n ")" ::: "memory")
#define PG8_WAIT_L(n) asm volatile("s_waitcnt lgkmcnt(" #n ")" ::: "memory")
#define PG8_BAR __builtin_amdgcn_s_barrier()
#define PG8_SCHED __builtin_amdgcn_sched_barrier(0)
    Unit cur, nxt; int ui = 0;
    if (!S.next(0, cur)) return;
    f32x4 acc[2][2][4][2];
#pragma unroll
    for (int a = 0; a < 2; ++a)
#pragma unroll
        for (int b = 0; b < 2; ++b)
#pragma unroll
            for (int m = 0; m < 4; ++m)
#pragma unroll
                for (int n = 0; n < 2; ++n) acc[a][b][m][n] = (f32x4){0.f, 0.f, 0.f, 0.f};
    bf16x8 At[4][2], B0[2][2], B1[2][2];
    const char* cA = (const char*)g.A + (size_t)cur.pm * tstep; const char* cB = (const char*)g.Bt + (size_t)cur.pn * tstep;
    PG8_STAGE(PG8_SB(0, 0), cB, voffB); PG8_STAGE(PG8_SB(0, 1), cB + hstep, voffB); PG8_STAGE(PG8_SA(0, 0), cA, voffA); PG8_STAGE(PG8_SA(0, 1), cA + hstep, voffA);
    if (wr == 1) PG8_BAR;
    PG8_WAIT_V(2); PG8_BAR;
    PG8_STAGE(PG8_SB(1, 0), cB + kstep, voffB); PG8_STAGE(PG8_SA(1, 0), cA + kstep, voffA); PG8_STAGE(PG8_SB(1, 1), cB + hstep + kstep, voffB);
    PG8_WAIT_V(6); PG8_BAR;
    for (;;) {
        const bool has_next = S.next(ui + 1, nxt);
        const char* nA = has_next ? (const char*)g.A + (size_t)nxt.pm * tstep : cA; const char* nB = has_next ? (const char*)g.Bt + (size_t)nxt.pn * tstep : cB;
        for (int t = 0; t < nt; t += 2) {
            const bool last = (t == nt - 2);
            const char* a1 = cA + (size_t)(t + 1) * kstep;
            const char* a2 = last ? nA : cA + (size_t)(t + 2) * kstep; const char* b2 = last ? nB : cB + (size_t)(t + 2) * kstep;
            const char* a3 = a2 + kstep; const char* b3 = b2 + kstep;
            PG8_LDB(B0, 0, 0); PG8_LDB(B1, 0, 1); PG8_SCHED; PG8_LDA(At, 0, 0); PG8_STAGE(PG8_SA(1, 1), a1 + hstep, voffA);
            PG8_WAIT_V(8); PG8_WAIT_L(0); PG8_BAR; PG8_MMA(0, 0, At, B0); PG8_MMA(0, 1, At, B1); PG8_BAR; PG8_SCHED;
            PG8_LDA(At, 0, 1); PG8_STAGE(PG8_SB(0, 0), b2, voffB); PG8_STAGE(PG8_SB(0, 1), b2 + hstep, voffB); PG8_STAGE(PG8_SA(0, 0), a2, voffA);
            PG8_WAIT_V(8); PG8_WAIT_L(0); PG8_BAR; PG8_MMA(1, 0, At, B0); PG8_MMA(1, 1, At, B1); PG8_BAR; PG8_SCHED;
            PG8_LDB(B0, 1, 0); PG8_LDB(B1, 1, 1); PG8_SCHED; PG8_LDA(At, 1, 0); PG8_STAGE(PG8_SA(0, 1), a2 + hstep, voffA);
            PG8_WAIT_V(8); PG8_WAIT_L(0); PG8_BAR; PG8_MMA(0, 0, At, B0); PG8_MMA(0, 1, At, B1); PG8_BAR; PG8_SCHED;
            PG8_LDA(At, 1, 1); PG8_STAGE(PG8_SB(1, 0), b3, voffB); PG8_STAGE(PG8_SB(1, 1), b3 + hstep, voffB); PG8_STAGE(PG8_SA(1, 0), a3, voffA);
            PG8_WAIT_V(8); PG8_WAIT_L(0); PG8_BAR; PG8_MMA(1, 0, At, B0); PG8_MMA(1, 1, At, B1); PG8_BAR; PG8_SCHED;
        }
        if (wr == 0) PG8_BAR;
        E(acc, cur, ui, wr, wc, fr, fq);
        if (!has_next) break;
#pragma unroll
        for (int a = 0; a < 2; ++a)
#pragma unroll
            for (int b = 0; b < 2; ++b)
#pragma unroll
                for (int m = 0; m < 4; ++m)
#pragma unroll
                    for (int n = 0; n < 2; ++n) acc[a][b][m][n] = (f32x4){0.f, 0.f, 0.f, 0.f};
        cur = nxt; cA = nA; cB = nB; ++ui;
        if (wr == 1) PG8_BAR;
    }
    PG8_WAIT_V(0);
    PG8_BAR;
#undef PG8_SA
#undef PG8_SB
#undef PG8_STAGE
#undef PG8_LDA
#undef PG8_LDB
#undef PG8_MMA
#undef PG8_WAIT_V
#undef PG8_WAIT_L
#undef PG8_BAR
#undef PG8_SCHED
}

struct EpiProj {
    static constexpr bool PERM = true;
    bf16_t* O; int ldc; const LAS float* rst;
    __device__ __forceinline__ void operator()(const f32x4 (&acc)[2][2][4][2], const Unit& u, int ui, int wr, int wc, int fr, int fq) const {
        const int row0 = u.pm * BM + wr * 64 + fr, col0 = u.pn * BM + wc * 32 + 8 * fq;
#pragma unroll
        for (int ai = 0; ai < 2; ++ai)
#pragma unroll
            for (int m = 0; m < 4; ++m) { const int row = row0 + ai * HALF + m * 16; bf16_t* rowp = O + (size_t)row * ldc + col0;
                const float rs = rst ? rst[ui * 256 + (row & 255)] : 1.0f;
#pragma unroll
                for (int bj = 0; bj < 2; ++bj) { const f32x4 v0 = acc[ai][bj][m][0] * rs, v1 = acc[ai][bj][m][1] * rs;
                    u32x4 w; w.x = pk2(v0[0], v0[1]); w.y = pk2(v0[2], v0[3]); w.z = pk2(v1[0], v1[1]); w.w = pk2(v1[2], v1[3]);
                    *(u32x4*)(rowp + bj * HALF) = w; } }
    }
};
struct EpiResid {
    static constexpr bool PERM = true;
    bf16_t* HB; float* ssq;
    __device__ __forceinline__ void operator()(const f32x4 (&acc)[2][2][4][2], const Unit& u, int ui, int wr, int wc, int fr, int fq) const {
        const int row0 = u.pm * BM + wr * 64 + fr, col0 = u.pn * BM + wc * 32 + 8 * fq;
#pragma unroll
        for (int ai = 0; ai < 2; ++ai) {
            u32x4 hv[4][2];
#pragma unroll
            for (int m = 0; m < 4; ++m)
#pragma unroll
                for (int bj = 0; bj < 2; ++bj) hv[m][bj] = *(const u32x4*)(HB + (size_t)(row0 + ai * HALF + m * 16) * DM + col0 + bj * HALF);
            __builtin_amdgcn_sched_barrier(0);
#pragma unroll
            for (int m = 0; m < 4; ++m) { const int row = row0 + ai * HALF + m * 16; bf16_t* rowb = HB + (size_t)row * DM + col0;
                float q = 0.f;
#pragma unroll
                for (int bj = 0; bj < 2; ++bj) { const u32x4 hw = hv[m][bj]; const f32x4 v0 = acc[ai][bj][m][0], v1 = acc[ai][bj][m][1];
                    u32x4 w;
                    w.x = pk2(bf2f(hw.x & 0xffffu) + v0[0], bf2f(hw.x >> 16) + v0[1]); w.y = pk2(bf2f(hw.y & 0xffffu) + v0[2], bf2f(hw.y >> 16) + v0[3]);
                    w.z = pk2(bf2f(hw.z & 0xffffu) + v1[0], bf2f(hw.z >> 16) + v1[1]); w.w = pk2(bf2f(hw.w & 0xffffu) + v1[2], bf2f(hw.w >> 16) + v1[3]);
                    *(u32x4*)(rowb + bj * HALF) = w;
                    const float r0 = bf2f(w.x & 0xffffu), r1 = bf2f(w.x >> 16), r2 = bf2f(w.y & 0xffffu), r3 = bf2f(w.y >> 16), r4 = bf2f(w.z & 0xffffu), r5 = bf2f(w.z >> 16), r6 = bf2f(w.w & 0xffffu), r7 = bf2f(w.w >> 16);
                    q += ((r0 * r0 + r1 * r1) + (r2 * r2 + r3 * r3)) + ((r4 * r4 + r5 * r5) + (r6 * r6 + r7 * r7)); }
                q += __shfl_xor(q, 16); q += __shfl_xor(q, 32);
                if (fq == 0) ssq[(size_t)row * 16 + u.pn * 4 + wc] = q; }
            __builtin_amdgcn_sched_barrier(0);
        }
    }
};
struct EpiLora {
    static constexpr bool PERM = true;
    bf16_t* O; const float* bias;
    __device__ __forceinline__ void operator()(const f32x4 (&acc)[2][2][4][2], const Unit& u, int ui, int wr, int wc, int fr, int fq) const {
        const int row0 = u.pm * BM + wr * 64 + fr, col0 = u.pn * BM + wc * 32 + 8 * fq, mode = u.pn >> 1;
        const float sc = (mode == 0) ? 0.60653066f : 1.0f;
#pragma unroll
        for (int bj = 0; bj < 2; ++bj) {
            const f32x4 c0 = *(const f32x4*)(bias + col0 + bj * HALF), c1 = *(const f32x4*)(bias + col0 + bj * HALF + 4);
#pragma unroll
            for (int ai = 0; ai < 2; ++ai)
#pragma unroll
                for (int m = 0; m < 4; ++m) { bf16_t* rowp = O + (size_t)(row0 + ai * HALF + m * 16) * NL + col0 + bj * HALF;
                    f32x4 v0 = acc[ai][bj][m][0] + c0, v1 = acc[ai][bj][m][1] + c1;
                    if (mode != 2) {
#pragma unroll
                        for (int j = 0; j < 4; ++j) { v0[j] = sc * sigmoidf_(v0[j]); v1[j] = sc * sigmoidf_(v1[j]); } }
                    u32x4 w; w.x = pk2(v0[0], v0[1]); w.y = pk2(v0[2], v0[3]); w.z = pk2(v1[0], v1[1]); w.w = pk2(v1[2], v1[3]);
                    *(u32x4*)rowp = w; }
        }
    }
};
struct EpiSwiglu {
    static constexpr bool PERM = true;
    bf16_t* O; const LAS float* rst;
    __device__ __forceinline__ void operator()(const f32x4 (&acc)[2][2][4][2], const Unit& u, int ui, int wr, int wc, int fr, int fq) const {
        const int row0 = u.pm * BM + wr * 64 + fr, col0 = u.pn * 128 + wc * 16 + 4 * fq;
#pragma unroll
        for (int ai = 0; ai < 2; ++ai)
#pragma unroll
            for (int m = 0; m < 4; ++m) { const int row = row0 + ai * HALF + m * 16; bf16_t* rowp = O + (size_t)row * DFF + col0;
                const float rs = rst[ui * 256 + (row & 255)];
#pragma unroll
                for (int bj = 0; bj < 2; ++bj) { const f32x4 gt = acc[ai][bj][m][0] * rs, up = acc[ai][bj][m][1] * rs; float o[4];
#pragma unroll
                    for (int j = 0; j < 4; ++j) o[j] = gt[j] * sigmoidf_(gt[j]) * up[j];
                    u32x2 w; w.x = pk2(o[0], o[1]); w.y = pk2(o[2], o[3]);
                    *(u32x2*)(rowp + bj * 64) = w; } }
    }
};
}

__device__ __forceinline__ void build_rs_table(LAS float* rst, const pg8::StaticOrder& S, const float* ssp) {
    const int tid = tid_opaque();
    pg8::Unit u;
    for (int i = 0; S.next(i, u); ++i) if (tid < 256) rst[i * 256 + tid] = row_rs(ssp, u.pm * 256 + tid);
    __syncthreads();
}
template <int KIND, int NB>
__device__ __forceinline__ void tail16(const bf16_t* A, const bf16_t* Bt, int N, int K, bf16_t* Out, int ldo, const float* ssp, float* ssq, LAS float* red, const float* lbias = nullptr, int b0 = 0, int nb = 0) {
    const int tid = tid_opaque(), wid = __builtin_amdgcn_readfirstlane(tid >> 6), lane = tid & 63, fr = lane & 15, fq = lane >> 4;
    const int ntile = (KIND == 2) ? N / 32 : N / (16 * NB), nks = K >> 7;
    const int row = MAIN_ROWS + fr;
    if (nb == 0) nb = gridDim.x;
    for (int tile = (int)blockIdx.x - b0; tile < ntile; tile += nb) {
        f32x4 acc[NB];
#pragma unroll
        for (int be = 0; be < NB; ++be) acc[be] = (f32x4){0.f, 0.f, 0.f, 0.f};
        const bf16_t* ap = A + (size_t)row * K + fq * 8;
        const bf16_t* bp[NB];
        if (KIND == 2) { const int f = tile * 16 + fr, pn = f >> 7, ft = f & 127, r0 = pn * 256 + ((ft >> 2) << 3) + (ft & 3); bp[0] = Bt + (size_t)r0 * K + fq * 8; bp[1] = Bt + (size_t)(r0 + 4) * K + fq * 8; }
        else {
#pragma unroll
            for (int be = 0; be < NB; ++be) bp[be] = Bt + (size_t)(tile * 16 * NB + be * 16 + fr) * K + fq * 8; }
        for (int ks = wid; ks < nks; ks += 8) {
            bf16x8 av[4], bv[NB][4];
#pragma unroll
            for (int u = 0; u < 4; ++u) { av[u] = *(const bf16x8*)(ap + ks * 128 + u * 32);
#pragma unroll
                for (int be = 0; be < NB; ++be) bv[be][u] = *(const bf16x8*)(bp[be] + ks * 128 + u * 32); }
            __builtin_amdgcn_sched_barrier(0);
#pragma unroll
            for (int u = 0; u < 4; ++u)
#pragma unroll
                for (int be = 0; be < NB; ++be) acc[be] = __builtin_amdgcn_mfma_f32_16x16x32_bf16(bv[be][u], av[u], acc[be], 0, 0, 0);
        }
#pragma unroll
        for (int be = 0; be < NB; ++be) *(LAS f32x4*)(red + ((wid * NB + be) * 64 + lane) * 4) = acc[be];
        __syncthreads();
        if (wid == 0) {
#pragma unroll
            for (int be = 0; be < NB; ++be) { f32x4 t = *(const LAS f32x4*)(red + (be * 64 + lane) * 4);
#pragma unroll
                for (int w = 1; w < 8; ++w) t += *(const LAS f32x4*)(red + ((w * NB + be) * 64 + lane) * 4);
                acc[be] = t; }
            if (KIND == 0) {
                const float rs = ssp ? row_rs(ssp, row) : 1.0f;
#pragma unroll
                for (int be = 0; be < NB; ++be) { const int col = tile * 16 * NB + be * 16 + fq * 4; f32x4 v = acc[be] * rs;
                    if (lbias) { const int mode = col >> 9;
                        if (mode != 2) { const float sc = (mode == 0) ? 0.60653066f : 1.0f;
#pragma unroll
                            for (int j = 0; j < 4; ++j) v[j] = sc * sigmoidf_(v[j] + lbias[col + j]); } }
                    u32x2 w; w.x = pk2(v[0], v[1]); w.y = pk2(v[2], v[3]);
                    *(u32x2*)(Out + (size_t)row * ldo + col) = w; }
            } else if (KIND == 1) {
                float q = 0.f;
#pragma unroll
                for (int be = 0; be < NB; ++be) { bf16_t* o = Out + (size_t)row * ldo + tile * 16 * NB + be * 16 + fq * 4; const u32x2 hw = *(const u32x2*)o;
                    u32x2 w; w.x = pk2(bf2f(hw.x & 0xffffu) + acc[be][0], bf2f(hw.x >> 16) + acc[be][1]); w.y = pk2(bf2f(hw.y & 0xffffu) + acc[be][2], bf2f(hw.y >> 16) + acc[be][3]);
                    *(u32x2*)o = w;
                    const float r0 = bf2f(w.x & 0xffffu), r1 = bf2f(w.x >> 16), r2 = bf2f(w.y & 0xffffu), r3 = bf2f(w.y >> 16);
                    q += (r0 * r0 + r1 * r1) + (r2 * r2 + r3 * r3); }
                q += __shfl_xor(q, 16); q += __shfl_xor(q, 32);
                if (fq == 0) ssq[(size_t)row * 16 + tile] = q;
            } else {
                const float rs = row_rs(ssp, row); float v[4];
#pragma unroll
                for (int j = 0; j < 4; ++j) { const float g = acc[0][j] * rs; v[j] = g * sigmoidf_(g) * (acc[1][j] * rs); }
                u32x2 w; w.x = pk2(v[0], v[1]); w.y = pk2(v[2], v[3]);
                *(u32x2*)(Out + (size_t)row * ldo + tile * 16 + fq * 4) = w;
            }
        }
        __syncthreads();
    }
}

__device__ __forceinline__ void norm_rows(CArgs a, int mode) {
    const int tid = tid_opaque(), wid = tid >> 6, lane = tid & 63;
    bf16_t* HB = (bf16_t*)(a->ws + WS_H); float* SS = (float*)(a->ws + WS_SS);
    for (int row = blockIdx.x * 8 + wid; row < (mode == 0 ? NROWS : MAIN_ROWS); row += gridDim.x * 8) {
        float x[16]; float ss = 0.f;
        if (mode == 0) {
            const float* src = (row >= MAIN_ROWS ? a->in[1] + (size_t)(row - MAIN_ROWS) * DM : a->in[0] + (size_t)row * DM);
#pragma unroll
            for (int i = 0; i < 2; ++i) { const f32x4 v0 = *(const f32x4*)(src + lane * 8 + 512 * i), v1 = *(const f32x4*)(src + lane * 8 + 512 * i + 4);
                u32x4 w; w.x = pk2(v0[0], v0[1]); w.y = pk2(v0[2], v0[3]); w.z = pk2(v1[0], v1[1]); w.w = pk2(v1[2], v1[3]);
                *(u32x4*)(HB + (size_t)row * DM + lane * 8 + 512 * i) = w;
                float r[8]; unpack8(w, r);
#pragma unroll
                for (int e = 0; e < 8; ++e) ss += r[e] * r[e]; }
            ss = wave_sum(ss);
            if (lane < 16) SS[(size_t)row * 16 + lane] = (lane == 0) ? ss : 0.f;
        } else {
#pragma unroll
            for (int i = 0; i < 2; ++i) { float r[8]; unpack8(*(const u32x4*)(HB + (size_t)row * DM + lane * 8 + 512 * i), r);
#pragma unroll
                for (int e = 0; e < 8; ++e) { x[i * 8 + e] = r[e]; ss += r[e] * r[e]; } }
            ss = wave_sum(ss);
            const float rs = rsqrtf(ss * (1.0f / DM) + RMS_EPS);
            float* o = a->out + (size_t)row * DM;
#pragma unroll
            for (int i = 0; i < 2; ++i) { const f32x4 g0 = *(const f32x4*)(a->in[25] + lane * 8 + 512 * i), g1 = *(const f32x4*)(a->in[25] + lane * 8 + 512 * i + 4);
                *(f32x4*)(o + lane * 8 + 512 * i) = (f32x4){x[i * 8] * rs * g0[0], x[i * 8 + 1] * rs * g0[1], x[i * 8 + 2] * rs * g0[2], x[i * 8 + 3] * rs * g0[3]};
                *(f32x4*)(o + lane * 8 + 512 * i + 4) = (f32x4){x[i * 8 + 4] * rs * g1[0], x[i * 8 + 5] * rs * g1[1], x[i * 8 + 6] * rs * g1[2], x[i * 8 + 7] * rs * g1[3]}; }
        }
    }
}

template <int KIND> __device__ __forceinline__ float wsrc(CArgs a, int l, int k, int n) {
    if (KIND == 0) {
        const float gk = a->in[2][(size_t)l * DM + k];
        if (n < NIN) return gk * a->in[3][((size_t)l * DM + k) * NIN + n];
        if (n < NIN + 32 && l > 0) return gk * a->in[17][((size_t)(l - 1) * DM + k) * 32 + (n - NIN)];
        return 0.f;
    } else if (KIND == 1) {
        return a->in[21][((size_t)l * DM + k) * DM + n];
    } else if (KIND == 2) {
        const int pn = n >> 8, c = n & 255, feat = pn * 128 + ((c >> 3) << 2) + (c & 3), isup = (c >> 2) & 1;
        return a->in[22][(size_t)l * DM + k] * a->in[23][((size_t)l * DM + k) * (2 * DFF) + feat + isup * DFF];
    } else if (KIND == 3) {
        return a->in[24][((size_t)l * DFF + k) * DM + n];
    } else {
        const int j = n >> 9, nn = n & 511;
        if (j == 0) return (k < 64) ? a->in[8][((size_t)l * 64 + k) * 512 + nn] : 0.f;
        if (j == 1) return (k >= 64 && k < 128) ? a->in[10][((size_t)l * 64 + (k - 64)) * 512 + nn] : 0.f;
        if (j == 2) return (k >= 128 && k < 288) ? a->in[11][((size_t)l * 160 + (k - 128)) * 512 + nn] : 0.f;
        return (k >= 288 && k < 320 && l > 0) ? a->in[20][((size_t)(l - 1) * 32 + (k - 288)) * 512 + nn] : 0.f;
    }
}
template <int KIND> __device__ __forceinline__ void conv_tile(CArgs a, int l, LAS float* tile, bf16_t* out, int ldo, int n0, int k0) {
    const int tid = tid_opaque(), kk = tid >> 6, nn = tid & 63;
#pragma unroll
    for (int i = 0; i < 8; ++i) tile[(kk + 8 * i) * 65 + nn] = wsrc<KIND>(a, l, k0 + kk + 8 * i, n0 + nn);
    __syncthreads();
    const int n = tid >> 3, kq = tid & 7;
    u32x4 w;
    w.x = pk2(tile[(kq * 8 + 0) * 65 + n], tile[(kq * 8 + 1) * 65 + n]); w.y = pk2(tile[(kq * 8 + 2) * 65 + n], tile[(kq * 8 + 3) * 65 + n]);
    w.z = pk2(tile[(kq * 8 + 4) * 65 + n], tile[(kq * 8 + 5) * 65 + n]); w.w = pk2(tile[(kq * 8 + 6) * 65 + n], tile[(kq * 8 + 7) * 65 + n]);
    *(u32x4*)(out + (size_t)(n0 + n) * ldo + k0 + kq * 8) = w;
    __syncthreads();
}
__device__ __forceinline__ void fold_tile(CArgs a, int l, LAS float* lds, bf16_t* out, int n0, int k0) {
    LAS float* P = lds; LAS float* W = lds + 64 * 128;
    const int tid = tid_opaque(), g = k0 >> 7, c0 = k0 & 127;
    const float* pw = a->in[5] + ((size_t)(l * 4 + g) * 128 + c0) * 128; const float* sc = a->in[6] + (size_t)l * 512 + g * 128;
    const float* wo = a->in[21] + ((size_t)l * DM + g * 128) * DM + n0;
    for (int i = tid; i < 64 * 128; i += 512) { const int d = i & 127; P[i] = pw[i] * sc[d]; }
    for (int i = tid; i < 128 * 64; i += 512) { const int d = i >> 6, n = i & 63; W[i] = wo[(size_t)d * DM + n]; }
    __syncthreads();
    const int n = tid & 63, cq = tid >> 6;
    float acc[8];
#pragma unroll
    for (int j = 0; j < 8; ++j) acc[j] = 0.f;
    for (int d = 0; d < 128; ++d) { const float wv = W[d * 64 + n];
#pragma unroll
        for (int j = 0; j < 8; ++j) acc[j] += P[(cq * 8 + j) * 128 + d] * wv; }
    u32x4 w; w.x = pk2(acc[0], acc[1]); w.y = pk2(acc[2], acc[3]); w.z = pk2(acc[4], acc[5]); w.w = pk2(acc[6], acc[7]);
    *(u32x4*)(out + (size_t)(n0 + n) * DM + k0 + cq * 8) = w;
    __syncthreads();
}
constexpr int WT_EARLY = 833, WT_ALL = 3201;
__device__ __forceinline__ void weight_prep(CArgs a, int lA, int vlo, int vhi, int lB, LAS float* lds, int b0, int nb) {
    const int nA = vhi - vlo, ntot = nA + (lB >= 0 ? WT_ALL : 0);
    for (int it = (int)blockIdx.x - b0; it < ntot; it += nb) {
        const int l = (it < nA) ? lA : lB, v = (it < nA) ? vlo + it : it - nA;
        unsigned char* wb = a->ws + WS_WB + (size_t)(l & 1) * WB_SIZE;
        bf16_t* WC = (bf16_t*)(wb + WB_WC); bf16_t* WO = (bf16_t*)(wb + WB_WOUT); bf16_t* WGU = (bf16_t*)(wb + WB_WGU); bf16_t* WDN = (bf16_t*)(wb + WB_WDN); bf16_t* WL = (bf16_t*)(wb + WB_WL);
        if (v < 640) { conv_tile<0>(a, l, lds, WC, DM, (v >> 4) * 64, (v & 15) * 64); }
        else if (v < 832) { const int q = v - 640; conv_tile<4>(a, l, lds, WL, KL, (q / 6) * 64, (q % 6) * 64); }
        else if (v == 832) { float* LB = (float*)(wb + WB_LB); const int t0 = tid_opaque();
            for (int i = t0; i < NL; i += 512) { const int j = i >> 9, nn = i & 511; LB[i] = (j == 0) ? a->in[7][l * 512 + nn] : (j == 1) ? a->in[9][l * 512 + nn] : (j == 3 && l > 0) ? a->in[19][(l - 1) * 512 + nn] : 0.f; } }
        else if (v < 961) { const int q = v - 833; fold_tile(a, l, lds, WO, (q & 15) * 64, (q >> 4) * 64); }
        else if (v < 1089) { const int q = v - 961; conv_tile<1>(a, l, lds, WO, DM, (q & 15) * 64, 512 + (q >> 4) * 64); }
        else if (v < 2497) { const int q = v - 1089; conv_tile<2>(a, l, lds, WGU, DM, (q >> 4) * 64, (q & 15) * 64); }
        else { const int q = v - 2497; conv_tile<3>(a, l, lds, WDN, DFF, (q / 44) * 64, (q % 44) * 64); }
    }
}

__device__ __forceinline__ void prep_phase(CArgs a, int l, int part, int b0, int nb) {
    const bf16_t* PROJ = (const bf16_t*)(a->ws + WS_R1);
    bf16_t* MIX = (bf16_t*)((unsigned char*)a->out + DO_MIX); bf16_t* LIN = (bf16_t*)((unsigned char*)a->out + DO_LIN);
    const int tid = tid_opaque(), gt = ((int)blockIdx.x - b0) * 512 + tid, nthr = nb * 512;
    if (part == 1)
    for (int it = gt; it < (MAIN_ROWS / 16 + 1) * 64; it += nthr) {
        const int run = it >> 6, c0 = (it & 63) * 8, win = 2 << (c0 >> 7);
        const int b = run >> 7, t0 = (run < MAIN_ROWS / 16) ? NMETA + (run & 127) * 16 : 0;
        float s[8], x[8], y[8];
#pragma unroll
        for (int e = 0; e < 8; ++e) s[e] = 0.f;
        const int pre = (t0 < win) ? t0 : win;
        for (int q = 1; q <= pre; ++q) { unpack8(*(const u32x4*)(PROJ + (size_t)row_of(b, t0 - q) * NPROJ + c0), x);
#pragma unroll
            for (int e = 0; e < 8; ++e) s[e] += x[e]; }
        for (int i = 0; i < 16; ++i) {
            const int t = t0 + i, row = row_of(b, t);
            unpack8(*(const u32x4*)(PROJ + (size_t)row * NPROJ + c0), x);
            if (t >= win) { unpack8(*(const u32x4*)(PROJ + (size_t)row_of(b, t - win) * NPROJ + c0), y);
#pragma unroll
                for (int e = 0; e < 8; ++e) s[e] += x[e] - y[e]; }
            else {
#pragma unroll
                for (int e = 0; e < 8; ++e) s[e] += x[e]; }
            const float inv = 1.0f / (float)((t + 1 < win) ? t + 1 : win);
            u32x4 o; o.x = pk2(s[0] * inv - x[0], s[1] * inv - x[1]); o.y = pk2(s[2] * inv - x[2], s[3] * inv - x[3]);
            o.z = pk2(s[4] * inv - x[4], s[5] * inv - x[5]); o.w = pk2(s[6] * inv - x[6], s[7] * inv - x[7]);
            *(u32x4*)(MIX + (size_t)row * DM + c0) = o;
        }
    }
    if (part == 0)
    for (int it = gt; it < NROWS * 48; it += nthr) {
        const int row = it / 48, cb = (it - row * 48) * 8;
        const int prow = (row >= MAIN_ROWS) ? (row > MAIN_ROWS ? row - 1 : -1) : ((row & (SEQ - 1)) ? row - 1 : NROWS - 1);
        u32x4 o = (u32x4){0u, 0u, 0u, 0u};
        if (cb < 320) {
            float xc[8], xp[8], mu[8], y[8];
            unpack8(*(const u32x4*)(PROJ + (size_t)row * NPROJ + 2048 + cb), xc);
            u32x4 wp = (u32x4){0u, 0u, 0u, 0u};
            if (prow >= 0) wp = *(const u32x4*)(PROJ + (size_t)prow * NPROJ + 2048 + cb);
            unpack8(wp, xp);
            const float* mp = (cb < 288) ? a->in[4] + (size_t)l * NSHIFT + 1536 + cb : a->in[18] + (l > 0 ? (l - 1) * 32 + (cb - 288) : 0);
            const f32x4 m0 = *(const f32x4*)mp, m1 = *(const f32x4*)(mp + 4);
            mu[0] = m0[0]; mu[1] = m0[1]; mu[2] = m0[2]; mu[3] = m0[3]; mu[4] = m1[0]; mu[5] = m1[1]; mu[6] = m1[2]; mu[7] = m1[3];
#pragma unroll
            for (int e = 0; e < 8; ++e) {
                const float sv = xc[e] + (xp[e] - xc[e]) * mu[e];
                y[e] = (cb < 64) ? 1.0f - 2.0f * __builtin_amdgcn_rcpf(1.0f + __builtin_amdgcn_exp2f(sv * 2.88539008f)) : (cb < 128) ? sv : (cb < 288) ? sigmoidf_(sv) : sv;
            }
            o.x = pk2(y[0], y[1]); o.y = pk2(y[2], y[3]); o.z = pk2(y[4], y[5]); o.w = pk2(y[6], y[7]);
        }
        *(u32x4*)(LIN + (size_t)row * KL + cb) = o;
    }
}

constexpr int TC = 16, NCH = TT / TC;
constexpr int SB_A = 0, SB_Q = 1, SB_W = 2, SB_B = 3, SB_K = 4, SB_V = 5, SB_G = 6, SB_Y = 7, SBUF = 8 * TC * 64 + TC * 4;
#define LDS_BARRIER() do { asm volatile("s_waitcnt lgkmcnt(0)" ::: "memory"); __builtin_amdgcn_s_barrier(); asm volatile("" ::: "memory"); } while (0)
__device__ __forceinline__ void scan_phase(CArgs a, int l, LAS float* lds) {
    const int bid = blockIdx.x; if (bid >= BATCH * 8) return;
    const int b = bid >> 3, h = bid & 7, tid = tid_opaque(), wid = __builtin_amdgcn_readfirstlane(tid >> 6), lane = tid & 63;
    const bf16_t* PROJ = (const bf16_t*)(a->ws + WS_R1); const bf16_t* LO = (const bf16_t*)(a->ws + WS_LO);
    bf16_t* VF = (bf16_t*)((unsigned char*)a->out + DO_VF); bf16_t* MIX = (bf16_t*)((unsigned char*)a->out + DO_MIX);
    if (wid < 4) {
        __builtin_amdgcn_s_setprio(2);
        const int rp = wid * 16 + (lane >> 3) * 2, seg = lane & 7;
        f32x2 S0[4], S1[4];
#pragma unroll
        for (int j = 0; j < 4; ++j) { S0[j] = (f32x2){0.f, 0.f}; S1[j] = (f32x2){0.f, 0.f}; }
        for (int it = 0; it < NCH + 2; ++it) {
            if (it >= 1 && it <= NCH) {
                LAS float* buf = lds + ((it - 1) & 1) * SBUF;
#pragma unroll 16
                for (int tl = 0; tl < TC; ++tl) {
                    const LAS float* base = buf + tl * 64 + seg * 8;
                    const f32x4 a0 = *(const LAS f32x4*)(base + SB_A * TC * 64), a1 = *(const LAS f32x4*)(base + SB_A * TC * 64 + 4);
                    const f32x4 q0 = *(const LAS f32x4*)(base + SB_Q * TC * 64), q1 = *(const LAS f32x4*)(base + SB_Q * TC * 64 + 4);
                    const f32x4 w0 = *(const LAS f32x4*)(base + SB_W * TC * 64), w1 = *(const LAS f32x4*)(base + SB_W * TC * 64 + 4);
                    const f32x4 b0 = *(const LAS f32x4*)(base + SB_B * TC * 64), b1 = *(const LAS f32x4*)(base + SB_B * TC * 64 + 4);
                    const f32x4 k0 = *(const LAS f32x4*)(base + SB_K * TC * 64), k1 = *(const LAS f32x4*)(base + SB_K * TC * 64 + 4);
                    const f32x2 vv = *(const LAS f32x2*)(buf + SB_V * TC * 64 + tl * 64 + rp);
                    const f32x2 sc = *(const LAS f32x2*)(buf + 8 * TC * 64 + tl * 4);
                    const f32x2 av[4] = {{a0[0], a0[1]}, {a0[2], a0[3]}, {a1[0], a1[1]}, {a1[2], a1[3]}};
                    const f32x2 qv[4] = {{q0[0], q0[1]}, {q0[2], q0[3]}, {q1[0], q1[1]}, {q1[2], q1[3]}};
                    const f32x2 wv[4] = {{w0[0], w0[1]}, {w0[2], w0[3]}, {w1[0], w1[1]}, {w1[2], w1[3]}};
                    const f32x2 bv[4] = {{b0[0], b0[1]}, {b0[2], b0[3]}, {b1[0], b1[1]}, {b1[2], b1[3]}};
                    const f32x2 kv[4] = {{k0[0], k0[1]}, {k0[2], k0[3]}, {k1[0], k1[1]}, {k1[2], k1[3]}};
                    f32x2 pa0 = S0[0] * av[0], pa1 = S1[0] * av[0], pq0 = S0[0] * qv[0], pq1 = S1[0] * qv[0];
#pragma unroll
                    for (int j = 1; j < 4; ++j) { pa0 += S0[j] * av[j]; pa1 += S1[j] * av[j]; pq0 += S0[j] * qv[j]; pq1 += S1[j] * qv[j]; }
                    float sa0 = pa0.x + pa0.y, sa1 = pa1.x + pa1.y, y0 = pq0.x + pq0.y, y1 = pq1.x + pq1.y;
                    allred8x4(sa0, sa1, y0, y1);
                    const f32x2 sav0 = {sa0, sa0}, sav1 = {sa1, sa1}, vv0 = {vv.x, vv.x}, vv1 = {vv.y, vv.y};
#pragma unroll
                    for (int j = 0; j < 4; ++j) { S0[j] = S0[j] * wv[j] + sav0 * bv[j] + vv0 * kv[j]; S1[j] = S1[j] * wv[j] + sav1 * bv[j] + vv1 * kv[j]; }
                    *(LAS f32x2*)(buf + SB_Y * TC * 64 + tl * 64 + rp) = (f32x2){y0 + sa0 * sc.x + vv.x * sc.y, y1 + sa1 * sc.x + vv.y * sc.y};
                }
            }
            LDS_BARRIER();
        }
        __builtin_amdgcn_s_setprio(0);
    } else {
        const int hw = wid - 4, ch = h * 64 + lane;
        const float mu_r = a->in[4][(size_t)l * NSHIFT + ch], mu_k = a->in[4][(size_t)l * NSHIFT + 512 + ch], mu_v = a->in[4][(size_t)l * NSHIFT + 1024 + ch];
        const float kk_c = a->in[12][l * 512 + ch], ka_c = a->in[13][l * 512 + ch], rk_c = a->in[14][l * 512 + ch], gw = a->in[15][l * 512 + ch], gb = a->in[16][l * 512 + ch];
        unsigned short ld[2][4][11];
#define SCAN_LOAD(c, P) do { _Pragma("unroll") for (int p = 0; p < 4; ++p) { const int t = (c) * TC + p * 4 + hw; const size_t m = (size_t)row_of(b, t); \
        const bf16_t* pr = PROJ + m * NPROJ + 512 + ch; ld[P][p][0] = pr[0]; ld[P][p][1] = pr[512]; ld[P][p][2] = pr[1024]; \
        if (t > 0) { const bf16_t* pp = PROJ + (size_t)row_of(b, t - 1) * NPROJ + 512 + ch; ld[P][p][3] = pp[0]; ld[P][p][4] = pp[512]; ld[P][p][5] = pp[1024]; } else { ld[P][p][3] = 0; ld[P][p][4] = 0; ld[P][p][5] = 0; } \
        const bf16_t* po = LO + m * NL + ch; ld[P][p][6] = po[0]; ld[P][p][7] = po[512]; ld[P][p][8] = po[1024]; ld[P][p][9] = po[1536]; \
        ld[P][p][10] = (l > 0) ? VF[m * 512 + ch] : (unsigned short)0; } } while (0)
#define PK2F(i) ((f32x2){bf2f(ld[par][2 * pp][i]), bf2f(ld[par][2 * pp + 1][i])})
        SCAN_LOAD(0, 0); SCAN_LOAD(1, 1);
        static_assert((NCH + 2) % 2 == 1, "the helper loop is unrolled by two with one trailing trip");
        for (int it2 = 0; it2 < NCH + 2; it2 += 2) {
#pragma unroll
          for (int par = 0; par < 2; ++par) { const int it = it2 + par; if (it >= NCH + 2) break;
            LAS float* buf = lds + (it & 1) * SBUF;
            if (it >= 2) {
#pragma unroll
                for (int p = 0; p < 4; ++p) {
                    const int tl = p * 4 + hw; const size_t m = (size_t)row_of(b, (it - 2) * TC + tl);
                    const float y = buf[SB_Y * TC * 64 + tl * 64 + lane];
                    float s1 = y, s2 = y * y, dum = 0.f; wave_sum3(s1, s2, dum);
                    const float mean = s1 * (1.0f / 64.0f), d = y - mean, var = fmaxf(s2 * (1.0f / 64.0f) - mean * mean, 0.f);
                    const float o = (d * rsqrtf(var + GN_EPS) * gw + gb + buf[8 * TC * 64 + tl * 4 + 2] * buf[SB_V * TC * 64 + tl * 64 + lane]) * buf[SB_G * TC * 64 + tl * 64 + lane];
                    if (it > 2 || b == 0) MIX[m * DM + 512 + ch] = (bf16_t)f2bf(o);
                }
            }
            if (it < NCH) {
#pragma unroll
                for (int pp = 0; pp < 2; ++pp) {
                    const int tl0 = (2 * pp) * 4 + hw, tl1 = tl0 + 4;
                    const f32x2 rc = PK2F(0), kc = PK2F(1), vc = PK2F(2), rpv = PK2F(3), kp = PK2F(4), vp = PK2F(5);
                    const f32x2 e = PK2F(6), av = PK2F(7), gv = PK2F(8), vm = PK2F(9);
                    const f32x2 r = rc + (rpv - rc) * mu_r, k = kc + (kp - kc) * mu_k; f32x2 v = vc + (vp - vc) * mu_v;
                    if (l == 0) {
                        if (it > 0 || b == 0) { VF[(size_t)row_of(b, it * TC + tl0) * 512 + ch] = (bf16_t)f2bf(v.x); VF[(size_t)row_of(b, it * TC + tl1) * 512 + ch] = (bf16_t)f2bf(v.y); }
                    } else { const f32x2 vf = PK2F(10); v = v + (vf - v) * vm; }
                    f32x2 kk = k * kk_c; f32x2 n2 = kk * kk; float n2a = n2.x, n2b = n2.y, dum = 0.f; wave_sum3(n2a, n2b, dum);
                    kk = kk * (f32x2){rsqrtf(fmaxf(n2a, 1e-24f)), rsqrtf(fmaxf(n2b, 1e-24f))};
                    const f32x2 k2 = k * ((av - 1.0f) * ka_c + 1.0f), bb = kk * av;
                    const f32x2 w = {__builtin_amdgcn_exp2f(e.x * -1.44269504f), __builtin_amdgcn_exp2f(e.y * -1.44269504f)};
                    const f32x2 brv = bb * r, krv = k2 * r, cfv = krv * rk_c, q = w * r;
                    float br0 = brv.x, kr0 = krv.x, cf0 = cfv.x, br1 = brv.y, kr1 = krv.y, cf1 = cfv.y; wave_sum3(br0, kr0, cf0); wave_sum3(br1, kr1, cf1);
                    buf[SB_A * TC * 64 + tl0 * 64 + lane] = -kk.x; buf[SB_Q * TC * 64 + tl0 * 64 + lane] = q.x; buf[SB_W * TC * 64 + tl0 * 64 + lane] = w.x;
                    buf[SB_B * TC * 64 + tl0 * 64 + lane] = bb.x; buf[SB_K * TC * 64 + tl0 * 64 + lane] = k2.x; buf[SB_V * TC * 64 + tl0 * 64 + lane] = v.x; buf[SB_G * TC * 64 + tl0 * 64 + lane] = gv.x;
                    buf[SB_A * TC * 64 + tl1 * 64 + lane] = -kk.y; buf[SB_Q * TC * 64 + tl1 * 64 + lane] = q.y; buf[SB_W * TC * 64 + tl1 * 64 + lane] = w.y;
                    buf[SB_B * TC * 64 + tl1 * 64 + lane] = bb.y; buf[SB_K * TC * 64 + tl1 * 64 + lane] = k2.y; buf[SB_V * TC * 64 + tl1 * 64 + lane] = v.y; buf[SB_G * TC * 64 + tl1 * 64 + lane] = gv.y;
                    if (lane < 3) { buf[8 * TC * 64 + tl0 * 4 + lane] = (lane == 0) ? br0 : (lane == 1) ? kr0 : cf0; buf[8 * TC * 64 + tl1 * 4 + lane] = (lane == 0) ? br1 : (lane == 1) ? kr1 : cf1; }
                }
                if (it + 2 < NCH) SCAN_LOAD(it + 2, par);
            }
            LDS_BARRIER();
          }
        }
#undef PK2F
#undef SCAN_LOAD
    }
}


#define XB_TMO      128
#define XB_XCNT(j)  (256  + 64 * (j))
#define XB_XSUB(j)  (1280 + 64 * (j))
#define XB_XGEN(j)  (2304 + 64 * (j))
#define XB_TOP      3328
#define XB_TOPGEN   3392
#define XCD_BAR_WORDS 3456
#define XB_SPIN_CAP (1u << 22)
__device__ __forceinline__ unsigned xb_ld(unsigned* p)              { return __hip_atomic_load(p, __ATOMIC_RELAXED, __HIP_MEMORY_SCOPE_AGENT); }
__device__ __forceinline__ unsigned xb_add(unsigned* p, unsigned v) { return __hip_atomic_fetch_add(p, v, __ATOMIC_RELAXED, __HIP_MEMORY_SCOPE_AGENT); }
__device__ __forceinline__ unsigned xb_xcc_id() { return (unsigned)__builtin_amdgcn_s_getreg((3 << 11) | 20) & 0xFu; }
#define XB_SPIN(cond, bar) do { unsigned _sp = 0; while (cond) { __builtin_amdgcn_s_sleep(1); \
    if ((++_sp & 255u) == 0u) { if (xb_ld(&(bar)[XB_TMO])) break; if (_sp > XB_SPIN_CAP) { atomicAdd(&(bar)[XB_TMO], 1u); break; } } } } while (0)
struct XcdBarrier { unsigned* bar; unsigned x; volatile LAS unsigned* st; };
__device__ __forceinline__ void xcd_barrier_complete(unsigned* bar, unsigned x, unsigned& nloc, unsigned& nx) {
    const unsigned G = gridDim.x;
    unsigned sum, cnt, mine, sp = 0u;
    for (;;) {
        sum = 0u; cnt = 0u; mine = 0u;
#pragma unroll
        for (unsigned j = 0; j < 16; ++j) { const unsigned c = xb_ld(&bar[XB_XCNT(j)]); sum += c; cnt += (c > 0u) ? 1u : 0u; mine = (j == x) ? c : mine; }
        if (sum == G) break;
        __builtin_amdgcn_s_sleep(1);
        if ((++sp & 255u) == 0u) { if (xb_ld(&bar[XB_TMO])) break; if (sp > XB_SPIN_CAP) { atomicAdd(&bar[XB_TMO], 1u); break; } }
    }
    nloc = mine > 0u ? mine : 1u; nx = cnt > 0u ? cnt : 1u;
}
__device__ __forceinline__ void xcd_barrier(const XcdBarrier& b, bool leader_thread) {
    asm volatile("s_waitcnt vmcnt(0)" ::: "memory");
    __syncthreads();
    if (leader_thread) {
        unsigned* bar = b.bar;
        __builtin_amdgcn_s_waitcnt(0);
        unsigned nloc = b.st[0], nx = b.st[1];
        if (nloc == 0u) { xcd_barrier_complete(bar, b.x, nloc, nx); b.st[0] = nloc; b.st[1] = nx; }
        const unsigned old = xb_add(&bar[XB_XSUB(b.x)], 1u);
        const unsigned gen = old / nloc;
        if (old + 1u == (gen + 1u) * nloc) {
            __builtin_amdgcn_fence(__ATOMIC_RELEASE, "agent");
            asm volatile("s_waitcnt vmcnt(0)" ::: "memory");
            const unsigned og = xb_add(&bar[XB_TOP], 1u);
            const unsigned tg = og / nx;
            if (og + 1u == (tg + 1u) * nx) xb_add(&bar[XB_TOPGEN], 1u);
            else XB_SPIN(xb_ld(&bar[XB_TOPGEN]) == tg, bar);
            __builtin_amdgcn_fence(__ATOMIC_ACQUIRE, "agent");
            xb_add(&bar[XB_XGEN(b.x)], 1u);
            asm volatile("s_waitcnt vmcnt(0)" ::: "memory");
        } else {
            XB_SPIN(xb_ld(&bar[XB_XGEN(b.x)]) == gen, bar);
            __builtin_amdgcn_fence(__ATOMIC_ACQUIRE, "agent");
            asm volatile("s_waitcnt vmcnt(0)" ::: "memory");
        }
    }
    __syncthreads();
}

__device__ __forceinline__ void sub_barrier(unsigned* cnt, unsigned nb, unsigned* tmo, bool leader_thread) {
    asm volatile("s_waitcnt vmcnt(0)" ::: "memory");
    __syncthreads();
    if (leader_thread) {
        __builtin_amdgcn_s_waitcnt(0);
        __builtin_amdgcn_fence(__ATOMIC_RELEASE, "agent");
        asm volatile("s_waitcnt vmcnt(0)" ::: "memory");
        (void)xb_add(cnt, 1u);
        unsigned sp = 0u;
        while (xb_ld(cnt) < nb) { __builtin_amdgcn_s_sleep(1); if ((++sp & 255u) == 0u) { if (xb_ld(tmo)) break; if (sp > XB_SPIN_CAP) { atomicAdd(tmo, 1u); break; } } }
        __builtin_amdgcn_fence(__ATOMIC_ACQUIRE, "agent");
        asm volatile("s_waitcnt vmcnt(0)" ::: "memory");
    }
    __syncthreads();
}

__global__ void __launch_bounds__(512, 2) mega(Args a_unused) {
    extern __shared__ __attribute__((aligned(16))) unsigned char shm[];
    LAS unsigned char* lds = (LAS unsigned char*)shm;
    cg::grid_group grid = cg::this_grid();
    CArgs a0 = (CArgs)__builtin_amdgcn_kernarg_segment_ptr();
    const int ph_lo = a0->ph_lo, ph_hi = a0->ph_hi;
    XcdBarrier xbar; xbar.bar = (unsigned*)(a0->ws + WS_BAR); xbar.x = xb_xcc_id(); xbar.st = (volatile LAS unsigned*)(lds + 131072 + 16384);
    { const int t0 = tid_opaque(); if (t0 == 0) { xbar.st[0] = 0u; xbar.st[1] = 0u; } __syncthreads(); }
    for (int ph = ph_lo; ph < ph_hi; ++ph) {
        if (ph > ph_lo) {
            if (ph == ph_lo + 1) { grid.sync(); if (tid_opaque() == 0) (void)xb_add(&xbar.bar[XB_XCNT(xbar.x)], 1u); }
            else xcd_barrier(xbar, tid_opaque() == 0);
        }
        CArgs a = a0; asm volatile("" : "+s"(a));
        if (ph == 0) {
            if (blockIdx.x == 0) { const int t0 = tid_opaque(); for (int i = t0; i < 4096; i += 512) __hip_atomic_store((unsigned*)(a->ws + WS_BAR) + i, 0u, __ATOMIC_RELAXED, __HIP_MEMORY_SCOPE_AGENT); }
            norm_rows(a, 0); weight_prep(a, 0, 0, WT_EARLY, -1, (LAS float*)lds, 0, gridDim.x); continue; }
        if (ph == NPH - 1) { norm_rows(a, 2); continue; }
        const int l = (ph - 1) / 7, s = (ph - 1) % 7;
        bf16_t* HB = (bf16_t*)(a->ws + WS_H); float* SS = (float*)(a->ws + WS_SS);
        const unsigned char* wb = a->ws + WS_WB + (size_t)(l & 1) * WB_SIZE;
        if (s == 0) {
            pg8::Gemm g{HB, (const bf16_t*)(wb + WB_WC) + (size_t)512 * DM, MR, NPROJ - 512, DM};
            pg8::StaticOrder S; S.init(MAIN_ROWS, g.N, gridDim.x, blockIdx.x);
            LAS float* rst = (LAS float*)(lds + 131072);
            build_rs_table(rst, S, SS);
            pg8::EpiProj E{(bf16_t*)(a->ws + WS_R1) + 512, NPROJ, rst};
            pg8::gemm_phase(lds, g, S, E);
            tail16<0, 2>(g.A, g.Bt, g.N, g.K, E.O, NPROJ, SS, nullptr, (LAS float*)lds);
        }
        else if (s == 2) {
            int kl = KL; asm volatile("" : "+s"(kl));
            pg8::Gemm g{(const bf16_t*)((unsigned char*)a->out + DO_LIN), (const bf16_t*)(wb + WB_WL), MR, NL, kl};
            pg8::StaticOrder S; S.init(MAIN_ROWS, g.N, gridDim.x, blockIdx.x);
            pg8::EpiLora E{(bf16_t*)(a->ws + WS_LO), (const float*)(wb + WB_LB)};
            pg8::gemm_phase(lds, g, S, E);
            tail16<0, 2>(g.A, g.Bt, g.N, g.K, E.O, g.N, nullptr, nullptr, (LAS float*)lds, E.bias);
        }
        else if (s == 1) prep_phase(a, l, 0, 0, gridDim.x);
        else if (s == 3) {
            if (blockIdx.x < BATCH * 8) scan_phase(a, l, (LAS float*)lds);
            else {
                const int b0 = BATCH * 8, nb = gridDim.x - BATCH * 8;
                {
                    pg8::Gemm g{HB, (const bf16_t*)(wb + WB_WC), MR, 512, DM};
                    pg8::StaticOrder S; S.init(MAIN_ROWS, 512, nb, (int)blockIdx.x - b0);
                    LAS float* rst = (LAS float*)(lds + 131072);
                    build_rs_table(rst, S, SS);
                    pg8::EpiProj E{(bf16_t*)(a->ws + WS_R1), NPROJ, rst};
                    pg8::gemm_phase(lds, g, S, E);
                    tail16<0, 2>(g.A, g.Bt, g.N, g.K, E.O, NPROJ, SS, nullptr, (LAS float*)lds, nullptr, b0, nb);
                }
                sub_barrier((unsigned*)(a->ws + WS_BAR) + 3600 + 64 * l, (unsigned)nb, (unsigned*)(a->ws + WS_BAR) + XB_TMO, tid_opaque() == 0);
                prep_phase(a, l, 1, b0, nb); weight_prep(a, 0, WT_EARLY, l == 0 ? WT_ALL : WT_EARLY, l + 1 < DEPTH ? l + 1 : -1, (LAS float*)lds, BATCH * 8, gridDim.x - BATCH * 8); }
        }
        else if (s == 4 || s == 6) {
            pg8::Gemm g{s == 4 ? (const bf16_t*)((unsigned char*)a->out + DO_MIX) : (const bf16_t*)(a->ws + WS_R1), (const bf16_t*)(wb + (s == 4 ? WB_WOUT : WB_WDN)), MR, DM, s == 4 ? DM : DFF};
            pg8::StaticOrder S; S.init(MAIN_ROWS, DM, gridDim.x, blockIdx.x);
            pg8::EpiResid E{HB, SS + (s == 4 ? (size_t)MR * 16 : 0)};
            pg8::gemm_phase(lds, g, S, E);
            tail16<1, 4>(g.A, g.Bt, g.N, g.K, HB, DM, nullptr, E.ssq, (LAS float*)lds);
        }
        else {
            pg8::Gemm g{HB, (const bf16_t*)(wb + WB_WGU), MR, 2 * DFF, DM}; pg8::StaticOrder S; S.init(MAIN_ROWS, 2 * DFF, gridDim.x, blockIdx.x);
            LAS float* rst = (LAS float*)(lds + 131072); build_rs_table(rst, S, SS + (size_t)MR * 16);
            pg8::EpiSwiglu E{(bf16_t*)(a->ws + WS_R1), rst};
            pg8::gemm_phase(lds, g, S, E);
            tail16<2, 2>(g.A, g.Bt, g.N, g.K, E.O, DFF, SS + (size_t)MR * 16, nullptr, (LAS float*)lds);
        }
    }
}

extern "C" void kernel_launch(void* const* d_in, const int* in_sizes, int n_in, void* d_out, int out_size, void* d_ws, size_t ws_size, hipStream_t stream) {
    static int grid = 0;
    if (grid == 0) {
        if (n_in != 26 || out_size != BATCH * SEQ * DM || ws_size < WS_TOTAL) { fprintf(stderr, "kernel_launch: unexpected shapes (n_in %d out %d ws %zu need %zu)\n", n_in, out_size, ws_size, (size_t)WS_TOTAL); grid = -1; return; }
        int dev = 0, cus = 0, per_cu = 0;
        hipGetDevice(&dev);
        hipDeviceGetAttribute(&cus, hipDeviceAttributeMultiprocessorCount, dev);
        if (hipFuncSetAttribute((const void*)mega, hipFuncAttributeMaxDynamicSharedMemorySize, LDS_BYTES) != hipSuccess) { fprintf(stderr, "kernel_launch: hipFuncSetAttribute failed\n"); grid = -1; return; }
        hipOccupancyMaxActiveBlocksPerMultiprocessor(&per_cu, (const void*)mega, 512, LDS_BYTES);
        if (per_cu < 1) { fprintf(stderr, "kernel_launch: occupancy query says %d blocks per CU\n", per_cu); per_cu = 1; }
        (void)hipGetLastError();
        grid = cus;
        fprintf(stderr, "kernel_launch: grid %d (per_cu %d)\n", grid, per_cu);
    }
    if (grid < 0) return;
    Args a{};
    for (int i = 0; i < 26; ++i) a.in[i] = (const float*)d_in[i];
    a.out = (float*)d_out; a.ws = (unsigned char*)d_ws;
#if MK_MULTI
    for (int ph = 0; ph < NPH; ++ph) {
        a.ph_lo = ph; a.ph_hi = ph + 1;
        void* args[] = {&a};
        hipError_t e = hipLaunchCooperativeKernel((const void*)mega, dim3(grid), dim3(512), args, LDS_BYTES, stream);
        if (e != hipSuccess) { fprintf(stderr, "cooperative launch failed: %s\n", hipGetErrorString(e)); break; }
    }
#else
    a.ph_lo = 0; a.ph_hi = NPH;
    void* args[] = {&a};
    hipError_t e = hipLaunchCooperativeKernel((const void*)mega, dim3(grid), dim3(512), args, LDS_BYTES, stream);
    if (e != hipSuccess) fprintf(stderr, "cooperative launch failed: %s (grid %d)\n", hipGetErrorString(e), grid);
#endif
}
```
